# Optimizing an MI355X kernel written in HIP

```python
import math
import jax, jax.numpy as jnp
from jax import lax
import numpy as np

D_MODEL = 2048
BATCH = 1
SEQ = 16384
DEPTH = 2

HEAD_DIM = 128
BLOCK = 128
A_HEADS = 8
A_PATTERNS = ((128, 1), (512, 4), (2048, 16))
B_HEADS = 8
IDX_HEADS = 16
IDX_DIM = 64
B_TOPK_MAX = 256
C_HEADS = 8
C_QK_DIM = 64
D_HEADS = 8
Q_LORA = 768
KV_LORA = 512
NOPE_DIM = 128
ROPE_DIM = 64
V_DIM = 128
ROPE_THETA = 10000.0
D_FF = 5632
LN_EPS = 1e-5
RMS_EPS = 1e-6
DIFF_EPS = 1e-5
ALPHA = (2 * DEPTH) ** 0.25
BETA = (8 * DEPTH) ** -0.25
N_EVEN = (DEPTH + 1) // 2
N_ODD = DEPTH // 2
EVEN_SPLITS = (A_HEADS * HEAD_DIM, A_HEADS * HEAD_DIM, A_HEADS * HEAD_DIM,
               B_HEADS * HEAD_DIM, B_HEADS * HEAD_DIM, B_HEADS * HEAD_DIM,
               IDX_HEADS * IDX_DIM, IDX_DIM, IDX_HEADS)
ODD_SPLITS = (C_HEADS * 2 * C_QK_DIM, C_HEADS * 2 * C_QK_DIM, C_HEADS * 2 * C_QK_DIM,
              Q_LORA, KV_LORA, ROPE_DIM)
EVEN_IN = sum(EVEN_SPLITS)
ODD_IN = sum(ODD_SPLITS)
EVEN_OUT = A_HEADS * HEAD_DIM + B_HEADS * HEAD_DIM
ODD_OUT = C_HEADS * 2 * C_QK_DIM + D_HEADS * V_DIM

kernel_name = "hybrid_dilated_dsa_diff_mla_block"


def _layernorm(x, g, b):
    xf = x.astype(jnp.float32)
    mu = jnp.mean(xf, -1, keepdims=True)
    var = jnp.mean(jnp.square(xf - mu), -1, keepdims=True)
    return ((xf - mu) * lax.rsqrt(var + LN_EPS) * g + b).astype(x.dtype)


def _rmsnorm(x, g, eps):
    xf = x.astype(jnp.float32)
    return (xf * lax.rsqrt(jnp.mean(xf * xf, -1, keepdims=True) + eps) * g).astype(x.dtype)


def _swiglu(x, wg, wu, wd):
    return (jax.nn.silu(x @ wg) * (x @ wu)) @ wd


def _alibi_slopes(n):
    return jnp.asarray([2.0 ** (-8.0 * (h + 1) / n) for h in range(n)], jnp.float32)


def _split(h, widths):
    out, off = [], 0
    for w in widths:
        out.append(h[..., off:off + w])
        off += w
    return out


def _to_blocks(t):
    b, s = t.shape[:2]
    return jnp.moveaxis(t.reshape((b, s // BLOCK, BLOCK) + t.shape[2:]), 1, 0)


def _from_blocks(t):
    t = jnp.moveaxis(t, 0, 1)
    return t.reshape((t.shape[0], t.shape[1] * t.shape[2]) + t.shape[3:])


def _rope(x, pos):
    half = x.shape[-1] // 2
    inv = ROPE_THETA ** (-jnp.arange(half, dtype=jnp.float32) / half)
    ang = pos.astype(jnp.float32)[:, None] * inv[None, :]
    shape = (1, x.shape[1]) + (1,) * (x.ndim - 3) + (half,)
    cos, sin = jnp.cos(ang).reshape(shape), jnp.sin(ang).reshape(shape)
    xf = x.astype(jnp.float32)
    x1, x2 = xf[..., :half], xf[..., half:]
    return jnp.concatenate([x1 * cos - x2 * sin, x1 * sin + x2 * cos], -1).astype(x.dtype)


def _dilated_branch(q, k, v, slopes, window, dilation):
    b, s, h, dh = q.shape
    span = window // dilation
    unit = dilation * span
    sp = -(-s // unit) * unit
    nb = sp // unit
    pad = ((0, 0), (0, sp - s), (0, 0), (0, 0))

    def grp(t):
        return jnp.pad(t, pad).reshape(b, nb, span, dilation, h, dh)

    def band(t):
        prev = jnp.pad(t, ((0, 0), (1, 0), (0, 0), (0, 0), (0, 0), (0, 0)))[:, :-1]
        return jnp.concatenate([prev, t], axis=2)

    qg = grp(q)
    kb, vb = band(grp(k)), band(grp(v))
    sc = jnp.einsum('bnqchd,bnkchd->bnchqk', qg, kb).astype(jnp.float32) * (dh ** -0.5)
    qi = jnp.arange(span)[:, None]
    kj = jnp.arange(2 * span)[None, :]
    dist = qi - kj + span
    blk = jnp.arange(nb)[:, None, None]
    valid = (dist >= 0) & (dist <= span) & (blk * span + kj[None] - span >= 0)
    bias = -slopes[:, None, None] * (dist * dilation).astype(jnp.float32)[None]
    sc = jnp.where(valid[None, :, None, None], sc + bias, -jnp.inf)
    m = jnp.max(sc, -1, keepdims=True)
    p = jnp.exp(sc - m)
    l = jnp.sum(p, -1, keepdims=True)
    o = jnp.einsum('bnchqk,bnkchd->bnqchd', (p / l).astype(v.dtype), vb)
    lse = (m + jnp.log(l))[..., 0]
    o = o.reshape(b, sp, h, dh)[:, :s]
    lse = jnp.transpose(lse, (0, 1, 4, 2, 3)).reshape(b, sp, h)[:, :s]
    return o, lse


def _mixer_a(q, k, v, slopes):
    outs, lses = [], []
    for window, dilation in A_PATTERNS:
        o, lse = _dilated_branch(q, k, v, slopes, window, dilation)
        outs.append(o)
        lses.append(lse)
    wts = jax.nn.softmax(jnp.stack(lses), axis=0)
    o = jnp.einsum('gbsh,gbshd->bshd', wts, jnp.stack(outs).astype(jnp.float32))
    return o.astype(q.dtype)


def _mixer_b(q, k, v, qi, ki, wi, slopes):
    b, s, h, dh = q.shape
    topk = min(B_TOPK_MAX, s // 4)
    kpos = jnp.arange(s, dtype=jnp.int32)

    def block(args):
        qb, qib, wib, start = args
        qpos = start + jnp.arange(BLOCK, dtype=jnp.int32)
        isc = jnp.einsum('bqhd,bsd->bqhs', qib, ki).astype(jnp.float32)
        isc = jnp.einsum('bqhs,bqh->bqs', jax.nn.relu(isc), wib.astype(jnp.float32))
        isc = jnp.where((kpos[None, :] <= qpos[:, None])[None], isc, -jnp.inf)
        _, sel = lax.top_k(isc, topk)
        kg = jax.vmap(lambda t, i: t[i])(k, sel)
        vg = jax.vmap(lambda t, i: t[i])(v, sel)
        dist = qpos[None, :, None] - sel
        sc = jnp.einsum('bqhd,bqkhd->bhqk', qb, kg).astype(jnp.float32) * (dh ** -0.5)
        sc = sc - slopes[None, :, None, None] * dist[:, None].astype(jnp.float32)
        sc = jnp.where((dist >= 0)[:, None], sc, -jnp.inf)
        p = jax.nn.softmax(sc, axis=-1)
        return jnp.einsum('bhqk,bqkhd->bqhd', p.astype(v.dtype), vg)

    starts = jnp.arange(s // BLOCK, dtype=jnp.int32) * BLOCK
    return _from_blocks(lax.map(block, (_to_blocks(q), _to_blocks(qi), _to_blocks(wi), starts)))


def _even_mixer(x, w_in, w_out):
    b, s, _ = x.shape
    aq, ak, av, bq, bk, bv, iq, ik, iw = _split(x @ w_in, EVEN_SPLITS)
    hd = lambda t, n, d: t.reshape(b, s, n, d)
    oa = _mixer_a(hd(aq, A_HEADS, HEAD_DIM), hd(ak, A_HEADS, HEAD_DIM), hd(av, A_HEADS, HEAD_DIM),
                  _alibi_slopes(A_HEADS))
    ob = _mixer_b(hd(bq, B_HEADS, HEAD_DIM), hd(bk, B_HEADS, HEAD_DIM), hd(bv, B_HEADS, HEAD_DIM),
                  hd(iq, IDX_HEADS, IDX_DIM), ik, iw * ((IDX_HEADS * IDX_DIM) ** -0.5),
                  _alibi_slopes(B_HEADS))
    o = jnp.concatenate([oa.reshape(b, s, -1), ob.reshape(b, s, -1)], -1)
    return o @ w_out


def _mixer_c(q, k, v, lam_params, subln_g, lam_init, slopes):
    s = q.shape[1]
    lp = lam_params.astype(jnp.float32)
    lam = jnp.exp(jnp.sum(lp[0] * lp[1])) - jnp.exp(jnp.sum(lp[2] * lp[3])) + lam_init
    k1, k2 = k[:, :, :, 0], k[:, :, :, 1]
    kpos = jnp.arange(s, dtype=jnp.int32)
    scale = C_QK_DIM ** -0.5

    def block(args):
        qb, start = args
        qpos = start + jnp.arange(BLOCK, dtype=jnp.int32)
        dist = qpos[:, None] - kpos[None, :]
        bias = jnp.where(dist >= 0, -slopes[:, None, None] * dist.astype(jnp.float32)[None], -jnp.inf)
        s1 = jnp.einsum('bqhd,bshd->bhqs', qb[:, :, :, 0], k1).astype(jnp.float32) * scale + bias
        s2 = jnp.einsum('bqhd,bshd->bhqs', qb[:, :, :, 1], k2).astype(jnp.float32) * scale + bias
        attn = jax.nn.softmax(s1, axis=-1) - lam * jax.nn.softmax(s2, axis=-1)
        return jnp.einsum('bhqs,bshd->bqhd', attn.astype(v.dtype), v)

    starts = jnp.arange(s // BLOCK, dtype=jnp.int32) * BLOCK
    o = _from_blocks(lax.map(block, (_to_blocks(q), starts)))
    return _rmsnorm(o, subln_g, DIFF_EPS) * (1.0 - lam_init)


def _mixer_d(cq, ckv, kpe, gq, gkv, w_uq, w_ukv):
    b, s, _ = cq.shape
    pos = jnp.arange(s, dtype=jnp.int32)
    qf = (_rmsnorm(cq, gq, RMS_EPS) @ w_uq).reshape(b, s, D_HEADS, NOPE_DIM + ROPE_DIM)
    q_nope, q_pe = qf[..., :NOPE_DIM], _rope(qf[..., NOPE_DIM:], pos)
    kvf = (_rmsnorm(ckv, gkv, RMS_EPS) @ w_ukv).reshape(b, s, D_HEADS, NOPE_DIM + V_DIM)
    k_nope, v = kvf[..., :NOPE_DIM], kvf[..., NOPE_DIM:]
    k_pe = _rope(kpe, pos)
    scale = (NOPE_DIM + ROPE_DIM) ** -0.5

    def block(args):
        qnb, qpb, start = args
        qpos = start + jnp.arange(BLOCK, dtype=jnp.int32)
        sc = (jnp.einsum('bqhd,bshd->bhqs', qnb, k_nope)
              + jnp.einsum('bqhd,bsd->bhqs', qpb, k_pe)).astype(jnp.float32) * scale
        sc = jnp.where((pos[None, :] <= qpos[:, None])[None, None], sc, -jnp.inf)
        p = jax.nn.softmax(sc, axis=-1)
        return jnp.einsum('bhqs,bshd->bqhd', p.astype(v.dtype), v)

    starts = jnp.arange(s // BLOCK, dtype=jnp.int32) * BLOCK
    return _from_blocks(lax.map(block, (_to_blocks(q_nope), _to_blocks(q_pe), starts)))


def _odd_mixer(x, w_in, w_out, lam_params, subln_g, gq, gkv, w_uq, w_ukv, lam_init):
    b, s, _ = x.shape
    cq_, ck_, cv_, mq, mkv, mkpe = _split(x @ w_in, ODD_SPLITS)
    oc = _mixer_c(cq_.reshape(b, s, C_HEADS, 2, C_QK_DIM), ck_.reshape(b, s, C_HEADS, 2, C_QK_DIM),
                  cv_.reshape(b, s, C_HEADS, 2 * C_QK_DIM), lam_params, subln_g, lam_init,
                  _alibi_slopes(C_HEADS))
    od = _mixer_d(mq, mkv, mkpe, gq, gkv, w_uq, w_ukv)
    o = jnp.concatenate([oc.reshape(b, s, -1), od.reshape(b, s, -1)], -1)
    return o @ w_out


def setup_inputs(seed: int = 0) -> dict:
    key = jax.random.key(seed)
    ks = jax.random.split(key, 20)
    n = lambda k, shp: jax.random.normal(k, shp, jnp.float32)
    return {
        "x": n(ks[0], (BATCH, SEQ, D_MODEL)),
        "ffn_w_gate": n(ks[1], (DEPTH, 2, D_MODEL, D_FF)) * D_MODEL ** -0.5,
        "ffn_w_up": n(ks[2], (DEPTH, 2, D_MODEL, D_FF)) * D_MODEL ** -0.5,
        "ffn_w_down": n(ks[3], (DEPTH, 2, D_FF, D_MODEL)) * (D_FF ** -0.5 * BETA),
        "ln_g": 1.0 + 0.02 * n(ks[4], (DEPTH, 3, D_MODEL)),
        "ln_b": 0.02 * n(ks[5], (DEPTH, 3, D_MODEL)),
        "ev_w_in": n(ks[6], (N_EVEN, D_MODEL, EVEN_IN)) * D_MODEL ** -0.5,
        "ev_w_out": n(ks[7], (N_EVEN, EVEN_OUT, D_MODEL)) * (EVEN_OUT ** -0.5 * BETA),
        "od_w_in": n(ks[8], (N_ODD, D_MODEL, ODD_IN)) * D_MODEL ** -0.5,
        "od_w_out": n(ks[9], (N_ODD, ODD_OUT, D_MODEL)) * (ODD_OUT ** -0.5 * BETA),
        "od_lambda": 0.1 * n(ks[10], (N_ODD, 4, C_QK_DIM)),
        "od_subln_g": 1.0 + 0.02 * n(ks[11], (N_ODD, 2 * C_QK_DIM)),
        "od_q_norm_g": 1.0 + 0.02 * n(ks[12], (N_ODD, Q_LORA)),
        "od_kv_norm_g": 1.0 + 0.02 * n(ks[13], (N_ODD, KV_LORA)),
        "od_w_uq": n(ks[14], (N_ODD, Q_LORA, D_HEADS * (NOPE_DIM + ROPE_DIM))) * Q_LORA ** -0.5,
        "od_w_ukv": n(ks[15], (N_ODD, KV_LORA, D_HEADS * (NOPE_DIM + V_DIM))) * KV_LORA ** -0.5,
    }


def reference(x, ffn_w_gate, ffn_w_up, ffn_w_down, ln_g, ln_b, ev_w_in, ev_w_out,
              od_w_in, od_w_out, od_lambda, od_subln_g, od_q_norm_g, od_kv_norm_g,
              od_w_uq, od_w_ukv):
    for i in range(DEPTH):
        j = i // 2
        x = _layernorm(ALPHA * x + 0.5 * _swiglu(x, ffn_w_gate[i, 0], ffn_w_up[i, 0], ffn_w_down[i, 0]),
                       ln_g[i, 0], ln_b[i, 0])
        if i % 2 == 0:
            mix = _even_mixer(x, ev_w_in[j], ev_w_out[j])
        else:
            lam_init = 0.8 - 0.6 * math.exp(-0.3 * i)
            mix = _odd_mixer(x, od_w_in[j], od_w_out[j], od_lambda[j], od_subln_g[j],
                             od_q_norm_g[j], od_kv_norm_g[j], od_w_uq[j], od_w_ukv[j], lam_init)
        x = _layernorm(ALPHA * x + mix, ln_g[i, 1], ln_b[i, 1])
        x = _layernorm(ALPHA * x + 0.5 * _swiglu(x, ffn_w_gate[i, 1], ffn_w_up[i, 1], ffn_w_down[i, 1]),
                       ln_g[i, 2], ln_b[i, 2])
    return x
```

```cpp
#include <hip/hip_runtime.h>
#include <cstdio>
#include <cstdint>
#include <cmath>
namespace pg8 {
#define PG8_LAS __attribute__((address_space(3)))
typedef unsigned short bf16_t;
typedef short bf16x8 __attribute__((ext_vector_type(8)));
typedef float f32x4 __attribute__((ext_vector_type(4)));
typedef unsigned u32x4 __attribute__((ext_vector_type(4)));
constexpr int BM = 256, BK = 64, HALF = 128, HTB = HALF * BK * 2  , STAGE_BYTES = 8 * HTB, NXCD = 8, WGM = 8;

__host__ __device__ __forceinline__ int lds_byte(int r, int c) { const int st = (r >> 4) * 2 + (c >> 5), rr = r & 15, cc = c & 31, ob = rr * 64 + cc * 2; return st * 1024 + (ob ^ (((ob >> 9) & 1) << 5)); }
__host__ __device__ __forceinline__ void stage_rc(int b, int& R, int& C) { const int st = b / 1024, sb = b % 1024, swz = sb ^ (((sb >> 9) & 1) << 5); R = (st >> 1) * 16 + swz / 64; C = (st & 1) * 32 + (swz % 64) / 2; }
__host__ __device__ __forceinline__ int perm32(int rho) { const int n = rho >> 4, i = rho & 15; return 8 * (i >> 2) + 4 * n + (i & 3); }

struct Unit { int pm, pn; };
struct Gemm { const bf16_t* A; const bf16_t* Bt; int M, N, K, lda; };

struct StaticOrder {
    int nM, nN, nwg, G, c;
    __host__ __device__ void init(int M, int N, int G_, int c_) { nM = M / BM; nN = N / BM; nwg = nM * nN; G = G_; c = c_; }
    __host__ __device__ bool next(int i, Unit& u) const {
        const long L = (long)i * G + c; if (L >= nwg) return false;
        int wgid = (int)L; { const int q = nwg / NXCD, r = nwg % NXCD, xcd = wgid % NXCD, off = wgid / NXCD; wgid = (xcd < r ? xcd * (q + 1) : r * (q + 1) + (xcd - r) * q) + off; }
        const int nig = WGM * nN, gid = wgid / nig, fm = gid * WGM, gsz = (nM - fm) < WGM ? (nM - fm) : WGM;
        u.pm = fm + ((wgid % nig) % gsz); u.pn = (wgid % nig) / gsz; return true;
    }
    __device__ __forceinline__ void a_ready(const Unit&) const {}
    __device__ __forceinline__ void done(const Unit&) const {}
};
__device__ __forceinline__ unsigned cvt_pk_bf16(float lo, float hi) { unsigned r; asm volatile("v_cvt_pk_bf16_f32 %0, %1, %2" : "=v"(r) : "v"(lo), "v"(hi)); return r; }
__device__ __forceinline__ float bf_lo(unsigned w) { return __uint_as_float(w << 16); }
__device__ __forceinline__ float bf_hi(unsigned w) { return __uint_as_float(w & 0xffff0000u); }
typedef unsigned u32x2 __attribute__((ext_vector_type(2)));
__device__ __forceinline__ float silu_f(float x) { return x * __builtin_amdgcn_rcpf(1.0f + __builtin_amdgcn_exp2f(-1.4426950408889634f * x)); }

struct EpiSwiglu {
    static constexpr bool PERM = true, AFTER_DRAIN = false;
    bf16_t* H; int ldh;
    __device__ __forceinline__ void operator()(const f32x4 (&acc)[2][2][4][2], const Unit& u, int wr, int wc, int fr, int fq) const {
        const int row0 = u.pm * BM + wr * 64 + fr, col0 = u.pn * HALF + wc * 32 + 8 * fq;
#pragma unroll
        for (int ai = 0; ai < 2; ++ai)
#pragma unroll
            for (int m = 0; m < 4; ++m) {
                const f32x4 g0 = acc[ai][0][m][0], g1 = acc[ai][0][m][1], u0 = acc[ai][1][m][0], u1 = acc[ai][1][m][1];
                u32x4 w;
                w.x = cvt_pk_bf16(silu_f(g0[0]) * u0[0], silu_f(g0[1]) * u0[1]); w.y = cvt_pk_bf16(silu_f(g0[2]) * u0[2], silu_f(g0[3]) * u0[3]);
                w.z = cvt_pk_bf16(silu_f(g1[0]) * u1[0], silu_f(g1[1]) * u1[1]); w.w = cvt_pk_bf16(silu_f(g1[2]) * u1[2], silu_f(g1[3]) * u1[3]);
                *(u32x4*)(H + (size_t)(row0 + ai * HALF + m * 16) * ldh + col0) = w;
            }
    }
};
struct EpiResid {
    static constexpr bool PERM = false, AFTER_DRAIN = false;
    const bf16_t* X; float* Y; int ldc; float alpha, w;
    __device__ __forceinline__ void operator()(const f32x4 (&acc)[2][2][4][2], const Unit& u, int wr, int wc, int fr, int fq) const {
        const int row0 = u.pm * BM + wr * 64 + fr, col0 = u.pn * BM + wc * 32 + 4 * fq;
#pragma unroll
        for (int ai = 0; ai < 2; ++ai)
#pragma unroll
            for (int m = 0; m < 4; ++m) { const size_t ro = (size_t)(row0 + ai * HALF + m * 16) * ldc + col0;
#pragma unroll
                for (int bj = 0; bj < 2; ++bj)
#pragma unroll
                    for (int n = 0; n < 2; ++n) { const size_t off = ro + bj * HALF + n * 16; const u32x2 xw = *(const u32x2*)(X + off); const f32x4 a = acc[ai][bj][m][n];
                        f32x4 y; y[0] = alpha * bf_lo(xw.x) + w * a[0]; y[1] = alpha * bf_hi(xw.x) + w * a[1]; y[2] = alpha * bf_lo(xw.y) + w * a[2]; y[3] = alpha * bf_hi(xw.y) + w * a[3];
                        *(f32x4*)(Y + off) = y; } }
    }
};
struct EpiBf16 {
    static constexpr bool PERM = true, AFTER_DRAIN = false;
    bf16_t* O; int ldc; float* sqA; int a_lo, a_hi; float* sqB; int b_lo, b_hi;
    __device__ __forceinline__ void operator()(const f32x4 (&acc)[2][2][4][2], const Unit& u, int wr, int wc, int fr, int fq) const {
        const int row0 = u.pm * BM + wr * 64 + fr, col0 = u.pn * BM + wc * 32 + 8 * fq;
        float* sq = (u.pn >= a_lo && u.pn < a_hi) ? sqA : ((u.pn >= b_lo && u.pn < b_hi) ? sqB : nullptr);
#pragma unroll
        for (int ai = 0; ai < 2; ++ai)
#pragma unroll
            for (int m = 0; m < 4; ++m) { bf16_t* rowp = O + (size_t)(row0 + ai * HALF + m * 16) * ldc + col0; float ss = 0.f;
#pragma unroll
                for (int bj = 0; bj < 2; ++bj) { const f32x4 v0 = acc[ai][bj][m][0], v1 = acc[ai][bj][m][1];
                    ss += (v0[0] * v0[0] + v0[1] * v0[1]) + (v0[2] * v0[2] + v0[3] * v0[3]) + (v1[0] * v1[0] + v1[1] * v1[1]) + (v1[2] * v1[2] + v1[3] * v1[3]);
                    u32x4 w; w.x = cvt_pk_bf16(v0[0], v0[1]); w.y = cvt_pk_bf16(v0[2], v0[3]); w.z = cvt_pk_bf16(v1[0], v1[1]); w.w = cvt_pk_bf16(v1[2], v1[3]);
                    *(u32x4*)(rowp + bj * HALF) = w; }
                if (sq) { ss += __shfl_xor(ss, 16); ss += __shfl_xor(ss, 32); if (fq == 0) atomicAdd(sq + row0 + ai * HALF + m * 16, ss); }
            }
    }
};
struct EpiScaleRow {
    static constexpr bool PERM = true, AFTER_DRAIN = false;
    bf16_t* O; int ldc; const float* sq; float invn, eps;
    __device__ __forceinline__ void operator()(const f32x4 (&acc)[2][2][4][2], const Unit& u, int wr, int wc, int fr, int fq) const {
        const int row0 = u.pm * BM + wr * 64 + fr, col0 = u.pn * BM + wc * 32 + 8 * fq;
#pragma unroll
        for (int ai = 0; ai < 2; ++ai)
#pragma unroll
            for (int m = 0; m < 4; ++m) { const int row = row0 + ai * HALF + m * 16; const float rs = 1.0f / sqrtf(sq[row] * invn + eps); bf16_t* rowp = O + (size_t)row * ldc + col0;
#pragma unroll
                for (int bj = 0; bj < 2; ++bj) { const f32x4 v0 = acc[ai][bj][m][0] * rs, v1 = acc[ai][bj][m][1] * rs;
                    u32x4 w; w.x = cvt_pk_bf16(v0[0], v0[1]); w.y = cvt_pk_bf16(v0[2], v0[3]); w.z = cvt_pk_bf16(v1[0], v1[1]); w.w = cvt_pk_bf16(v1[2], v1[3]);
                    *(u32x4*)(rowp + bj * HALF) = w; } }
    }
};
struct EpiUkv {
    static constexpr bool PERM = true, AFTER_DRAIN = false;
    bf16_t* KD; bf16_t* VD; const float* sq; float invn, eps;
    __device__ __forceinline__ void operator()(const f32x4 (&acc)[2][2][4][2], const Unit& u, int wr, int wc, int fr, int fq) const {
        const int row0 = u.pm * BM + wr * 64 + fr, cc = wc * 32 + 8 * fq;
#pragma unroll
        for (int ai = 0; ai < 2; ++ai)
#pragma unroll
            for (int m = 0; m < 4; ++m) { const int row = row0 + ai * HALF + m * 16; const float rs = 1.0f / sqrtf(sq[row] * invn + eps);
#pragma unroll
                for (int bj = 0; bj < 2; ++bj) { const f32x4 v0 = acc[ai][bj][m][0] * rs, v1 = acc[ai][bj][m][1] * rs;
                    u32x4 w; w.x = cvt_pk_bf16(v0[0], v0[1]); w.y = cvt_pk_bf16(v0[2], v0[3]); w.z = cvt_pk_bf16(v1[0], v1[1]); w.w = cvt_pk_bf16(v1[2], v1[3]);
                    bf16_t* dst = bj == 0 ? KD + (size_t)row * 1536 + u.pn * 192 + cc : VD + (size_t)row * 1024 + u.pn * 128 + cc;
                    *(u32x4*)dst = w; } }
    }
};
template <class Epi, class Sched, bool ALIGN_EPI = false, bool SP2 = false>
__device__ __forceinline__ void gemm_phase(PG8_LAS unsigned char* lds, const Gemm g, const Sched& S, const Epi& E) {
    int tid_o_ = threadIdx.x; asm volatile("" : "+v"(tid_o_)); const int tid = tid_o_, wid = __builtin_amdgcn_readfirstlane(tid >> 6), lane = tid & 63, wr = wid >> 2, wc = wid & 3, fr = lane & 15, fq = lane >> 4;
    const int K = g.K, nt = K / BK;
    unsigned voffA[2], voffB[2];
#pragma unroll
    for (int i = 0; i < 2; ++i) { int R, C; stage_rc(tid * 16 + i * 8192, R, C); const int Rb = Epi::PERM ? ((R & ~31) + perm32(R & 31)) : R;
        voffA[i] = (unsigned)(R * g.lda + C) * 2u; voffB[i] = (unsigned)(Rb * K + C) * 2u; }
    const size_t kstep = (size_t)(BK * 2);
    const size_t hstepB = (size_t)HALF * K * 2, hstepA = (size_t)HALF * g.lda * 2;
    const size_t tstepA = 2 * hstepA, tstepB = 2 * hstepB;
    const unsigned ldsw = (unsigned)wid * 1024u;
    const int aoff = lds_byte(wr * 64 + fr, fq * 8), boff = lds_byte(wc * 32 + fr, fq * 8);
#define PG8_SA(b, h) (((b) * 2 + (h)) * HTB)
#define PG8_SB(b, h) ((4 + (b) * 2 + (h)) * HTB)
#define PG8_STAGE(bufoff, gbase, voff) do { _Pragma("unroll") for (int _i = 0; _i < 2; ++_i) \
        __builtin_amdgcn_global_load_lds((const unsigned*)((const char*)(gbase) + (voff)[_i]), (PG8_LAS unsigned*)(lds + (bufoff) + ldsw + _i * 8192), 16, 0, 0); } while (0)
#define PG8_LDA(dst, b, h) do { _Pragma("unroll") for (int m = 0; m < 4; ++m) _Pragma("unroll") for (int k = 0; k < 2; ++k) dst[m][k] = *(const PG8_LAS bf16x8*)(lds + PG8_SA(b, h) + aoff + m * 2048 + k * 1024); } while (0)
#define PG8_LDB(dst, b, h) do { _Pragma("unroll") for (int n = 0; n < 2; ++n) _Pragma("unroll") for (int k = 0; k < 2; ++k) dst[n][k] = *(const PG8_LAS bf16x8*)(lds + PG8_SB(b, h) + boff + n * 2048 + k * 1024); } while (0)
#define PG8_MMA(ai, bj, At, Bt) do { __builtin_amdgcn_s_setprio(1); _Pragma("unroll") for (int m = 0; m < 4; ++m) _Pragma("unroll") for (int n = 0; n < 2; ++n) _Pragma("unroll") for (int k = 0; k < 2; ++k) \
        acc[ai][bj][m][n] = __builtin_amdgcn_mfma_f32_16x16x32_bf16(Bt[n][k], At[m][k], acc[ai][bj][m][n], 0, 0, 0); __builtin_amdgcn_s_setprio(0); } while (0)
#define PG8_WAIT_V(n) asm volatile("s_waitcnt vmcnt(" #n ")" ::: "memory")
#define PG8_WAIT_L(n) asm volatile("s_waitcnt lgkmcnt(" #n ")" ::: "memory")
#define PG8_BAR __builtin_amdgcn_s_barrier()
#define PG8_SCHED __builtin_amdgcn_sched_barrier(0)
    Unit cur, nxt; int ui = 0;
    if (!S.next(0, cur)) return;
    f32x4 acc[2][2][4][2];
#pragma unroll
    for (int a = 0; a < 2; ++a)
#pragma unroll
        for (int b = 0; b < 2; ++b)
#pragma unroll
            for (int m = 0; m < 4; ++m)
#pragma unroll
                for (int n = 0; n < 2; ++n) acc[a][b][m][n] = (f32x4){0.f, 0.f, 0.f, 0.f};
    bf16x8 At[4][2], B0[2][2], B1[2][2];
    const char* cA = (const char*)g.A + (size_t)cur.pm * tstepA; const char* cB = (const char*)g.Bt + (size_t)cur.pn * tstepB;
    S.a_ready(cur);
    if constexpr (SP2) {
        PG8_STAGE(PG8_SB(0, 0), cB, voffB); PG8_STAGE(PG8_SB(0, 1), cB + hstepB, voffB); PG8_STAGE(PG8_SA(0, 0), cA, voffA); PG8_STAGE(PG8_SA(0, 1), cA + hstepA, voffA);
        if (wr == 1) PG8_BAR;
        PG8_WAIT_V(2); PG8_BAR;
        PG8_STAGE(PG8_SB(1, 0), cB + kstep, voffB); PG8_STAGE(PG8_SA(1, 0), cA + kstep, voffA); PG8_STAGE(PG8_SB(1, 1), cB + hstepB + kstep, voffB);
        PG8_WAIT_V(6); PG8_BAR;
    } else {
        PG8_STAGE(PG8_SB(0, 0), cB, voffB); PG8_STAGE(PG8_SA(0, 0), cA, voffA); PG8_STAGE(PG8_SB(0, 1), cB + hstepB, voffB); PG8_STAGE(PG8_SA(0, 1), cA + hstepA, voffA);
        if (wr == 1) PG8_BAR;
        PG8_WAIT_V(4); PG8_BAR;
        PG8_STAGE(PG8_SB(1, 0), cB + kstep, voffB); PG8_STAGE(PG8_SA(1, 0), cA + kstep, voffA); PG8_STAGE(PG8_SB(1, 1), cB + hstepB + kstep, voffB);
        PG8_WAIT_V(6); PG8_BAR;
    }
    for (;;) {
        const bool has_next = S.next(ui + 1, nxt);
        const char* nA = has_next ? (const char*)g.A + (size_t)nxt.pm * tstepA : cA; const char* nB = has_next ? (const char*)g.Bt + (size_t)nxt.pn * tstepB : cB;
        for (int t = 0; t < nt; t += 2) {
            const bool last = (t == nt - 2);
            const char* a1 = cA + (size_t)(t + 1) * kstep;
            const char* a2 = last ? nA : cA + (size_t)(t + 2) * kstep; const char* b2 = last ? nB : cB + (size_t)(t + 2) * kstep;
            const char* a3 = a2 + kstep; const char* b3 = b2 + kstep;
            if (last && has_next) S.a_ready(nxt);
            if constexpr (SP2) {
            PG8_LDB(B0, 0, 0); PG8_LDB(B1, 0, 1); PG8_SCHED; PG8_LDA(At, 0, 0); PG8_STAGE(PG8_SA(1, 1), a1 + hstepA, voffA);
            PG8_WAIT_V(8); PG8_WAIT_L(0); PG8_BAR; PG8_MMA(0, 0, At, B0); PG8_MMA(0, 1, At, B1); PG8_BAR; PG8_SCHED;
            PG8_LDA(At, 0, 1); PG8_STAGE(PG8_SB(0, 0), b2, voffB); PG8_STAGE(PG8_SB(0, 1), b2 + hstepB, voffB); PG8_STAGE(PG8_SA(0, 0), a2, voffA);
            PG8_WAIT_V(8); PG8_WAIT_L(0); PG8_BAR; PG8_MMA(1, 0, At, B0); PG8_MMA(1, 1, At, B1); PG8_BAR; PG8_SCHED;
            PG8_LDB(B0, 1, 0); PG8_LDB(B1, 1, 1); PG8_SCHED; PG8_LDA(At, 1, 0); PG8_STAGE(PG8_SA(0, 1), a2 + hstepA, voffA);
            PG8_WAIT_V(8); PG8_WAIT_L(0); PG8_BAR; PG8_MMA(0, 0, At, B0); PG8_MMA(0, 1, At, B1); PG8_BAR; PG8_SCHED;
            PG8_LDA(At, 1, 1); PG8_STAGE(PG8_SB(1, 0), b3, voffB); PG8_STAGE(PG8_SB(1, 1), b3 + hstepB, voffB); PG8_STAGE(PG8_SA(1, 0), a3, voffA);
            PG8_WAIT_V(8); PG8_WAIT_L(0); PG8_BAR; PG8_MMA(1, 0, At, B0); PG8_MMA(1, 1, At, B1); PG8_BAR; PG8_SCHED;
            } else {
            PG8_LDB(B0, 0, 0); PG8_SCHED; PG8_LDA(At, 0, 0); PG8_STAGE(PG8_SA(1, 1), a1 + hstepA, voffA);
            PG8_WAIT_L(8); PG8_BAR; PG8_WAIT_L(0); PG8_MMA(0, 0, At, B0); PG8_BAR; PG8_SCHED;
            PG8_LDB(B1, 0, 1); PG8_STAGE(PG8_SB(0, 0), b2, voffB);
            PG8_BAR; PG8_WAIT_L(0); PG8_MMA(0, 1, At, B1); PG8_BAR;
            PG8_LDA(At, 0, 1); PG8_STAGE(PG8_SA(0, 0), a2, voffA);
            PG8_BAR; PG8_WAIT_L(0); PG8_MMA(1, 0, At, B0); PG8_BAR; PG8_SCHED;
            PG8_STAGE(PG8_SB(0, 1), b2 + hstepB, voffB);
            PG8_WAIT_V(6); PG8_BAR; PG8_MMA(1, 1, At, B1); PG8_BAR;
            PG8_LDB(B0, 1, 0); PG8_SCHED; PG8_LDA(At, 1, 0); PG8_STAGE(PG8_SA(0, 1), a2 + hstepA, voffA);
            PG8_WAIT_L(8); PG8_BAR; PG8_WAIT_L(0); PG8_MMA(0, 0, At, B0); PG8_BAR; PG8_SCHED;
            PG8_LDB(B1, 1, 1); PG8_STAGE(PG8_SB(1, 0), b3, voffB);
            PG8_BAR; PG8_WAIT_L(0); PG8_MMA(0, 1, At, B1); PG8_BAR;
            PG8_LDA(At, 1, 1); PG8_STAGE(PG8_SA(1, 0), a3, voffA);
            PG8_BAR; PG8_WAIT_L(0); PG8_MMA(1, 0, At, B0); PG8_BAR; PG8_SCHED;
            PG8_STAGE(PG8_SB(1, 1), b3 + hstepB, voffB);
            PG8_WAIT_V(6); PG8_BAR; PG8_MMA(1, 1, At, B1); PG8_BAR;
            }
        }
        if constexpr (ALIGN_EPI) { if (wr == 0) PG8_BAR; }
        if constexpr (!Epi::AFTER_DRAIN) { E(acc, cur, wr, wc, fr, fq); S.done(cur); }
        if (!has_next) break;
#pragma unroll
        for (int a = 0; a < 2; ++a)
#pragma unroll
            for (int b = 0; b < 2; ++b)
#pragma unroll
                for (int m = 0; m < 4; ++m)
#pragma unroll
                    for (int n = 0; n < 2; ++n) acc[a][b][m][n] = (f32x4){0.f, 0.f, 0.f, 0.f};
        cur = nxt; cA = nA; cB = nB; ++ui;
        if constexpr (ALIGN_EPI) { if (wr == 1) PG8_BAR; }
    }
    PG8_WAIT_V(0);
    if constexpr (!ALIGN_EPI) { if (wr == 0) PG8_BAR; }
    PG8_BAR;
    if constexpr (Epi::AFTER_DRAIN) { E.fused(acc, cur, wr, wc, fr, fq, lds, wid, lane); S.done(cur); }
#undef PG8_SA
#undef PG8_SB
#undef PG8_STAGE
#undef PG8_LDA
#undef PG8_LDB
#undef PG8_MMA
#undef PG8_WAIT_V
#undef PG8_WAIT_L
#undef PG8_BAR
#undef PG8_SCHED
}
}

constexpr int S = 16384, DM = 2048, DFF = 5632, NGU = 2 * DFF;
constexpr int EIN = 7248, EINP = 7424, OIN = 4416, OINP = 4608;
constexpr float ALPHA = 1.4142135623730951f;
constexpr float LN_EPS = 1e-5f, RMS_EPS = 1e-6f, DIFF_EPS = 1e-5f;
constexpr int NWAVES = 8;
constexpr size_t MiB = 1u << 20;
constexpr size_t WS_CTL = 0, CTL_ZERO_BYTES = 1 * MiB;
constexpr size_t WS_LSE = 1 * MiB;
constexpr size_t WS_WFA = 4 * MiB, WS_WFB = 70 * MiB;
constexpr size_t WF_DOWN_OFF = (size_t)NGU * DM * 2;
constexpr size_t WS_WEIN = 136 * MiB, WS_WOIN = 165 * MiB, WS_WEOUT = 183 * MiB, WS_WOOUT = 191 * MiB, WS_WUQ = 199 * MiB, WS_WUKV = 202 * MiB;
constexpr size_t WS_X = 204 * MiB;
constexpr size_t WS_Y = 268 * MiB;
constexpr size_t WS_HP = 396 * MiB;
constexpr size_t WS_O = 628 * MiB;
constexpr size_t WS_END = 692 * MiB;
constexpr int CW_BAR = 4096;
constexpr int CW_SQQ = 65536, CW_SQKV = 65536 + 16384;
constexpr int RING_OFF = 0, RING_BYTES = 131072;
constexpr int LDSCTL_OFF = RING_BYTES, MISC_OFF = LDSCTL_OFF + 320;
constexpr int LDS_BYTES = 147456;

#define GAS __attribute__((address_space(1)))
#define LAS __attribute__((address_space(3)))
typedef unsigned short bf16;
typedef unsigned v4u __attribute__((ext_vector_type(4)));
typedef unsigned v2u __attribute__((ext_vector_type(2)));
typedef float f32x4 __attribute__((ext_vector_type(4)));
typedef short bf16x8 __attribute__((ext_vector_type(8)));
typedef GAS unsigned gu32;
#define LDS_WAIT() asm volatile("s_waitcnt lgkmcnt(0)" ::: "memory")
#define VM_WAIT() asm volatile("s_waitcnt vmcnt(0)" ::: "memory")
__device__ __forceinline__ unsigned f2bf(float f) { unsigned u = __builtin_bit_cast(unsigned, f); return (u + 0x7fffu + ((u >> 16) & 1u)) >> 16; }
__device__ __forceinline__ unsigned pk2(float lo, float hi) { return f2bf(lo) | (f2bf(hi) << 16); }
__device__ __forceinline__ float bflo(unsigned w) { return __uint_as_float(w << 16); }
__device__ __forceinline__ float bfhi(unsigned w) { return __uint_as_float(w & 0xffff0000u); }
#define XB_TMO      128
#define XB_XCNT(j)  (256  + 64 * (j))
#define XB_XSUB(j)  (1280 + 64 * (j))
#define XB_XGEN(j)  (2304 + 64 * (j))
#define XB_TOP      3328
#define XB_TOPGEN   3392
#define XCD_BAR_WORDS 3456
#define XB_SPIN_CAP (1u << 18)

__device__ __forceinline__ unsigned xb_ld(unsigned* p)              { return __hip_atomic_load(p, __ATOMIC_RELAXED, __HIP_MEMORY_SCOPE_AGENT); }
__device__ __forceinline__ unsigned xb_add(unsigned* p, unsigned v) { return __hip_atomic_fetch_add(p, v, __ATOMIC_RELAXED, __HIP_MEMORY_SCOPE_AGENT); }
__device__ __forceinline__ unsigned xb_xcc_id() { return (unsigned)__builtin_amdgcn_s_getreg((3 << 11) | 20) & 0xFu; }
#define XB_SPIN(cond, bar) do { unsigned _sp = 0; while (cond) { __builtin_amdgcn_s_sleep(1); \
    if ((++_sp & 255u) == 0u) { if (xb_ld(&(bar)[XB_TMO])) break; if (_sp > XB_SPIN_CAP) { atomicAdd(&(bar)[XB_TMO], 1u); break; } } } } while (0)

struct XcdBarrier {
    unsigned* bar; unsigned x;
    volatile LAS unsigned* st;
};

__device__ __forceinline__ XcdBarrier xcd_barrier_post(unsigned* bar, volatile LAS unsigned* st) {
    XcdBarrier b; b.bar = bar; b.x = xb_xcc_id(); b.st = st;
    if (threadIdx.x == 0) (void)xb_add(&bar[XB_XCNT(b.x)], 1u);
    return b;
}
__device__ __forceinline__ void xcd_barrier_complete(unsigned* bar, unsigned x, unsigned& nloc, unsigned& nx) {
    const unsigned G = gridDim.x * gridDim.y * gridDim.z;
    unsigned sum, cnt, mine, sp = 0u;
    for (;;) {
        sum = 0u; cnt = 0u; mine = 0u;
#pragma unroll
        for (unsigned j = 0; j < 16; ++j) { const unsigned c = xb_ld(&bar[XB_XCNT(j)]); sum += c; cnt += (c > 0u) ? 1u : 0u; mine = (j == x) ? c : mine; }
        if (sum == G) break;
        __builtin_amdgcn_s_sleep(1);
        if ((++sp & 255u) == 0u) { if (xb_ld(&bar[XB_TMO])) break; if (sp > XB_SPIN_CAP) { atomicAdd(&bar[XB_TMO], 1u); break; } }
    }
    nloc = mine > 0u ? mine : 1u; nx = cnt > 0u ? cnt : 1u;
}

__device__ __forceinline__ void xcd_barrier(const XcdBarrier& b) {
    asm volatile("s_waitcnt vmcnt(0)" ::: "memory");
    __syncthreads();
    if (threadIdx.x == 0) {
        unsigned* bar = b.bar;
        __builtin_amdgcn_s_waitcnt(0);
        unsigned nloc = b.st[0], nx = b.st[1];
        if (nloc == 0u) { xcd_barrier_complete(bar, b.x, nloc, nx); b.st[0] = nloc; b.st[1] = nx; }
        const unsigned old = xb_add(&bar[XB_XSUB(b.x)], 1u);
        const unsigned gen = old / nloc;
        if (old + 1u == (gen + 1u) * nloc) {
            __builtin_amdgcn_fence(__ATOMIC_RELEASE, "agent");
            asm volatile("s_waitcnt vmcnt(0)" ::: "memory");
            const unsigned og = xb_add(&bar[XB_TOP], 1u);
            const unsigned tg = og / nx;
            if (og + 1u == (tg + 1u) * nx) xb_add(&bar[XB_TOPGEN], 1u);
            else XB_SPIN(xb_ld(&bar[XB_TOPGEN]) == tg, bar);
            __builtin_amdgcn_fence(__ATOMIC_ACQUIRE, "agent");
            xb_add(&bar[XB_XGEN(b.x)], 1u);
            asm volatile("s_waitcnt vmcnt(0)" ::: "memory");
        } else {
            XB_SPIN(xb_ld(&bar[XB_XGEN(b.x)]) == gen, bar);
            __builtin_amdgcn_fence(__ATOMIC_ACQUIRE, "agent");
            asm volatile("s_waitcnt vmcnt(0)" ::: "memory");
        }
    }
    __syncthreads();
}

namespace fa {
typedef short bf16x8 __attribute__((ext_vector_type(8)));
typedef short s16x4 __attribute__((ext_vector_type(4)));
typedef float f32x16 __attribute__((ext_vector_type(16)));
typedef unsigned u32x4 __attribute__((ext_vector_type(4)));
typedef unsigned u32x2 __attribute__((ext_vector_type(2)));
typedef unsigned short bf16;
#define FA_SBAR() __builtin_amdgcn_sched_barrier(0)
__device__ __forceinline__ int crow(int r, int hi) { return (r & 3) + 8 * (r >> 2) + 4 * hi; }
__device__ __forceinline__ unsigned cvtpk(float lo, float hi) { unsigned r; asm volatile("v_cvt_pk_bf16_f32 %0, %1, %2" : "=v"(r) : "v"(lo), "v"(hi)); return r; }
__device__ __forceinline__ int v_st(int k, int c) { const int kk = (k & ~0xC) | ((k & 4) << 1) | ((k & 8) >> 1); return ((kk >> 3) * 4 + (c >> 5)) * 512 + ((kk & 7) * 32 + (c & 31)) * 2; }
__device__ __forceinline__ int v_rd_base(int lane) { return ((lane & 3) << 3) | (((lane >> 2) & 3) << 6) | (((lane >> 4) & 1) << 5) | (((lane >> 5) & 1) << 8); }
constexpr int v_rd_off(int d0, int ks, int half) { return d0 * 512 + ks * 4096 + half * 2048; }
template <int OFF> __device__ __forceinline__ s16x4 tr_read(int vb) { s16x4 r; asm volatile("ds_read_b64_tr_b16 %0, %1 offset:%2" : "=&v"(r) : "v"(vb), "i"(OFF) : "memory"); return r; }
template <int D0> __device__ __forceinline__ void pv_one(f32x16& od, int vb, bf16x8 pa0, bf16x8 pa1, bf16x8 pa2, bf16x8 pa3) {
    const s16x4 l0 = tr_read<v_rd_off(D0, 0, 0)>(vb), h0 = tr_read<v_rd_off(D0, 0, 1)>(vb), l1 = tr_read<v_rd_off(D0, 1, 0)>(vb), h1 = tr_read<v_rd_off(D0, 1, 1)>(vb);
    const s16x4 l2 = tr_read<v_rd_off(D0, 2, 0)>(vb), h2 = tr_read<v_rd_off(D0, 2, 1)>(vb), l3 = tr_read<v_rd_off(D0, 3, 0)>(vb), h3 = tr_read<v_rd_off(D0, 3, 1)>(vb);
    asm volatile("s_waitcnt lgkmcnt(0)" ::: "memory"); FA_SBAR();
#define FA_PK(L, H) (bf16x8){L[0], L[1], L[2], L[3], H[0], H[1], H[2], H[3]}
    od = __builtin_amdgcn_mfma_f32_32x32x16_bf16(pa0, FA_PK(l0, h0), od, 0, 0, 0);
    od = __builtin_amdgcn_mfma_f32_32x32x16_bf16(pa1, FA_PK(l1, h1), od, 0, 0, 0);
    od = __builtin_amdgcn_mfma_f32_32x32x16_bf16(pa2, FA_PK(l2, h2), od, 0, 0, 0);
    od = __builtin_amdgcn_mfma_f32_32x32x16_bf16(pa3, FA_PK(l3, h3), od, 0, 0, 0);
#undef FA_PK
}
__device__ __forceinline__ void pv_d0(f32x16* o, int vb, bf16x8 pa0, bf16x8 pa1, bf16x8 pa2, bf16x8 pa3) {
    pv_one<0>(o[0], vb, pa0, pa1, pa2, pa3); pv_one<1>(o[1], vb, pa0, pa1, pa2, pa3); pv_one<2>(o[2], vb, pa0, pa1, pa2, pa3); pv_one<3>(o[3], vb, pa0, pa1, pa2, pa3);
}
struct UnitP {
    const bf16* Q; size_t ldq;
    const bf16* K; size_t ldk;
    const bf16* V; size_t ldv;
    int q0;
    int kt0, kt1;
    float sl2;
    float c2;
    const unsigned* mask;
};
constexpr int WIN = 128;
constexpr float THR2 = 11.5f;
template <int DQK, bool WINDOW, bool ALIBI, bool MASK, bool ROPEQ>
__device__ __forceinline__ void attn_unit(const UnitP& U, LAS unsigned char* lds, f32x16 (&o)[4], float& lse2) {
    constexpr int KROWB = DQK * 2, SHM_V = 16384, SHM_K = 64 * KROWB, KOFF = 2 * SHM_V, WSOFF = KOFF + 2 * SHM_K;
    constexpr int KCH = DQK / 8, KPT = 64 * KCH / 512, ND0 = DQK / 16;
    int tid_o_ = threadIdx.x; asm volatile("" : "+v"(tid_o_)); const int tid = tid_o_, wid = __builtin_amdgcn_readfirstlane(tid >> 6), lane = tid & 63, r32 = lane & 31, hi = lane >> 5;
    LAS float* wsf = (LAS float*)(lds + WSOFF + wid * 256);
    float m_reg = -1e30f, l_reg = 0.f;
#pragma unroll
    for (int d = 0; d < 4; ++d)
#pragma unroll
        for (int r = 0; r < 16; ++r) o[d][r] = 0.f;
    bf16x8 qr[ND0];
    const int qi = U.q0 + wid * 32 + r32;
    {   const bf16* Qw = U.Q + (size_t)(wid * 32 + r32) * U.ldq + hi * 8;
#pragma unroll
        for (int d0 = 0; d0 < ND0; ++d0) qr[d0] = *(const bf16x8*)(Qw + d0 * 16);
        if constexpr (ROPEQ) {
#pragma unroll
            for (int pb = 0; pb < 2; ++pb) { bf16x8 a = qr[ND0 - 4 + pb], b = qr[ND0 - 2 + pb];
#pragma unroll
                for (int e = 0; e < 8; ++e) { const int fi = pb * 16 + hi * 8 + e; const float inv = __builtin_amdgcn_exp2f(-0.41524101186092029f * (float)fi);
                    const float ang = (float)qi * inv; const float n = rintf(ang * 0.15915494309189535f);
                    float rr = fmaf(-n, 6.2831854820251465f, ang); rr = fmaf(-n, -1.7484555e-07f, rr); const float fr = rr * 0.15915494309189535f;
                    const float sn = __builtin_amdgcn_sinf(fr), cs = __builtin_amdgcn_cosf(fr);
                    const float x1 = __uint_as_float((unsigned)(unsigned short)a[e] << 16), x2 = __uint_as_float((unsigned)(unsigned short)b[e] << 16);
                    const unsigned w = cvtpk(x1 * cs - x2 * sn, x1 * sn + x2 * cs); a[e] = (short)(w & 0xffffu); b[e] = (short)(w >> 16); }
                qr[ND0 - 4 + pb] = a; qr[ND0 - 2 + pb] = b; }
        }
    }
    unsigned kgo[KPT], vgo[2];
#pragma unroll
    for (int i_ = 0; i_ < KPT; ++i_) { const int p_ = (wid + 8 * i_) * 1024 + lane * 16, row_ = p_ / KROWB, wi_ = (p_ % KROWB) ^ ((row_ & 7) << 4); kgo[i_] = (unsigned)((size_t)row_ * U.ldk * 2 + wi_); }
#pragma unroll
    for (int i_ = 0; i_ < 2; ++i_) { const int p_ = (wid + 8 * i_) * 1024 + lane * 16, sub_ = p_ >> 9, rem_ = p_ & 511, kk_ = (sub_ >> 2) * 8 + (rem_ >> 6), k_ = (kk_ & ~0xC) | ((kk_ & 4) << 1) | ((kk_ & 8) >> 1), col_ = (sub_ & 3) * 32 + ((rem_ & 63) >> 1);
        vgo[i_] = (unsigned)(((size_t)k_ * U.ldv + col_) * 2); }
#define FA_DMA(k0_, b_) do { const char* kg_ = (const char*)U.K + (size_t)(k0_) * U.ldk * 2; const char* vg_ = (const char*)U.V + (size_t)(k0_) * U.ldv * 2; \
        _Pragma("unroll") for (int i_ = 0; i_ < KPT; ++i_) __builtin_amdgcn_global_load_lds((const unsigned*)(kg_ + kgo[i_]), (LAS unsigned*)(lds + KOFF + (b_) * SHM_K + (wid + 8 * i_) * 1024), 16, 0, 0); \
        _Pragma("unroll") for (int i_ = 0; i_ < 2; ++i_) __builtin_amdgcn_global_load_lds((const unsigned*)(vg_ + vgo[i_]), (LAS unsigned*)(lds + (b_) * SHM_V + (wid + 8 * i_) * 1024), 16, 0, 0); } while (0)
    const int vb0 = (int)(unsigned)(uintptr_t)lds + v_rd_base(lane);
    const int NT = U.kt1 - U.kt0;
    const int qw0 = U.q0 + wid * 32, qw1 = qw0 + 31;
    u32x2 mw = {0u, 0u}, mwn = {0u, 0u};
    const unsigned* mrow = MASK ? U.mask + (size_t)(wid * 32 + r32) * 512 : nullptr;
    FA_DMA(U.kt0 * 64, 0); if constexpr (MASK) mw = *(const u32x2*)(mrow + U.kt0 * 2);
    asm volatile("s_waitcnt vmcnt(0)" ::: "memory"); __syncthreads();
    for (int jt = 0; jt < NT; ++jt) {
        const int k0 = (U.kt0 + jt) * 64, buf = jt & 1;
        const bool more = jt + 1 < NT;
        if (more) { FA_DMA(k0 + 64, buf ^ 1); if constexpr (MASK) mwn = *(const u32x2*)(mrow + (k0 >> 5) + 2); }
        const bool active = (k0 <= qw1) && (!WINDOW || (k0 + 63 >= qw0 - WIN));
        if (active) {
            f32x16 p0, p1;
#pragma unroll
            for (int r = 0; r < 16; ++r) { p0[r] = 0.f; p1[r] = 0.f; }
            const LAS unsigned char* kb = lds + KOFF + buf * SHM_K + r32 * KROWB; const int lp = (hi * 16) ^ ((r32 & 7) << 4);
            const LAS unsigned char* kq[4] = {kb + lp, kb + (lp ^ 32), kb + (lp ^ 64), kb + (lp ^ 96)};
#pragma unroll
            for (int d0 = 0; d0 < ND0; ++d0) {
                const bf16x8 b0 = *(const LAS bf16x8*)(kq[d0 & 3] + (d0 >> 2) * 128), b1 = *(const LAS bf16x8*)(kq[d0 & 3] + (d0 >> 2) * 128 + 32 * KROWB);
                p0 = __builtin_amdgcn_mfma_f32_32x32x16_bf16(b0, qr[d0], p0, 0, 0, 0);
                p1 = __builtin_amdgcn_mfma_f32_32x32x16_bf16(b1, qr[d0], p1, 0, 0, 0);
                if ((d0 & 3) == 3) FA_SBAR(); }
            const int lim = qi - k0 - 4 * hi;
            const float tb = ALIBI ? U.sl2 * (float)(-lim) : 0.f;
#pragma unroll
            for (int r = 0; r < 16; ++r) { const int c = (r & 3) + 8 * (r >> 2);
                if constexpr (ALIBI) { p0[r] = fmaf(p0[r], U.c2, fmaf((float)c, U.sl2, tb)); p1[r] = fmaf(p1[r], U.c2, fmaf((float)(c + 32), U.sl2, tb)); }
                else { p0[r] *= U.c2; p1[r] *= U.c2; } }
            const bool need_mask = (k0 + 63 > qw0) || (WINDOW && (k0 < qw1 - WIN));
            if (need_mask) {
#pragma unroll
                for (int r = 0; r < 16; ++r) { const int c = (r & 3) + 8 * (r >> 2); const int d0_ = lim - c, d1_ = lim - c - 32;
                    const bool ok0 = WINDOW ? ((unsigned)d0_ <= (unsigned)WIN) : (d0_ >= 0), ok1 = WINDOW ? ((unsigned)d1_ <= (unsigned)WIN) : (d1_ >= 0);
                    p0[r] = ok0 ? p0[r] : -INFINITY; p1[r] = ok1 ? p1[r] : -INFINITY; }
            }
            if constexpr (MASK) { const unsigned w0 = mw.x >> (4 * hi), w1 = mw.y >> (4 * hi);
#pragma unroll
                for (int r = 0; r < 16; ++r) { const int c = (r & 3) + 8 * (r >> 2);
                    const unsigned b0 = (unsigned)((int)(w0 << (31 - c)) >> 31), b1 = (unsigned)((int)(w1 << (31 - c)) >> 31);
                    p0[r] = __uint_as_float((__float_as_uint(p0[r]) & b0) | (0xff800000u & ~b0)); p1[r] = __uint_as_float((__float_as_uint(p1[r]) & b1) | (0xff800000u & ~b1)); }
            }
            FA_SBAR();
            float pmax = p0[0];
#pragma unroll
            for (int r = 1; r < 16; ++r) pmax = fmaxf(pmax, p0[r]);
#pragma unroll
            for (int r = 0; r < 16; ++r) pmax = fmaxf(pmax, p1[r]);
            { auto rr = __builtin_amdgcn_permlane32_swap(__float_as_uint(pmax), __float_as_uint(pmax), false, false); pmax = fmaxf(__uint_as_float(rr[0]), __uint_as_float(rr[1])); }
            float mn, alpha;
            if (__builtin_expect(__all(pmax - m_reg <= THR2), 1)) { mn = m_reg; alpha = 1.f; }
            else { mn = fmaxf(m_reg, pmax); alpha = __builtin_amdgcn_exp2f(m_reg - mn); m_reg = mn; }
            float ps = 0.f;
#pragma unroll
            for (int r = 0; r < 16; ++r) { p0[r] = __builtin_amdgcn_exp2f(p0[r] - mn); p1[r] = __builtin_amdgcn_exp2f(p1[r] - mn); ps += p0[r] + p1[r]; }
            { auto rr = __builtin_amdgcn_permlane32_swap(__float_as_uint(ps), __float_as_uint(ps), false, false); ps = __uint_as_float(rr[0]) + __uint_as_float(rr[1]); }
            l_reg = l_reg * alpha + ps;
            FA_SBAR();
            bf16x8 pa0, pa1, pa2, pa3;
#define FA_PK4(P, BASE, OUT) do { unsigned a0 = cvtpk(P[BASE + 0], P[BASE + 1]), a1 = cvtpk(P[BASE + 2], P[BASE + 3]);   \
    unsigned b0 = cvtpk(P[BASE + 4], P[BASE + 5]), b1 = cvtpk(P[BASE + 6], P[BASE + 7]);                              \
    auto r0 = __builtin_amdgcn_permlane32_swap(a0, b0, false, false); auto r1 = __builtin_amdgcn_permlane32_swap(a1, b1, false, false); \
    u32x4 w = {r0[0], r1[0], r0[1], r1[1]}; OUT = *reinterpret_cast<bf16x8*>(&w); } while (0)
            FA_PK4(p0, 0, pa0); FA_PK4(p0, 8, pa1); FA_PK4(p1, 0, pa2); FA_PK4(p1, 8, pa3);
#undef FA_PK4
            FA_SBAR();
            if (__any(alpha < 1.f)) { if (hi == 0) wsf[r32] = alpha; asm volatile("s_waitcnt lgkmcnt(0)" ::: "memory");
#pragma unroll
                for (int r = 0; r < 16; ++r) { const float al = wsf[crow(r, hi)];
#pragma unroll
                    for (int d = 0; d < 4; ++d) o[d][r] *= al; }
                asm volatile("s_waitcnt lgkmcnt(0)" ::: "memory"); }
            pv_d0(o, vb0 + buf * SHM_V, pa0, pa1, pa2, pa3);
        }
        if (more) { if constexpr (MASK) mw = mwn; }
        asm volatile("s_waitcnt vmcnt(0)" ::: "memory");
        __syncthreads();
    }
    if (hi == 0) wsf[32 + r32] = l_reg; asm volatile("s_waitcnt lgkmcnt(0)" ::: "memory");
#pragma unroll
    for (int r = 0; r < 16; ++r) { const float rl = __builtin_amdgcn_rcpf(wsf[32 + crow(r, hi)]);
#pragma unroll
        for (int d = 0; d < 4; ++d) o[d][r] *= rl; }
    asm volatile("s_waitcnt lgkmcnt(0)" ::: "memory");
    lse2 = m_reg + __builtin_amdgcn_logf(l_reg);
#undef FA_DMA
}
__device__ __forceinline__ void store_o_bf16(const f32x16 (&o)[4], bf16* outw, size_t ldo, int r32, int hi) {
    asm volatile("" : "+v"(r32), "+v"(hi));
    const bool odd = r32 & 1;
#pragma unroll
    for (int d0 = 0; d0 < 4; ++d0)
#pragma unroll
        for (int rp = 0; rp < 8; ++rp) { const int r0 = 2 * rp, r1 = 2 * rp + 1;
            const float send = odd ? o[d0][r0] : o[d0][r1]; const float recv = __shfl_xor(send, 1);
            const unsigned w = odd ? cvtpk(recv, o[d0][r1]) : cvtpk(o[d0][r0], recv);
            const int row = crow(odd ? r1 : r0, hi), col = d0 * 32 + (r32 & ~1);
            *(unsigned*)(outw + (size_t)row * ldo + col) = w; }
}
}
struct Frame {
    LAS unsigned char* lds;
    volatile LAS unsigned* MISC;
    gu32* ctl;
    int tid, lane, wave;
    int vcu, G, gw, NGW;
};
__device__ __forceinline__ float wave_sum(float v) {
#pragma unroll
    for (int o = 1; o < 64; o <<= 1) v += __shfl_xor(v, o);
    return v;
}
template <int MODE>
__device__ __forceinline__ void transpose_item(const float* W, int K, int N, int nblk, bf16* WT, const float* kscale, LAS float* scr, int item, int lane) {
    const int kb = item / nblk, nb = item % nblk, k0 = 64 * kb, n0 = 32 * nb;
    const int nl = n0 + (lane & 31); const bool inb = nl < N;
#pragma unroll 8
    for (int i = 0; i < 32; ++i) { const int kk = 2 * i + (lane >> 5); float v = inb ? W[(size_t)(k0 + kk) * N + nl] : 0.f; if (kscale) v *= kscale[k0 + kk]; scr[kk * 33 + (lane & 31)] = v; }
    LDS_WAIT(); asm volatile("" ::: "memory");
    const int c = lane & 7;
#pragma unroll
    for (int j = 0; j < 4; ++j) { const int n = (lane >> 3) + 8 * j; const LAS float* s = scr + (8 * c) * 33 + n;
        v4u o; o.x = pk2(s[0 * 33], s[1 * 33]); o.y = pk2(s[2 * 33], s[3 * 33]); o.z = pk2(s[4 * 33], s[5 * 33]); o.w = pk2(s[6 * 33], s[7 * 33]);
        const int ng = n0 + n; const int drow = MODE == 0 ? ng : ((ng >> 7) * 256 + (ng & 127) + (MODE == 2 ? 128 : 0));
        *(GAS v4u*)(WT + (size_t)drow * K + k0 + 8 * c) = o; }
    LDS_WAIT(); asm volatile("" ::: "memory");
}
template <int MODE>
__device__ __forceinline__ void convert_weight(Frame& F, const float* W, int K, int N, int Npad, bf16* WT, const float* kscale) {
    LAS float* scr = (LAS float*)(F.lds + RING_OFF + F.wave * 16384);
    const int nblk = Npad / 32, nitems = (K / 64) * nblk;
    for (int it = F.gw; it < nitems; it += F.NGW) transpose_item<MODE>(W, K, N, nblk, WT, kscale, scr, it, F.lane);
}
__device__ __forceinline__ void convert_ffn(Frame& F, const float* wg, const float* wu, const float* wd, unsigned char* dst) {
    convert_weight<1>(F, wg, DM, DFF, DFF, (bf16*)dst, nullptr);
    convert_weight<2>(F, wu, DM, DFF, DFF, (bf16*)dst, nullptr);
    convert_weight<0>(F, wd, DFF, DM, DM, (bf16*)(dst + WF_DOWN_OFF), nullptr);
}
__device__ __forceinline__ void convert_x(Frame& F, const float* x, bf16* X) {
    const size_t n8 = (size_t)S * DM / 8;
    for (size_t i = (size_t)F.gw * 64 + F.lane; i < n8; i += (size_t)F.NGW * 64) {
        const f32x4 a = *(const GAS f32x4*)(x + i * 8), b = *(const GAS f32x4*)(x + i * 8 + 4);
        v4u o; o.x = pk2(a[0], a[1]); o.y = pk2(a[2], a[3]); o.z = pk2(b[0], b[1]); o.w = pk2(b[2], b[3]);
        *(GAS v4u*)(X + i * 8) = o; }
}
__device__ __forceinline__ void scale_x(Frame& F, const bf16* X, float* Y) {
    const size_t n8 = (size_t)S * DM / 8;
    for (size_t i = (size_t)F.gw * 64 + F.lane; i < n8; i += (size_t)F.NGW * 64) {
        const v4u w = *(const GAS v4u*)(X + i * 8);
        f32x4 a = {ALPHA * bflo(w.x), ALPHA * bfhi(w.x), ALPHA * bflo(w.y), ALPHA * bfhi(w.y)}, b = {ALPHA * bflo(w.z), ALPHA * bfhi(w.z), ALPHA * bflo(w.w), ALPHA * bfhi(w.w)};
        *(GAS f32x4*)(Y + i * 8) = a; *(GAS f32x4*)(Y + i * 8 + 4) = b; }
}
template <bool FINAL>
__device__ __forceinline__ void ln_phase(Frame& F, const float* Y, const float* g, const float* b, bf16* X, float* out) {
    for (int row = F.gw; row < S; row += F.NGW) {
        const GAS f32x4* yr = (const GAS f32x4*)(Y + (size_t)row * DM) + F.lane;
        f32x4 v[8]; float s = 0.f;
#pragma unroll
        for (int j = 0; j < 8; ++j) { v[j] = yr[64 * j]; s += (v[j][0] + v[j][1]) + (v[j][2] + v[j][3]); }
        const float mean = wave_sum(s) * (1.f / DM); float s2 = 0.f;
#pragma unroll
        for (int j = 0; j < 8; ++j) { v[j] = v[j] - mean; s2 += (v[j][0] * v[j][0] + v[j][1] * v[j][1]) + (v[j][2] * v[j][2] + v[j][3] * v[j][3]); }
        const float rstd = 1.f / sqrtf(wave_sum(s2) * (1.f / DM) + LN_EPS);
#pragma unroll
        for (int j = 0; j < 8; ++j) { const f32x4 gg = ((const GAS f32x4*)g)[64 * j + F.lane], bb = ((const GAS f32x4*)b)[64 * j + F.lane];
            const f32x4 o = v[j] * rstd * gg + bb;
            if (FINAL) ((GAS f32x4*)(out + (size_t)row * DM))[64 * j + F.lane] = o;
            else { v2u w; w.x = pk2(o[0], o[1]); w.y = pk2(o[2], o[3]); ((GAS v2u*)(X + (size_t)row * DM))[64 * j + F.lane] = w; } }
    }
}
constexpr float LOG2E = 1.4426950408889634f;
__device__ __forceinline__ void mixer_a_phase(Frame& F, const bf16* P, bf16* OA, float* LSE) {
    const int wid = F.wave, r32 = F.lane & 31, hi = F.lane >> 5;
    for (int u = F.vcu; u < 1536; u += F.G) {
        const int g = u >> 9, rem = u & 511, h = rem >> 6, j = rem & 63;
        const int dsh = 2 * g, d = 1 << dsh, c = j >> (6 - dsh), blk = j & ((64 >> dsh) - 1), I0 = blk * 256;
        fa::UnitP U; U.ldq = U.ldk = U.ldv = (size_t)d * EINP;
        const bf16* base = P + (size_t)c * EINP + h * 128;
        U.Q = base + (size_t)I0 * U.ldq; U.K = base + 1024; U.V = base + 2048;
        U.q0 = I0; U.kt0 = I0 ? (I0 >> 6) - 2 : 0; U.kt1 = (I0 >> 6) + 4;
        U.sl2 = exp2f(-(float)(h + 1)) * (float)d * LOG2E; U.c2 = 0.08838834764831845f * LOG2E; U.mask = nullptr;
        fa::f32x16 o[4]; float lse2;
        fa::attn_unit<128, true, true, false, false>(U, F.lds, o, lse2);
        const int row0 = I0 + wid * 32;
        fa::store_o_bf16(o, OA + (size_t)g * S * 1024 + ((size_t)row0 * d + c) * 1024 + h * 128, (size_t)d * 1024, r32, hi);
        if (hi == 0) LSE[((size_t)g * S + (size_t)(row0 + r32) * d + c) * 8 + h] = lse2;
    }
}
__device__ __forceinline__ void merge_a(Frame& F, const bf16* OA, const float* LSE, bf16* O) {
    const int h = F.lane >> 3;
    for (int pos = F.gw; pos < S; pos += F.NGW) {
        const float l0 = LSE[((size_t)0 * S + pos) * 8 + h], l1 = LSE[((size_t)1 * S + pos) * 8 + h], l2 = LSE[((size_t)2 * S + pos) * 8 + h];
        const float mx = fmaxf(l0, fmaxf(l1, l2)); float w0 = exp2f(l0 - mx), w1 = exp2f(l1 - mx), w2 = exp2f(l2 - mx); const float inv = 1.f / (w0 + w1 + w2); w0 *= inv; w1 *= inv; w2 *= inv;
#pragma unroll
        for (int hf = 0; hf < 2; ++hf) { const size_t off = (size_t)pos * 1024 + 16 * F.lane + 8 * hf;
            const v4u a = *(const GAS v4u*)(OA + off), b = *(const GAS v4u*)(OA + (size_t)S * 1024 + off), c = *(const GAS v4u*)(OA + (size_t)2 * S * 1024 + off);
            v4u o;
            o.x = pk2(w0 * bflo(a.x) + w1 * bflo(b.x) + w2 * bflo(c.x), w0 * bfhi(a.x) + w1 * bfhi(b.x) + w2 * bfhi(c.x));
            o.y = pk2(w0 * bflo(a.y) + w1 * bflo(b.y) + w2 * bflo(c.y), w0 * bfhi(a.y) + w1 * bfhi(b.y) + w2 * bfhi(c.y));
            o.z = pk2(w0 * bflo(a.z) + w1 * bflo(b.z) + w2 * bflo(c.z), w0 * bfhi(a.z) + w1 * bfhi(b.z) + w2 * bfhi(c.z));
            o.w = pk2(w0 * bflo(a.w) + w1 * bflo(b.w) + w2 * bflo(c.w), w0 * bfhi(a.w) + w1 * bfhi(b.w) + w2 * bfhi(c.w));
            *(GAS v4u*)(O + (size_t)pos * DM + 16 * F.lane + 8 * hf) = o; }
    }
}
typedef float f32x16 __attribute__((ext_vector_type(16)));
__device__ __forceinline__ unsigned okey(float f) { const unsigned u = __float_as_uint(f); return (u & 0x80000000u) ? ~u : (u | 0x80000000u); }
__device__ __forceinline__ int hswz(int w) { return (w & ~31) | ((w ^ (w >> 5)) & 31); }
__device__ __forceinline__ void find_kth(const LAS unsigned* hq, int target, int lane, int& bin, int& above) {
    unsigned w[32]; unsigned cl = 0;
#pragma unroll
    for (int i = 0; i < 32; ++i) { w[i] = hq[32 * lane + ((i ^ lane) & 31)]; cl += (w[i] & 0xffffu) + (w[i] >> 16); }
    unsigned suf = cl;
#pragma unroll
    for (int off = 1; off < 64; off <<= 1) { const unsigned t = __shfl_down(suf, off); if (lane + off < 64) suf += t; }
    const unsigned long long bal = __ballot((int)suf >= target);
    if (bal == 0ull) { bin = -1; above = 0; return; }
    const int L = 63 - __clzll((long long)bal);
    int cum = (int)(suf - cl), fb = -1, fab = 0;
#pragma unroll
    for (int i = 31; i >= 0; --i) { const int h16 = (int)(w[i] >> 16), l16 = (int)(w[i] & 0xffffu);
        if (fb < 0) { if (cum + h16 >= target) { fb = 2 * i + 1; fab = cum; } else { cum += h16; if (cum + l16 >= target) { fb = 2 * i; fab = cum; } else cum += l16; } } }
    bin = __shfl(fb, L) + 64 * L; above = __shfl(fab, L);
}
__device__ __forceinline__ void indexer_wave(const bf16* P, unsigned* MASKB, LAS unsigned* hist, int wu, int lane) {
    const int r32 = lane & 31, hi = lane >> 5, q = 2 * wu + hi;
    bf16x8 af[4];
    {   const int jq = (r32 >> 2) & 1, head = (r32 & 3) + 4 * (r32 >> 3);
        const bf16* qrow = P + (size_t)(2 * wu + jq) * EINP + 6144 + head * 64 + hi * 8;
#pragma unroll
        for (int ks = 0; ks < 4; ++ks) af[ks] = *(const bf16x8*)(qrow + ks * 16); }
    float wq[16];
    {   const v4u a = *(const GAS v4u*)(P + (size_t)q * EINP + 7232), b = *(const GAS v4u*)(P + (size_t)q * EINP + 7240);
        wq[0] = bflo(a.x); wq[1] = bfhi(a.x); wq[2] = bflo(a.y); wq[3] = bfhi(a.y); wq[4] = bflo(a.z); wq[5] = bfhi(a.z); wq[6] = bflo(a.w); wq[7] = bfhi(a.w);
        wq[8] = bflo(b.x); wq[9] = bfhi(b.x); wq[10] = bflo(b.y); wq[11] = bfhi(b.y); wq[12] = bflo(b.z); wq[13] = bfhi(b.z); wq[14] = bflo(b.w); wq[15] = bfhi(b.w);
#pragma unroll
        for (int r = 0; r < 16; ++r) wq[r] *= 0.03125f; }
    const int nt = (2 * wu + 2 + 31) >> 5, nt2 = (nt + 1) & ~1;
    const bf16* kbase = P + (size_t)r32 * EINP + 7168 + hi * 8;
#define IDX_LOAD(dst, kt_) do { const bf16* kp_ = kbase + (size_t)(kt_) * 32 * EINP; _Pragma("unroll") for (int ks = 0; ks < 4; ++ks) dst[ks] = *(const bf16x8*)(kp_ + ks * 16); } while (0)
#define IDX_SCORE(bc_, key32_) do { f32x16 acc_; _Pragma("unroll") for (int r = 0; r < 16; ++r) acc_[r] = 0.f; \
        _Pragma("unroll") for (int ks = 0; ks < 4; ++ks) acc_ = __builtin_amdgcn_mfma_f32_32x32x16_bf16(af[ks], bc_[ks], acc_, 0, 0, 0); \
        float isc_ = 0.f; _Pragma("unroll") for (int r = 0; r < 16; ++r) isc_ = fmaf(wq[r], fmaxf(acc_[r], 0.f), isc_); key32_ = okey(isc_); } while (0)
#define IDX_ZERO() do { _Pragma("unroll") for (int i = 0; i < 16; ++i) ((LAS v4u*)hist)[i * 64 + lane] = (v4u){0u, 0u, 0u, 0u}; LDS_WAIT(); } while (0)
    bf16x8 bc[4], bn[4];
    IDX_ZERO();
    IDX_LOAD(bc, 0);
    for (int kt = 0; kt < nt; ++kt) {
        if (kt + 1 < nt) IDX_LOAD(bn, kt + 1);
        unsigned key32; IDX_SCORE(bc, key32);
        if (kt * 32 + r32 <= q) { const int bin = (int)(key32 >> 20); __hip_atomic_fetch_add(hist + hi * 2048 + hswz(bin >> 1), 1u << ((bin & 1) * 16), __ATOMIC_RELAXED, __HIP_MEMORY_SCOPE_WORKGROUP); }
#pragma unroll
        for (int ks = 0; ks < 4; ++ks) bc[ks] = bn[ks];
    }
    LDS_WAIT();
    int b0, a0, b1, a1; find_kth(hist, 256, lane, b0, a0); find_kth(hist + 2048, 256, lane, b1, a1);
    const int mybin = hi ? b1 : b0;
    unsigned tau = 0u;
    if (b0 >= 0 || b1 >= 0) {
        IDX_ZERO();
        IDX_LOAD(bc, 0);
        for (int kt = 0; kt < nt; ++kt) {
            if (kt + 1 < nt) IDX_LOAD(bn, kt + 1);
            unsigned key32; IDX_SCORE(bc, key32);
            if (kt * 32 + r32 <= q && (int)(key32 >> 20) == mybin) { const int bin = (int)((key32 >> 8) & 0xfffu); __hip_atomic_fetch_add(hist + hi * 2048 + hswz(bin >> 1), 1u << ((bin & 1) * 16), __ATOMIC_RELAXED, __HIP_MEMORY_SCOPE_WORKGROUP); }
#pragma unroll
            for (int ks = 0; ks < 4; ++ks) bc[ks] = bn[ks];
        }
        LDS_WAIT();
        int s0 = 0, s1 = 0, t0, t1;
        if (b0 >= 0) find_kth(hist, 256 - a0, lane, s0, t0);
        if (b1 >= 0) find_kth(hist + 2048, 256 - a1, lane, s1, t1);
        const int mysub = hi ? s1 : s0;
        tau = mybin < 0 ? 0u : (((unsigned)mybin << 20) | ((unsigned)(mysub < 0 ? 0 : mysub) << 8));
    }
    IDX_LOAD(bc, 0);
    for (int kt = 0; kt < nt2; ++kt) {
        if (kt + 1 < nt2) IDX_LOAD(bn, kt + 1);
        unsigned key32; IDX_SCORE(bc, key32);
        const bool sel = (kt * 32 + r32 <= q) && (key32 >= tau);
        const unsigned long long bal = __ballot(sel);
        if (lane == 0) MASKB[(size_t)(2 * wu) * 512 + kt] = (unsigned)bal;
        if (lane == 32) MASKB[(size_t)(2 * wu + 1) * 512 + kt] = (unsigned)(bal >> 32);
#pragma unroll
        for (int ks = 0; ks < 4; ++ks) bc[ks] = bn[ks];
    }
#undef IDX_LOAD
#undef IDX_SCORE
#undef IDX_ZERO
}
__device__ __forceinline__ void indexer_phase(Frame& F, const bf16* P, unsigned* MASKB) {
    LAS unsigned* hist = (LAS unsigned*)(F.lds + RING_OFF + F.wave * 16384);
    for (int i = 0;; ++i) { const int idx = F.gw + i * F.NGW; if (idx >= 8192) break;
        const int seg = idx >> 11, r = idx & 2047, wu = (seg & 1) ? (seg * 2048 + 2047 - r) : (seg * 2048 + r);
        indexer_wave(P, MASKB, hist, wu, F.lane); }
}
__device__ __forceinline__ void mixer_b_phase(Frame& F, const bf16* P, const unsigned* MASKB, bf16* O) {
    const int wid = F.wave, r32 = F.lane & 31, hi = F.lane >> 5;
    for (int e = F.vcu; e < 512; e += F.G) {
        const int pairidx = e & 255, second = e >> 8, h = pairidx >> 5, j = pairidx & 31, qb = second ? 63 - j : j;
        fa::UnitP U; U.ldq = U.ldk = U.ldv = (size_t)EINP;
        U.Q = P + (size_t)(qb * 256) * EINP + 3072 + h * 128; U.K = P + 4096 + h * 128; U.V = P + 5120 + h * 128;
        U.q0 = qb * 256; U.kt0 = 0; U.kt1 = (qb + 1) * 4;
        U.sl2 = exp2f(-(float)(h + 1)) * LOG2E; U.c2 = 0.08838834764831845f * LOG2E; U.mask = MASKB + (size_t)(qb * 256) * 512;
        fa::f32x16 o[4]; float lse2;
        fa::attn_unit<128, false, true, true, false>(U, F.lds, o, lse2);
        fa::store_o_bf16(o, O + (size_t)(qb * 256 + wid * 32) * DM + 1024 + h * 128, (size_t)DM, r32, hi);
    }
}
__device__ __forceinline__ void kpe_fill(Frame& F, const bf16* P, bf16* KD) {
    const int i = F.lane & 31, hh = (F.lane >> 5) * 4;
    const float inv = exp2f(-0.41524101186092029f * (float)i);
    for (int s = F.gw; s < S; s += F.NGW) {
        const bf16* kp = P + (size_t)s * OINP + 4352;
        const float x1 = __uint_as_float((unsigned)kp[i] << 16), x2 = __uint_as_float((unsigned)kp[32 + i] << 16);
        const float ang = (float)s * inv; const float n = rintf(ang * 0.15915494309189535f);
        float rr = fmaf(-n, 6.2831854820251465f, ang); rr = fmaf(-n, -1.7484555e-07f, rr); const float fr = rr * 0.15915494309189535f;
        const float sn = __builtin_amdgcn_sinf(fr), cs = __builtin_amdgcn_cosf(fr);
        const bf16 o1 = (bf16)f2bf(x1 * cs - x2 * sn), o2 = (bf16)f2bf(x1 * sn + x2 * cs);
#pragma unroll
        for (int h = 0; h < 4; ++h) { bf16* kd = KD + (size_t)s * 1536 + (hh + h) * 192 + 128; kd[i] = o1; kd[32 + i] = o2; }
    }
}
__device__ __forceinline__ void mixer_c_phase(Frame& F, const bf16* P, const float* lam_p, const float* subln_g, float lam_init, float* SCR, bf16* O) {
    const int wid = F.wave, r32 = F.lane & 31, hi = F.lane >> 5;
    const float lam = expf(wave_sum(lam_p[F.lane] * lam_p[64 + F.lane])) - expf(wave_sum(lam_p[128 + F.lane] * lam_p[192 + F.lane])) + lam_init;
    int ord = 0;
    for (int e = F.vcu; e < 512; e += F.G, ++ord) {
        const int pairidx = e & 255, second = e >> 8, h = pairidx >> 5, j = pairidx & 31, qb = second ? 63 - j : j;
        f32x4* scr = (f32x4*)(SCR + (((size_t)(ord & 1) * F.G + blockIdx.x) * 512 + F.tid) * 64);
        for (int sub = 0; sub < 2; ++sub) {
            fa::UnitP U; U.ldq = U.ldk = U.ldv = (size_t)OINP;
            U.Q = P + (size_t)(qb * 256) * OINP + h * 128 + sub * 64; U.K = P + 1024 + h * 128 + sub * 64; U.V = P + 2048 + h * 128;
            U.q0 = qb * 256; U.kt0 = 0; U.kt1 = (qb + 1) * 4;
            U.sl2 = exp2f(-(float)(h + 1)) * LOG2E; U.c2 = 0.125f * LOG2E; U.mask = nullptr;
            fa::f32x16 o[4]; float lse2;
            fa::attn_unit<64, false, true, false, false>(U, F.lds, o, lse2);
            if (sub == 0) {
#pragma unroll
                for (int d = 0; d < 4; ++d)
#pragma unroll
                    for (int k = 0; k < 4; ++k) scr[d * 4 + k] = (f32x4){o[d][4 * k], o[d][4 * k + 1], o[d][4 * k + 2], o[d][4 * k + 3]};
            } else {
                float ss[16];
#pragma unroll
                for (int r = 0; r < 16; ++r) ss[r] = 0.f;
#pragma unroll
                for (int d = 0; d < 4; ++d)
#pragma unroll
                    for (int k = 0; k < 4; ++k) { const f32x4 s1 = scr[d * 4 + k];
#pragma unroll
                        for (int e2 = 0; e2 < 4; ++e2) { const int r = 4 * k + e2; const float v = s1[e2] - lam * o[d][r]; o[d][r] = v; ss[r] += v * v; } }
#pragma unroll
                for (int r = 0; r < 16; ++r) { float t = ss[r]; t += __shfl_xor(t, 1); t += __shfl_xor(t, 2); t += __shfl_xor(t, 4); t += __shfl_xor(t, 8); t += __shfl_xor(t, 16);
                    ss[r] = (1.0f - lam_init) / sqrtf(t * (1.0f / 128.0f) + DIFF_EPS); }
#pragma unroll
                for (int d = 0; d < 4; ++d) { const float gcol = subln_g[d * 32 + r32];
#pragma unroll
                    for (int r = 0; r < 16; ++r) o[d][r] *= ss[r] * gcol; }
                fa::store_o_bf16(o, O + (size_t)(qb * 256 + wid * 32) * DM + h * 128, (size_t)DM, r32, hi);
            }
        }
    }
}
__device__ __forceinline__ void mixer_d_phase(Frame& F, const bf16* QF, const bf16* KD, const bf16* VD, bf16* O) {
    const int wid = F.wave, r32 = F.lane & 31, hi = F.lane >> 5;
    for (int e = F.vcu; e < 512; e += F.G) {
        const int pairidx = e & 255, second = e >> 8, h = pairidx >> 5, j = pairidx & 31, qb = second ? 63 - j : j;
        fa::UnitP U; U.ldq = 1536; U.ldk = 1536; U.ldv = 1024;
        U.Q = QF + (size_t)(qb * 256) * 1536 + h * 192; U.K = KD + h * 192; U.V = VD + h * 128;
        U.q0 = qb * 256; U.kt0 = 0; U.kt1 = (qb + 1) * 4;
        U.sl2 = 0.f; U.c2 = 0.07216878364870322f * LOG2E; U.mask = nullptr;
        fa::f32x16 o[4]; float lse2;
        fa::attn_unit<192, false, false, false, true>(U, F.lds, o, lse2);
        fa::store_o_bf16(o, O + (size_t)(qb * 256 + wid * 32) * DM + 1024 + h * 128, (size_t)DM, r32, hi);
    }
}
struct Args { const float* in[16]; float* out; unsigned char* ws; };
#define GRID_BAR() do { xcd_barrier(bar); int t_ = threadIdx.x; asm volatile("" : "+v"(t_)); F.tid = t_; F.lane = t_ & 63; } while (0)

#define FFN_PHASES(WF)                                                                                                           \
    {   pg8::Gemm g{X, (const bf16*)(WF), S, NGU, DM, DM}; pg8::StaticOrder So; So.init(S, NGU, F.G, (int)blockIdx.x);            \
        pg8::EpiSwiglu E{H, DFF};                                                                                                 \
        pg8::gemm_phase<pg8::EpiSwiglu, pg8::StaticOrder, true, true>(F.lds + RING_OFF, g, So, E); }                              \
    GRID_BAR();                                                                                                                   \
    {   pg8::Gemm g{H, (const bf16*)((WF) + WF_DOWN_OFF), S, DM, DFF, DFF}; pg8::StaticOrder So; So.init(S, DM, F.G, (int)blockIdx.x); \
        pg8::EpiResid E{X, Y, DM, ALPHA, 0.5f};                                                                                   \
        pg8::gemm_phase<pg8::EpiResid, pg8::StaticOrder, true, true>(F.lds + RING_OFF, g, So, E); }                               \
    GRID_BAR();

__global__ void __launch_bounds__(NWAVES * 64, 2) fwd_kernel(Args args) {
    extern __shared__ __attribute__((aligned(16))) unsigned char lds[];
    Frame F;
    F.lds = (LAS unsigned char*)lds;
    F.MISC = (volatile LAS unsigned*)(F.lds + MISC_OFF);
    F.tid = threadIdx.x; F.lane = F.tid & 63; F.wave = __builtin_amdgcn_readfirstlane(F.tid >> 6);
    F.G = gridDim.x; { const int bx = blockIdx.x; F.vcu = (F.G % 8 == 0) ? (bx % 8) * (F.G / 8) + bx / 8 : bx; }
    F.gw = F.vcu * NWAVES + F.wave; F.NGW = F.G * NWAVES;
    unsigned char* ws = args.ws;
    F.ctl = (gu32*)(ws + WS_CTL);
    for (int u = F.tid; u < (LDS_BYTES - LDSCTL_OFF) / 4; u += NWAVES * 64) ((LAS unsigned*)(F.lds + LDSCTL_OFF))[u] = 0u;
    __syncthreads();
    XcdBarrier bar = xcd_barrier_post((unsigned*)(F.ctl + CW_BAR), F.MISC + 8);

    const float* x_in = args.in[0];
    const float* w_gate = args.in[1]; const float* w_up = args.in[2]; const float* w_down = args.in[3];
    const float* ln_g = args.in[4]; const float* ln_b = args.in[5];
    bf16* X = (bf16*)(ws + WS_X); float* Y = (float*)(ws + WS_Y); bf16* H = (bf16*)(ws + WS_HP);
    bf16* P = (bf16*)(ws + WS_HP); bf16* O = (bf16*)(ws + WS_O);
    bf16* OA = (bf16*)(ws + WS_Y); unsigned* MASKB = (unsigned*)(ws + WS_Y + 96 * MiB); float* LSE = (float*)(ws + WS_LSE);
    bf16* QF = (bf16*)(ws + WS_Y); bf16* KD = (bf16*)(ws + WS_Y + 48 * MiB); bf16* VD = (bf16*)(ws + WS_Y + 96 * MiB);
    float* SQQ = (float*)(ws + (size_t)CW_SQQ * 4); float* SQKV = (float*)(ws + (size_t)CW_SQKV * 4);
    unsigned char* WFA = ws + WS_WFA; unsigned char* WFB = ws + WS_WFB;
    constexpr size_t GSZ = (size_t)DM * DFF;

    convert_ffn(F, w_gate + 0 * GSZ, w_up + 0 * GSZ, w_down + 0 * GSZ, WFA);
    convert_ffn(F, w_gate + 1 * GSZ, w_up + 1 * GSZ, w_down + 1 * GSZ, WFB);
    convert_weight<0>(F, args.in[6], DM, EIN, EINP, (bf16*)(ws + WS_WEIN), nullptr);
    convert_weight<0>(F, args.in[7], DM, DM, DM, (bf16*)(ws + WS_WEOUT), nullptr);
    convert_weight<0>(F, args.in[8], DM, OIN, OINP, (bf16*)(ws + WS_WOIN), nullptr);
    convert_weight<0>(F, args.in[9], DM, DM, DM, (bf16*)(ws + WS_WOOUT), nullptr);
    convert_weight<0>(F, args.in[14], 768, 1536, 1536, (bf16*)(ws + WS_WUQ), args.in[12]);
    convert_weight<0>(F, args.in[15], 512, 2048, 2048, (bf16*)(ws + WS_WUKV), args.in[13]);
    convert_x(F, x_in, X);
    GRID_BAR();
    FFN_PHASES(WFA)
    ln_phase<false>(F, Y, ln_g + 0 * DM, ln_b + 0 * DM, X, nullptr);
    convert_ffn(F, w_gate + 2 * GSZ, w_up + 2 * GSZ, w_down + 2 * GSZ, WFA);
    GRID_BAR();
    {
        pg8::Gemm g{X, (const bf16*)(ws + WS_WEIN), S, EINP, DM, DM}; pg8::StaticOrder So; So.init(S, EINP, F.G, (int)blockIdx.x);
        pg8::EpiBf16 E{P, EINP, nullptr, 0, 0, nullptr, 0, 0};
        pg8::gemm_phase<pg8::EpiBf16, pg8::StaticOrder, true, true>(F.lds + RING_OFF, g, So, E); }
    GRID_BAR();
    mixer_a_phase(F, P, OA, LSE);
    __syncthreads();
    indexer_phase(F, P, MASKB);
    GRID_BAR();
    merge_a(F, OA, LSE, O);
    mixer_b_phase(F, P, MASKB, O);
    GRID_BAR();
    {
        pg8::Gemm g{O, (const bf16*)(ws + WS_WEOUT), S, DM, DM, DM}; pg8::StaticOrder So; So.init(S, DM, F.G, (int)blockIdx.x);
        pg8::EpiResid E{X, Y, DM, ALPHA, 1.0f};
        pg8::gemm_phase<pg8::EpiResid, pg8::StaticOrder, true, true>(F.lds + RING_OFF, g, So, E); }
    GRID_BAR();
    ln_phase<false>(F, Y, ln_g + 1 * DM, ln_b + 1 * DM, X, nullptr);
    GRID_BAR();
    FFN_PHASES(WFB)
    ln_phase<false>(F, Y, ln_g + 2 * DM, ln_b + 2 * DM, X, nullptr);
    convert_ffn(F, w_gate + 3 * GSZ, w_up + 3 * GSZ, w_down + 3 * GSZ, WFB);
    GRID_BAR();
    FFN_PHASES(WFA)
    ln_phase<false>(F, Y, ln_g + 3 * DM, ln_b + 3 * DM, X, nullptr);
    GRID_BAR();
    {
        pg8::Gemm g{X, (const bf16*)(ws + WS_WOIN), S, OINP, DM, DM}; pg8::StaticOrder So; So.init(S, OINP, F.G, (int)blockIdx.x);
        pg8::EpiBf16 E{P, OINP, SQQ, 12, 15, SQKV, 15, 17};
        pg8::gemm_phase<pg8::EpiBf16, pg8::StaticOrder, true, true>(F.lds + RING_OFF, g, So, E); }
    GRID_BAR();
    {
        pg8::Gemm g{P + 3072, (const bf16*)(ws + WS_WUQ), S, 1536, 768, OINP}; pg8::StaticOrder So; So.init(S, 1536, F.G, (int)blockIdx.x);
        pg8::EpiScaleRow E{QF, 1536, SQQ, 1.0f / 768.0f, RMS_EPS};
        pg8::gemm_phase<pg8::EpiScaleRow, pg8::StaticOrder, true, true>(F.lds + RING_OFF, g, So, E); }
    {   pg8::Gemm g{P + 3840, (const bf16*)(ws + WS_WUKV), S, 2048, 512, OINP}; pg8::StaticOrder So; So.init(S, 2048, F.G, (int)blockIdx.x);
        pg8::EpiUkv E{KD, VD, SQKV, 1.0f / 512.0f, RMS_EPS};
        pg8::gemm_phase<pg8::EpiUkv, pg8::StaticOrder, true, true>(F.lds + RING_OFF, g, So, E); }
    kpe_fill(F, P, KD);
    GRID_BAR();
    mixer_c_phase(F, P, args.in[10], args.in[11], 0.35550906759096874f, (float*)(ws + WS_HP + 160 * MiB), O);
    mixer_d_phase(F, QF, KD, VD, O);
    GRID_BAR();
    {
        pg8::Gemm g{O, (const bf16*)(ws + WS_WOOUT), S, DM, DM, DM}; pg8::StaticOrder So; So.init(S, DM, F.G, (int)blockIdx.x);
        pg8::EpiResid E{X, Y, DM, ALPHA, 1.0f};
        pg8::gemm_phase<pg8::EpiResid, pg8::StaticOrder, true, true>(F.lds + RING_OFF, g, So, E); }
    GRID_BAR();
    ln_phase<false>(F, Y, ln_g + 4 * DM, ln_b + 4 * DM, X, nullptr);
    GRID_BAR();
    FFN_PHASES(WFB)
    ln_phase<true>(F, Y, ln_g + 5 * DM, ln_b + 5 * DM, nullptr, args.out);
}

extern "C" void kernel_launch(void* const* d_in, const int* in_sizes, int n_in, void* d_out, int out_size, void* d_ws, size_t ws_size, hipStream_t stream) {
    static int grid = 0;
    if (grid == 0) {
        if (n_in != 16 || in_sizes[0] != S * DM || out_size != S * DM || ws_size < WS_END) { fprintf(stderr, "kernel_launch: unexpected shapes (n_in %d, in0 %d, out %d, ws %zu < %zu)\n", n_in, n_in > 0 ? in_sizes[0] : -1, out_size, ws_size, (size_t)WS_END); grid = -1; return; }
        int dev = 0, cus = 0, per_cu = 0;
        if (hipGetDevice(&dev) != hipSuccess || hipDeviceGetAttribute(&cus, hipDeviceAttributeMultiprocessorCount, dev) != hipSuccess) { grid = -1; return; }
        if (hipFuncSetAttribute((const void*)fwd_kernel, hipFuncAttributeMaxDynamicSharedMemorySize, LDS_BYTES) != hipSuccess) { fprintf(stderr, "kernel_launch: hipFuncSetAttribute failed\n"); grid = -1; return; }
        if (hipOccupancyMaxActiveBlocksPerMultiprocessor(&per_cu, (const void*)fwd_kernel, NWAVES * 64, LDS_BYTES) != hipSuccess || per_cu < 1)
            fprintf(stderr, "kernel_launch: occupancy query reports %d workgroups per CU\n", per_cu);
        (void)hipGetLastError();
        grid = cus;
    }
    if (grid < 0) return;
    if (hipMemsetAsync((char*)d_ws + WS_CTL, 0, CTL_ZERO_BYTES, stream) != hipSuccess) return;
    Args a{};
    for (int i = 0; i < 16; ++i) a.in[i] = (const float*)d_in[i];
    a.out = (float*)d_out; a.ws = (unsigned char*)d_ws;
    hipLaunchKernelGGL(fwd_kernel, dim3(grid), dim3(NWAVES * 64), LDS_BYTES, stream, a);
}
```

```cpp
#include <hip/hip_runtime.h>
#include <cstdio>
#include <cstdint>
#include <cmath>
namespace pg8 {
#define PG8_LAS __attribute__((address_space(3)))
typedef unsigned short bf16_t;
typedef short bf16x8 __attribute__((ext_vector_type(8)));
typedef float f32x4 __attribute__((ext_vector_type(4)));
typedef unsigned u32x4 __attribute__((ext_vector_type(4)));
constexpr int BM = 256, BK = 64, HALF = 128, HTB = HALF * BK * 2  , STAGE_BYTES = 8 * HTB, NXCD = 8, WGM = 8;

__host__ __device__ __forceinline__ int lds_byte(int r, int c) { const int st = (r >> 4) * 2 + (c >> 5), rr = r & 15, cc = c & 31, ob = rr * 64 + cc * 2; return st * 1024 + (ob ^ (((ob >> 9) & 1) << 5)); }
__host__ __device__ __forceinline__ void stage_rc(int b, int& R, int& C) { const int st = b / 1024, sb = b % 1024, swz = sb ^ (((sb >> 9) & 1) << 5); R = (st >> 1) * 16 + swz / 64; C = (st & 1) * 32 + (swz % 64) / 2; }
__host__ __device__ __forceinline__ int perm32(int rho) { const int n = rho >> 4, i = rho & 15; return 8 * (i >> 2) + 4 * n + (i & 3); }

struct Unit { int pm, pn; };
struct Gemm { const bf16_t* A; const bf16_t* Bt; int M, N, K, lda; };

struct StaticOrder {
    int nM, nN, nwg, G, c;
    __host__ __device__ void init(int M, int N, int G_, int c_) { nM = M / BM; nN = N / BM; nwg = nM * nN; G = G_; c = c_; }
    __host__ __device__ bool next(int i, Unit& u) const {
        const long L = (long)i * G + c; if (L >= nwg) return false;
        int wgid = (int)L; { const int q = nwg / NXCD, r = nwg % NXCD, xcd = wgid % NXCD, off = wgid / NXCD; wgid = (xcd < r ? xcd * (q + 1) : r * (q + 1) + (xcd - r) * q) + off; }
        const int nig = WGM * nN, gid = wgid / nig, fm = gid * WGM, gsz = (nM - fm) < WGM ? (nM - fm) : WGM;
        u.pm = fm + ((wgid % nig) % gsz); u.pn = (wgid % nig) / gsz; return true;
    }
    __device__ __forceinline__ void a_ready(const Unit&) const {}
    __device__ __forceinline__ void done(const Unit&) const {}
};
__device__ __forceinline__ unsigned cvt_pk_bf16(float lo, float hi) { unsigned r; asm volatile("v_cvt_pk_bf16_f32 %0, %1, %2" : "=v"(r) : "v"(lo), "v"(hi)); return r; }
__device__ __forceinline__ float bf_lo(unsigned w) { return __uint_as_float(w << 16); }
__device__ __forceinline__ float bf_hi(unsigned w) { return __uint_as_float(w & 0xffff0000u); }
typedef unsigned u32x2 __attribute__((ext_vector_type(2)));
__device__ __forceinline__ float silu_f(float x) { return x * __builtin_amdgcn_rcpf(1.0f + __builtin_amdgcn_exp2f(-1.4426950408889634f * x)); }

struct EpiSwiglu {
    static constexpr bool PERM = true, AFTER_DRAIN = false;
    bf16_t* H; int ldh;
    __device__ __forceinline__ void operator()(const f32x4 (&acc)[2][2][4][2], const Unit& u, int wr, int wc, int fr, int fq) const {
        const int row0 = u.pm * BM + wr * 64 + fr, col0 = u.pn * HALF + wc * 32 + 8 * fq;
#pragma unroll
        for (int ai = 0; ai < 2; ++ai)
#pragma unroll
            for (int m = 0; m < 4; ++m) {
                const f32x4 g0 = acc[ai][0][m][0], g1 = acc[ai][0][m][1], u0 = acc[ai][1][m][0], u1 = acc[ai][1][m][1];
                u32x4 w;
                w.x = cvt_pk_bf16(silu_f(g0[0]) * u0[0], silu_f(g0[1]) * u0[1]); w.y = cvt_pk_bf16(silu_f(g0[2]) * u0[2], silu_f(g0[3]) * u0[3]);
                w.z = cvt_pk_bf16(silu_f(g1[0]) * u1[0], silu_f(g1[1]) * u1[1]); w.w = cvt_pk_bf16(silu_f(g1[2]) * u1[2], silu_f(g1[3]) * u1[3]);
                *(u32x4*)(H + (size_t)(row0 + ai * HALF + m * 16) * ldh + col0) = w;
            }
    }
};
struct EpiResid {
    static constexpr bool PERM = false, AFTER_DRAIN = false;
    const bf16_t* X; float* Y; int ldc; float alpha, w;
    __device__ __forceinline__ void operator()(const f32x4 (&acc)[2][2][4][2], const Unit& u, int wr, int wc, int fr, int fq) const {
        const int row0 = u.pm * BM + wr * 64 + fr, col0 = u.pn * BM + wc * 32 + 4 * fq;
#pragma unroll
        for (int ai = 0; ai < 2; ++ai)
#pragma unroll
            for (int m = 0; m < 4; ++m) { const size_t ro = (size_t)(row0 + ai * HALF + m * 16) * ldc + col0;
#pragma unroll
                for (int bj = 0; bj < 2; ++bj)
#pragma unroll
                    for (int n = 0; n < 2; ++n) { const size_t off = ro + bj * HALF + n * 16; const u32x2 xw = *(const u32x2*)(X + off); const f32x4 a = acc[ai][bj][m][n];
                        f32x4 y; y[0] = alpha * bf_lo(xw.x) + w * a[0]; y[1] = alpha * bf_hi(xw.x) + w * a[1]; y[2] = alpha * bf_lo(xw.y) + w * a[2]; y[3] = alpha * bf_hi(xw.y) + w * a[3];
                        *(f32x4*)(Y + off) = y; } }
    }
};
struct EpiBf16 {
    static constexpr bool PERM = true, AFTER_DRAIN = false;
    bf16_t* O; int ldc; float* sqA; int a_lo, a_hi; float* sqB; int b_lo, b_hi;
    __device__ __forceinline__ void operator()(const f32x4 (&acc)[2][2][4][2], const Unit& u, int wr, int wc, int fr, int fq) const {
        const int row0 = u.pm * BM + wr * 64 + fr, col0 = u.pn * BM + wc * 32 + 8 * fq;
        float* sq = (u.pn >= a_lo && u.pn < a_hi) ? sqA : ((u.pn >= b_lo && u.pn < b_hi) ? sqB : nullptr);
#pragma unroll
        for (int ai = 0; ai < 2; ++ai)
#pragma unroll
            for (int m = 0; m < 4; ++m) { bf16_t* rowp = O + (size_t)(row0 + ai * HALF + m * 16) * ldc + col0; float ss = 0.f;
#pragma unroll
                for (int bj = 0; bj < 2; ++bj) { const f32x4 v0 = acc[ai][bj][m][0], v1 = acc[ai][bj][m][1];
                    ss += (v0[0] * v0[0] + v0[1] * v0[1]) + (v0[2] * v0[2] + v0[3] * v0[3]) + (v1[0] * v1[0] + v1[1] * v1[1]) + (v1[2] * v1[2] + v1[3] * v1[3]);
                    u32x4 w; w.x = cvt_pk_bf16(v0[0], v0[1]); w.y = cvt_pk_bf16(v0[2], v0[3]); w.z = cvt_pk_bf16(v1[0], v1[1]); w.w = cvt_pk_bf16(v1[2], v1[3]);
                    *(u32x4*)(rowp + bj * HALF) = w; }
                if (sq) { ss += __shfl_xor(ss, 16); ss += __shfl_xor(ss, 32); if (fq == 0) atomicAdd(sq + row0 + ai * HALF + m * 16, ss); }
            }
    }
};
struct EpiScaleRow {
    static constexpr bool PERM = true, AFTER_DRAIN = false;
    bf16_t* O; int ldc; const float* sq; float invn, eps;
    __device__ __forceinline__ void operator()(const f32x4 (&acc)[2][2][4][2], const Unit& u, int wr, int wc, int fr, int fq) const {
        const int row0 = u.pm * BM + wr * 64 + fr, col0 = u.pn * BM + wc * 32 + 8 * fq;
#pragma unroll
        for (int ai = 0; ai < 2; ++ai)
#pragma unroll
            for (int m = 0; m < 4; ++m) { const int row = row0 + ai * HALF + m * 16; const float rs = 1.0f / sqrtf(sq[row] * invn + eps); bf16_t* rowp = O + (size_t)row * ldc + col0;
#pragma unroll
                for (int bj = 0; bj < 2; ++bj) { const f32x4 v0 = acc[ai][bj][m][0] * rs, v1 = acc[ai][bj][m][1] * rs;
                    u32x4 w; w.x = cvt_pk_bf16(v0[0], v0[1]); w.y = cvt_pk_bf16(v0[2], v0[3]); w.z = cvt_pk_bf16(v1[0], v1[1]); w.w = cvt_pk_bf16(v1[2], v1[3]);
                    *(u32x4*)(rowp + bj * HALF) = w; } }
    }
};
struct EpiUkv {
    static constexpr bool PERM = true, AFTER_DRAIN = false;
    bf16_t* KD; bf16_t* VD; const float* sq; float invn, eps;
    __device__ __forceinline__ void operator()(const f32x4 (&acc)[2][2][4][2], const Unit& u, int wr, int wc, int fr, int fq) const {
        const int row0 = u.pm * BM + wr * 64 + fr, cc = wc * 32 + 8 * fq;
#pragma unroll
        for (int ai = 0; ai < 2; ++ai)
#pragma unroll
            for (int m = 0; m < 4; ++m) { const int row = row0 + ai * HALF + m * 16; const float rs = 1.0f / sqrtf(sq[row] * invn + eps);
#pragma unroll
                for (int bj = 0; bj < 2; ++bj) { const f32x4 v0 = acc[ai][bj][m][0] * rs, v1 = acc[ai][bj][m][1] * rs;
                    u32x4 w; w.x = cvt_pk_bf16(v0[0], v0[1]); w.y = cvt_pk_bf16(v0[2], v0[3]); w.z = cvt_pk_bf16(v1[0], v1[1]); w.w = cvt_pk_bf16(v1[2], v1[3]);
                    bf16_t* dst = bj == 0 ? KD + (size_t)row * 1536 + u.pn * 192 + cc : VD + (size_t)row * 1024 + u.pn * 128 + cc;
                    *(u32x4*)dst = w; } }
    }
};
template <class Epi, class Sched, bool ALIGN_EPI = false, bool SP2 = false>
__device__ __forceinline__ void gemm_phase(PG8_LAS unsigned char* lds, const Gemm g, const Sched& S, const Epi& E) {
    int tid_o_ = threadIdx.x; asm volatile("" : "+v"(tid_o_)); const int tid = tid_o_, wid = __builtin_amdgcn_readfirstlane(tid >> 6), lane = tid & 63, wr = wid >> 2, wc = wid & 3, fr = lane & 15, fq = lane >> 4;
    const int K = g.K, nt = K / BK;
    unsigned voffA[2], voffB[2];
#pragma unroll
    for (int i = 0; i < 2; ++i) { int R, C; stage_rc(tid * 16 + i * 8192, R, C); const int Rb = Epi::PERM ? ((R & ~31) + perm32(R & 31)) : R;
        voffA[i] = (unsigned)(R * g.lda + C) * 2u; voffB[i] = (unsigned)(Rb * K + C) * 2u; }
    const size_t kstep = (size_t)(BK * 2);
    const size_t hstepB = (size_t)HALF * K * 2, hstepA = (size_t)HALF * g.lda * 2;
    const size_t tstepA = 2 * hstepA, tstepB = 2 * hstepB;
    const unsigned ldsw = (unsigned)wid * 1024u;
    const int aoff = lds_byte(wr * 64 + fr, fq * 8), boff = lds_byte(wc * 32 + fr, fq * 8);
#define PG8_SA(b, h) (((b) * 2 + (h)) * HTB)
#define PG8_SB(b, h) ((4 + (b) * 2 + (h)) * HTB)
#define PG8_STAGE(bufoff, gbase, voff) do { _Pragma("unroll") for (int _i = 0; _i < 2; ++_i) \
        __builtin_amdgcn_global_load_lds((const unsigned*)((const char*)(gbase) + (voff)[_i]), (PG8_LAS unsigned*)(lds + (bufoff) + ldsw + _i * 8192), 16, 0, 0); } while (0)
#define PG8_LDA(dst, b, h) do { _Pragma("unroll") for (int m = 0; m < 4; ++m) _Pragma("unroll") for (int k = 0; k < 2; ++k) dst[m][k] = *(const PG8_LAS bf16x8*)(lds + PG8_SA(b, h) + aoff + m * 2048 + k * 1024); } while (0)
#define PG8_LDB(dst, b, h) do { _Pragma("unroll") for (int n = 0; n < 2; ++n) _Pragma("unroll") for (int k = 0; k < 2; ++k) dst[n][k] = *(const PG8_LAS bf16x8*)(lds + PG8_SB(b, h) + boff + n * 2048 + k * 1024); } while (0)
#define PG8_MMA(ai, bj, At, Bt) do { __builtin_amdgcn_s_setprio(1); _Pragma("unroll") for (int m = 0; m < 4; ++m) _Pragma("unroll") for (int n = 0; n < 2; ++n) _Pragma("unroll") for (int k = 0; k < 2; ++k) \
        acc[ai][bj][m][n] = __builtin_amdgcn_mfma_f32_16x16x32_bf16(Bt[n][k], At[m][k], acc[ai][bj][m][n], 0, 0, 0); __builtin_amdgcn_s_setprio(0); } while (0)
#define PG8_WAIT_V(n) asm volatile("s_waitcnt vmcnt(" #n ")" ::: "memory")
#define PG8_WAIT_L(n) asm volatile("s_waitcnt lgkmcnt(" #n ")" ::: "memory")
#define PG8_BAR __builtin_amdgcn_s_barrier()
#define PG8_SCHED __builtin_amdgcn_sched_barrier(0)
    Unit cur, nxt; int ui = 0;
    if (!S.next(0, cur)) return;
    f32x4 acc[2][2][4][2];
#pragma unroll
    for (int a = 0; a < 2; ++a)
#pragma unroll
        for (int b = 0; b < 2; ++b)
#pragma unroll
            for (int m = 0; m < 4; ++m)
#pragma unroll
                for (int n = 0; n < 2; ++n) acc[a][b][m][n] = (f32x4){0.f, 0.f, 0.f, 0.f};
    bf16x8 At[4][2], B0[2][2], B1[2][2];
    const char* cA = (const char*)g.A + (size_t)cur.pm * tstepA; const char* cB = (const char*)g.Bt + (size_t)cur.pn * tstepB;
    S.a_ready(cur);
    if constexpr (SP2) {
        PG8_STAGE(PG8_SB(0, 0), cB, voffB); PG8_STAGE(PG8_SB(0, 1), cB + hstepB, voffB); PG8_STAGE(PG8_SA(0, 0), cA, voffA); PG8_STAGE(PG8_SA(0, 1), cA + hstepA, voffA);
        if (wr == 1) PG8_BAR;
        PG8_WAIT_V(2); PG8_BAR;
        PG8_STAGE(PG8_SB(1, 0), cB + kstep, voffB); PG8_STAGE(PG8_SA(1, 0), cA + kstep, voffA); PG8_STAGE(PG8_SB(1, 1), cB + hstepB + kstep, voffB);
        PG8_WAIT_V(6); PG8_BAR;
    } else {
        PG8_STAGE(PG8_SB(0, 0), cB, voffB); PG8_STAGE(PG8_SA(0, 0), cA, voffA); PG8_STAGE(PG8_SB(0, 1), cB + hstepB, voffB); PG8_STAGE(PG8_SA(0, 1), cA + hstepA, voffA);
        if (wr == 1) PG8_BAR;
        PG8_WAIT_V(4); PG8_BAR;
        PG8_STAGE(PG8_SB(1, 0), cB + kstep, voffB); PG8_STAGE(PG8_SA(1, 0), cA + kstep, voffA); PG8_STAGE(PG8_SB(1, 1), cB + hstepB + kstep, voffB);
        PG8_WAIT_V(6); PG8_BAR;
    }
    for (;;) {
        const bool has_next = S.next(ui + 1, nxt);
        const char* nA = has_next ? (const char*)g.A + (size_t)nxt.pm * tstepA : cA; const char* nB = has_next ? (const char*)g.Bt + (size_t)nxt.pn * tstepB : cB;
        for (int t = 0; t < nt; t += 2) {
            const bool last = (t == nt - 2);
            const char* a1 = cA + (size_t)(t + 1) * kstep;
            const char* a2 = last ? nA : cA + (size_t)(t + 2) * kstep; const char* b2 = last ? nB : cB + (size_t)(t + 2) * kstep;
            const char* a3 = a2 + kstep; const char* b3 = b2 + kstep;
            if (last && has_next) S.a_ready(nxt);
            if constexpr (SP2) {
            PG8_LDB(B0, 0, 0); PG8_LDB(B1, 0, 1); PG8_SCHED; PG8_LDA(At, 0, 0); PG8_STAGE(PG8_SA(1, 1), a1 + hstepA, voffA);
            PG8_WAIT_V(8); PG8_WAIT_L(0); PG8_BAR; PG8_MMA(0, 0, At, B0); PG8_MMA(0, 1, At, B1); PG8_BAR; PG8_SCHED;
            PG8_LDA(At, 0, 1); PG8_STAGE(PG8_SB(0, 0), b2, voffB); PG8_STAGE(PG8_SB(0, 1), b2 + hstepB, voffB); PG8_STAGE(PG8_SA(0, 0), a2, voffA);
            PG8_WAIT_V(8); PG8_WAIT_L(0); PG8_BAR; PG8_MMA(1, 0, At, B0); PG8_MMA(1, 1, At, B1); PG8_BAR; PG8_SCHED;
            PG8_LDB(B0, 1, 0); PG8_LDB(B1, 1, 1); PG8_SCHED; PG8_LDA(At, 1, 0); PG8_STAGE(PG8_SA(0, 1), a2 + hstepA, voffA);
            PG8_WAIT_V(8); PG8_WAIT_L(0); PG8_BAR; PG8_MMA(0, 0, At, B0); PG8_MMA(0, 1, At, B1); PG8_BAR; PG8_SCHED;
            PG8_LDA(At, 1, 1); PG8_STAGE(PG8_SB(1, 0), b3, voffB); PG8_STAGE(PG8_SB(1, 1), b3 + hstepB, voffB); PG8_STAGE(PG8_SA(1, 0), a3, voffA);
            PG8_WAIT_V(8); PG8_WAIT_L(0); PG8_BAR; PG8_MMA(1, 0, At, B0); PG8_MMA(1, 1, At, B1); PG8_BAR; PG8_SCHED;
            } else {
            PG8_LDB(B0, 0, 0); PG8_SCHED; PG8_LDA(At, 0, 0); PG8_STAGE(PG8_SA(1, 1), a1 + hstepA, voffA);
            PG8_WAIT_L(8); PG8_BAR; PG8_WAIT_L(0); PG8_MMA(0, 0, At, B0); PG8_BAR; PG8_SCHED;
            PG8_LDB(B1, 0, 1); PG8_STAGE(PG8_SB(0, 0), b2, voffB);
            PG8_BAR; PG8_WAIT_L(0); PG8_MMA(0, 1, At, B1); PG8_BAR;
            PG8_LDA(At, 0, 1); PG8_STAGE(PG8_SA(0, 0), a2, voffA);
            PG8_BAR; PG8_WAIT_L(0); PG8_MMA(1, 0, At, B0); PG8_BAR; PG8_SCHED;
            PG8_STAGE(PG8_SB(0, 1), b2 + hstepB, voffB);
            PG8_WAIT_V(6); PG8_BAR; PG8_MMA(1, 1, At, B1); PG8_BAR;
            PG8_LDB(B0, 1, 0); PG8_SCHED; PG8_LDA(At, 1, 0); PG8_STAGE(PG8_SA(0, 1), a2 + hstepA, voffA);
            PG8_WAIT_L(8); PG8_BAR; PG8_WAIT_L(0); PG8_MMA(0, 0, At, B0); PG8_BAR; PG8_SCHED;
            PG8_LDB(B1, 1, 1); PG8_STAGE(PG8_SB(1, 0), b3, voffB);
            PG8_BAR; PG8_WAIT_L(0); PG8_MMA(0, 1, At, B1); PG8_BAR;
            PG8_LDA(At, 1, 1); PG8_STAGE(PG8_SA(1, 0), a3, voffA);
            PG8_BAR; PG8_WAIT_L(0); PG8_MMA(1, 0, At, B0); PG8_BAR; PG8_SCHED;
            PG8_STAGE(PG8_SB(1, 1), b3 + hstepB, voffB);
            PG8_WAIT_V(6); PG8_BAR; PG8_MMA(1, 1, At, B1); PG8_BAR;
            }
        }
        if constexpr (ALIGN_EPI) { if (wr == 0) PG8_BAR; }
        if constexpr (!Epi::AFTER_DRAIN) { E(acc, cur, wr, wc, fr, fq); S.done(cur); }
        if (!has_next) break;
#pragma unroll
        for (int a = 0; a < 2; ++a)
#pragma unroll
            for (int b = 0; b < 2; ++b)
#pragma unroll
                for (int m = 0; m < 4; ++m)
#pragma unroll
                    for (int n = 0; n < 2; ++n) acc[a][b][m][n] = (f32x4){0.f, 0.f, 0.f, 0.f};
        cur = nxt; cA = nA; cB = nB; ++ui;
        if constexpr (ALIGN_EPI) { if (wr == 1) PG8_BAR; }
    }
    PG8_WAIT_V(0);
    if constexpr (!ALIGN_EPI) { if (wr == 0) PG8_BAR; }
    PG8_BAR;
    if constexpr (Epi::AFTER_DRAIN) { E.fused(acc, cur, wr, wc, fr, fq, lds, wid, lane); S.done(cur); }
#undef PG8_SA
#undef PG8_SB
#undef PG8_STAGE
#undef PG8_LDA
#undef PG8_LDB
#undef PG8_MMA
#undef PG8_WAIT_V
#undef PG8_WAIT_L
#undef PG8_BAR
#undef PG8_SCHED
}
}

constexpr int S = 16384, DM = 2048, DFF = 5632, NGU = 2 * DFF;
constexpr int EIN = 7248, EINP = 7424, OIN = 4416, OINP = 4608;
constexpr float ALPHA = 1.4142135623730951f;
constexpr float LN_EPS = 1e-5f, RMS_EPS = 1e-6f, DIFF_EPS = 1e-5f;
constexpr int NWAVES = 8;
constexpr size_t MiB = 1u << 20;
constexpr size_t WS_CTL = 0, CTL_ZERO_BYTES = 1 * MiB;
constexpr size_t WS_LSE = 1 * MiB;
constexpr size_t WS_WFA = 4 * MiB, WS_WFB = 70 * MiB;
constexpr size_t WF_DOWN_OFF = (size_t)NGU * DM * 2;
constexpr size_t WS_WEIN = 136 * MiB, WS_WOIN = 165 * MiB, WS_WEOUT = 183 * MiB, WS_WOOUT = 191 * MiB, WS_WUQ = 199 * MiB, WS_WUKV = 202 * MiB;
constexpr size_t WS_X = 204 * MiB;
constexpr size_t WS_Y = 268 * MiB;
constexpr size_t WS_HP = 396 * MiB;
constexpr size_t WS_O = 628 * MiB;
constexpr size_t WS_END = 692 * MiB;
constexpr int CW_BAR = 4096;
constexpr int CW_QCD = 2048;
constexpr int CW_NRM = 1024;
constexpr int CW_SQQ = 65536, CW_SQKV = 65536 + 16384;
constexpr int RING_OFF = 0, RING_BYTES = 131072;
constexpr int KI_RING_OFF = RING_BYTES;
constexpr int LDSCTL_OFF = RING_BYTES + 16384, MISC_OFF = LDSCTL_OFF + 320;
constexpr int LDS_BYTES = 151552;

#define GAS __attribute__((address_space(1)))
#define LAS __attribute__((address_space(3)))
typedef unsigned short bf16;
typedef unsigned v4u __attribute__((ext_vector_type(4)));
typedef unsigned v2u __attribute__((ext_vector_type(2)));
typedef float f32x4 __attribute__((ext_vector_type(4)));
typedef short bf16x8 __attribute__((ext_vector_type(8)));
typedef GAS unsigned gu32;
#define LDS_WAIT() asm volatile("s_waitcnt lgkmcnt(0)" ::: "memory")
#define VM_WAIT() asm volatile("s_waitcnt vmcnt(0)" ::: "memory")
__device__ __forceinline__ unsigned f2bf(float f) { unsigned u = __builtin_bit_cast(unsigned, f); return (u + 0x7fffu + ((u >> 16) & 1u)) >> 16; }
__device__ __forceinline__ unsigned pk2(float lo, float hi) { return f2bf(lo) | (f2bf(hi) << 16); }
__device__ __forceinline__ float bflo(unsigned w) { return __uint_as_float(w << 16); }
__device__ __forceinline__ float bfhi(unsigned w) { return __uint_as_float(w & 0xffff0000u); }
#define XB_TMO      128
#define XB_XCNT(j)  (256  + 64 * (j))
#define XB_XSUB(j)  (1280 + 64 * (j))
#define XB_XGEN(j)  (2304 + 64 * (j))
#define XB_TOP      3328
#define XB_TOPGEN   3392
#define XCD_BAR_WORDS 3456
#define XB_SPIN_CAP (1u << 18)

__device__ __forceinline__ unsigned xb_ld(unsigned* p)              { return __hip_atomic_load(p, __ATOMIC_RELAXED, __HIP_MEMORY_SCOPE_AGENT); }
__device__ __forceinline__ unsigned xb_add(unsigned* p, unsigned v) { return __hip_atomic_fetch_add(p, v, __ATOMIC_RELAXED, __HIP_MEMORY_SCOPE_AGENT); }
__device__ __forceinline__ unsigned xb_xcc_id() { return (unsigned)__builtin_amdgcn_s_getreg((3 << 11) | 20) & 0xFu; }
#define XB_SPIN(cond, bar) do { unsigned _sp = 0; while (cond) { __builtin_amdgcn_s_sleep(1); \
    if ((++_sp & 255u) == 0u) { if (xb_ld(&(bar)[XB_TMO])) break; if (_sp > XB_SPIN_CAP) { atomicAdd(&(bar)[XB_TMO], 1u); break; } } } } while (0)

struct XcdBarrier {
    unsigned* bar; unsigned x;
    volatile LAS unsigned* st;
};

__device__ __forceinline__ XcdBarrier xcd_barrier_post(unsigned* bar, volatile LAS unsigned* st) {
    XcdBarrier b; b.bar = bar; b.x = xb_xcc_id(); b.st = st;
    if (threadIdx.x == 0) (void)xb_add(&bar[XB_XCNT(b.x)], 1u);
    return b;
}
__device__ __forceinline__ void xcd_barrier_complete(unsigned* bar, unsigned x, unsigned& nloc, unsigned& nx) {
    const unsigned G = gridDim.x * gridDim.y * gridDim.z;
    unsigned sum, cnt, mine, sp = 0u;
    for (;;) {
        sum = 0u; cnt = 0u; mine = 0u;
#pragma unroll
        for (unsigned j = 0; j < 16; ++j) { const unsigned c = xb_ld(&bar[XB_XCNT(j)]); sum += c; cnt += (c > 0u) ? 1u : 0u; mine = (j == x) ? c : mine; }
        if (sum == G) break;
        __builtin_amdgcn_s_sleep(1);
        if ((++sp & 255u) == 0u) { if (xb_ld(&bar[XB_TMO])) break; if (sp > XB_SPIN_CAP) { atomicAdd(&bar[XB_TMO], 1u); break; } }
    }
    nloc = mine > 0u ? mine : 1u; nx = cnt > 0u ? cnt : 1u;
}

__device__ __forceinline__ void xcd_barrier(const XcdBarrier& b) {
    asm volatile("s_waitcnt vmcnt(0)" ::: "memory");
    __syncthreads();
    if (threadIdx.x == 0) {
        unsigned* bar = b.bar;
        __builtin_amdgcn_s_waitcnt(0);
        unsigned nloc = b.st[0], nx = b.st[1];
        if (nloc == 0u) { xcd_barrier_complete(bar, b.x, nloc, nx); b.st[0] = nloc; b.st[1] = nx; }
        const unsigned old = xb_add(&bar[XB_XSUB(b.x)], 1u);
        const unsigned gen = old / nloc;
        if (old + 1u == (gen + 1u) * nloc) {
            __builtin_amdgcn_fence(__ATOMIC_RELEASE, "agent");
            asm volatile("s_waitcnt vmcnt(0)" ::: "memory");
            const unsigned og = xb_add(&bar[XB_TOP], 1u);
            const unsigned tg = og / nx;
            if (og + 1u == (tg + 1u) * nx) xb_add(&bar[XB_TOPGEN], 1u);
            else XB_SPIN(xb_ld(&bar[XB_TOPGEN]) == tg, bar);
            __builtin_amdgcn_fence(__ATOMIC_ACQUIRE, "agent");
            xb_add(&bar[XB_XGEN(b.x)], 1u);
            asm volatile("s_waitcnt vmcnt(0)" ::: "memory");
        } else {
            XB_SPIN(xb_ld(&bar[XB_XGEN(b.x)]) == gen, bar);
            __builtin_amdgcn_fence(__ATOMIC_ACQUIRE, "agent");
            asm volatile("s_waitcnt vmcnt(0)" ::: "memory");
        }
    }
    __syncthreads();
}

namespace fa {
typedef short bf16x8 __attribute__((ext_vector_type(8)));
typedef short s16x4 __attribute__((ext_vector_type(4)));
typedef float f32x16 __attribute__((ext_vector_type(16)));
typedef unsigned u32x4 __attribute__((ext_vector_type(4)));
typedef unsigned u32x2 __attribute__((ext_vector_type(2)));
typedef unsigned short bf16;
#define FA_SBAR() __builtin_amdgcn_sched_barrier(0)
__device__ __forceinline__ int crow(int r, int hi) { return (r & 3) + 8 * (r >> 2) + 4 * hi; }
__device__ __forceinline__ unsigned cvtpk(float lo, float hi) { unsigned r; asm volatile("v_cvt_pk_bf16_f32 %0, %1, %2" : "=v"(r) : "v"(lo), "v"(hi)); return r; }
__device__ __forceinline__ int v_st(int k, int c) { const int kk = (k & ~0xC) | ((k & 4) << 1) | ((k & 8) >> 1); return ((kk >> 3) * 4 + (c >> 5)) * 512 + ((kk & 7) * 32 + (c & 31)) * 2; }
__device__ __forceinline__ int v_rd_base(int lane) { return ((lane & 3) << 3) | (((lane >> 2) & 3) << 6) | (((lane >> 4) & 1) << 5) | (((lane >> 5) & 1) << 8); }
constexpr int v_rd_off(int d0, int ks, int half) { return d0 * 512 + ks * 4096 + half * 2048; }
template <int OFF> __device__ __forceinline__ s16x4 tr_read(int vb) { s16x4 r; asm volatile("ds_read_b64_tr_b16 %0, %1 offset:%2" : "=&v"(r) : "v"(vb), "i"(OFF) : "memory"); return r; }
template <int D0> __device__ __forceinline__ void pv_one(f32x16& od, int vb, bf16x8 pa0, bf16x8 pa1, bf16x8 pa2, bf16x8 pa3) {
    const s16x4 l0 = tr_read<v_rd_off(D0, 0, 0)>(vb), h0 = tr_read<v_rd_off(D0, 0, 1)>(vb), l1 = tr_read<v_rd_off(D0, 1, 0)>(vb), h1 = tr_read<v_rd_off(D0, 1, 1)>(vb);
    const s16x4 l2 = tr_read<v_rd_off(D0, 2, 0)>(vb), h2 = tr_read<v_rd_off(D0, 2, 1)>(vb), l3 = tr_read<v_rd_off(D0, 3, 0)>(vb), h3 = tr_read<v_rd_off(D0, 3, 1)>(vb);
    asm volatile("s_waitcnt lgkmcnt(0)" ::: "memory"); FA_SBAR();
#define FA_PK(L, H) (bf16x8){L[0], L[1], L[2], L[3], H[0], H[1], H[2], H[3]}
    od = __builtin_amdgcn_mfma_f32_32x32x16_bf16(pa0, FA_PK(l0, h0), od, 0, 0, 0);
    od = __builtin_amdgcn_mfma_f32_32x32x16_bf16(pa1, FA_PK(l1, h1), od, 0, 0, 0);
    od = __builtin_amdgcn_mfma_f32_32x32x16_bf16(pa2, FA_PK(l2, h2), od, 0, 0, 0);
    od = __builtin_amdgcn_mfma_f32_32x32x16_bf16(pa3, FA_PK(l3, h3), od, 0, 0, 0);
#undef FA_PK
}
__device__ __forceinline__ void pv_d0(f32x16* o, int vb, bf16x8 pa0, bf16x8 pa1, bf16x8 pa2, bf16x8 pa3) {
    pv_one<0>(o[0], vb, pa0, pa1, pa2, pa3); pv_one<1>(o[1], vb, pa0, pa1, pa2, pa3); pv_one<2>(o[2], vb, pa0, pa1, pa2, pa3); pv_one<3>(o[3], vb, pa0, pa1, pa2, pa3);
}
struct UnitP {
    const bf16* Q; size_t ldq;
    const bf16* K; size_t ldk;
    const bf16* V; size_t ldv;
    int q0;
    int kt0, kt1;
    float sl2;
    float c2;
    const unsigned* mask;
};
constexpr int WIN = 128;
constexpr float THR2 = 11.5f;
template <int DQK, bool WINDOW, bool ALIBI, bool MASK, bool ROPEQ>
__device__ __forceinline__ void attn_unit(const UnitP& U, LAS unsigned char* lds, f32x16 (&o)[4], float& lse2) {
    constexpr int KROWB = DQK * 2, SHM_V = 16384, SHM_K = 64 * KROWB, KOFF = 2 * SHM_V, WSOFF = KOFF + 2 * 64 * 192 * 2;
    constexpr int KCH = DQK / 8, KPT = 64 * KCH / 512, ND0 = DQK / 16;
    int tid_o_ = threadIdx.x; asm volatile("" : "+v"(tid_o_)); const int tid = tid_o_, wid = __builtin_amdgcn_readfirstlane(tid >> 6), lane = tid & 63, r32 = lane & 31, hi = lane >> 5;
    LAS float* wsf = (LAS float*)(lds + WSOFF + wid * 256);
    float m_reg = -1e30f, l_reg = 0.f;
#pragma unroll
    for (int d = 0; d < 4; ++d)
#pragma unroll
        for (int r = 0; r < 16; ++r) o[d][r] = 0.f;
    bf16x8 qr[ND0];
    const int qi = U.q0 + wid * 32 + r32;
    {   const bf16* Qw = U.Q + (size_t)(wid * 32 + r32) * U.ldq + hi * 8;
#pragma unroll
        for (int d0 = 0; d0 < ND0; ++d0) qr[d0] = *(const bf16x8*)(Qw + d0 * 16);
        if constexpr (ROPEQ) {
#pragma unroll
            for (int pb = 0; pb < 2; ++pb) { bf16x8 a = qr[ND0 - 4 + pb], b = qr[ND0 - 2 + pb];
#pragma unroll
                for (int e = 0; e < 8; ++e) { const int fi = pb * 16 + hi * 8 + e; const float inv = __builtin_amdgcn_exp2f(-0.41524101186092029f * (float)fi);
                    const float ang = (float)qi * inv; const float n = rintf(ang * 0.15915494309189535f);
                    float rr = fmaf(-n, 6.2831854820251465f, ang); rr = fmaf(-n, -1.7484555e-07f, rr); const float fr = rr * 0.15915494309189535f;
                    const float sn = __builtin_amdgcn_sinf(fr), cs = __builtin_amdgcn_cosf(fr);
                    const float x1 = __uint_as_float((unsigned)(unsigned short)a[e] << 16), x2 = __uint_as_float((unsigned)(unsigned short)b[e] << 16);
                    const unsigned w = cvtpk(x1 * cs - x2 * sn, x1 * sn + x2 * cs); a[e] = (short)(w & 0xffffu); b[e] = (short)(w >> 16); }
                qr[ND0 - 4 + pb] = a; qr[ND0 - 2 + pb] = b; }
        }
    }
    unsigned kgo[KPT], vgo[2];
#pragma unroll
    for (int i_ = 0; i_ < KPT; ++i_) { const int p_ = (wid + 8 * i_) * 1024 + lane * 16, row_ = p_ / KROWB, wi_ = (p_ % KROWB) ^ ((row_ & 7) << 4); kgo[i_] = (unsigned)((size_t)row_ * U.ldk * 2 + wi_); }
#pragma unroll
    for (int i_ = 0; i_ < 2; ++i_) { const int p_ = (wid + 8 * i_) * 1024 + lane * 16, sub_ = p_ >> 9, rem_ = p_ & 511, kk_ = (sub_ >> 2) * 8 + (rem_ >> 6), k_ = (kk_ & ~0xC) | ((kk_ & 4) << 1) | ((kk_ & 8) >> 1), col_ = (sub_ & 3) * 32 + ((rem_ & 63) >> 1);
        vgo[i_] = (unsigned)(((size_t)k_ * U.ldv + col_) * 2); }
#define FA_DMA(k0_, b_) do { const char* kg_ = (const char*)U.K + (size_t)(k0_) * U.ldk * 2; const char* vg_ = (const char*)U.V + (size_t)(k0_) * U.ldv * 2; \
        _Pragma("unroll") for (int i_ = 0; i_ < KPT; ++i_) __builtin_amdgcn_global_load_lds((const unsigned*)(kg_ + kgo[i_]), (LAS unsigned*)(lds + KOFF + (b_) * SHM_K + (wid + 8 * i_) * 1024), 16, 0, 0); \
        _Pragma("unroll") for (int i_ = 0; i_ < 2; ++i_) __builtin_amdgcn_global_load_lds((const unsigned*)(vg_ + vgo[i_]), (LAS unsigned*)(lds + (b_) * SHM_V + (wid + 8 * i_) * 1024), 16, 0, 0); } while (0)
    const int vb0 = (int)(unsigned)(uintptr_t)lds + v_rd_base(lane);
    const int NT = U.kt1 - U.kt0;
    const int qw0 = U.q0 + wid * 32, qw1 = qw0 + 31;
    u32x2 mw = {0u, 0u}, mwn = {0u, 0u};
    const unsigned* mrow = MASK ? U.mask + (size_t)(wid * 32 + r32) * 512 : nullptr;
    FA_DMA(U.kt0 * 64, 0); if constexpr (MASK) mw = *(const u32x2*)(mrow + U.kt0 * 2);
    asm volatile("s_waitcnt vmcnt(0)" ::: "memory"); __syncthreads();
    for (int jt = 0; jt < NT; ++jt) {
        const int k0 = (U.kt0 + jt) * 64, buf = jt & 1;
        const bool more = jt + 1 < NT;
        if (more) { FA_DMA(k0 + 64, buf ^ 1); if constexpr (MASK) mwn = *(const u32x2*)(mrow + (k0 >> 5) + 2); }
        const bool active = (k0 <= qw1) && (!WINDOW || (k0 + 63 >= qw0 - WIN));
        if (active) {
            f32x16 p0, p1;
#pragma unroll
            for (int r = 0; r < 16; ++r) { p0[r] = 0.f; p1[r] = 0.f; }
            const LAS unsigned char* kb = lds + KOFF + buf * SHM_K + r32 * KROWB; const int lp = (hi * 16) ^ ((r32 & 7) << 4);
            const LAS unsigned char* kq[4] = {kb + lp, kb + (lp ^ 32), kb + (lp ^ 64), kb + (lp ^ 96)};
#pragma unroll
            for (int d0 = 0; d0 < ND0; ++d0) {
                const bf16x8 b0 = *(const LAS bf16x8*)(kq[d0 & 3] + (d0 >> 2) * 128), b1 = *(const LAS bf16x8*)(kq[d0 & 3] + (d0 >> 2) * 128 + 32 * KROWB);
                p0 = __builtin_amdgcn_mfma_f32_32x32x16_bf16(b0, qr[d0], p0, 0, 0, 0);
                p1 = __builtin_amdgcn_mfma_f32_32x32x16_bf16(b1, qr[d0], p1, 0, 0, 0);
                if ((d0 & 3) == 3) FA_SBAR(); }
            const int lim = qi - k0 - 4 * hi;
            const float tb = ALIBI ? U.sl2 * (float)(-lim) : 0.f;
#pragma unroll
            for (int r = 0; r < 16; ++r) { const int c = (r & 3) + 8 * (r >> 2);
                if constexpr (ALIBI) { p0[r] = fmaf(p0[r], U.c2, fmaf((float)c, U.sl2, tb)); p1[r] = fmaf(p1[r], U.c2, fmaf((float)(c + 32), U.sl2, tb)); }
                else { p0[r] *= U.c2; p1[r] *= U.c2; } }
            const bool need_mask = (k0 + 63 > qw0) || (WINDOW && (k0 < qw1 - WIN));
            if (need_mask) {
#pragma unroll
                for (int r = 0; r < 16; ++r) { const int c = (r & 3) + 8 * (r >> 2); const int d0_ = lim - c, d1_ = lim - c - 32;
                    const bool ok0 = WINDOW ? ((unsigned)d0_ <= (unsigned)WIN) : (d0_ >= 0), ok1 = WINDOW ? ((unsigned)d1_ <= (unsigned)WIN) : (d1_ >= 0);
                    p0[r] = ok0 ? p0[r] : -INFINITY; p1[r] = ok1 ? p1[r] : -INFINITY; }
            }
            if constexpr (MASK) { const unsigned w0 = mw.x >> (4 * hi), w1 = mw.y >> (4 * hi);
#pragma unroll
                for (int r = 0; r < 16; ++r) { const int c = (r & 3) + 8 * (r >> 2);
                    const unsigned b0 = (unsigned)((int)(w0 << (31 - c)) >> 31), b1 = (unsigned)((int)(w1 << (31 - c)) >> 31);
                    p0[r] = __uint_as_float((__float_as_uint(p0[r]) & b0) | (0xff800000u & ~b0)); p1[r] = __uint_as_float((__float_as_uint(p1[r]) & b1) | (0xff800000u & ~b1)); }
            }
            FA_SBAR();
            float pmax = p0[0];
#pragma unroll
            for (int r = 1; r < 16; ++r) pmax = fmaxf(pmax, p0[r]);
#pragma unroll
            for (int r = 0; r < 16; ++r) pmax = fmaxf(pmax, p1[r]);
            { auto rr = __builtin_amdgcn_permlane32_swap(__float_as_uint(pmax), __float_as_uint(pmax), false, false); pmax = fmaxf(__uint_as_float(rr[0]), __uint_as_float(rr[1])); }
            float mn, alpha;
            if (__builtin_expect(__all(pmax - m_reg <= THR2), 1)) { mn = m_reg; alpha = 1.f; }
            else { mn = fmaxf(m_reg, pmax); alpha = __builtin_amdgcn_exp2f(m_reg - mn); m_reg = mn; }
            float ps = 0.f;
#pragma unroll
            for (int r = 0; r < 16; ++r) { p0[r] = __builtin_amdgcn_exp2f(p0[r] - mn); p1[r] = __builtin_amdgcn_exp2f(p1[r] - mn); ps += p0[r] + p1[r]; }
            { auto rr = __builtin_amdgcn_permlane32_swap(__float_as_uint(ps), __float_as_uint(ps), false, false); ps = __uint_as_float(rr[0]) + __uint_as_float(rr[1]); }
            l_reg = l_reg * alpha + ps;
            FA_SBAR();
            bf16x8 pa0, pa1, pa2, pa3;
#define FA_PK4(P, BASE, OUT) do { unsigned a0 = cvtpk(P[BASE + 0], P[BASE + 1]), a1 = cvtpk(P[BASE + 2], P[BASE + 3]);   \
    unsigned b0 = cvtpk(P[BASE + 4], P[BASE + 5]), b1 = cvtpk(P[BASE + 6], P[BASE + 7]);                              \
    auto r0 = __builtin_amdgcn_permlane32_swap(a0, b0, false, false); auto r1 = __builtin_amdgcn_permlane32_swap(a1, b1, false, false); \
    u32x4 w = {r0[0], r1[0], r0[1], r1[1]}; OUT = *reinterpret_cast<bf16x8*>(&w); } while (0)
            FA_PK4(p0, 0, pa0); FA_PK4(p0, 8, pa1); FA_PK4(p1, 0, pa2); FA_PK4(p1, 8, pa3);
#undef FA_PK4
            FA_SBAR();
            if (__any(alpha < 1.f)) { if (hi == 0) wsf[r32] = alpha; asm volatile("s_waitcnt lgkmcnt(0)" ::: "memory");
#pragma unroll
                for (int r = 0; r < 16; ++r) { const float al = wsf[crow(r, hi)];
#pragma unroll
                    for (int d = 0; d < 4; ++d) o[d][r] *= al; }
                asm volatile("s_waitcnt lgkmcnt(0)" ::: "memory"); }
            pv_d0(o, vb0 + buf * SHM_V, pa0, pa1, pa2, pa3);
        }
        if (more) { if constexpr (MASK) mw = mwn; }
        asm volatile("s_waitcnt vmcnt(0)" ::: "memory");
        __syncthreads();
    }
    if (hi == 0) wsf[32 + r32] = l_reg; asm volatile("s_waitcnt lgkmcnt(0)" ::: "memory");
#pragma unroll
    for (int r = 0; r < 16; ++r) { const float rl = __builtin_amdgcn_rcpf(wsf[32 + crow(r, hi)]);
#pragma unroll
        for (int d = 0; d < 4; ++d) o[d][r] *= rl; }
    asm volatile("s_waitcnt lgkmcnt(0)" ::: "memory");
    lse2 = m_reg + __builtin_amdgcn_logf(l_reg);
#undef FA_DMA
}
__device__ __forceinline__ void store_o_bf16(const f32x16 (&o)[4], bf16* outw, size_t ldo, int r32, int hi) {
    asm volatile("" : "+v"(r32), "+v"(hi));
    const bool odd = r32 & 1;
#pragma unroll
    for (int d0 = 0; d0 < 4; ++d0)
#pragma unroll
        for (int rp = 0; rp < 8; ++rp) { const int r0 = 2 * rp, r1 = 2 * rp + 1;
            const float send = odd ? o[d0][r0] : o[d0][r1]; const float recv = __shfl_xor(send, 1);
            const unsigned w = odd ? cvtpk(recv, o[d0][r1]) : cvtpk(o[d0][r0], recv);
            const int row = crow(odd ? r1 : r0, hi), col = d0 * 32 + (r32 & ~1);
            *(unsigned*)(outw + (size_t)row * ldo + col) = w; }
}
}
struct Frame {
    LAS unsigned char* lds;
    volatile LAS unsigned* MISC;
    gu32* ctl;
    int tid, lane, wave;
    int vcu, G, gw, NGW;
};
__device__ __forceinline__ float wave_sum(float v) {
#pragma unroll
    for (int o = 1; o < 64; o <<= 1) v += __shfl_xor(v, o);
    return v;
}
template <int MODE>
__device__ __forceinline__ void transpose_item(const float* W, int K, int N, int nblk, bf16* WT, const float* kscale, LAS float* scr, int item, int lane) {
    const int kb = item / nblk, nb = item % nblk, k0 = 64 * kb, n0 = 32 * nb;
    const int nl = n0 + (lane & 31); const bool inb = nl < N;
#pragma unroll 8
    for (int i = 0; i < 32; ++i) { const int kk = 2 * i + (lane >> 5); float v = inb ? W[(size_t)(k0 + kk) * N + nl] : 0.f; if (kscale) v *= kscale[k0 + kk]; scr[kk * 33 + (lane & 31)] = v; }
    LDS_WAIT(); asm volatile("" ::: "memory");
    const int c = lane & 7;
#pragma unroll
    for (int j = 0; j < 4; ++j) { const int n = (lane >> 3) + 8 * j; const LAS float* s = scr + (8 * c) * 33 + n;
        v4u o; o.x = pk2(s[0 * 33], s[1 * 33]); o.y = pk2(s[2 * 33], s[3 * 33]); o.z = pk2(s[4 * 33], s[5 * 33]); o.w = pk2(s[6 * 33], s[7 * 33]);
        const int ng = n0 + n; const int drow = MODE == 0 ? ng : ((ng >> 7) * 256 + (ng & 127) + (MODE == 2 ? 128 : 0));
        *(GAS v4u*)(WT + (size_t)drow * K + k0 + 8 * c) = o; }
    LDS_WAIT(); asm volatile("" ::: "memory");
}
template <int MODE>
__device__ __forceinline__ void convert_weight(Frame& F, const float* W, int K, int N, int Npad, bf16* WT, const float* kscale) {
    LAS float* scr = (LAS float*)(F.lds + RING_OFF + F.wave * 16384);
    const int nblk = Npad / 32, nitems = (K / 64) * nblk;
    for (int it = F.gw; it < nitems; it += F.NGW) transpose_item<MODE>(W, K, N, nblk, WT, kscale, scr, it, F.lane);
}
__device__ __forceinline__ void convert_ffn(Frame& F, const float* wg, const float* wu, const float* wd, unsigned char* dst) {
    convert_weight<1>(F, wg, DM, DFF, DFF, (bf16*)dst, nullptr);
    convert_weight<2>(F, wu, DM, DFF, DFF, (bf16*)dst, nullptr);
    convert_weight<0>(F, wd, DFF, DM, DM, (bf16*)(dst + WF_DOWN_OFF), nullptr);
}
__device__ __forceinline__ void convert_x(Frame& F, const float* x, bf16* X) {
    const size_t n8 = (size_t)S * DM / 8;
    for (size_t i = (size_t)F.gw * 64 + F.lane; i < n8; i += (size_t)F.NGW * 64) {
        const f32x4 a = *(const GAS f32x4*)(x + i * 8), b = *(const GAS f32x4*)(x + i * 8 + 4);
        v4u o; o.x = pk2(a[0], a[1]); o.y = pk2(a[2], a[3]); o.z = pk2(b[0], b[1]); o.w = pk2(b[2], b[3]);
        *(GAS v4u*)(X + i * 8) = o; }
}
__device__ __forceinline__ void scale_x(Frame& F, const bf16* X, float* Y) {
    const size_t n8 = (size_t)S * DM / 8;
    for (size_t i = (size_t)F.gw * 64 + F.lane; i < n8; i += (size_t)F.NGW * 64) {
        const v4u w = *(const GAS v4u*)(X + i * 8);
        f32x4 a = {ALPHA * bflo(w.x), ALPHA * bfhi(w.x), ALPHA * bflo(w.y), ALPHA * bfhi(w.y)}, b = {ALPHA * bflo(w.z), ALPHA * bfhi(w.z), ALPHA * bflo(w.w), ALPHA * bfhi(w.w)};
        *(GAS f32x4*)(Y + i * 8) = a; *(GAS f32x4*)(Y + i * 8 + 4) = b; }
}
template <bool FINAL>
__device__ __forceinline__ void ln_phase(Frame& F, const float* Y, const float* g, const float* b, bf16* X, float* out) {
    for (int row = F.gw; row < S; row += F.NGW) {
        const GAS f32x4* yr = (const GAS f32x4*)(Y + (size_t)row * DM) + F.lane;
        f32x4 v[8]; float s = 0.f;
#pragma unroll
        for (int j = 0; j < 8; ++j) { v[j] = yr[64 * j]; s += (v[j][0] + v[j][1]) + (v[j][2] + v[j][3]); }
        const float mean = wave_sum(s) * (1.f / DM); float s2 = 0.f;
#pragma unroll
        for (int j = 0; j < 8; ++j) { v[j] = v[j] - mean; s2 += (v[j][0] * v[j][0] + v[j][1] * v[j][1]) + (v[j][2] * v[j][2] + v[j][3] * v[j][3]); }
        const float rstd = 1.f / sqrtf(wave_sum(s2) * (1.f / DM) + LN_EPS);
#pragma unroll
        for (int j = 0; j < 8; ++j) { const f32x4 gg = ((const GAS f32x4*)g)[64 * j + F.lane], bb = ((const GAS f32x4*)b)[64 * j + F.lane];
            const f32x4 o = v[j] * rstd * gg + bb;
            if (FINAL) ((GAS f32x4*)(out + (size_t)row * DM))[64 * j + F.lane] = o;
            else { v2u w; w.x = pk2(o[0], o[1]); w.y = pk2(o[2], o[3]); ((GAS v2u*)(X + (size_t)row * DM))[64 * j + F.lane] = w; } }
    }
}
constexpr float LOG2E = 1.4426950408889634f;
__device__ __forceinline__ void mixer_a_phase(Frame& F, const bf16* P, bf16* OA, float* LSE) {
    const int wid = F.wave, r32 = F.lane & 31, hi = F.lane >> 5;
    for (int u = F.vcu; u < 1536; u += F.G) {
        const int g = u >> 9, rem = u & 511, h = rem >> 6, j = rem & 63;
        const int dsh = 2 * g, d = 1 << dsh, c = j >> (6 - dsh), blk = j & ((64 >> dsh) - 1), I0 = blk * 256;
        fa::UnitP U; U.ldq = U.ldk = U.ldv = (size_t)d * EINP;
        const bf16* base = P + (size_t)c * EINP + h * 128;
        U.Q = base + (size_t)I0 * U.ldq; U.K = base + 1024; U.V = base + 2048;
        U.q0 = I0; U.kt0 = I0 ? (I0 >> 6) - 2 : 0; U.kt1 = (I0 >> 6) + 4;
        U.sl2 = exp2f(-(float)(h + 1)) * (float)d * LOG2E; U.c2 = 0.08838834764831845f * LOG2E; U.mask = nullptr;
        fa::f32x16 o[4]; float lse2;
        fa::attn_unit<128, true, true, false, false>(U, F.lds, o, lse2);
        const int row0 = I0 + wid * 32;
        fa::store_o_bf16(o, OA + (size_t)g * S * 1024 + ((size_t)row0 * d + c) * 1024 + h * 128, (size_t)d * 1024, r32, hi);
        if (hi == 0) LSE[((size_t)g * S + (size_t)(row0 + r32) * d + c) * 8 + h] = lse2;
    }
}
__device__ __forceinline__ void merge_a(Frame& F, const bf16* OA, const float* LSE, bf16* O) {
    const int h = F.lane >> 3;
    for (int pos = F.gw; pos < S; pos += F.NGW) {
        const float l0 = LSE[((size_t)0 * S + pos) * 8 + h], l1 = LSE[((size_t)1 * S + pos) * 8 + h], l2 = LSE[((size_t)2 * S + pos) * 8 + h];
        const float mx = fmaxf(l0, fmaxf(l1, l2)); float w0 = exp2f(l0 - mx), w1 = exp2f(l1 - mx), w2 = exp2f(l2 - mx); const float inv = 1.f / (w0 + w1 + w2); w0 *= inv; w1 *= inv; w2 *= inv;
#pragma unroll
        for (int hf = 0; hf < 2; ++hf) { const size_t off = (size_t)pos * 1024 + 16 * F.lane + 8 * hf;
            const v4u a = *(const GAS v4u*)(OA + off), b = *(const GAS v4u*)(OA + (size_t)S * 1024 + off), c = *(const GAS v4u*)(OA + (size_t)2 * S * 1024 + off);
            v4u o;
            o.x = pk2(w0 * bflo(a.x) + w1 * bflo(b.x) + w2 * bflo(c.x), w0 * bfhi(a.x) + w1 * bfhi(b.x) + w2 * bfhi(c.x));
            o.y = pk2(w0 * bflo(a.y) + w1 * bflo(b.y) + w2 * bflo(c.y), w0 * bfhi(a.y) + w1 * bfhi(b.y) + w2 * bfhi(c.y));
            o.z = pk2(w0 * bflo(a.z) + w1 * bflo(b.z) + w2 * bflo(c.z), w0 * bfhi(a.z) + w1 * bfhi(b.z) + w2 * bfhi(c.z));
            o.w = pk2(w0 * bflo(a.w) + w1 * bflo(b.w) + w2 * bflo(c.w), w0 * bfhi(a.w) + w1 * bfhi(b.w) + w2 * bfhi(c.w));
            *(GAS v4u*)(O + (size_t)pos * DM + 16 * F.lane + 8 * hf) = o; }
    }
}
typedef float f32x16 __attribute__((ext_vector_type(16)));
__device__ __forceinline__ unsigned okey(float f) { const unsigned u = __float_as_uint(f); return (u & 0x80000000u) ? ~u : (u | 0x80000000u); }
__device__ __forceinline__ int hswz(int w) { return (w & ~31) | ((w ^ (w >> 5)) & 31); }
__device__ __forceinline__ void find_kth(const LAS unsigned* hq, int target, int lane, int& bin, int& above) {
    unsigned w[32]; unsigned cl = 0;
#pragma unroll
    for (int i = 0; i < 32; ++i) { w[i] = hq[32 * lane + ((i ^ lane) & 31)]; cl += (w[i] & 0xffffu) + (w[i] >> 16); }
    unsigned suf = cl;
#pragma unroll
    for (int off = 1; off < 64; off <<= 1) { const unsigned t = __shfl_down(suf, off); if (lane + off < 64) suf += t; }
    const unsigned long long bal = __ballot((int)suf >= target);
    if (bal == 0ull) { bin = -1; above = 0; return; }
    const int L = 63 - __clzll((long long)bal);
    int cum = (int)(suf - cl), fb = -1, fab = 0;
#pragma unroll
    for (int i = 31; i >= 0; --i) { const int h16 = (int)(w[i] >> 16), l16 = (int)(w[i] & 0xffffu);
        if (fb < 0) { if (cum + h16 >= target) { fb = 2 * i + 1; fab = cum; } else { cum += h16; if (cum + l16 >= target) { fb = 2 * i; fab = cum; } else cum += l16; } } }
    bin = __shfl(fb, L) + 64 * L; above = __shfl(fab, L);
}
__device__ __forceinline__ void indexer_unit(const bf16* P, unsigned* MASKB, LAS unsigned char* lds, int unit, int wid, int lane) {
    const int r32 = lane & 31, hi = lane >> 5, wu = unit * 8 + wid, q = 2 * wu + hi;
    LAS unsigned* hist = (LAS unsigned*)(lds + RING_OFF + wid * 16384);
    LAS unsigned char* ring = lds + KI_RING_OFF;
    bf16x8 af[4];
    {   const int jq = (r32 >> 2) & 1, head = (r32 & 3) + 4 * (r32 >> 3);
        const bf16* qrow = P + (size_t)(2 * wu + jq) * EINP + 6144 + head * 64 + hi * 8;
#pragma unroll
        for (int ks = 0; ks < 4; ++ks) af[ks] = *(const bf16x8*)(qrow + ks * 16); }
    float wq[16];
    {   const v4u a = *(const GAS v4u*)(P + (size_t)q * EINP + 7232), b = *(const GAS v4u*)(P + (size_t)q * EINP + 7240);
        wq[0] = bflo(a.x); wq[1] = bfhi(a.x); wq[2] = bflo(a.y); wq[3] = bfhi(a.y); wq[4] = bflo(a.z); wq[5] = bfhi(a.z); wq[6] = bflo(a.w); wq[7] = bfhi(a.w);
        wq[8] = bflo(b.x); wq[9] = bfhi(b.x); wq[10] = bflo(b.y); wq[11] = bfhi(b.y); wq[12] = bflo(b.z); wq[13] = bfhi(b.z); wq[14] = bflo(b.w); wq[15] = bfhi(b.w);
#pragma unroll
        for (int r = 0; r < 16; ++r) wq[r] *= 0.03125f; }
    const int NS = (16 * unit + 16 + 63) >> 6;
    const bool any256 = 16 * unit + 15 >= 255;
    const int prow = wid * 8 + (lane >> 3);
    const char* kgsrc = (const char*)(P + 7168) + (size_t)prow * EINP * 2 + (((lane & 7) * 16) ^ ((prow & 7) << 4));
    const int lp = (hi * 16) ^ ((r32 & 7) << 4);
    const int fo0 = r32 * 128 + lp, fo1 = r32 * 128 + (lp ^ 32), fo2 = r32 * 128 + (lp ^ 64), fo3 = r32 * 128 + (lp ^ 96);
#define IDX_DMA(s_) __builtin_amdgcn_global_load_lds((const unsigned*)(kgsrc + (size_t)(s_) * 64 * EINP * 2), (LAS unsigned*)(ring + ((s_) & 1) * 8192 + wid * 1024), 16, 0, 0)
#define IDX_SCORE(slot_, t_, key32_) do { const LAS unsigned char* fb_ = ring + (slot_) * 8192 + (t_) * 4096; \
        const bf16x8 b0_ = *(const LAS bf16x8*)(fb_ + fo0), b1_ = *(const LAS bf16x8*)(fb_ + fo1), b2_ = *(const LAS bf16x8*)(fb_ + fo2), b3_ = *(const LAS bf16x8*)(fb_ + fo3); \
        f32x16 acc_; _Pragma("unroll") for (int r = 0; r < 16; ++r) acc_[r] = 0.f; \
        acc_ = __builtin_amdgcn_mfma_f32_32x32x16_bf16(af[0], b0_, acc_, 0, 0, 0); acc_ = __builtin_amdgcn_mfma_f32_32x32x16_bf16(af[1], b1_, acc_, 0, 0, 0); \
        acc_ = __builtin_amdgcn_mfma_f32_32x32x16_bf16(af[2], b2_, acc_, 0, 0, 0); acc_ = __builtin_amdgcn_mfma_f32_32x32x16_bf16(af[3], b3_, acc_, 0, 0, 0); \
        float isc_ = 0.f; _Pragma("unroll") for (int r = 0; r < 16; ++r) isc_ = fmaf(wq[r], fmaxf(acc_[r], 0.f), isc_); key32_ = okey(isc_); } while (0)
#define IDX_ZERO() do { _Pragma("unroll") for (int i = 0; i < 16; ++i) ((LAS v4u*)hist)[i * 64 + lane] = (v4u){0u, 0u, 0u, 0u}; LDS_WAIT(); } while (0)
#define IDX_PASS(BODY) do { IDX_DMA(0); \
        for (int s_ = 0; s_ < NS; ++s_) { asm volatile("s_waitcnt vmcnt(0)" ::: "memory"); __builtin_amdgcn_s_barrier(); asm volatile("" ::: "memory"); \
            if (s_ + 1 < NS) IDX_DMA(s_ + 1); \
            _Pragma("unroll") for (int t_ = 0; t_ < 2; ++t_) { const int kt = 2 * s_ + t_; unsigned key32; IDX_SCORE(s_ & 1, t_, key32); BODY } } \
        __builtin_amdgcn_s_barrier(); } while (0)
    IDX_ZERO();
    IDX_PASS({ if (kt * 32 + r32 <= q) { const int bin = (int)(key32 >> 20); __hip_atomic_fetch_add(hist + hi * 2048 + hswz(bin >> 1), 1u << ((bin & 1) * 16), __ATOMIC_RELAXED, __HIP_MEMORY_SCOPE_WORKGROUP); } });
    LDS_WAIT();
    int b0, a0, b1, a1; find_kth(hist, 256, lane, b0, a0); find_kth(hist + 2048, 256, lane, b1, a1);
    const int mybin = hi ? b1 : b0;
    unsigned tau = 0u;
    if (any256) {
        IDX_ZERO();
        IDX_PASS({ if (kt * 32 + r32 <= q && (int)(key32 >> 20) == mybin) { const int bin = (int)((key32 >> 8) & 0xfffu); __hip_atomic_fetch_add(hist + hi * 2048 + hswz(bin >> 1), 1u << ((bin & 1) * 16), __ATOMIC_RELAXED, __HIP_MEMORY_SCOPE_WORKGROUP); } });
        LDS_WAIT();
        int s0 = 0, s1 = 0, t0, t1;
        if (b0 >= 0) find_kth(hist, 256 - a0, lane, s0, t0);
        if (b1 >= 0) find_kth(hist + 2048, 256 - a1, lane, s1, t1);
        const int mysub = hi ? s1 : s0;
        tau = mybin < 0 ? 0u : (((unsigned)mybin << 20) | ((unsigned)(mysub < 0 ? 0 : mysub) << 8));
    }
    IDX_PASS({ const bool sel = (kt * 32 + r32 <= q) && (key32 >= tau); const unsigned long long bal = __ballot(sel);
               if (lane == 0) MASKB[(size_t)(2 * wu) * 512 + kt] = (unsigned)bal;
               if (lane == 32) MASKB[(size_t)(2 * wu + 1) * 512 + kt] = (unsigned)(bal >> 32); });
#undef IDX_DMA
#undef IDX_SCORE
#undef IDX_ZERO
#undef IDX_PASS
}
__device__ __forceinline__ void indexer_phase(Frame& F, const bf16* P, unsigned* MASKB) {
    for (int i = 0;; ++i) { const int idx = F.vcu + i * F.G; if (idx >= 1024) break;
        const int seg = idx >> 8, r = idx & 255, unit = (seg & 1) ? (seg * 256 + 255 - r) : (seg * 256 + r);
        indexer_unit(P, MASKB, F.lds, unit, F.wave, F.lane); }
}
__device__ __forceinline__ void mixer_b_phase(Frame& F, const bf16* P, const unsigned* MASKB, bf16* O) {
    const int wid = F.wave, r32 = F.lane & 31, hi = F.lane >> 5;
    for (int e = F.vcu; e < 512; e += F.G) {
        const int pairidx = e & 255, second = e >> 8, h = pairidx >> 5, j = pairidx & 31, qb = second ? 63 - j : j;
        fa::UnitP U; U.ldq = U.ldk = U.ldv = (size_t)EINP;
        U.Q = P + (size_t)(qb * 256) * EINP + 3072 + h * 128; U.K = P + 4096 + h * 128; U.V = P + 5120 + h * 128;
        U.q0 = qb * 256; U.kt0 = 0; U.kt1 = (qb + 1) * 4;
        U.sl2 = exp2f(-(float)(h + 1)) * LOG2E; U.c2 = 0.08838834764831845f * LOG2E; U.mask = MASKB + (size_t)(qb * 256) * 512;
        fa::f32x16 o[4]; float lse2;
        fa::attn_unit<128, false, true, true, false>(U, F.lds, o, lse2);
        fa::store_o_bf16(o, O + (size_t)(qb * 256 + wid * 32) * DM + 1024 + h * 128, (size_t)DM, r32, hi);
    }
}
__device__ __forceinline__ void kpe_fill(Frame& F, const bf16* P, bf16* KD) {
    const int i = F.lane & 31, hh = (F.lane >> 5) * 4;
    const float inv = exp2f(-0.41524101186092029f * (float)i);
    for (int s = F.gw; s < S; s += F.NGW) {
        const bf16* kp = P + (size_t)s * OINP + 4352;
        const float x1 = __uint_as_float((unsigned)kp[i] << 16), x2 = __uint_as_float((unsigned)kp[32 + i] << 16);
        const float ang = (float)s * inv; const float n = rintf(ang * 0.15915494309189535f);
        float rr = fmaf(-n, 6.2831854820251465f, ang); rr = fmaf(-n, -1.7484555e-07f, rr); const float fr = rr * 0.15915494309189535f;
        const float sn = __builtin_amdgcn_sinf(fr), cs = __builtin_amdgcn_cosf(fr);
        const bf16 o1 = (bf16)f2bf(x1 * cs - x2 * sn), o2 = (bf16)f2bf(x1 * sn + x2 * cs);
#pragma unroll
        for (int h = 0; h < 4; ++h) { bf16* kd = KD + (size_t)s * 1536 + (hh + h) * 192 + 128; kd[i] = o1; kd[32 + i] = o2; }
    }
}
__device__ __forceinline__ void c_norm_bounds(Frame& F, const bf16* P, unsigned* NRM) {
    float mx = 0.f;
    for (int s = F.gw; s < S; s += F.NGW) {
        const v4u* rp = (const v4u*)(P + (size_t)s * OINP + 32 * F.lane); float ss = 0.f;
#pragma unroll
        for (int j = 0; j < 4; ++j) { const v4u w = rp[j];
            ss += bflo(w.x) * bflo(w.x) + bfhi(w.x) * bfhi(w.x) + bflo(w.y) * bflo(w.y) + bfhi(w.y) * bfhi(w.y) + bflo(w.z) * bflo(w.z) + bfhi(w.z) * bfhi(w.z) + bflo(w.w) * bflo(w.w) + bfhi(w.w) * bfhi(w.w); }
        ss += __shfl_xor(ss, 1); mx = fmaxf(mx, ss); }
    if ((F.lane & 1) == 0) atomicMax(NRM + (F.lane >> 1), __float_as_uint(mx));
}
__device__ __forceinline__ void mixer_c_unit(Frame& F, const bf16* P, float lam, const float* subln_g, float lam_init, float* SCR, bf16* O, const unsigned* NRM, int h, int qb, int ord) {
    const int wid = F.wave, r32 = F.lane & 31, hi = F.lane >> 5;
    {
        f32x4* scr = (f32x4*)(SCR + (((size_t)(ord & 1) * F.G + blockIdx.x) * 512 + F.tid) * 64);
        for (int sub = 0; sub < 2; ++sub) {
            fa::UnitP U; U.ldq = U.ldk = U.ldv = (size_t)OINP;
            U.Q = P + (size_t)(qb * 256) * OINP + h * 128 + sub * 64; U.K = P + 1024 + h * 128 + sub * 64; U.V = P + 2048 + h * 128;
            U.q0 = qb * 256; U.kt0 = 0; U.kt1 = (qb + 1) * 4;
            U.sl2 = exp2f(-(float)(h + 1)) * LOG2E; U.c2 = 0.125f * LOG2E; U.mask = nullptr;
            {
                const float B = sqrtf(__uint_as_float(NRM[h * 2 + sub]) * __uint_as_float(NRM[16 + h * 2 + sub])) * U.c2 * 1.01f;
                const float dmax = (2.f * B + 160.f) / U.sl2; const float kmin = (float)U.q0 - dmax;
                if (kmin > 0.f) U.kt0 = (int)(kmin * (1.f / 64.f)); }
            fa::f32x16 o[4]; float lse2;
            fa::attn_unit<64, false, true, false, false>(U, F.lds, o, lse2);
            if (sub == 0) {
#pragma unroll
                for (int d = 0; d < 4; ++d)
#pragma unroll
                    for (int k = 0; k < 4; ++k) scr[d * 4 + k] = (f32x4){o[d][4 * k], o[d][4 * k + 1], o[d][4 * k + 2], o[d][4 * k + 3]};
            } else {
                float ss[16];
#pragma unroll
                for (int r = 0; r < 16; ++r) ss[r] = 0.f;
#pragma unroll
                for (int d = 0; d < 4; ++d)
#pragma unroll
                    for (int k = 0; k < 4; ++k) { const f32x4 s1 = scr[d * 4 + k];
#pragma unroll
                        for (int e2 = 0; e2 < 4; ++e2) { const int r = 4 * k + e2; const float v = s1[e2] - lam * o[d][r]; o[d][r] = v; ss[r] += v * v; } }
#pragma unroll
                for (int r = 0; r < 16; ++r) { float t = ss[r]; t += __shfl_xor(t, 1); t += __shfl_xor(t, 2); t += __shfl_xor(t, 4); t += __shfl_xor(t, 8); t += __shfl_xor(t, 16);
                    ss[r] = (1.0f - lam_init) / sqrtf(t * (1.0f / 128.0f) + DIFF_EPS); }
#pragma unroll
                for (int d = 0; d < 4; ++d) { const float gcol = subln_g[d * 32 + r32];
#pragma unroll
                    for (int r = 0; r < 16; ++r) o[d][r] *= ss[r] * gcol; }
                fa::store_o_bf16(o, O + (size_t)(qb * 256 + wid * 32) * DM + h * 128, (size_t)DM, r32, hi);
            }
        }
    }
}
__device__ __forceinline__ void mixer_d_unit(Frame& F, const bf16* QF, const bf16* KD, const bf16* VD, bf16* O, int h, int qb) {
    const int wid = F.wave, r32 = F.lane & 31, hi = F.lane >> 5;
    {
        fa::UnitP U; U.ldq = 1536; U.ldk = 1536; U.ldv = 1024;
        U.Q = QF + (size_t)(qb * 256) * 1536 + h * 192; U.K = KD + h * 192; U.V = VD + h * 128;
        U.q0 = qb * 256; U.kt0 = 0; U.kt1 = (qb + 1) * 4;
        U.sl2 = 0.f; U.c2 = 0.07216878364870322f * LOG2E; U.mask = nullptr;
        fa::f32x16 o[4]; float lse2;
        fa::attn_unit<192, false, false, false, true>(U, F.lds, o, lse2);
        fa::store_o_bf16(o, O + (size_t)(qb * 256 + wid * 32) * DM + 1024 + h * 128, (size_t)DM, r32, hi);
    }
}
__device__ __forceinline__ void mixer_cd_phase(Frame& F, const bf16* P, const float* lam_p, const float* subln_g, float lam_init, float* SCR, const unsigned* NRM,
                                               const bf16* QF, const bf16* KD, const bf16* VD, bf16* O, gu32* qctr) {
    const float lam = expf(wave_sum(lam_p[F.lane] * lam_p[64 + F.lane])) - expf(wave_sum(lam_p[128 + F.lane] * lam_p[192 + F.lane])) + lam_init;
    int ord = 0;
    for (;;) {
        if (F.tid == 0) F.MISC[16] = __hip_atomic_fetch_add(qctr, 1u, __ATOMIC_RELAXED, __HIP_MEMORY_SCOPE_AGENT);
        __syncthreads(); const int e = (int)F.MISC[16]; __syncthreads();
        if (e >= 1024) break;
        const int idx = e >> 1;
        if ((e & 1) == 0) { mixer_c_unit(F, P, lam, subln_g, lam_init, SCR, O, NRM, 7 - (idx >> 6), 63 - (idx & 63), ord); ++ord; }
        else mixer_d_unit(F, QF, KD, VD, O, idx & 7, 63 - (idx >> 3));
    }
}
struct Args { const float* in[16]; float* out; unsigned char* ws; };
#define GRID_BAR() do { xcd_barrier(bar); int t_ = threadIdx.x; asm volatile("" : "+v"(t_)); F.tid = t_; F.lane = t_ & 63; } while (0)

#define FFN_PHASES(WF)                                                                                                           \
    {   pg8::Gemm g{X, (const bf16*)(WF), S, NGU, DM, DM}; pg8::StaticOrder So; So.init(S, NGU, F.G, (int)blockIdx.x);            \
        pg8::EpiSwiglu E{H, DFF};                                                                                                 \
        pg8::gemm_phase<pg8::EpiSwiglu, pg8::StaticOrder, true, true>(F.lds + RING_OFF, g, So, E); }                              \
    GRID_BAR();                                                                                                                   \
    {   pg8::Gemm g{H, (const bf16*)((WF) + WF_DOWN_OFF), S, DM, DFF, DFF}; pg8::StaticOrder So; So.init(S, DM, F.G, (int)blockIdx.x); \
        pg8::EpiResid E{X, Y, DM, ALPHA, 0.5f};                                                                                   \
        pg8::gemm_phase<pg8::EpiResid, pg8::StaticOrder, true, true>(F.lds + RING_OFF, g, So, E); }                               \
    GRID_BAR();

__global__ void __launch_bounds__(NWAVES * 64, 2) fwd_kernel(Args args) {
    extern __shared__ __attribute__((aligned(16))) unsigned char lds[];
    Frame F;
    F.lds = (LAS unsigned char*)lds;
    F.MISC = (volatile LAS unsigned*)(F.lds + MISC_OFF);
    F.tid = threadIdx.x; F.lane = F.tid & 63; F.wave = __builtin_amdgcn_readfirstlane(F.tid >> 6);
    F.G = gridDim.x; { const int bx = blockIdx.x; F.vcu = (F.G % 8 == 0) ? (bx % 8) * (F.G / 8) + bx / 8 : bx; }
    F.gw = F.vcu * NWAVES + F.wave; F.NGW = F.G * NWAVES;
    unsigned char* ws = args.ws;
    F.ctl = (gu32*)(ws + WS_CTL);
    for (int u = F.tid; u < (LDS_BYTES - LDSCTL_OFF) / 4; u += NWAVES * 64) ((LAS unsigned*)(F.lds + LDSCTL_OFF))[u] = 0u;
    __syncthreads();
    XcdBarrier bar = xcd_barrier_post((unsigned*)(F.ctl + CW_BAR), F.MISC + 8);

    const float* x_in = args.in[0];
    const float* w_gate = args.in[1]; const float* w_up = args.in[2]; const float* w_down = args.in[3];
    const float* ln_g = args.in[4]; const float* ln_b = args.in[5];
    bf16* X = (bf16*)(ws + WS_X); float* Y = (float*)(ws + WS_Y); bf16* H = (bf16*)(ws + WS_HP);
    bf16* P = (bf16*)(ws + WS_HP); bf16* O = (bf16*)(ws + WS_O);
    bf16* OA = (bf16*)(ws + WS_Y); unsigned* MASKB = (unsigned*)(ws + WS_Y + 96 * MiB); float* LSE = (float*)(ws + WS_LSE);
    bf16* QF = (bf16*)(ws + WS_Y); bf16* KD = (bf16*)(ws + WS_Y + 48 * MiB); bf16* VD = (bf16*)(ws + WS_Y + 96 * MiB);
    float* SQQ = (float*)(ws + (size_t)CW_SQQ * 4); float* SQKV = (float*)(ws + (size_t)CW_SQKV * 4);
    unsigned char* WFA = ws + WS_WFA; unsigned char* WFB = ws + WS_WFB;
    constexpr size_t GSZ = (size_t)DM * DFF;

    convert_ffn(F, w_gate + 0 * GSZ, w_up + 0 * GSZ, w_down + 0 * GSZ, WFA);
    convert_ffn(F, w_gate + 1 * GSZ, w_up + 1 * GSZ, w_down + 1 * GSZ, WFB);
    convert_weight<0>(F, args.in[6], DM, EIN, EINP, (bf16*)(ws + WS_WEIN), nullptr);
    convert_weight<0>(F, args.in[7], DM, DM, DM, (bf16*)(ws + WS_WEOUT), nullptr);
    convert_weight<0>(F, args.in[8], DM, OIN, OINP, (bf16*)(ws + WS_WOIN), nullptr);
    convert_weight<0>(F, args.in[9], DM, DM, DM, (bf16*)(ws + WS_WOOUT), nullptr);
    convert_weight<0>(F, args.in[14], 768, 1536, 1536, (bf16*)(ws + WS_WUQ), args.in[12]);
    convert_weight<0>(F, args.in[15], 512, 2048, 2048, (bf16*)(ws + WS_WUKV), args.in[13]);
    convert_x(F, x_in, X);
    GRID_BAR();
    FFN_PHASES(WFA)
    ln_phase<false>(F, Y, ln_g + 0 * DM, ln_b + 0 * DM, X, nullptr);
    convert_ffn(F, w_gate + 2 * GSZ, w_up + 2 * GSZ, w_down + 2 * GSZ, WFA);
    GRID_BAR();
    {
        pg8::Gemm g{X, (const bf16*)(ws + WS_WEIN), S, EINP, DM, DM}; pg8::StaticOrder So; So.init(S, EINP, F.G, (int)blockIdx.x);
        pg8::EpiBf16 E{P, EINP, nullptr, 0, 0, nullptr, 0, 0};
        pg8::gemm_phase<pg8::EpiBf16, pg8::StaticOrder, true, true>(F.lds + RING_OFF, g, So, E); }
    GRID_BAR();
    mixer_a_phase(F, P, OA, LSE);
    __syncthreads();
    indexer_phase(F, P, MASKB);
    GRID_BAR();
    merge_a(F, OA, LSE, O);
    mixer_b_phase(F, P, MASKB, O);
    GRID_BAR();
    {
        pg8::Gemm g{O, (const bf16*)(ws + WS_WEOUT), S, DM, DM, DM}; pg8::StaticOrder So; So.init(S, DM, F.G, (int)blockIdx.x);
        pg8::EpiResid E{X, Y, DM, ALPHA, 1.0f};
        pg8::gemm_phase<pg8::EpiResid, pg8::StaticOrder, true, true>(F.lds + RING_OFF, g, So, E); }
    GRID_BAR();
    ln_phase<false>(F, Y, ln_g + 1 * DM, ln_b + 1 * DM, X, nullptr);
    GRID_BAR();
    FFN_PHASES(WFB)
    ln_phase<false>(F, Y, ln_g + 2 * DM, ln_b + 2 * DM, X, nullptr);
    convert_ffn(F, w_gate + 3 * GSZ, w_up + 3 * GSZ, w_down + 3 * GSZ, WFB);
    GRID_BAR();
    FFN_PHASES(WFA)
    ln_phase<false>(F, Y, ln_g + 3 * DM, ln_b + 3 * DM, X, nullptr);
    GRID_BAR();
    {
        pg8::Gemm g{X, (const bf16*)(ws + WS_WOIN), S, OINP, DM, DM}; pg8::StaticOrder So; So.init(S, OINP, F.G, (int)blockIdx.x);
        pg8::EpiBf16 E{P, OINP, SQQ, 12, 15, SQKV, 15, 17};
        pg8::gemm_phase<pg8::EpiBf16, pg8::StaticOrder, true, true>(F.lds + RING_OFF, g, So, E); }
    GRID_BAR();
    {
        pg8::Gemm g{P + 3072, (const bf16*)(ws + WS_WUQ), S, 1536, 768, OINP}; pg8::StaticOrder So; So.init(S, 1536, F.G, (int)blockIdx.x);
        pg8::EpiScaleRow E{QF, 1536, SQQ, 1.0f / 768.0f, RMS_EPS};
        pg8::gemm_phase<pg8::EpiScaleRow, pg8::StaticOrder, true, true>(F.lds + RING_OFF, g, So, E); }
    {   pg8::Gemm g{P + 3840, (const bf16*)(ws + WS_WUKV), S, 2048, 512, OINP}; pg8::StaticOrder So; So.init(S, 2048, F.G, (int)blockIdx.x);
        pg8::EpiUkv E{KD, VD, SQKV, 1.0f / 512.0f, RMS_EPS};
        pg8::gemm_phase<pg8::EpiUkv, pg8::StaticOrder, true, true>(F.lds + RING_OFF, g, So, E); }
    kpe_fill(F, P, KD);
    c_norm_bounds(F, P, (unsigned*)(F.ctl + CW_NRM));
    GRID_BAR();
    mixer_cd_phase(F, P, args.in[10], args.in[11], 0.35550906759096874f, (float*)(ws + WS_HP + 160 * MiB), (const unsigned*)(F.ctl + CW_NRM), QF, KD, VD, O, F.ctl + CW_QCD);
    GRID_BAR();
    {
        pg8::Gemm g{O, (const bf16*)(ws + WS_WOOUT), S, DM, DM, DM}; pg8::StaticOrder So; So.init(S, DM, F.G, (int)blockIdx.x);
        pg8::EpiResid E{X, Y, DM, ALPHA, 1.0f};
        pg8::gemm_phase<pg8::EpiResid, pg8::StaticOrder, true, true>(F.lds + RING_OFF, g, So, E); }
    GRID_BAR();
    ln_phase<false>(F, Y, ln_g + 4 * DM, ln_b + 4 * DM, X, nullptr);
    GRID_BAR();
    FFN_PHASES(WFB)
    ln_phase<true>(F, Y, ln_g + 5 * DM, ln_b + 5 * DM, nullptr, args.out);
}

extern "C" void kernel_launch(void* const* d_in, const int* in_sizes, int n_in, void* d_out, int out_size, void* d_ws, size_t ws_size, hipStream_t stream) {
    static int grid = 0;
    if (grid == 0) {
        if (n_in != 16 || in_sizes[0] != S * DM || out_size != S * DM || ws_size < WS_END) { fprintf(stderr, "kernel_launch: unexpected shapes (n_in %d, in0 %d, out %d, ws %zu < %zu)\n", n_in, n_in > 0 ? in_sizes[0] : -1, out_size, ws_size, (size_t)WS_END); grid = -1; return; }
        int dev = 0, cus = 0, per_cu = 0;
        if (hipGetDevice(&dev) != hipSuccess || hipDeviceGetAttribute(&cus, hipDeviceAttributeMultiprocessorCount, dev) != hipSuccess) { grid = -1; return; }
        if (hipFuncSetAttribute((const void*)fwd_kernel, hipFuncAttributeMaxDynamicSharedMemorySize, LDS_BYTES) != hipSuccess) { fprintf(stderr, "kernel_launch: hipFuncSetAttribute failed\n"); grid = -1; return; }
        if (hipOccupancyMaxActiveBlocksPerMultiprocessor(&per_cu, (const void*)fwd_kernel, NWAVES * 64, LDS_BYTES) != hipSuccess || per_cu < 1)
            fprintf(stderr, "kernel_launch: occupancy query reports %d workgroups per CU\n", per_cu);
        (void)hipGetLastError();
        grid = cus;
    }
    if (grid < 0) return;
    if (hipMemsetAsync((char*)d_ws + WS_CTL, 0, CTL_ZERO_BYTES, stream) != hipSuccess) return;
    Args a{};
    for (int i = 0; i < 16; ++i) a.in[i] = (const float*)d_in[i];
    a.out = (float*)d_out; a.ws = (unsigned char*)d_ws;
    hipLaunchKernelGGL(fwd_kernel, dim3(grid), dim3(NWAVES * 64), LDS_BYTES, stream, a);
}
```

```cpp
#include <hip/hip_runtime.h>
#include <cstdio>
#include <cstdint>
#include <cmath>
namespace pg8 {
#define PG8_LAS __attribute__((address_space(3)))
typedef unsigned short bf16_t;
typedef short bf16x8 __attribute__((ext_vector_type(8)));
typedef float f32x4 __attribute__((ext_vector_type(4)));
typedef unsigned u32x4 __attribute__((ext_vector_type(4)));
constexpr int BM = 256, BK = 64, HALF = 128, HTB = HALF * BK * 2  , STAGE_BYTES = 8 * HTB, NXCD = 8, WGM = 8;

__host__ __device__ __forceinline__ int lds_byte(int r, int c) { const int st = (r >> 4) * 2 + (c >> 5), rr = r & 15, cc = c & 31, ob = rr * 64 + cc * 2; return st * 1024 + (ob ^ (((ob >> 9) & 1) << 5)); }
__host__ __device__ __forceinline__ void stage_rc(int b, int& R, int& C) { const int st = b / 1024, sb = b % 1024, swz = sb ^ (((sb >> 9) & 1) << 5); R = (st >> 1) * 16 + swz / 64; C = (st & 1) * 32 + (swz % 64) / 2; }
__host__ __device__ __forceinline__ int perm32(int rho) { const int n = rho >> 4, i = rho & 15; return 8 * (i >> 2) + 4 * n + (i & 3); }

struct Unit { int pm, pn; };
struct Gemm { const bf16_t* A; const bf16_t* Bt; int M, N, K, lda; };

struct StaticOrder {
    int nM, nN, nwg, G, c;
    __host__ __device__ void init(int M, int N, int G_, int c_) { nM = M / BM; nN = N / BM; nwg = nM * nN; G = G_; c = c_; }
    __host__ __device__ bool next(int i, Unit& u) const {
        const long L = (long)i * G + c; if (L >= nwg) return false;
        int wgid = (int)L; { const int q = nwg / NXCD, r = nwg % NXCD, xcd = wgid % NXCD, off = wgid / NXCD; wgid = (xcd < r ? xcd * (q + 1) : r * (q + 1) + (xcd - r) * q) + off; }
        const int nig = WGM * nN, gid = wgid / nig, fm = gid * WGM, gsz = (nM - fm) < WGM ? (nM - fm) : WGM;
        u.pm = fm + ((wgid % nig) % gsz); u.pn = (wgid % nig) / gsz; return true;
    }
    __device__ __forceinline__ void a_ready(const Unit&) const {}
    __device__ __forceinline__ void done(const Unit&) const {}
};
__device__ __forceinline__ unsigned cvt_pk_bf16(float lo, float hi) { unsigned r; asm volatile("v_cvt_pk_bf16_f32 %0, %1, %2" : "=v"(r) : "v"(lo), "v"(hi)); return r; }
__device__ __forceinline__ float bf_lo(unsigned w) { return __uint_as_float(w << 16); }
__device__ __forceinline__ float bf_hi(unsigned w) { return __uint_as_float(w & 0xffff0000u); }
typedef unsigned u32x2 __attribute__((ext_vector_type(2)));
__device__ __forceinline__ float silu_f(float x) { return x * __builtin_amdgcn_rcpf(1.0f + __builtin_amdgcn_exp2f(-1.4426950408889634f * x)); }

struct EpiSwiglu {
    static constexpr bool PERM = true, AFTER_DRAIN = false;
    bf16_t* H; int ldh;
    __device__ __forceinline__ void operator()(const f32x4 (&acc)[2][2][4][2], const Unit& u, int wr, int wc, int fr, int fq) const {
        const int row0 = u.pm * BM + wr * 64 + fr, col0 = u.pn * HALF + wc * 32 + 8 * fq;
#pragma unroll
        for (int ai = 0; ai < 2; ++ai)
#pragma unroll
            for (int m = 0; m < 4; ++m) {
                const f32x4 g0 = acc[ai][0][m][0], g1 = acc[ai][0][m][1], u0 = acc[ai][1][m][0], u1 = acc[ai][1][m][1];
                u32x4 w;
                w.x = cvt_pk_bf16(silu_f(g0[0]) * u0[0], silu_f(g0[1]) * u0[1]); w.y = cvt_pk_bf16(silu_f(g0[2]) * u0[2], silu_f(g0[3]) * u0[3]);
                w.z = cvt_pk_bf16(silu_f(g1[0]) * u1[0], silu_f(g1[1]) * u1[1]); w.w = cvt_pk_bf16(silu_f(g1[2]) * u1[2], silu_f(g1[3]) * u1[3]);
                *(u32x4*)(H + (size_t)(row0 + ai * HALF + m * 16) * ldh + col0) = w;
            }
    }
};
struct EpiResid {
    static constexpr bool PERM = false, AFTER_DRAIN = false;
    const bf16_t* X; float* Y; int ldc; float alpha, w;
    __device__ __forceinline__ void operator()(const f32x4 (&acc)[2][2][4][2], const Unit& u, int wr, int wc, int fr, int fq) const {
        const int row0 = u.pm * BM + wr * 64 + fr, col0 = u.pn * BM + wc * 32 + 4 * fq;
#pragma unroll
        for (int ai = 0; ai < 2; ++ai)
#pragma unroll
            for (int m = 0; m < 4; ++m) { const size_t ro = (size_t)(row0 + ai * HALF + m * 16) * ldc + col0;
#pragma unroll
                for (int bj = 0; bj < 2; ++bj)
#pragma unroll
                    for (int n = 0; n < 2; ++n) { const size_t off = ro + bj * HALF + n * 16; const u32x2 xw = *(const u32x2*)(X + off); const f32x4 a = acc[ai][bj][m][n];
                        f32x4 y; y[0] = alpha * bf_lo(xw.x) + w * a[0]; y[1] = alpha * bf_hi(xw.x) + w * a[1]; y[2] = alpha * bf_lo(xw.y) + w * a[2]; y[3] = alpha * bf_hi(xw.y) + w * a[3];
                        *(f32x4*)(Y + off) = y; } }
    }
};
struct EpiBf16 {
    static constexpr bool PERM = true, AFTER_DRAIN = false;
    bf16_t* O; int ldc; float* sqA; int a_lo, a_hi; float* sqB; int b_lo, b_hi;
    __device__ __forceinline__ void operator()(const f32x4 (&acc)[2][2][4][2], const Unit& u, int wr, int wc, int fr, int fq) const {
        const int row0 = u.pm * BM + wr * 64 + fr, col0 = u.pn * BM + wc * 32 + 8 * fq;
        float* sq = (u.pn >= a_lo && u.pn < a_hi) ? sqA : ((u.pn >= b_lo && u.pn < b_hi) ? sqB : nullptr);
#pragma unroll
        for (int ai = 0; ai < 2; ++ai)
#pragma unroll
            for (int m = 0; m < 4; ++m) { bf16_t* rowp = O + (size_t)(row0 + ai * HALF + m * 16) * ldc + col0; float ss = 0.f;
#pragma unroll
                for (int bj = 0; bj < 2; ++bj) { const f32x4 v0 = acc[ai][bj][m][0], v1 = acc[ai][bj][m][1];
                    ss += (v0[0] * v0[0] + v0[1] * v0[1]) + (v0[2] * v0[2] + v0[3] * v0[3]) + (v1[0] * v1[0] + v1[1] * v1[1]) + (v1[2] * v1[2] + v1[3] * v1[3]);
                    u32x4 w; w.x = cvt_pk_bf16(v0[0], v0[1]); w.y = cvt_pk_bf16(v0[2], v0[3]); w.z = cvt_pk_bf16(v1[0], v1[1]); w.w = cvt_pk_bf16(v1[2], v1[3]);
                    *(u32x4*)(rowp + bj * HALF) = w; }
                if (sq) { ss += __shfl_xor(ss, 16); ss += __shfl_xor(ss, 32); if (fq == 0) atomicAdd(sq + row0 + ai * HALF + m * 16, ss); }
            }
    }
};
struct EpiScaleRow {
    static constexpr bool PERM = true, AFTER_DRAIN = false;
    bf16_t* O; int ldc; const float* sq; float invn, eps;
    __device__ __forceinline__ void operator()(const f32x4 (&acc)[2][2][4][2], const Unit& u, int wr, int wc, int fr, int fq) const {
        const int row0 = u.pm * BM + wr * 64 + fr, col0 = u.pn * BM + wc * 32 + 8 * fq;
#pragma unroll
        for (int ai = 0; ai < 2; ++ai)
#pragma unroll
            for (int m = 0; m < 4; ++m) { const int row = row0 + ai * HALF + m * 16; const float rs = 1.0f / sqrtf(sq[row] * invn + eps); bf16_t* rowp = O + (size_t)row * ldc + col0;
#pragma unroll
                for (int bj = 0; bj < 2; ++bj) { const f32x4 v0 = acc[ai][bj][m][0] * rs, v1 = acc[ai][bj][m][1] * rs;
                    u32x4 w; w.x = cvt_pk_bf16(v0[0], v0[1]); w.y = cvt_pk_bf16(v0[2], v0[3]); w.z = cvt_pk_bf16(v1[0], v1[1]); w.w = cvt_pk_bf16(v1[2], v1[3]);
                    *(u32x4*)(rowp + bj * HALF) = w; } }
    }
};
struct EpiUkv {
    static constexpr bool PERM = true, AFTER_DRAIN = false;
    bf16_t* KD; bf16_t* VD; const float* sq; float invn, eps;
    __device__ __forceinline__ void operator()(const f32x4 (&acc)[2][2][4][2], const Unit& u, int wr, int wc, int fr, int fq) const {
        const int row0 = u.pm * BM + wr * 64 + fr, cc = wc * 32 + 8 * fq;
#pragma unroll
        for (int ai = 0; ai < 2; ++ai)
#pragma unroll
            for (int m = 0; m < 4; ++m) { const int row = row0 + ai * HALF + m * 16; const float rs = 1.0f / sqrtf(sq[row] * invn + eps);
#pragma unroll
                for (int bj = 0; bj < 2; ++bj) { const f32x4 v0 = acc[ai][bj][m][0] * rs, v1 = acc[ai][bj][m][1] * rs;
                    u32x4 w; w.x = cvt_pk_bf16(v0[0], v0[1]); w.y = cvt_pk_bf16(v0[2], v0[3]); w.z = cvt_pk_bf16(v1[0], v1[1]); w.w = cvt_pk_bf16(v1[2], v1[3]);
                    bf16_t* dst = bj == 0 ? KD + (size_t)row * 1536 + u.pn * 192 + cc : VD + (size_t)row * 1024 + u.pn * 128 + cc;
                    *(u32x4*)dst = w; } }
    }
};
template <class Epi, class Sched, bool ALIGN_EPI = false, bool SP2 = false>
__device__ __forceinline__ void gemm_phase(PG8_LAS unsigned char* lds, const Gemm g, const Sched& S, const Epi& E) {
    int tid_o_ = threadIdx.x; asm volatile("" : "+v"(tid_o_)); const int tid = tid_o_, wid = __builtin_amdgcn_readfirstlane(tid >> 6), lane = tid & 63, wr = wid >> 2, wc = wid & 3, fr = lane & 15, fq = lane >> 4;
    const int K = g.K, nt = K / BK;
    unsigned voffA[2], voffB[2];
#pragma unroll
    for (int i = 0; i < 2; ++i) { int R, C; stage_rc(tid * 16 + i * 8192, R, C); const int Rb = Epi::PERM ? ((R & ~31) + perm32(R & 31)) : R;
        voffA[i] = (unsigned)(R * g.lda + C) * 2u; voffB[i] = (unsigned)(Rb * K + C) * 2u; }
    const size_t kstep = (size_t)(BK * 2);
    const size_t hstepB = (size_t)HALF * K * 2, hstepA = (size_t)HALF * g.lda * 2;
    const size_t tstepA = 2 * hstepA, tstepB = 2 * hstepB;
    const unsigned ldsw = (unsigned)wid * 1024u;
    const int aoff = lds_byte(wr * 64 + fr, fq * 8), boff = lds_byte(wc * 32 + fr, fq * 8);
#define PG8_SA(b, h) (((b) * 2 + (h)) * HTB)
#define PG8_SB(b, h) ((4 + (b) * 2 + (h)) * HTB)
#define PG8_STAGE(bufoff, gbase, voff) do { _Pragma("unroll") for (int _i = 0; _i < 2; ++_i) \
        __builtin_amdgcn_global_load_lds((const unsigned*)((const char*)(gbase) + (voff)[_i]), (PG8_LAS unsigned*)(lds + (bufoff) + ldsw + _i * 8192), 16, 0, 0); } while (0)
#define PG8_LDA(dst, b, h) do { _Pragma("unroll") for (int m = 0; m < 4; ++m) _Pragma("unroll") for (int k = 0; k < 2; ++k) dst[m][k] = *(const PG8_LAS bf16x8*)(lds + PG8_SA(b, h) + aoff + m * 2048 + k * 1024); } while (0)
#define PG8_LDB(dst, b, h) do { _Pragma("unroll") for (int n = 0; n < 2; ++n) _Pragma("unroll") for (int k = 0; k < 2; ++k) dst[n][k] = *(const PG8_LAS bf16x8*)(lds + PG8_SB(b, h) + boff + n * 2048 + k * 1024); } while (0)
#define PG8_MMA(ai, bj, At, Bt) do { __builtin_amdgcn_s_setprio(1); _Pragma("unroll") for (int m = 0; m < 4; ++m) _Pragma("unroll") for (int n = 0; n < 2; ++n) _Pragma("unroll") for (int k = 0; k < 2; ++k) \
        acc[ai][bj][m][n] = __builtin_amdgcn_mfma_f32_16x16x32_bf16(Bt[n][k], At[m][k], acc[ai][bj][m][n], 0, 0, 0); __builtin_amdgcn_s_setprio(0); } while (0)
#define PG8_WAIT_V(n) asm volatile("s_waitcnt vmcnt(" #n ")" ::: "memory")
#define PG8_WAIT_L(n) asm volatile("s_waitcnt lgkmcnt(" #n ")" ::: "memory")
#define PG8_BAR __builtin_amdgcn_s_barrier()
#define PG8_SCHED __builtin_amdgcn_sched_barrier(0)
    Unit cur, nxt; int ui = 0;
    if (!S.next(0, cur)) return;
    f32x4 acc[2][2][4][2];
#pragma unroll
    for (int a = 0; a < 2; ++a)
#pragma unroll
        for (int b = 0; b < 2; ++b)
#pragma unroll
            for (int m = 0; m < 4; ++m)
#pragma unroll
                for (int n = 0; n < 2; ++n) acc[a][b][m][n] = (f32x4){0.f, 0.f, 0.f, 0.f};
    bf16x8 At[4][2], B0[2][2], B1[2][2];
    const char* cA = (const char*)g.A + (size_t)cur.pm * tstepA; const char* cB = (const char*)g.Bt + (size_t)cur.pn * tstepB;
    S.a_ready(cur);
    if constexpr (SP2) {
        PG8_STAGE(PG8_SB(0, 0), cB, voffB); PG8_STAGE(PG8_SB(0, 1), cB + hstepB, voffB); PG8_STAGE(PG8_SA(0, 0), cA, voffA); PG8_STAGE(PG8_SA(0, 1), cA + hstepA, voffA);
        if (wr == 1) PG8_BAR;
        PG8_WAIT_V(2); PG8_BAR;
        PG8_STAGE(PG8_SB(1, 0), cB + kstep, voffB); PG8_STAGE(PG8_SA(1, 0), cA + kstep, voffA); PG8_STAGE(PG8_SB(1, 1), cB + hstepB + kstep, voffB);
        PG8_WAIT_V(6); PG8_BAR;
    } else {
        PG8_STAGE(PG8_SB(0, 0), cB, voffB); PG8_STAGE(PG8_SA(0, 0), cA, voffA); PG8_STAGE(PG8_SB(0, 1), cB + hstepB, voffB); PG8_STAGE(PG8_SA(0, 1), cA + hstepA, voffA);
        if (wr == 1) PG8_BAR;
        PG8_WAIT_V(4); PG8_BAR;
        PG8_STAGE(PG8_SB(1, 0), cB + kstep, voffB); PG8_STAGE(PG8_SA(1, 0), cA + kstep, voffA); PG8_STAGE(PG8_SB(1, 1), cB + hstepB + kstep, voffB);
        PG8_WAIT_V(6); PG8_BAR;
    }
    for (;;) {
        const bool has_next = S.next(ui + 1, nxt);
        const char* nA = has_next ? (const char*)g.A + (size_t)nxt.pm * tstepA : cA; const char* nB = has_next ? (const char*)g.Bt + (size_t)nxt.pn * tstepB : cB;
        for (int t = 0; t < nt; t += 2) {
            const bool last = (t == nt - 2);
            const char* a1 = cA + (size_t)(t + 1) * kstep;
            const char* a2 = last ? nA : cA + (size_t)(t + 2) * kstep; const char* b2 = last ? nB : cB + (size_t)(t + 2) * kstep;
            const char* a3 = a2 + kstep; const char* b3 = b2 + kstep;
            if (last && has_next) S.a_ready(nxt);
            if constexpr (SP2) {
            PG8_LDB(B0, 0, 0); PG8_LDB(B1, 0, 1); PG8_SCHED; PG8_LDA(At, 0, 0); PG8_STAGE(PG8_SA(1, 1), a1 + hstepA, voffA);
            PG8_WAIT_V(8); PG8_WAIT_L(0); PG8_BAR; PG8_MMA(0, 0, At, B0); PG8_MMA(0, 1, At, B1); PG8_BAR; PG8_SCHED;
            PG8_LDA(At, 0, 1); PG8_STAGE(PG8_SB(0, 0), b2, voffB); PG8_STAGE(PG8_SB(0, 1), b2 + hstepB, voffB); PG8_STAGE(PG8_SA(0, 0), a2, voffA);
            PG8_WAIT_V(8); PG8_WAIT_L(0); PG8_BAR; PG8_MMA(1, 0, At, B0); PG8_MMA(1, 1, At, B1); PG8_BAR; PG8_SCHED;
            PG8_LDB(B0, 1, 0); PG8_LDB(B1, 1, 1); PG8_SCHED; PG8_LDA(At, 1, 0); PG8_STAGE(PG8_SA(0, 1), a2 + hstepA, voffA);
            PG8_WAIT_V(8); PG8_WAIT_L(0); PG8_BAR; PG8_MMA(0, 0, At, B0); PG8_MMA(0, 1, At, B1); PG8_BAR; PG8_SCHED;
            PG8_LDA(At, 1, 1); PG8_STAGE(PG8_SB(1, 0), b3, voffB); PG8_STAGE(PG8_SB(1, 1), b3 + hstepB, voffB); PG8_STAGE(PG8_SA(1, 0), a3, voffA);
            PG8_WAIT_V(8); PG8_WAIT_L(0); PG8_BAR; PG8_MMA(1, 0, At, B0); PG8_MMA(1, 1, At, B1); PG8_BAR; PG8_SCHED;
            } else {
            PG8_LDB(B0, 0, 0); PG8_SCHED; PG8_LDA(At, 0, 0); PG8_STAGE(PG8_SA(1, 1), a1 + hstepA, voffA);
            PG8_WAIT_L(8); PG8_BAR; PG8_WAIT_L(0); PG8_MMA(0, 0, At, B0); PG8_BAR; PG8_SCHED;
            PG8_LDB(B1, 0, 1); PG8_STAGE(PG8_SB(0, 0), b2, voffB);
            PG8_BAR; PG8_WAIT_L(0); PG8_MMA(0, 1, At, B1); PG8_BAR;
            PG8_LDA(At, 0, 1); PG8_STAGE(PG8_SA(0, 0), a2, voffA);
            PG8_BAR; PG8_WAIT_L(0); PG8_MMA(1, 0, At, B0); PG8_BAR; PG8_SCHED;
            PG8_STAGE(PG8_SB(0, 1), b2 + hstepB, voffB);
            PG8_WAIT_V(6); PG8_BAR; PG8_MMA(1, 1, At, B1); PG8_BAR;
            PG8_LDB(B0, 1, 0); PG8_SCHED; PG8_LDA(At, 1, 0); PG8_STAGE(PG8_SA(0, 1), a2 + hstepA, voffA);
            PG8_WAIT_L(8); PG8_BAR; PG8_WAIT_L(0); PG8_MMA(0, 0, At, B0); PG8_BAR; PG8_SCHED;
            PG8_LDB(B1, 1, 1); PG8_STAGE(PG8_SB(1, 0), b3, voffB);
            PG8_BAR; PG8_WAIT_L(0); PG8_MMA(0, 1, At, B1); PG8_BAR;
            PG8_LDA(At, 1, 1); PG8_STAGE(PG8_SA(1, 0), a3, voffA);
            PG8_BAR; PG8_WAIT_L(0); PG8_MMA(1, 0, At, B0); PG8_BAR; PG8_SCHED;
            PG8_STAGE(PG8_SB(1, 1), b3 + hstepB, voffB);
            PG8_WAIT_V(6); PG8_BAR; PG8_MMA(1, 1, At, B1); PG8_BAR;
            }
        }
        if constexpr (ALIGN_EPI) { if (wr == 0) PG8_BAR; }
        if constexpr (!Epi::AFTER_DRAIN) { E(acc, cur, wr, wc, fr, fq); S.done(cur); }
        if (!has_next) break;
#pragma unroll
        for (int a = 0; a < 2; ++a)
#pragma unroll
            for (int b = 0; b < 2; ++b)
#pragma unroll
                for (int m = 0; m < 4; ++m)
#pragma unroll
                    for (int n = 0; n < 2; ++n) acc[a][b][m][n] = (f32x4){0.f, 0.f, 0.f, 0.f};
        cur = nxt; cA = nA; cB = nB; ++ui;
        if constexpr (ALIGN_EPI) { if (wr == 1) PG8_BAR; }
    }
    PG8_WAIT_V(0);
    if constexpr (!ALIGN_EPI) { if (wr == 0) PG8_BAR; }
    PG8_BAR;
    if constexpr (Epi::AFTER_DRAIN) { E.fused(acc, cur, wr, wc, fr, fq, lds, wid, lane); S.done(cur); }
#undef PG8_SA
#undef PG8_SB
#undef PG8_STAGE
#undef PG8_LDA
#undef PG8_LDB
#undef PG8_MMA
#undef PG8_WAIT_V
#undef PG8_WAIT_L
#undef PG8_BAR
#undef PG8_SCHED
}
}

constexpr int S = 16384, DM = 2048, DFF = 5632, NGU = 2 * DFF;
constexpr int EIN = 7248, EINP = 7424, OIN = 4416, OINP = 4608;
constexpr float ALPHA = 1.4142135623730951f;
constexpr float LN_EPS = 1e-5f, RMS_EPS = 1e-6f, DIFF_EPS = 1e-5f;
constexpr int NWAVES = 8;
constexpr size_t MiB = 1u << 20;
constexpr size_t WS_CTL = 0, CTL_ZERO_BYTES = 1 * MiB;
constexpr size_t WS_LSE = 1 * MiB;
constexpr size_t WS_WFA = 4 * MiB, WS_WFB = 70 * MiB;
constexpr size_t WF_DOWN_OFF = (size_t)NGU * DM * 2;
constexpr size_t WS_WEIN = 136 * MiB, WS_WOIN = 165 * MiB, WS_WEOUT = 183 * MiB, WS_WOOUT = 191 * MiB, WS_WUQ = 199 * MiB, WS_WUKV = 202 * MiB;
constexpr size_t WS_X = 204 * MiB;
constexpr size_t WS_Y = 268 * MiB;
constexpr size_t WS_HP = 396 * MiB;
constexpr size_t WS_O = 628 * MiB;
constexpr size_t WS_END = 692 * MiB;
constexpr int CW_BAR = 4096;
constexpr int CW_QCD = 2048;
constexpr int CW_QB = 2112;
constexpr int CW_NRMB = 1088;
constexpr int CW_NEAR = 1152;
constexpr int CW_NRM = 1024;
constexpr int CW_SQQ = 65536, CW_SQKV = 65536 + 16384;
constexpr int RING_OFF = 0, RING_BYTES = 131072;
constexpr int KI_RING_OFF = RING_BYTES;
constexpr int LDSCTL_OFF = RING_BYTES + 16384, MISC_OFF = LDSCTL_OFF + 320;
constexpr int LDS_BYTES = 151552;

#define GAS __attribute__((address_space(1)))
#define LAS __attribute__((address_space(3)))
typedef unsigned short bf16;
typedef unsigned v4u __attribute__((ext_vector_type(4)));
typedef unsigned v2u __attribute__((ext_vector_type(2)));
typedef float f32x4 __attribute__((ext_vector_type(4)));
typedef short bf16x8 __attribute__((ext_vector_type(8)));
typedef GAS unsigned gu32;
#define LDS_WAIT() asm volatile("s_waitcnt lgkmcnt(0)" ::: "memory")
#define VM_WAIT() asm volatile("s_waitcnt vmcnt(0)" ::: "memory")
__device__ __forceinline__ unsigned f2bf(float f) { unsigned u = __builtin_bit_cast(unsigned, f); return (u + 0x7fffu + ((u >> 16) & 1u)) >> 16; }
__device__ __forceinline__ unsigned pk2(float lo, float hi) { return f2bf(lo) | (f2bf(hi) << 16); }
__device__ __forceinline__ float bflo(unsigned w) { return __uint_as_float(w << 16); }
__device__ __forceinline__ float bfhi(unsigned w) { return __uint_as_float(w & 0xffff0000u); }
#define XB_TMO      128
#define XB_XCNT(j)  (256  + 64 * (j))
#define XB_XSUB(j)  (1280 + 64 * (j))
#define XB_XGEN(j)  (2304 + 64 * (j))
#define XB_TOP      3328
#define XB_TOPGEN   3392
#define XCD_BAR_WORDS 3456
#define XB_SPIN_CAP (1u << 18)

__device__ __forceinline__ unsigned xb_ld(unsigned* p)              { return __hip_atomic_load(p, __ATOMIC_RELAXED, __HIP_MEMORY_SCOPE_AGENT); }
__device__ __forceinline__ unsigned xb_add(unsigned* p, unsigned v) { return __hip_atomic_fetch_add(p, v, __ATOMIC_RELAXED, __HIP_MEMORY_SCOPE_AGENT); }
__device__ __forceinline__ unsigned xb_xcc_id() { return (unsigned)__builtin_amdgcn_s_getreg((3 << 11) | 20) & 0xFu; }
#define XB_SPIN(cond, bar) do { unsigned _sp = 0; while (cond) { __builtin_amdgcn_s_sleep(1); \
    if ((++_sp & 255u) == 0u) { if (xb_ld(&(bar)[XB_TMO])) break; if (_sp > XB_SPIN_CAP) { atomicAdd(&(bar)[XB_TMO], 1u); break; } } } } while (0)

struct XcdBarrier {
    unsigned* bar; unsigned x;
    volatile LAS unsigned* st;
};

__device__ __forceinline__ XcdBarrier xcd_barrier_post(unsigned* bar, volatile LAS unsigned* st) {
    XcdBarrier b; b.bar = bar; b.x = xb_xcc_id(); b.st = st;
    if (threadIdx.x == 0) (void)xb_add(&bar[XB_XCNT(b.x)], 1u);
    return b;
}
__device__ __forceinline__ void xcd_barrier_complete(unsigned* bar, unsigned x, unsigned& nloc, unsigned& nx) {
    const unsigned G = gridDim.x * gridDim.y * gridDim.z;
    unsigned sum, cnt, mine, sp = 0u;
    for (;;) {
        sum = 0u; cnt = 0u; mine = 0u;
#pragma unroll
        for (unsigned j = 0; j < 16; ++j) { const unsigned c = xb_ld(&bar[XB_XCNT(j)]); sum += c; cnt += (c > 0u) ? 1u : 0u; mine = (j == x) ? c : mine; }
        if (sum == G) break;
        __builtin_amdgcn_s_sleep(1);
        if ((++sp & 255u) == 0u) { if (xb_ld(&bar[XB_TMO])) break; if (sp > XB_SPIN_CAP) { atomicAdd(&bar[XB_TMO], 1u); break; } }
    }
    nloc = mine > 0u ? mine : 1u; nx = cnt > 0u ? cnt : 1u;
}

__device__ __forceinline__ void xcd_barrier(const XcdBarrier& b) {
    asm volatile("s_waitcnt vmcnt(0)" ::: "memory");
    __syncthreads();
    if (threadIdx.x == 0) {
        unsigned* bar = b.bar;
        __builtin_amdgcn_s_waitcnt(0);
        unsigned nloc = b.st[0], nx = b.st[1];
        if (nloc == 0u) { xcd_barrier_complete(bar, b.x, nloc, nx); b.st[0] = nloc; b.st[1] = nx; }
        const unsigned old = xb_add(&bar[XB_XSUB(b.x)], 1u);
        const unsigned gen = old / nloc;
        if (old + 1u == (gen + 1u) * nloc) {
            __builtin_amdgcn_fence(__ATOMIC_RELEASE, "agent");
            asm volatile("s_waitcnt vmcnt(0)" ::: "memory");
            const unsigned og = xb_add(&bar[XB_TOP], 1u);
            const unsigned tg = og / nx;
            if (og + 1u == (tg + 1u) * nx) xb_add(&bar[XB_TOPGEN], 1u);
            else XB_SPIN(xb_ld(&bar[XB_TOPGEN]) == tg, bar);
            __builtin_amdgcn_fence(__ATOMIC_ACQUIRE, "agent");
            xb_add(&bar[XB_XGEN(b.x)], 1u);
            asm volatile("s_waitcnt vmcnt(0)" ::: "memory");
        } else {
            XB_SPIN(xb_ld(&bar[XB_XGEN(b.x)]) == gen, bar);
            __builtin_amdgcn_fence(__ATOMIC_ACQUIRE, "agent");
            asm volatile("s_waitcnt vmcnt(0)" ::: "memory");
        }
    }
    __syncthreads();
}

namespace fa {
typedef short bf16x8 __attribute__((ext_vector_type(8)));
typedef short s16x4 __attribute__((ext_vector_type(4)));
typedef float f32x16 __attribute__((ext_vector_type(16)));
typedef unsigned u32x4 __attribute__((ext_vector_type(4)));
typedef unsigned u32x2 __attribute__((ext_vector_type(2)));
typedef unsigned short bf16;
#define FA_SBAR() __builtin_amdgcn_sched_barrier(0)
__device__ __forceinline__ int lane_opaque() { int l = (int)__builtin_amdgcn_mbcnt_hi(~0u, __builtin_amdgcn_mbcnt_lo(~0u, 0u)); asm volatile("" : "+v"(l)); return l; }
__device__ __forceinline__ float shx(float v, int m, int l) { return __int_as_float(__builtin_amdgcn_ds_bpermute((l ^ m) << 2, __float_as_int(v))); }
__device__ __forceinline__ int crow(int r, int hi) { return (r & 3) + 8 * (r >> 2) + 4 * hi; }
__device__ __forceinline__ unsigned cvtpk(float lo, float hi) { unsigned r; asm volatile("v_cvt_pk_bf16_f32 %0, %1, %2" : "=v"(r) : "v"(lo), "v"(hi)); return r; }
__device__ __forceinline__ int v_st(int k, int c) { const int kk = (k & ~0xC) | ((k & 4) << 1) | ((k & 8) >> 1); return ((kk >> 3) * 4 + (c >> 5)) * 512 + ((kk & 7) * 32 + (c & 31)) * 2; }
__device__ __forceinline__ int v_rd_base(int lane) { return ((lane & 3) << 3) | (((lane >> 2) & 3) << 6) | (((lane >> 4) & 1) << 5) | (((lane >> 5) & 1) << 8); }
constexpr int v_rd_off(int d0, int ks, int half) { return d0 * 512 + ks * 4096 + half * 2048; }
template <int OFF> __device__ __forceinline__ s16x4 tr_read(int vb) { s16x4 r; asm volatile("ds_read_b64_tr_b16 %0, %1 offset:%2" : "=&v"(r) : "v"(vb), "i"(OFF) : "memory"); return r; }
template <int D0> __device__ __forceinline__ void pv_one(f32x16& od, int vb, bf16x8 pa0, bf16x8 pa1, bf16x8 pa2, bf16x8 pa3) {
    const s16x4 l0 = tr_read<v_rd_off(D0, 0, 0)>(vb), h0 = tr_read<v_rd_off(D0, 0, 1)>(vb), l1 = tr_read<v_rd_off(D0, 1, 0)>(vb), h1 = tr_read<v_rd_off(D0, 1, 1)>(vb);
    const s16x4 l2 = tr_read<v_rd_off(D0, 2, 0)>(vb), h2 = tr_read<v_rd_off(D0, 2, 1)>(vb), l3 = tr_read<v_rd_off(D0, 3, 0)>(vb), h3 = tr_read<v_rd_off(D0, 3, 1)>(vb);
    asm volatile("s_waitcnt lgkmcnt(0)" ::: "memory"); FA_SBAR();
#define FA_PK(L, H) (bf16x8){L[0], L[1], L[2], L[3], H[0], H[1], H[2], H[3]}
    od = __builtin_amdgcn_mfma_f32_32x32x16_bf16(pa0, FA_PK(l0, h0), od, 0, 0, 0);
    od = __builtin_amdgcn_mfma_f32_32x32x16_bf16(pa1, FA_PK(l1, h1), od, 0, 0, 0);
    od = __builtin_amdgcn_mfma_f32_32x32x16_bf16(pa2, FA_PK(l2, h2), od, 0, 0, 0);
    od = __builtin_amdgcn_mfma_f32_32x32x16_bf16(pa3, FA_PK(l3, h3), od, 0, 0, 0);
#undef FA_PK
}
__device__ __forceinline__ void pv_d0(f32x16* o, int vb, bf16x8 pa0, bf16x8 pa1, bf16x8 pa2, bf16x8 pa3) {
    pv_one<0>(o[0], vb, pa0, pa1, pa2, pa3); pv_one<1>(o[1], vb, pa0, pa1, pa2, pa3); pv_one<2>(o[2], vb, pa0, pa1, pa2, pa3); pv_one<3>(o[3], vb, pa0, pa1, pa2, pa3);
}
struct UnitP {
    const bf16* Q; size_t ldq;
    const bf16* K; size_t ldk;
    const bf16* V; size_t ldv;
    int q0;
    int kt0, kt1;
    float sl2;
    float c2;
    const unsigned* mask;
};
constexpr int WIN = 128;
constexpr float THR2 = 11.5f;
template <int DQK, bool WINDOW, bool ALIBI, bool MASK, bool ROPEQ>
__device__ __forceinline__ void attn_unit(const UnitP& U, LAS unsigned char* lds, f32x16 (&o)[4], float& lse2) {
    constexpr int KROWB = DQK * 2, SHM_V = 16384, SHM_K = 64 * KROWB, KOFF = 2 * SHM_V, WSOFF = KOFF + 2 * 64 * 192 * 2;
    constexpr int KCH = DQK / 8, KPT = 64 * KCH / 512, ND0 = DQK / 16;
    int tid_o_ = threadIdx.x; asm volatile("" : "+v"(tid_o_)); const int tid = tid_o_, wid = __builtin_amdgcn_readfirstlane(tid >> 6), lane = tid & 63, r32 = lane & 31, hi = lane >> 5;
    LAS float* wsf = (LAS float*)(lds + WSOFF + wid * 256);
    float m_reg = -1e30f, l_reg = 0.f;
#pragma unroll
    for (int d = 0; d < 4; ++d)
#pragma unroll
        for (int r = 0; r < 16; ++r) o[d][r] = 0.f;
    bf16x8 qr[ND0];
    const int qi = U.q0 + wid * 32 + r32;
    {   const bf16* Qw = U.Q + (size_t)(wid * 32 + r32) * U.ldq + hi * 8;
#pragma unroll
        for (int d0 = 0; d0 < ND0; ++d0) qr[d0] = *(const bf16x8*)(Qw + d0 * 16);
        if constexpr (ROPEQ) {
#pragma unroll
            for (int pb = 0; pb < 2; ++pb) { bf16x8 a = qr[ND0 - 4 + pb], b = qr[ND0 - 2 + pb];
#pragma unroll
                for (int e = 0; e < 8; ++e) { const int fi = pb * 16 + hi * 8 + e; const float inv = __builtin_amdgcn_exp2f(-0.41524101186092029f * (float)fi);
                    const float ang = (float)qi * inv; const float n = rintf(ang * 0.15915494309189535f);
                    float rr = fmaf(-n, 6.2831854820251465f, ang); rr = fmaf(-n, -1.7484555e-07f, rr); const float fr = rr * 0.15915494309189535f;
                    const float sn = __builtin_amdgcn_sinf(fr), cs = __builtin_amdgcn_cosf(fr);
                    const float x1 = __uint_as_float((unsigned)(unsigned short)a[e] << 16), x2 = __uint_as_float((unsigned)(unsigned short)b[e] << 16);
                    const unsigned w = cvtpk(x1 * cs - x2 * sn, x1 * sn + x2 * cs); a[e] = (short)(w & 0xffffu); b[e] = (short)(w >> 16); }
                qr[ND0 - 4 + pb] = a; qr[ND0 - 2 + pb] = b; }
        }
    }
    unsigned kgo[KPT], vgo[2];
#pragma unroll
    for (int i_ = 0; i_ < KPT; ++i_) { const int p_ = (wid + 8 * i_) * 1024 + lane * 16, row_ = p_ / KROWB, wi_ = (p_ % KROWB) ^ ((row_ & 7) << 4); kgo[i_] = (unsigned)((size_t)row_ * U.ldk * 2 + wi_); }
#pragma unroll
    for (int i_ = 0; i_ < 2; ++i_) { const int p_ = (wid + 8 * i_) * 1024 + lane * 16, sub_ = p_ >> 9, rem_ = p_ & 511, kk_ = (sub_ >> 2) * 8 + (rem_ >> 6), k_ = (kk_ & ~0xC) | ((kk_ & 4) << 1) | ((kk_ & 8) >> 1), col_ = (sub_ & 3) * 32 + ((rem_ & 63) >> 1);
        vgo[i_] = (unsigned)(((size_t)k_ * U.ldv + col_) * 2); }
#define FA_DMA(k0_, b_) do { const char* kg_ = (const char*)U.K + (size_t)(k0_) * U.ldk * 2; const char* vg_ = (const char*)U.V + (size_t)(k0_) * U.ldv * 2; \
        _Pragma("unroll") for (int i_ = 0; i_ < KPT; ++i_) __builtin_amdgcn_global_load_lds((const unsigned*)(kg_ + kgo[i_]), (LAS unsigned*)(lds + KOFF + (b_) * SHM_K + (wid + 8 * i_) * 1024), 16, 0, 0); \
        _Pragma("unroll") for (int i_ = 0; i_ < 2; ++i_) __builtin_amdgcn_global_load_lds((const unsigned*)(vg_ + vgo[i_]), (LAS unsigned*)(lds + (b_) * SHM_V + (wid + 8 * i_) * 1024), 16, 0, 0); } while (0)
    const int vb0 = (int)(unsigned)(uintptr_t)lds + v_rd_base(lane);
    const int NT = U.kt1 - U.kt0;
    const int qw0 = U.q0 + wid * 32, qw1 = qw0 + 31;
    u32x2 mw = {0u, 0u}, mwn = {0u, 0u};
    const unsigned* mrow = MASK ? U.mask + (size_t)(wid * 32 + r32) * 512 : nullptr;
    FA_DMA(U.kt0 * 64, 0); if constexpr (MASK) mw = *(const u32x2*)(mrow + U.kt0 * 2);
    asm volatile("s_waitcnt vmcnt(0)" ::: "memory"); __syncthreads();
    for (int jt = 0; jt < NT; ++jt) {
        const int k0 = (U.kt0 + jt) * 64, buf = jt & 1;
        const bool more = jt + 1 < NT;
        if (more) { FA_DMA(k0 + 64, buf ^ 1); if constexpr (MASK) mwn = *(const u32x2*)(mrow + (k0 >> 5) + 2); }
        const bool active = (k0 <= qw1) && (!WINDOW || (k0 + 63 >= qw0 - WIN));
        if (active) {
            f32x16 p0, p1;
#pragma unroll
            for (int r = 0; r < 16; ++r) { p0[r] = 0.f; p1[r] = 0.f; }
            const LAS unsigned char* kb = lds + KOFF + buf * SHM_K + r32 * KROWB; const int lp = (hi * 16) ^ ((r32 & 7) << 4);
            const LAS unsigned char* kq[4] = {kb + lp, kb + (lp ^ 32), kb + (lp ^ 64), kb + (lp ^ 96)};
#pragma unroll
            for (int d0 = 0; d0 < ND0; ++d0) {
                const bf16x8 b0 = *(const LAS bf16x8*)(kq[d0 & 3] + (d0 >> 2) * 128), b1 = *(const LAS bf16x8*)(kq[d0 & 3] + (d0 >> 2) * 128 + 32 * KROWB);
                p0 = __builtin_amdgcn_mfma_f32_32x32x16_bf16(b0, qr[d0], p0, 0, 0, 0);
                p1 = __builtin_amdgcn_mfma_f32_32x32x16_bf16(b1, qr[d0], p1, 0, 0, 0);
                if ((d0 & 3) == 3) FA_SBAR(); }
            const int lim = qi - k0 - 4 * hi;
            const float tb = ALIBI ? U.sl2 * (float)(-lim) : 0.f;
#pragma unroll
            for (int r = 0; r < 16; ++r) { const int c = (r & 3) + 8 * (r >> 2);
                if constexpr (ALIBI) { p0[r] = fmaf(p0[r], U.c2, fmaf((float)c, U.sl2, tb)); p1[r] = fmaf(p1[r], U.c2, fmaf((float)(c + 32), U.sl2, tb)); }
                else { p0[r] *= U.c2; p1[r] *= U.c2; } }
            const bool need_mask = (k0 + 63 > qw0) || (WINDOW && (k0 < qw1 - WIN));
            if (need_mask) {
#pragma unroll
                for (int r = 0; r < 16; ++r) { const int c = (r & 3) + 8 * (r >> 2); const int d0_ = lim - c, d1_ = lim - c - 32;
                    const bool ok0 = WINDOW ? ((unsigned)d0_ <= (unsigned)WIN) : (d0_ >= 0), ok1 = WINDOW ? ((unsigned)d1_ <= (unsigned)WIN) : (d1_ >= 0);
                    p0[r] = ok0 ? p0[r] : -INFINITY; p1[r] = ok1 ? p1[r] : -INFINITY; }
            }
            if constexpr (MASK) { const unsigned w0 = mw.x >> (4 * hi), w1 = mw.y >> (4 * hi);
#pragma unroll
                for (int r = 0; r < 16; ++r) { const int c = (r & 3) + 8 * (r >> 2);
                    const unsigned b0 = (unsigned)((int)(w0 << (31 - c)) >> 31), b1 = (unsigned)((int)(w1 << (31 - c)) >> 31);
                    p0[r] = __uint_as_float((__float_as_uint(p0[r]) & b0) | (0xff800000u & ~b0)); p1[r] = __uint_as_float((__float_as_uint(p1[r]) & b1) | (0xff800000u & ~b1)); }
            }
            FA_SBAR();
            float pmax = p0[0];
#pragma unroll
            for (int r = 1; r < 16; ++r) pmax = fmaxf(pmax, p0[r]);
#pragma unroll
            for (int r = 0; r < 16; ++r) pmax = fmaxf(pmax, p1[r]);
            { auto rr = __builtin_amdgcn_permlane32_swap(__float_as_uint(pmax), __float_as_uint(pmax), false, false); pmax = fmaxf(__uint_as_float(rr[0]), __uint_as_float(rr[1])); }
            float mn, alpha;
            if (__builtin_expect(__all(pmax - m_reg <= THR2), 1)) { mn = m_reg; alpha = 1.f; }
            else { mn = fmaxf(m_reg, pmax); alpha = __builtin_amdgcn_exp2f(m_reg - mn); m_reg = mn; }
            float ps = 0.f;
#pragma unroll
            for (int r = 0; r < 16; ++r) { p0[r] = __builtin_amdgcn_exp2f(p0[r] - mn); p1[r] = __builtin_amdgcn_exp2f(p1[r] - mn); ps += p0[r] + p1[r]; }
            { auto rr = __builtin_amdgcn_permlane32_swap(__float_as_uint(ps), __float_as_uint(ps), false, false); ps = __uint_as_float(rr[0]) + __uint_as_float(rr[1]); }
            l_reg = l_reg * alpha + ps;
            FA_SBAR();
            bf16x8 pa0, pa1, pa2, pa3;
#define FA_PK4(P, BASE, OUT) do { unsigned a0 = cvtpk(P[BASE + 0], P[BASE + 1]), a1 = cvtpk(P[BASE + 2], P[BASE + 3]);   \
    unsigned b0 = cvtpk(P[BASE + 4], P[BASE + 5]), b1 = cvtpk(P[BASE + 6], P[BASE + 7]);                              \
    auto r0 = __builtin_amdgcn_permlane32_swap(a0, b0, false, false); auto r1 = __builtin_amdgcn_permlane32_swap(a1, b1, false, false); \
    u32x4 w = {r0[0], r1[0], r0[1], r1[1]}; OUT = *reinterpret_cast<bf16x8*>(&w); } while (0)
            FA_PK4(p0, 0, pa0); FA_PK4(p0, 8, pa1); FA_PK4(p1, 0, pa2); FA_PK4(p1, 8, pa3);
#undef FA_PK4
            FA_SBAR();
            if (__any(alpha < 1.f)) { if (hi == 0) wsf[r32] = alpha; asm volatile("s_waitcnt lgkmcnt(0)" ::: "memory");
#pragma unroll
                for (int r = 0; r < 16; ++r) { const float al = wsf[crow(r, hi)];
#pragma unroll
                    for (int d = 0; d < 4; ++d) o[d][r] *= al; }
                asm volatile("s_waitcnt lgkmcnt(0)" ::: "memory"); }
            pv_d0(o, vb0 + buf * SHM_V, pa0, pa1, pa2, pa3);
        }
        if (more) { if constexpr (MASK) mw = mwn; }
        asm volatile("s_waitcnt vmcnt(0)" ::: "memory");
        __syncthreads();
    }
    if (hi == 0) wsf[32 + r32] = l_reg; asm volatile("s_waitcnt lgkmcnt(0)" ::: "memory");
#pragma unroll
    for (int r = 0; r < 16; ++r) { const float rl = __builtin_amdgcn_rcpf(wsf[32 + crow(r, hi)]);
#pragma unroll
        for (int d = 0; d < 4; ++d) o[d][r] *= rl; }
    asm volatile("s_waitcnt lgkmcnt(0)" ::: "memory");
    lse2 = m_reg + __builtin_amdgcn_logf(l_reg);
#undef FA_DMA
}
template <int DQK, bool ALIBI, bool MASK, bool ROPEQ>
__device__ __forceinline__ void attn_unit4(const UnitP& U, LAS unsigned char* lds, f32x16 (&o)[4], float& lse2) {
    constexpr int KROWB = DQK * 2, SHM_V = 16384, SHM_K = 64 * KROWB, KOFF = 3 * SHM_V, WSOFF = KOFF + 3 * 64 * 192 * 2, AUGOFF = WSOFF + 2048;
    constexpr int KCH = DQK / 8, KPT = 64 * KCH / 512, ND0 = DQK / 16;
#define FA4_SWZ(row_) ((KROWB == 256) ? (((row_) & 15) << 4) : ((((row_) >> 1) & 7) << 4))
    int tid_o_ = threadIdx.x; asm volatile("" : "+v"(tid_o_)); const int tid = tid_o_, wid = __builtin_amdgcn_readfirstlane(tid >> 6), lane = tid & 63, r32 = lane & 31, hi = lane >> 5;
    LAS float* wsf = (LAS float*)(lds + WSOFF + wid * 256);
    float m_reg = -1e30f, l_reg = 0.f;
#pragma unroll
    for (int d = 0; d < 4; ++d)
#pragma unroll
        for (int r = 0; r < 16; ++r) o[d][r] = 0.f;
    bf16x8 qr[ND0];
    const int qi = U.q0 + wid * 32 + r32;
    {   const bf16* Qw = U.Q + (size_t)(wid * 32 + r32) * U.ldq + hi * 8;
#pragma unroll
        for (int d0 = 0; d0 < ND0; ++d0) qr[d0] = *(const bf16x8*)(Qw + d0 * 16);
        if constexpr (ROPEQ) {
#pragma unroll
            for (int pb = 0; pb < 2; ++pb) { bf16x8 a = qr[ND0 - 4 + pb], b = qr[ND0 - 2 + pb];
#pragma unroll
                for (int e = 0; e < 8; ++e) { const int fi = pb * 16 + hi * 8 + e; const float inv = __builtin_amdgcn_exp2f(-0.41524101186092029f * (float)fi);
                    const float ang = (float)qi * inv; const float n = rintf(ang * 0.15915494309189535f);
                    float rr = fmaf(-n, 6.2831854820251465f, ang); rr = fmaf(-n, -1.7484555e-07f, rr); const float fr = rr * 0.15915494309189535f;
                    const float sn = __builtin_amdgcn_sinf(fr), cs = __builtin_amdgcn_cosf(fr);
                    const float x1 = __uint_as_float((unsigned)(unsigned short)a[e] << 16), x2 = __uint_as_float((unsigned)(unsigned short)b[e] << 16);
                    const unsigned w = cvtpk(x1 * cs - x2 * sn, x1 * sn + x2 * cs); a[e] = (short)(w & 0xffffu); b[e] = (short)(w >> 16); }
                qr[ND0 - 4 + pb] = a; qr[ND0 - 2 + pb] = b; }
        }
    }
    bf16x8 qaug = {0, 0, 0, 0, 0, 0, 0, 0};
    if constexpr (ALIBI) { const float g_ = U.sl2 / U.c2; const unsigned gh_ = (__float_as_uint(g_) + 0x7fffu + ((__float_as_uint(g_) >> 16) & 1u)) & 0xffff0000u; const float gl_ = g_ - __uint_as_float(gh_);
        const unsigned glb_ = (__float_as_uint(gl_) + 0x7fffu + ((__float_as_uint(gl_) >> 16) & 1u)) & 0xffff0000u;
        const unsigned w0_ = (__float_as_uint(-128.f * __uint_as_float(gh_)) >> 16) | (__float_as_uint(-__uint_as_float(gh_)) & 0xffff0000u);
        const unsigned w1_ = (__float_as_uint(-128.f * __uint_as_float(glb_)) >> 16) | (__float_as_uint(-__uint_as_float(glb_)) & 0xffff0000u);
        const u32x4 qa_ = {hi ? 0u : w0_, hi ? 0u : w1_, 0u, 0u}; qaug = *reinterpret_cast<const bf16x8*>(&qa_); }
    const LAS unsigned char* augp = lds + AUGOFF + r32 * 32 + hi * 16;
    unsigned kgo[KPT], vgo[2];
#pragma unroll
    for (int i_ = 0; i_ < KPT; ++i_) { const int p_ = (wid + 8 * i_) * 1024 + lane * 16, row_ = p_ / KROWB, wi_ = (p_ % KROWB) ^ FA4_SWZ(row_); kgo[i_] = (unsigned)((size_t)row_ * U.ldk * 2 + wi_); }
#pragma unroll
    for (int i_ = 0; i_ < 2; ++i_) { const int p_ = (wid + 8 * i_) * 1024 + lane * 16, sub_ = p_ >> 9, rem_ = p_ & 511, kk_ = (sub_ >> 2) * 8 + (rem_ >> 6), k_ = (kk_ & ~0xC) | ((kk_ & 4) << 1) | ((kk_ & 8) >> 1), col_ = (sub_ & 3) * 32 + ((rem_ & 63) >> 1);
        vgo[i_] = (unsigned)(((size_t)k_ * U.ldv + col_) * 2); }
#define FA3_DMA(k0_, kb_, vb_) do { const char* kg_ = (const char*)U.K + (size_t)(k0_) * U.ldk * 2; const char* vg_ = (const char*)U.V + (size_t)(k0_) * U.ldv * 2; \
        _Pragma("unroll") for (int i_ = 0; i_ < KPT; ++i_) __builtin_amdgcn_global_load_lds((const unsigned*)(kg_ + kgo[i_]), (LAS unsigned*)(lds + KOFF + (kb_) * SHM_K + (wid + 8 * i_) * 1024), 16, 0, 0); \
        _Pragma("unroll") for (int i_ = 0; i_ < 2; ++i_) __builtin_amdgcn_global_load_lds((const unsigned*)(vg_ + vgo[i_]), (LAS unsigned*)(lds + (vb_) * SHM_V + (wid + 8 * i_) * 1024), 16, 0, 0); \
        if constexpr (ALIBI) { if (tid < 128) { const int rel_ = U.q0 + 255 - ((k0_) + (tid >> 1)); const unsigned ab_ = (__float_as_uint((float)(rel_ >> 7)) >> 16) | (__float_as_uint((float)(rel_ & 127)) & 0xffff0000u); \
            const unsigned z_ = (tid & 1) ? 0u : ab_; *(LAS u32x4*)(lds + AUGOFF + (kb_) * 2048 + tid * 16) = (u32x4){z_, z_, 0u, 0u}; } } } while (0)
    const int vb0 = (int)(unsigned)(uintptr_t)lds + v_rd_base(lane);
    const int NT = U.kt1 - U.kt0;
    const int qw0 = U.q0 + wid * 32, qw1 = qw0 + 31;
    const int swz_ = FA4_SWZ(r32); const int lp = (hi * 16) ^ (swz_ & 0x70); const int hsw = (KROWB == 256) ? (swz_ & 0x80) : 0;
    const LAS unsigned char* kbase = lds + KOFF + r32 * KROWB;
    const LAS unsigned char* kq0 = kbase + lp; const LAS unsigned char* kq1 = kbase + (lp ^ 32); const LAS unsigned char* kq2 = kbase + (lp ^ 64); const LAS unsigned char* kq3 = kbase + (lp ^ 96);
    bf16x8 pa0, pa1, pa2, pa3;
#define FA3_PK4(P, BASE, OUT) do { unsigned a0 = cvtpk(P[BASE + 0], P[BASE + 1]), a1 = cvtpk(P[BASE + 2], P[BASE + 3]);   \
    unsigned b0 = cvtpk(P[BASE + 4], P[BASE + 5]), b1 = cvtpk(P[BASE + 6], P[BASE + 7]);                              \
    auto r0 = __builtin_amdgcn_permlane32_swap(a0, b0, false, false); auto r1 = __builtin_amdgcn_permlane32_swap(a1, b1, false, false); \
    u32x4 w = {r0[0], r1[0], r0[1], r1[1]}; OUT = *reinterpret_cast<bf16x8*>(&w); } while (0)
#define FA3_SCORE(kb_, k0_, MW) do { f32x16 p0, p1; _Pragma("unroll") for (int r = 0; r < 16; ++r) { p0[r] = 0.f; p1[r] = 0.f; } const int so_ = (kb_) * SHM_K; \
        _Pragma("unroll") for (int d0 = 0; d0 < ND0; ++d0) { const LAS unsigned char* kp_ = ((d0 & 3) == 0 ? kq0 : (d0 & 3) == 1 ? kq1 : (d0 & 3) == 2 ? kq2 : kq3) + so_ + ((KROWB == 256) ? (((d0 >> 2) * 128) ^ hsw) : (d0 >> 2) * 128); \
            const bf16x8 b0_ = *(const LAS bf16x8*)(kp_), b1_ = *(const LAS bf16x8*)(kp_ + 32 * KROWB); \
            p0 = __builtin_amdgcn_mfma_f32_32x32x16_bf16(b0_, qr[d0], p0, 0, 0, 0); p1 = __builtin_amdgcn_mfma_f32_32x32x16_bf16(b1_, qr[d0], p1, 0, 0, 0); \
            if ((d0 & 3) == 3) FA_SBAR(); } \
        if constexpr (ALIBI) { const bf16x8 a0_ = *(const LAS bf16x8*)(augp + (kb_) * 2048), a1_ = *(const LAS bf16x8*)(augp + (kb_) * 2048 + 1024); \
            p0 = __builtin_amdgcn_mfma_f32_32x32x16_bf16(a0_, qaug, p0, 0, 0, 0); p1 = __builtin_amdgcn_mfma_f32_32x32x16_bf16(a1_, qaug, p1, 0, 0, 0); } \
        const int lim_ = qi - (k0_) - 4 * hi; \
        if ((k0_) + 63 > qw0) { _Pragma("unroll") for (int r = 0; r < 16; ++r) { const int c = (r & 3) + 8 * (r >> 2); p0[r] = (lim_ - c >= 0) ? p0[r] : -INFINITY; p1[r] = (lim_ - c - 32 >= 0) ? p1[r] : -INFINITY; } } \
        if constexpr (MASK) { const unsigned w0_ = MW.x >> (4 * hi), w1_ = MW.y >> (4 * hi); \
            _Pragma("unroll") for (int r = 0; r < 16; ++r) { const int c = (r & 3) + 8 * (r >> 2); \
                const unsigned b0_ = (unsigned)((int)(w0_ << (31 - c)) >> 31), b1_ = (unsigned)((int)(w1_ << (31 - c)) >> 31); \
                p0[r] = __uint_as_float((__float_as_uint(p0[r]) & b0_) | (0xff800000u & ~b0_)); p1[r] = __uint_as_float((__float_as_uint(p1[r]) & b1_) | (0xff800000u & ~b1_)); } } \
        FA_SBAR(); \
        float pmax_ = p0[0]; \
        _Pragma("unroll") for (int r = 1; r < 16; ++r) pmax_ = fmaxf(pmax_, p0[r]); \
        _Pragma("unroll") for (int r = 0; r < 16; ++r) pmax_ = fmaxf(pmax_, p1[r]); \
        { auto rr = __builtin_amdgcn_permlane32_swap(__float_as_uint(pmax_), __float_as_uint(pmax_), false, false); pmax_ = fmaxf(__uint_as_float(rr[0]), __uint_as_float(rr[1])); } \
        pmax_ *= U.c2; float mn_, alpha_; \
        if (__builtin_expect(__all(pmax_ - m_reg <= THR2), 1)) { mn_ = m_reg; alpha_ = 1.f; } \
        else { mn_ = fmaxf(m_reg, pmax_); alpha_ = __builtin_amdgcn_exp2f(m_reg - mn_); m_reg = mn_; } \
        float ps_ = 0.f; \
        _Pragma("unroll") for (int r = 0; r < 16; ++r) { p0[r] = __builtin_amdgcn_exp2f(fmaf(p0[r], U.c2, -mn_)); p1[r] = __builtin_amdgcn_exp2f(fmaf(p1[r], U.c2, -mn_)); ps_ += p0[r] + p1[r]; } \
        { auto rr = __builtin_amdgcn_permlane32_swap(__float_as_uint(ps_), __float_as_uint(ps_), false, false); ps_ = __uint_as_float(rr[0]) + __uint_as_float(rr[1]); } \
        l_reg = l_reg * alpha_ + ps_; \
        FA_SBAR(); \
        FA3_PK4(p0, 0, pa0); FA3_PK4(p0, 8, pa1); FA3_PK4(p1, 0, pa2); FA3_PK4(p1, 8, pa3); \
        FA_SBAR(); \
        if (__any(alpha_ < 1.f)) { if (hi == 0) wsf[r32] = alpha_; asm volatile("s_waitcnt lgkmcnt(0)" ::: "memory"); \
            _Pragma("unroll") for (int r = 0; r < 16; ++r) { const float al = wsf[crow(r, hi)]; _Pragma("unroll") for (int d = 0; d < 4; ++d) o[d][r] *= al; } \
            asm volatile("s_waitcnt lgkmcnt(0)" ::: "memory"); } } while (0)
    u32x2 mw = {0u, 0u}, mwn = {0u, 0u};
    const unsigned* mrow = MASK ? U.mask + (size_t)(wid * 32 + r32) * 512 : nullptr;
    FA3_DMA(U.kt0 * 64, 0, 0); if constexpr (MASK) mw = *(const u32x2*)(mrow + U.kt0 * 2);
    if (NT > 1) FA3_DMA(U.kt0 * 64 + 64, 1, 1);
    asm volatile("s_waitcnt vmcnt(0)" ::: "memory"); __syncthreads();
    int sl = 0;
#pragma nounroll
    for (int jt = 0; jt < NT; ++jt) {
        const int k0 = (U.kt0 + jt) * 64; const int s2 = sl == 0 ? 2 : sl - 1;
        if constexpr (MASK) { if (jt + 1 < NT) mwn = *(const u32x2*)(mrow + (k0 >> 5) + 2); }
        const bool more2 = jt + 2 < NT;
        if (more2) FA3_DMA(k0 + 128, s2, s2);
        if (k0 <= qw1) { FA3_SCORE(sl, k0, mw); pv_d0(o, vb0 + sl * SHM_V, pa0, pa1, pa2, pa3); }
        if constexpr (MASK) mw = mwn;
        sl = sl == 2 ? 0 : sl + 1;
        if (more2) asm volatile("s_waitcnt vmcnt(%0)" :: "n"(KPT + 2) : "memory");
        else asm volatile("s_waitcnt vmcnt(0)" ::: "memory");
        __syncthreads();
    }
    if (hi == 0) wsf[32 + r32] = l_reg; asm volatile("s_waitcnt lgkmcnt(0)" ::: "memory");
#pragma unroll
    for (int r = 0; r < 16; ++r) { const float rl = __builtin_amdgcn_rcpf(wsf[32 + crow(r, hi)]);
#pragma unroll
        for (int d = 0; d < 4; ++d) o[d][r] *= rl; }
    asm volatile("s_waitcnt lgkmcnt(0)" ::: "memory");
    lse2 = m_reg + __builtin_amdgcn_logf(l_reg);
#undef FA3_DMA
#undef FA4_SWZ
#undef FA3_PK4
#undef FA3_SCORE
}
__device__ __forceinline__ void store_o_bf16(const f32x16 (&o)[4], bf16* outw, size_t ldo, int r32, int hi) {
    asm volatile("" : "+v"(r32), "+v"(hi));
    const bool odd = r32 & 1; const int lo_ = lane_opaque();
#pragma unroll
    for (int d0 = 0; d0 < 4; ++d0)
#pragma unroll
        for (int rp = 0; rp < 8; ++rp) { const int r0 = 2 * rp, r1 = 2 * rp + 1;
            const float send = odd ? o[d0][r0] : o[d0][r1]; const float recv = shx(send, 1, lo_);
            const unsigned w = odd ? cvtpk(recv, o[d0][r1]) : cvtpk(o[d0][r0], recv);
            const int row = crow(odd ? r1 : r0, hi), col = d0 * 32 + (r32 & ~1);
            *(unsigned*)(outw + (size_t)row * ldo + col) = w; }
}
}
struct Frame {
    LAS unsigned char* lds;
    volatile LAS unsigned* MISC;
    gu32* ctl;
    int tid, lane, wave;
    int vcu, G, gw, NGW;
};
__device__ __forceinline__ float wave_sum(float v) {
    int l = (int)__builtin_amdgcn_mbcnt_hi(~0u, __builtin_amdgcn_mbcnt_lo(~0u, 0u)); asm volatile("" : "+v"(l));
#pragma unroll
    for (int o = 1; o < 64; o <<= 1) v += __int_as_float(__builtin_amdgcn_ds_bpermute((l ^ o) << 2, __float_as_int(v)));
    return v;
}
template <int MODE>
__device__ __forceinline__ void transpose_item(const float* W, int K, int N, int nblk, bf16* WT, const float* kscale, LAS float* scr, int item, int lane) {
    const int kb = item / nblk, nb = item % nblk, k0 = 64 * kb, n0 = 32 * nb;
    const int c4 = 4 * (lane & 7), nl = n0 + c4; const bool inb = nl < N;
    f32x4 v[8];
#pragma unroll
    for (int i = 0; i < 8; ++i) { const int kk = 8 * i + (lane >> 3); v[i] = inb ? *(const GAS f32x4*)(W + (size_t)(k0 + kk) * N + nl) : (f32x4){0.f, 0.f, 0.f, 0.f}; }
#pragma unroll
    for (int i = 0; i < 8; ++i) { const int kk = 8 * i + (lane >> 3); f32x4 x = v[i]; if (kscale) x = x * kscale[k0 + kk];
        LAS float* d = scr + kk * 33 + c4; d[0] = x[0]; d[1] = x[1]; d[2] = x[2]; d[3] = x[3]; }
    LDS_WAIT(); asm volatile("" ::: "memory");
    const int c = lane & 7;
#pragma unroll
    for (int j = 0; j < 4; ++j) { const int n = (lane >> 3) + 8 * j; const LAS float* s = scr + (8 * c) * 33 + n;
        v4u o; o.x = pk2(s[0 * 33], s[1 * 33]); o.y = pk2(s[2 * 33], s[3 * 33]); o.z = pk2(s[4 * 33], s[5 * 33]); o.w = pk2(s[6 * 33], s[7 * 33]);
        const int ng = n0 + n; const int drow = MODE == 0 ? ng : ((ng >> 7) * 256 + (ng & 127) + (MODE == 2 ? 128 : 0));
        *(GAS v4u*)(WT + (size_t)drow * K + k0 + 8 * c) = o; }
    LDS_WAIT(); asm volatile("" ::: "memory");
}
template <int MODE>
__device__ __forceinline__ void convert_weight(Frame& F, const float* W, int K, int N, int Npad, bf16* WT, const float* kscale) {
    LAS float* scr = (LAS float*)(F.lds + RING_OFF + F.wave * 16384);
    const int nblk = Npad / 32, nitems = (K / 64) * nblk;
    for (int it = F.gw; it < nitems; it += F.NGW) transpose_item<MODE>(W, K, N, nblk, WT, kscale, scr, it, F.lane);
}
__device__ __forceinline__ void convert_ffn(Frame& F, const float* wg, const float* wu, const float* wd, unsigned char* dst) {
    convert_weight<1>(F, wg, DM, DFF, DFF, (bf16*)dst, nullptr);
    convert_weight<2>(F, wu, DM, DFF, DFF, (bf16*)dst, nullptr);
    convert_weight<0>(F, wd, DFF, DM, DM, (bf16*)(dst + WF_DOWN_OFF), nullptr);
}
__device__ __forceinline__ void convert_x(Frame& F, const float* x, bf16* X) {
    const size_t n8 = (size_t)S * DM / 8;
    for (size_t i = (size_t)F.gw * 64 + F.lane; i < n8; i += (size_t)F.NGW * 64) {
        const f32x4 a = *(const GAS f32x4*)(x + i * 8), b = *(const GAS f32x4*)(x + i * 8 + 4);
        v4u o; o.x = pk2(a[0], a[1]); o.y = pk2(a[2], a[3]); o.z = pk2(b[0], b[1]); o.w = pk2(b[2], b[3]);
        *(GAS v4u*)(X + i * 8) = o; }
}
__device__ __forceinline__ void scale_x(Frame& F, const bf16* X, float* Y) {
    const size_t n8 = (size_t)S * DM / 8;
    for (size_t i = (size_t)F.gw * 64 + F.lane; i < n8; i += (size_t)F.NGW * 64) {
        const v4u w = *(const GAS v4u*)(X + i * 8);
        f32x4 a = {ALPHA * bflo(w.x), ALPHA * bfhi(w.x), ALPHA * bflo(w.y), ALPHA * bfhi(w.y)}, b = {ALPHA * bflo(w.z), ALPHA * bfhi(w.z), ALPHA * bflo(w.w), ALPHA * bfhi(w.w)};
        *(GAS f32x4*)(Y + i * 8) = a; *(GAS f32x4*)(Y + i * 8 + 4) = b; }
}
template <bool FINAL>
__device__ __forceinline__ void ln_phase(Frame& F, const float* Y, const float* g, const float* b, bf16* X, float* out) {
    for (int row = F.gw; row < S; row += F.NGW) {
        const GAS f32x4* yr = (const GAS f32x4*)(Y + (size_t)row * DM) + F.lane;
        f32x4 v[8]; float s = 0.f;
#pragma unroll
        for (int j = 0; j < 8; ++j) { v[j] = yr[64 * j]; s += (v[j][0] + v[j][1]) + (v[j][2] + v[j][3]); }
        const float mean = wave_sum(s) * (1.f / DM); float s2 = 0.f;
#pragma unroll
        for (int j = 0; j < 8; ++j) { v[j] = v[j] - mean; s2 += (v[j][0] * v[j][0] + v[j][1] * v[j][1]) + (v[j][2] * v[j][2] + v[j][3] * v[j][3]); }
        const float rstd = 1.f / sqrtf(wave_sum(s2) * (1.f / DM) + LN_EPS);
#pragma unroll
        for (int j = 0; j < 8; ++j) { const f32x4 gg = ((const GAS f32x4*)g)[64 * j + F.lane], bb = ((const GAS f32x4*)b)[64 * j + F.lane];
            const f32x4 o = v[j] * rstd * gg + bb;
            if (FINAL) ((GAS f32x4*)(out + (size_t)row * DM))[64 * j + F.lane] = o;
            else { v2u w; w.x = pk2(o[0], o[1]); w.y = pk2(o[2], o[3]); ((GAS v2u*)(X + (size_t)row * DM))[64 * j + F.lane] = w; } }
    }
}
constexpr float LOG2E = 1.4426950408889634f;
__device__ __forceinline__ void mixer_a_phase(Frame& F, const bf16* P, bf16* OA, float* LSE) {
    const int wid = F.wave, r32 = F.lane & 31, hi = F.lane >> 5;
    for (int u = F.vcu; u < 1536; u += F.G) {
        const int g = u >> 9, rem = u & 511, h = rem >> 6, j = rem & 63;
        const int dsh = 2 * g, d = 1 << dsh, c = j >> (6 - dsh), blk = j & ((64 >> dsh) - 1), I0 = blk * 256;
        fa::UnitP U; U.ldq = U.ldk = U.ldv = (size_t)d * EINP;
        const bf16* base = P + (size_t)c * EINP + h * 128;
        U.Q = base + (size_t)I0 * U.ldq; U.K = base + 1024; U.V = base + 2048;
        U.q0 = I0; U.kt0 = I0 ? (I0 >> 6) - 2 : 0; U.kt1 = (I0 >> 6) + 4;
        U.sl2 = exp2f(-(float)(h + 1)) * (float)d * LOG2E; U.c2 = 0.08838834764831845f * LOG2E; U.mask = nullptr;
        fa::f32x16 o[4]; float lse2;
        fa::attn_unit<128, true, true, false, false>(U, F.lds, o, lse2);
        const int row0 = I0 + wid * 32;
        fa::store_o_bf16(o, OA + (size_t)g * S * 1024 + ((size_t)row0 * d + c) * 1024 + h * 128, (size_t)d * 1024, r32, hi);
        if (hi == 0) LSE[((size_t)g * S + (size_t)(row0 + r32) * d + c) * 8 + h] = lse2;
    }
}
__device__ __forceinline__ void merge_a(Frame& F, const bf16* OA, const float* LSE, bf16* O) {
    const int h = F.lane >> 3;
    for (int pos = F.gw; pos < S; pos += F.NGW) {
        const float l0 = LSE[((size_t)0 * S + pos) * 8 + h], l1 = LSE[((size_t)1 * S + pos) * 8 + h], l2 = LSE[((size_t)2 * S + pos) * 8 + h];
        const float mx = fmaxf(l0, fmaxf(l1, l2)); float w0 = exp2f(l0 - mx), w1 = exp2f(l1 - mx), w2 = exp2f(l2 - mx); const float inv = 1.f / (w0 + w1 + w2); w0 *= inv; w1 *= inv; w2 *= inv;
#pragma unroll
        for (int hf = 0; hf < 2; ++hf) { const size_t off = (size_t)pos * 1024 + 16 * F.lane + 8 * hf;
            const v4u a = *(const GAS v4u*)(OA + off), b = *(const GAS v4u*)(OA + (size_t)S * 1024 + off), c = *(const GAS v4u*)(OA + (size_t)2 * S * 1024 + off);
            v4u o;
            o.x = pk2(w0 * bflo(a.x) + w1 * bflo(b.x) + w2 * bflo(c.x), w0 * bfhi(a.x) + w1 * bfhi(b.x) + w2 * bfhi(c.x));
            o.y = pk2(w0 * bflo(a.y) + w1 * bflo(b.y) + w2 * bflo(c.y), w0 * bfhi(a.y) + w1 * bfhi(b.y) + w2 * bfhi(c.y));
            o.z = pk2(w0 * bflo(a.z) + w1 * bflo(b.z) + w2 * bflo(c.z), w0 * bfhi(a.z) + w1 * bfhi(b.z) + w2 * bfhi(c.z));
            o.w = pk2(w0 * bflo(a.w) + w1 * bflo(b.w) + w2 * bflo(c.w), w0 * bfhi(a.w) + w1 * bfhi(b.w) + w2 * bfhi(c.w));
            *(GAS v4u*)(O + (size_t)pos * DM + 16 * F.lane + 8 * hf) = o; }
    }
}
typedef float f32x16 __attribute__((ext_vector_type(16)));
__device__ __forceinline__ unsigned okey(float f) { const unsigned u = __float_as_uint(f); return (u & 0x80000000u) ? ~u : (u | 0x80000000u); }
__device__ __forceinline__ int hswz(int w) { return (w & ~31) | ((w ^ (w >> 5)) & 31); }
__device__ __forceinline__ void find_kth(const LAS unsigned* hq, int target, int lane, int& bin, int& above) {
    unsigned w[32]; unsigned cl = 0;
#pragma unroll
    for (int i = 0; i < 32; ++i) { w[i] = hq[32 * lane + ((i ^ lane) & 31)]; cl += (w[i] & 0xffffu) + (w[i] >> 16); }
    unsigned suf = cl;
#pragma unroll
    for (int off = 1; off < 64; off <<= 1) { const unsigned t = __shfl_down(suf, off); if (lane + off < 64) suf += t; }
    const unsigned long long bal = __ballot((int)suf >= target);
    if (bal == 0ull) { bin = -1; above = 0; return; }
    const int L = 63 - __clzll((long long)bal);
    int cum = (int)(suf - cl), fb = -1, fab = 0;
#pragma unroll
    for (int i = 31; i >= 0; --i) { const int h16 = (int)(w[i] >> 16), l16 = (int)(w[i] & 0xffffu);
        if (fb < 0) { if (cum + h16 >= target) { fb = 2 * i + 1; fab = cum; } else { cum += h16; if (cum + l16 >= target) { fb = 2 * i; fab = cum; } else cum += l16; } } }
    bin = __shfl(fb, L) + 64 * L; above = __shfl(fab, L);
}
__device__ __forceinline__ void indexer_unit(const bf16* P, unsigned* MASKB, unsigned* NEARBLK, LAS unsigned char* lds, int unit, int wid, int lane) {
    const int r32 = lane & 31, hi = lane >> 5, wu = unit * 8 + wid, q = 2 * wu + hi;
    LAS unsigned* hist = (LAS unsigned*)(lds + RING_OFF + wid * 16384);
    LAS unsigned char* ring = lds + KI_RING_OFF;
    bf16x8 af[4];
    {   const int jq = (r32 >> 2) & 1, head = (r32 & 3) + 4 * (r32 >> 3);
        const bf16* qrow = P + (size_t)(2 * wu + jq) * EINP + 6144 + head * 64 + hi * 8;
#pragma unroll
        for (int ks = 0; ks < 4; ++ks) af[ks] = *(const bf16x8*)(qrow + ks * 16); }
    float wq[16];
    {   const v4u a = *(const GAS v4u*)(P + (size_t)q * EINP + 7232), b = *(const GAS v4u*)(P + (size_t)q * EINP + 7240);
        wq[0] = bflo(a.x); wq[1] = bfhi(a.x); wq[2] = bflo(a.y); wq[3] = bfhi(a.y); wq[4] = bflo(a.z); wq[5] = bfhi(a.z); wq[6] = bflo(a.w); wq[7] = bfhi(a.w);
        wq[8] = bflo(b.x); wq[9] = bfhi(b.x); wq[10] = bflo(b.y); wq[11] = bfhi(b.y); wq[12] = bflo(b.z); wq[13] = bfhi(b.z); wq[14] = bflo(b.w); wq[15] = bfhi(b.w);
#pragma unroll
        for (int r = 0; r < 16; ++r) wq[r] *= 0.03125f; }
    const int NS = (16 * unit + 16 + 63) >> 6;
    const bool any256 = 16 * unit + 15 >= 255;
    const int prow = wid * 8 + (lane >> 3);
    const char* kgsrc = (const char*)(P + 7168) + (size_t)prow * EINP * 2 + (((lane & 7) * 16) ^ ((prow & 7) << 4));
    const int lp = (hi * 16) ^ ((r32 & 7) << 4);
    const int fo0 = r32 * 128 + lp, fo1 = r32 * 128 + (lp ^ 32), fo2 = r32 * 128 + (lp ^ 64), fo3 = r32 * 128 + (lp ^ 96);
#define IDX_DMA(s_) __builtin_amdgcn_global_load_lds((const unsigned*)(kgsrc + (size_t)(s_) * 64 * EINP * 2), (LAS unsigned*)(ring + ((s_) & 1) * 8192 + wid * 1024), 16, 0, 0)
#define IDX_SCORE(slot_, t_, key32_) do { const LAS unsigned char* fb_ = ring + (slot_) * 8192 + (t_) * 4096; \
        const bf16x8 b0_ = *(const LAS bf16x8*)(fb_ + fo0), b1_ = *(const LAS bf16x8*)(fb_ + fo1), b2_ = *(const LAS bf16x8*)(fb_ + fo2), b3_ = *(const LAS bf16x8*)(fb_ + fo3); \
        f32x16 acc_; _Pragma("unroll") for (int r = 0; r < 16; ++r) acc_[r] = 0.f; \
        acc_ = __builtin_amdgcn_mfma_f32_32x32x16_bf16(af[0], b0_, acc_, 0, 0, 0); acc_ = __builtin_amdgcn_mfma_f32_32x32x16_bf16(af[1], b1_, acc_, 0, 0, 0); \
        acc_ = __builtin_amdgcn_mfma_f32_32x32x16_bf16(af[2], b2_, acc_, 0, 0, 0); acc_ = __builtin_amdgcn_mfma_f32_32x32x16_bf16(af[3], b3_, acc_, 0, 0, 0); \
        float isc_ = 0.f; _Pragma("unroll") for (int r = 0; r < 16; ++r) isc_ = fmaf(wq[r], fmaxf(acc_[r], 0.f), isc_); key32_ = okey(isc_); } while (0)
#define IDX_ZERO() do { _Pragma("unroll") for (int i = 0; i < 16; ++i) ((LAS v4u*)hist)[i * 64 + lane] = (v4u){0u, 0u, 0u, 0u}; LDS_WAIT(); } while (0)
#define IDX_PASS(...) do { IDX_DMA(0); \
        for (int s_ = 0; s_ < NS; ++s_) { asm volatile("s_waitcnt vmcnt(0)" ::: "memory"); __builtin_amdgcn_s_barrier(); asm volatile("" ::: "memory"); \
            if (s_ + 1 < NS) IDX_DMA(s_ + 1); \
            _Pragma("unroll") for (int t_ = 0; t_ < 2; ++t_) { const int kt = 2 * s_ + t_; unsigned key32; IDX_SCORE(s_ & 1, t_, key32); __VA_ARGS__ } } \
        __builtin_amdgcn_s_barrier(); } while (0)
    IDX_ZERO();
    IDX_PASS({ if (kt * 32 + r32 <= q) { const int bin = (int)(key32 >> 20); __hip_atomic_fetch_add(hist + hi * 2048 + hswz(bin >> 1), 1u << ((bin & 1) * 16), __ATOMIC_RELAXED, __HIP_MEMORY_SCOPE_WORKGROUP); } });
    LDS_WAIT();
    int b0, a0, b1, a1; find_kth(hist, 256, lane, b0, a0); find_kth(hist + 2048, 256, lane, b1, a1);
    const int mybin = hi ? b1 : b0;
    unsigned tau = 0u;
    if (any256) {
        IDX_ZERO();
        IDX_PASS({ if (kt * 32 + r32 <= q && (int)(key32 >> 20) == mybin) { const int bin = (int)((key32 >> 8) & 0xfffu); __hip_atomic_fetch_add(hist + hi * 2048 + hswz(bin >> 1), 1u << ((bin & 1) * 16), __ATOMIC_RELAXED, __HIP_MEMORY_SCOPE_WORKGROUP); } });
        LDS_WAIT();
        int s0 = 0, s1 = 0, t0, t1;
        if (b0 >= 0) find_kth(hist, 256 - a0, lane, s0, t0);
        if (b1 >= 0) find_kth(hist + 2048, 256 - a1, lane, s1, t1);
        const int mysub = hi ? s1 : s0;
        tau = mybin < 0 ? 0u : (((unsigned)mybin << 20) | ((unsigned)(mysub < 0 ? 0 : mysub) << 8));
    }
    int last0 = 0, last1 = 0;
    IDX_PASS({ const bool sel = (kt * 32 + r32 <= q) && (key32 >= tau); const unsigned long long bal = __ballot(sel);
               const unsigned w0_ = (unsigned)bal, w1_ = (unsigned)(bal >> 32);
               if (w0_) last0 = kt * 32 + 31 - __clz((int)w0_); if (w1_) last1 = kt * 32 + 31 - __clz((int)w1_);
               if (lane == 0) MASKB[(size_t)(2 * wu) * 512 + kt] = w0_;
               if (lane == 32) MASKB[(size_t)(2 * wu + 1) * 512 + kt] = w1_; });
    if (lane == 0) { const int d0_ = 2 * wu - last0, d1_ = 2 * wu + 1 - last1; atomicMax(NEARBLK + (wu >> 7), (unsigned)(d0_ > d1_ ? d0_ : d1_)); }
#undef IDX_DMA
#undef IDX_SCORE
#undef IDX_ZERO
#undef IDX_PASS
}
__device__ __forceinline__ void indexer_phase(Frame& F, const bf16* P, unsigned* MASKB, unsigned* NEARBLK) {
    for (int i = 0;; ++i) { const int idx = F.vcu + i * F.G; if (idx >= 1024) break;
        const int seg = idx >> 8, r = idx & 255, unit = (seg & 1) ? (seg * 256 + 255 - r) : (seg * 256 + r);
        indexer_unit(P, MASKB, NEARBLK, F.lds, unit, F.wave, F.lane); }
}
__device__ __forceinline__ void b_norm_bounds(Frame& F, const bf16* P, unsigned* NRM) {
    float mx = 0.f;
    for (int s = F.gw; s < S; s += F.NGW) {
        const v4u* rp = (const v4u*)(P + (size_t)s * EINP + 3072 + 32 * F.lane); float ss = 0.f;
#pragma unroll
        for (int j = 0; j < 4; ++j) { const v4u w = rp[j];
            ss += bflo(w.x) * bflo(w.x) + bfhi(w.x) * bfhi(w.x) + bflo(w.y) * bflo(w.y) + bfhi(w.y) * bfhi(w.y) + bflo(w.z) * bflo(w.z) + bfhi(w.z) * bfhi(w.z) + bflo(w.w) * bflo(w.w) + bfhi(w.w) * bfhi(w.w); }
        ss += __shfl_xor(ss, 1); ss += __shfl_xor(ss, 2); mx = fmaxf(mx, ss); }
    if ((F.lane & 3) == 0) atomicMax(NRM + (F.lane >> 2), __float_as_uint(mx));
}
__device__ __forceinline__ void mixer_b_phase(Frame& F, const bf16* P, const unsigned* MASKB, bf16* O, const unsigned* NRM, const unsigned* NEARBLK, gu32* qctr) {
    const int wid = F.wave, r32 = F.lane & 31, hi = F.lane >> 5;
    for (;;) {
        if (F.tid == 0) F.MISC[16] = __hip_atomic_fetch_add(qctr, 1u, __ATOMIC_RELAXED, __HIP_MEMORY_SCOPE_AGENT);
        __syncthreads(); const int e = (int)F.MISC[16]; __syncthreads();
        if (e >= 512) break;
        const int h = 7 - (e >> 6), qb = 63 - (e & 63);
        fa::UnitP U; U.ldq = U.ldk = U.ldv = (size_t)EINP;
        U.Q = P + (size_t)(qb * 256) * EINP + 3072 + h * 128; U.K = P + 4096 + h * 128; U.V = P + 5120 + h * 128;
        U.q0 = qb * 256; U.kt0 = 0; U.kt1 = (qb + 1) * 4;
        U.sl2 = exp2f(-(float)(h + 1)) * LOG2E; U.c2 = 0.08838834764831845f * LOG2E; U.mask = MASKB + (size_t)(qb * 256) * 512;
        {
            const float B = sqrtf(__uint_as_float(NRM[h]) * __uint_as_float(NRM[8 + h])) * U.c2 * 1.01f;
            const float dmax = (2.f * B + 160.f) / U.sl2 + (float)NEARBLK[qb]; const float kmin = (float)U.q0 - dmax;
            if (kmin > 0.f) U.kt0 = (int)(kmin * (1.f / 64.f)); }
        fa::f32x16 o[4]; float lse2;
        fa::attn_unit4<128, true, true, false>(U, F.lds, o, lse2);
        fa::store_o_bf16(o, O + (size_t)(qb * 256 + wid * 32) * DM + 1024 + h * 128, (size_t)DM, r32, hi);
    }
}
__device__ __forceinline__ void kpe_fill(Frame& F, const bf16* P, bf16* KD) {
    const int i = F.lane & 31, hh = (F.lane >> 5) * 4;
    const float inv = exp2f(-0.41524101186092029f * (float)i);
    for (int s = F.gw; s < S; s += F.NGW) {
        const bf16* kp = P + (size_t)s * OINP + 4352;
        const float x1 = __uint_as_float((unsigned)kp[i] << 16), x2 = __uint_as_float((unsigned)kp[32 + i] << 16);
        const float ang = (float)s * inv; const float n = rintf(ang * 0.15915494309189535f);
        float rr = fmaf(-n, 6.2831854820251465f, ang); rr = fmaf(-n, -1.7484555e-07f, rr); const float fr = rr * 0.15915494309189535f;
        const float sn = __builtin_amdgcn_sinf(fr), cs = __builtin_amdgcn_cosf(fr);
        const bf16 o1 = (bf16)f2bf(x1 * cs - x2 * sn), o2 = (bf16)f2bf(x1 * sn + x2 * cs);
#pragma unroll
        for (int h = 0; h < 4; ++h) { bf16* kd = KD + (size_t)s * 1536 + (hh + h) * 192 + 128; kd[i] = o1; kd[32 + i] = o2; }
    }
}
__device__ __forceinline__ void c_norm_bounds(Frame& F, const bf16* P, unsigned* NRM) {
    float mx = 0.f;
    for (int s = F.gw; s < S; s += F.NGW) {
        const v4u* rp = (const v4u*)(P + (size_t)s * OINP + 32 * F.lane); float ss = 0.f;
#pragma unroll
        for (int j = 0; j < 4; ++j) { const v4u w = rp[j];
            ss += bflo(w.x) * bflo(w.x) + bfhi(w.x) * bfhi(w.x) + bflo(w.y) * bflo(w.y) + bfhi(w.y) * bfhi(w.y) + bflo(w.z) * bflo(w.z) + bfhi(w.z) * bfhi(w.z) + bflo(w.w) * bflo(w.w) + bfhi(w.w) * bfhi(w.w); }
        ss += __shfl_xor(ss, 1); mx = fmaxf(mx, ss); }
    if ((F.lane & 1) == 0) atomicMax(NRM + (F.lane >> 1), __float_as_uint(mx));
}
__device__ __forceinline__ void mixer_c_unit(Frame& F, const bf16* P, float lam, const float* subln_g, float lam_init, float* SCR, bf16* O, const unsigned* NRM, int h, int qb, int ord) {
    const int wid = F.wave, r32 = F.lane & 31, hi = F.lane >> 5;
    {
        int tq_ = F.tid; asm volatile("" : "+v"(tq_));
        f32x4* scr = (f32x4*)(SCR + (((size_t)(ord & 1) * F.G + blockIdx.x) * 512 + tq_) * 64);
        for (int sub = 0; sub < 2; ++sub) {
            fa::UnitP U; U.ldq = U.ldk = U.ldv = (size_t)OINP;
            U.Q = P + (size_t)(qb * 256) * OINP + h * 128 + sub * 64; U.K = P + 1024 + h * 128 + sub * 64; U.V = P + 2048 + h * 128;
            U.q0 = qb * 256; U.kt0 = 0; U.kt1 = (qb + 1) * 4;
            U.sl2 = exp2f(-(float)(h + 1)) * LOG2E; U.c2 = 0.125f * LOG2E; U.mask = nullptr;
            {
                const float B = sqrtf(__uint_as_float(NRM[h * 2 + sub]) * __uint_as_float(NRM[16 + h * 2 + sub])) * U.c2 * 1.01f;
                const float dmax = (2.f * B + 160.f) / U.sl2; const float kmin = (float)U.q0 - dmax;
                if (kmin > 0.f) U.kt0 = (int)(kmin * (1.f / 64.f)); }
            fa::f32x16 o[4]; float lse2;
            fa::attn_unit4<64, true, false, false>(U, F.lds, o, lse2);
            if (sub == 0) {
#pragma unroll
                for (int d = 0; d < 4; ++d)
#pragma unroll
                    for (int k = 0; k < 4; ++k) scr[d * 4 + k] = (f32x4){o[d][4 * k], o[d][4 * k + 1], o[d][4 * k + 2], o[d][4 * k + 3]};
            } else {
                float ss[16]; const int lo_ = fa::lane_opaque();
#pragma unroll
                for (int r = 0; r < 16; ++r) ss[r] = 0.f;
#pragma unroll
                for (int d = 0; d < 4; ++d)
#pragma unroll
                    for (int k = 0; k < 4; ++k) { const f32x4 s1 = scr[d * 4 + k];
#pragma unroll
                        for (int e2 = 0; e2 < 4; ++e2) { const int r = 4 * k + e2; const float v = s1[e2] - lam * o[d][r]; o[d][r] = v; ss[r] += v * v; } }
#pragma unroll
                for (int r = 0; r < 16; ++r) { float t = ss[r]; t += fa::shx(t, 1, lo_); t += fa::shx(t, 2, lo_); t += fa::shx(t, 4, lo_); t += fa::shx(t, 8, lo_); t += fa::shx(t, 16, lo_);
                    ss[r] = (1.0f - lam_init) / sqrtf(t * (1.0f / 128.0f) + DIFF_EPS); }
#pragma unroll
                for (int d = 0; d < 4; ++d) { const float gcol = subln_g[d * 32 + r32];
#pragma unroll
                    for (int r = 0; r < 16; ++r) o[d][r] *= ss[r] * gcol; }
                fa::store_o_bf16(o, O + (size_t)(qb * 256 + wid * 32) * DM + h * 128, (size_t)DM, r32, hi);
            }
        }
    }
}
__device__ __forceinline__ void mixer_d_unit(Frame& F, const bf16* QF, const bf16* KD, const bf16* VD, bf16* O, int h, int qb) {
    const int wid = F.wave, r32 = F.lane & 31, hi = F.lane >> 5;
    {
        fa::UnitP U; U.ldq = 1536; U.ldk = 1536; U.ldv = 1024;
        U.Q = QF + (size_t)(qb * 256) * 1536 + h * 192; U.K = KD + h * 192; U.V = VD + h * 128;
        U.q0 = qb * 256; U.kt0 = 0; U.kt1 = (qb + 1) * 4;
        U.sl2 = 0.f; U.c2 = 0.07216878364870322f * LOG2E; U.mask = nullptr;
        fa::f32x16 o[4]; float lse2;
        fa::attn_unit4<192, false, false, true>(U, F.lds, o, lse2);
        fa::store_o_bf16(o, O + (size_t)(qb * 256 + wid * 32) * DM + 1024 + h * 128, (size_t)DM, r32, hi);
    }
}
__device__ __forceinline__ void mixer_cd_phase(Frame& F, const bf16* P, const float* lam_p, const float* subln_g, float lam_init, float* SCR, const unsigned* NRM,
                                               const bf16* QF, const bf16* KD, const bf16* VD, bf16* O, gu32* qctr) {
    const float lam = expf(wave_sum(lam_p[F.lane] * lam_p[64 + F.lane])) - expf(wave_sum(lam_p[128 + F.lane] * lam_p[192 + F.lane])) + lam_init;
    int ord = 0;
    for (;;) {
        if (F.tid == 0) F.MISC[16] = __hip_atomic_fetch_add(qctr, 1u, __ATOMIC_RELAXED, __HIP_MEMORY_SCOPE_AGENT);
        __syncthreads(); const int e = (int)F.MISC[16]; __syncthreads();
        if (e >= 1024) break;
        const int idx = e >> 1;
        if ((e & 1) == 0) { mixer_c_unit(F, P, lam, subln_g, lam_init, SCR, O, NRM, 7 - (idx >> 6), 63 - (idx & 63), ord); ++ord; }
        else mixer_d_unit(F, QF, KD, VD, O, idx & 7, 63 - (idx >> 3));
    }
}
struct Args { const float* in[16]; float* out; unsigned char* ws; };
#define GRID_BAR() do { xcd_barrier(bar); int t_ = threadIdx.x; asm volatile("" : "+v"(t_)); F.tid = t_; F.lane = t_ & 63; } while (0)

#define FFN_PHASES(WF)                                                                                                           \
    {   pg8::Gemm g{X, (const bf16*)(WF), S, NGU, DM, DM}; pg8::StaticOrder So; So.init(S, NGU, F.G, (int)blockIdx.x);            \
        pg8::EpiSwiglu E{H, DFF};                                                                                                 \
        pg8::gemm_phase<pg8::EpiSwiglu, pg8::StaticOrder, true, true>(F.lds + RING_OFF, g, So, E); }                              \
    GRID_BAR();                                                                                                                   \
    {   pg8::Gemm g{H, (const bf16*)((WF) + WF_DOWN_OFF), S, DM, DFF, DFF}; pg8::StaticOrder So; So.init(S, DM, F.G, (int)blockIdx.x); \
        pg8::EpiResid E{X, Y, DM, ALPHA, 0.5f};                                                                                   \
        pg8::gemm_phase<pg8::EpiResid, pg8::StaticOrder, true, true>(F.lds + RING_OFF, g, So, E); }                               \
    GRID_BAR();

__global__ void __launch_bounds__(NWAVES * 64, 2) fwd_kernel(Args args) {
    extern __shared__ __attribute__((aligned(16))) unsigned char lds[];
    Frame F;
    F.lds = (LAS unsigned char*)lds;
    F.MISC = (volatile LAS unsigned*)(F.lds + MISC_OFF);
    F.tid = threadIdx.x; F.lane = F.tid & 63; F.wave = __builtin_amdgcn_readfirstlane(F.tid >> 6);
    F.G = gridDim.x; { const int bx = blockIdx.x; F.vcu = (F.G % 8 == 0) ? (bx % 8) * (F.G / 8) + bx / 8 : bx; }
    F.gw = F.vcu * NWAVES + F.wave; F.NGW = F.G * NWAVES;
    unsigned char* ws = args.ws;
    F.ctl = (gu32*)(ws + WS_CTL);
    for (int u = F.tid; u < (LDS_BYTES - LDSCTL_OFF) / 4; u += NWAVES * 64) ((LAS unsigned*)(F.lds + LDSCTL_OFF))[u] = 0u;
    __syncthreads();
    XcdBarrier bar = xcd_barrier_post((unsigned*)(F.ctl + CW_BAR), F.MISC + 8);

    const float* x_in = args.in[0];
    const float* w_gate = args.in[1]; const float* w_up = args.in[2]; const float* w_down = args.in[3];
    const float* ln_g = args.in[4]; const float* ln_b = args.in[5];
    bf16* X = (bf16*)(ws + WS_X); float* Y = (float*)(ws + WS_Y); bf16* H = (bf16*)(ws + WS_HP);
    bf16* P = (bf16*)(ws + WS_HP); bf16* O = (bf16*)(ws + WS_O);
    bf16* OA = (bf16*)(ws + WS_Y); unsigned* MASKB = (unsigned*)(ws + WS_Y + 96 * MiB); float* LSE = (float*)(ws + WS_LSE);
    bf16* QF = (bf16*)(ws + WS_Y); bf16* KD = (bf16*)(ws + WS_Y + 48 * MiB); bf16* VD = (bf16*)(ws + WS_Y + 96 * MiB);
    float* SQQ = (float*)(ws + (size_t)CW_SQQ * 4); float* SQKV = (float*)(ws + (size_t)CW_SQKV * 4);
    unsigned char* WFA = ws + WS_WFA; unsigned char* WFB = ws + WS_WFB;
    constexpr size_t GSZ = (size_t)DM * DFF;

    convert_ffn(F, w_gate + 0 * GSZ, w_up + 0 * GSZ, w_down + 0 * GSZ, WFA);
    convert_ffn(F, w_gate + 1 * GSZ, w_up + 1 * GSZ, w_down + 1 * GSZ, WFB);
    convert_weight<0>(F, args.in[6], DM, EIN, EINP, (bf16*)(ws + WS_WEIN), nullptr);
    convert_weight<0>(F, args.in[7], DM, DM, DM, (bf16*)(ws + WS_WEOUT), nullptr);
    convert_weight<0>(F, args.in[8], DM, OIN, OINP, (bf16*)(ws + WS_WOIN), nullptr);
    convert_weight<0>(F, args.in[9], DM, DM, DM, (bf16*)(ws + WS_WOOUT), nullptr);
    convert_weight<0>(F, args.in[14], 768, 1536, 1536, (bf16*)(ws + WS_WUQ), args.in[12]);
    convert_weight<0>(F, args.in[15], 512, 2048, 2048, (bf16*)(ws + WS_WUKV), args.in[13]);
    convert_x(F, x_in, X);
    GRID_BAR();
    FFN_PHASES(WFA)
    ln_phase<false>(F, Y, ln_g + 0 * DM, ln_b + 0 * DM, X, nullptr);
    convert_ffn(F, w_gate + 2 * GSZ, w_up + 2 * GSZ, w_down + 2 * GSZ, WFA);
    GRID_BAR();
    {
        pg8::Gemm g{X, (const bf16*)(ws + WS_WEIN), S, EINP, DM, DM}; pg8::StaticOrder So; So.init(S, EINP, F.G, (int)blockIdx.x);
        pg8::EpiBf16 E{P, EINP, nullptr, 0, 0, nullptr, 0, 0};
        pg8::gemm_phase<pg8::EpiBf16, pg8::StaticOrder, true, true>(F.lds + RING_OFF, g, So, E); }
    GRID_BAR();
    mixer_a_phase(F, P, OA, LSE);
    __syncthreads();
    indexer_phase(F, P, MASKB, (unsigned*)(F.ctl + CW_NEAR));
    b_norm_bounds(F, P, (unsigned*)(F.ctl + CW_NRMB));
    GRID_BAR();
    merge_a(F, OA, LSE, O);
    mixer_b_phase(F, P, MASKB, O, (const unsigned*)(F.ctl + CW_NRMB), (const unsigned*)(F.ctl + CW_NEAR), F.ctl + CW_QB);
    GRID_BAR();
    {
        pg8::Gemm g{O, (const bf16*)(ws + WS_WEOUT), S, DM, DM, DM}; pg8::StaticOrder So; So.init(S, DM, F.G, (int)blockIdx.x);
        pg8::EpiResid E{X, Y, DM, ALPHA, 1.0f};
        pg8::gemm_phase<pg8::EpiResid, pg8::StaticOrder, true, true>(F.lds + RING_OFF, g, So, E); }
    GRID_BAR();
    ln_phase<false>(F, Y, ln_g + 1 * DM, ln_b + 1 * DM, X, nullptr);
    GRID_BAR();
    FFN_PHASES(WFB)
    ln_phase<false>(F, Y, ln_g + 2 * DM, ln_b + 2 * DM, X, nullptr);
    convert_ffn(F, w_gate + 3 * GSZ, w_up + 3 * GSZ, w_down + 3 * GSZ, WFB);
    GRID_BAR();
    FFN_PHASES(WFA)
    ln_phase<false>(F, Y, ln_g + 3 * DM, ln_b + 3 * DM, X, nullptr);
    GRID_BAR();
    {
        pg8::Gemm g{X, (const bf16*)(ws + WS_WOIN), S, OINP, DM, DM}; pg8::StaticOrder So; So.init(S, OINP, F.G, (int)blockIdx.x);
        pg8::EpiBf16 E{P, OINP, SQQ, 12, 15, SQKV, 15, 17};
        pg8::gemm_phase<pg8::EpiBf16, pg8::StaticOrder, true, true>(F.lds + RING_OFF, g, So, E); }
    GRID_BAR();
    {
        pg8::Gemm g{P + 3072, (const bf16*)(ws + WS_WUQ), S, 1536, 768, OINP}; pg8::StaticOrder So; So.init(S, 1536, F.G, (int)blockIdx.x);
        pg8::EpiScaleRow E{QF, 1536, SQQ, 1.0f / 768.0f, RMS_EPS};
        pg8::gemm_phase<pg8::EpiScaleRow, pg8::StaticOrder, true, true>(F.lds + RING_OFF, g, So, E); }
    {   pg8::Gemm g{P + 3840, (const bf16*)(ws + WS_WUKV), S, 2048, 512, OINP}; pg8::StaticOrder So; So.init(S, 2048, F.G, (int)blockIdx.x);
        pg8::EpiUkv E{KD, VD, SQKV, 1.0f / 512.0f, RMS_EPS};
        pg8::gemm_phase<pg8::EpiUkv, pg8::StaticOrder, true, true>(F.lds + RING_OFF, g, So, E); }
    kpe_fill(F, P, KD);
    c_norm_bounds(F, P, (unsigned*)(F.ctl + CW_NRM));
    GRID_BAR();
    mixer_cd_phase(F, P, args.in[10], args.in[11], 0.35550906759096874f, (float*)(ws + WS_HP + 160 * MiB), (const unsigned*)(F.ctl + CW_NRM), QF, KD, VD, O, F.ctl + CW_QCD);
    GRID_BAR();
    {
        pg8::Gemm g{O, (const bf16*)(ws + WS_WOOUT), S, DM, DM, DM}; pg8::StaticOrder So; So.init(S, DM, F.G, (int)blockIdx.x);
        pg8::EpiResid E{X, Y, DM, ALPHA, 1.0f};
        pg8::gemm_phase<pg8::EpiResid, pg8::StaticOrder, true, true>(F.lds + RING_OFF, g, So, E); }
    GRID_BAR();
    ln_phase<false>(F, Y, ln_g + 4 * DM, ln_b + 4 * DM, X, nullptr);
    GRID_BAR();
    FFN_PHASES(WFB)
    ln_phase<true>(F, Y, ln_g + 5 * DM, ln_b + 5 * DM, nullptr, args.out);
}

extern "C" void kernel_launch(void* const* d_in, const int* in_sizes, int n_in, void* d_out, int out_size, void* d_ws, size_t ws_size, hipStream_t stream) {
    static int grid = 0;
    if (grid == 0) {
        if (n_in != 16 || in_sizes[0] != S * DM || out_size != S * DM || ws_size < WS_END) { fprintf(stderr, "kernel_launch: unexpected shapes (n_in %d, in0 %d, out %d, ws %zu < %zu)\n", n_in, n_in > 0 ? in_sizes[0] : -1, out_size, ws_size, (size_t)WS_END); grid = -1; return; }
        int dev = 0, cus = 0, per_cu = 0;
        if (hipGetDevice(&dev) != hipSuccess || hipDeviceGetAttribute(&cus, hipDeviceAttributeMultiprocessorCount, dev) != hipSuccess) { grid = -1; return; }
        if (hipFuncSetAttribute((const void*)fwd_kernel, hipFuncAttributeMaxDynamicSharedMemorySize, LDS_BYTES) != hipSuccess) { fprintf(stderr, "kernel_launch: hipFuncSetAttribute failed\n"); grid = -1; return; }
        if (hipOccupancyMaxActiveBlocksPerMultiprocessor(&per_cu, (const void*)fwd_kernel, NWAVES * 64, LDS_BYTES) != hipSuccess || per_cu < 1)
            fprintf(stderr, "kernel_launch: occupancy query reports %d workgroups per CU\n", per_cu);
        (void)hipGetLastError();
        grid = cus;
    }
    if (grid < 0) return;
    if (hipMemsetAsync((char*)d_ws + WS_CTL, 0, CTL_ZERO_BYTES, stream) != hipSuccess) return;
    Args a{};
    for (int i = 0; i < 16; ++i) a.in[i] = (const float*)d_in[i];
    a.out = (float*)d_out; a.ws = (unsigned char*)d_ws;
    hipLaunchKernelGGL(fwd_kernel, dim3(grid), dim3(NWAVES * 64), LDS_BYTES, stream, a);
}
```

```cpp
#include <hip/hip_runtime.h>
#include <cstdio>
#include <cstdint>
#include <cmath>
namespace pg8 {
#define PG8_LAS __attribute__((address_space(3)))
typedef unsigned short bf16_t;
typedef short bf16x8 __attribute__((ext_vector_type(8)));
typedef float f32x4 __attribute__((ext_vector_type(4)));
typedef unsigned u32x4 __attribute__((ext_vector_type(4)));
constexpr int BM = 256, BK = 64, HALF = 128, HTB = HALF * BK * 2  , STAGE_BYTES = 8 * HTB, NXCD = 8, WGM = 8;

__host__ __device__ __forceinline__ int lds_byte(int r, int c) { const int st = (r >> 4) * 2 + (c >> 5), rr = r & 15, cc = c & 31, ob = rr * 64 + cc * 2; return st * 1024 + (ob ^ (((ob >> 9) & 1) << 5)); }
__host__ __device__ __forceinline__ void stage_rc(int b, int& R, int& C) { const int st = b / 1024, sb = b % 1024, swz = sb ^ (((sb >> 9) & 1) << 5); R = (st >> 1) * 16 + swz / 64; C = (st & 1) * 32 + (swz % 64) / 2; }
__host__ __device__ __forceinline__ int perm32(int rho) { const int n = rho >> 4, i = rho & 15; return 8 * (i >> 2) + 4 * n + (i & 3); }

struct Unit { int pm, pn; };
struct Gemm { const bf16_t* A; const bf16_t* Bt; int M, N, K, lda; };

struct StaticOrder {
    int nM, nN, nwg, G, c;
    __host__ __device__ void init(int M, int N, int G_, int c_) { nM = M / BM; nN = N / BM; nwg = nM * nN; G = G_; c = c_; }
    __host__ __device__ bool next(int i, Unit& u) const {
        const long L = (long)i * G + c; if (L >= nwg) return false;
        int wgid = (int)L; { const int q = nwg / NXCD, r = nwg % NXCD, xcd = wgid % NXCD, off = wgid / NXCD; wgid = (xcd < r ? xcd * (q + 1) : r * (q + 1) + (xcd - r) * q) + off; }
        const int nig = WGM * nN, gid = wgid / nig, fm = gid * WGM, gsz = (nM - fm) < WGM ? (nM - fm) : WGM;
        u.pm = fm + ((wgid % nig) % gsz); u.pn = (wgid % nig) / gsz; return true;
    }
    __device__ __forceinline__ void a_ready(const Unit&) const {}
    __device__ __forceinline__ void done(const Unit&) const {}
};
__device__ __forceinline__ unsigned cvt_pk_bf16(float lo, float hi) { unsigned r; asm volatile("v_cvt_pk_bf16_f32 %0, %1, %2" : "=v"(r) : "v"(lo), "v"(hi)); return r; }
__device__ __forceinline__ float bf_lo(unsigned w) { return __uint_as_float(w << 16); }
__device__ __forceinline__ float bf_hi(unsigned w) { return __uint_as_float(w & 0xffff0000u); }
typedef unsigned u32x2 __attribute__((ext_vector_type(2)));
__device__ __forceinline__ float silu_f(float x) { return x * __builtin_amdgcn_rcpf(1.0f + __builtin_amdgcn_exp2f(-1.4426950408889634f * x)); }

struct EpiSwiglu {
    static constexpr bool PERM = true, AFTER_DRAIN = false;
    bf16_t* H; int ldh;
    __device__ __forceinline__ void operator()(const f32x4 (&acc)[2][2][4][2], const Unit& u, int wr, int wc, int fr, int fq) const {
        const int row0 = u.pm * BM + wr * 64 + fr, col0 = u.pn * HALF + wc * 32 + 8 * fq;
#pragma unroll
        for (int ai = 0; ai < 2; ++ai)
#pragma unroll
            for (int m = 0; m < 4; ++m) {
                const f32x4 g0 = acc[ai][0][m][0], g1 = acc[ai][0][m][1], u0 = acc[ai][1][m][0], u1 = acc[ai][1][m][1];
                u32x4 w;
                w.x = cvt_pk_bf16(silu_f(g0[0]) * u0[0], silu_f(g0[1]) * u0[1]); w.y = cvt_pk_bf16(silu_f(g0[2]) * u0[2], silu_f(g0[3]) * u0[3]);
                w.z = cvt_pk_bf16(silu_f(g1[0]) * u1[0], silu_f(g1[1]) * u1[1]); w.w = cvt_pk_bf16(silu_f(g1[2]) * u1[2], silu_f(g1[3]) * u1[3]);
                *(u32x4*)(H + (size_t)(row0 + ai * HALF + m * 16) * ldh + col0) = w;
            }
    }
};
struct EpiResid {
    static constexpr bool PERM = true, AFTER_DRAIN = false;
    const bf16_t* X; bf16_t* Y; int ldc; float alpha, w;
    __device__ __forceinline__ void operator()(const f32x4 (&acc)[2][2][4][2], const Unit& u, int wr, int wc, int fr, int fq) const {
        const int row0 = u.pm * BM + wr * 64 + fr, col0 = u.pn * BM + wc * 32 + 8 * fq;
#pragma unroll
        for (int ai = 0; ai < 2; ++ai)
#pragma unroll
            for (int m = 0; m < 4; ++m) { const size_t ro = (size_t)(row0 + ai * HALF + m * 16) * ldc + col0;
#pragma unroll
                for (int bj = 0; bj < 2; ++bj) { const size_t off = ro + bj * HALF; const u32x4 xw = *(const u32x4*)(X + off); const f32x4 a0 = acc[ai][bj][m][0], a1 = acc[ai][bj][m][1];
                    u32x4 y;
                    y.x = cvt_pk_bf16(alpha * bf_lo(xw.x) + w * a0[0], alpha * bf_hi(xw.x) + w * a0[1]); y.y = cvt_pk_bf16(alpha * bf_lo(xw.y) + w * a0[2], alpha * bf_hi(xw.y) + w * a0[3]);
                    y.z = cvt_pk_bf16(alpha * bf_lo(xw.z) + w * a1[0], alpha * bf_hi(xw.z) + w * a1[1]); y.w = cvt_pk_bf16(alpha * bf_lo(xw.w) + w * a1[2], alpha * bf_hi(xw.w) + w * a1[3]);
                    *(u32x4*)(Y + off) = y; } }
    }
};
struct EpiBf16 {
    static constexpr bool PERM = true, AFTER_DRAIN = false;
    bf16_t* O; int ldc; float* sqA; int a_lo, a_hi; float* sqB; int b_lo, b_hi;
    __device__ __forceinline__ void operator()(const f32x4 (&acc)[2][2][4][2], const Unit& u, int wr, int wc, int fr, int fq) const {
        const int row0 = u.pm * BM + wr * 64 + fr, col0 = u.pn * BM + wc * 32 + 8 * fq;
        float* sq = (u.pn >= a_lo && u.pn < a_hi) ? sqA : ((u.pn >= b_lo && u.pn < b_hi) ? sqB : nullptr);
#pragma unroll
        for (int ai = 0; ai < 2; ++ai)
#pragma unroll
            for (int m = 0; m < 4; ++m) { bf16_t* rowp = O + (size_t)(row0 + ai * HALF + m * 16) * ldc + col0; float ss = 0.f;
#pragma unroll
                for (int bj = 0; bj < 2; ++bj) { const f32x4 v0 = acc[ai][bj][m][0], v1 = acc[ai][bj][m][1];
                    ss += (v0[0] * v0[0] + v0[1] * v0[1]) + (v0[2] * v0[2] + v0[3] * v0[3]) + (v1[0] * v1[0] + v1[1] * v1[1]) + (v1[2] * v1[2] + v1[3] * v1[3]);
                    u32x4 w; w.x = cvt_pk_bf16(v0[0], v0[1]); w.y = cvt_pk_bf16(v0[2], v0[3]); w.z = cvt_pk_bf16(v1[0], v1[1]); w.w = cvt_pk_bf16(v1[2], v1[3]);
                    *(u32x4*)(rowp + bj * HALF) = w; }
                if (sq) { ss += __shfl_xor(ss, 16); ss += __shfl_xor(ss, 32); if (fq == 0) atomicAdd(sq + row0 + ai * HALF + m * 16, ss); }
            }
    }
};
struct EpiScaleRow {
    static constexpr bool PERM = true, AFTER_DRAIN = false;
    bf16_t* O; int ldc; const float* sq; float invn, eps;
    __device__ __forceinline__ void operator()(const f32x4 (&acc)[2][2][4][2], const Unit& u, int wr, int wc, int fr, int fq) const {
        const int row0 = u.pm * BM + wr * 64 + fr, col0 = u.pn * BM + wc * 32 + 8 * fq;
#pragma unroll
        for (int ai = 0; ai < 2; ++ai)
#pragma unroll
            for (int m = 0; m < 4; ++m) { const int row = row0 + ai * HALF + m * 16; const float rs = 1.0f / sqrtf(sq[row] * invn + eps); bf16_t* rowp = O + (size_t)row * ldc + col0;
#pragma unroll
                for (int bj = 0; bj < 2; ++bj) { const f32x4 v0 = acc[ai][bj][m][0] * rs, v1 = acc[ai][bj][m][1] * rs;
                    u32x4 w; w.x = cvt_pk_bf16(v0[0], v0[1]); w.y = cvt_pk_bf16(v0[2], v0[3]); w.z = cvt_pk_bf16(v1[0], v1[1]); w.w = cvt_pk_bf16(v1[2], v1[3]);
                    *(u32x4*)(rowp + bj * HALF) = w; } }
    }
};
struct EpiUkv {
    static constexpr bool PERM = true, AFTER_DRAIN = false;
    bf16_t* KD; bf16_t* VD; const float* sq; float invn, eps;
    __device__ __forceinline__ void operator()(const f32x4 (&acc)[2][2][4][2], const Unit& u, int wr, int wc, int fr, int fq) const {
        const int row0 = u.pm * BM + wr * 64 + fr, cc = wc * 32 + 8 * fq;
#pragma unroll
        for (int ai = 0; ai < 2; ++ai)
#pragma unroll
            for (int m = 0; m < 4; ++m) { const int row = row0 + ai * HALF + m * 16; const float rs = 1.0f / sqrtf(sq[row] * invn + eps);
#pragma unroll
                for (int bj = 0; bj < 2; ++bj) { const f32x4 v0 = acc[ai][bj][m][0] * rs, v1 = acc[ai][bj][m][1] * rs;
                    u32x4 w; w.x = cvt_pk_bf16(v0[0], v0[1]); w.y = cvt_pk_bf16(v0[2], v0[3]); w.z = cvt_pk_bf16(v1[0], v1[1]); w.w = cvt_pk_bf16(v1[2], v1[3]);
                    bf16_t* dst = bj == 0 ? KD + (size_t)row * 1536 + u.pn * 192 + cc : VD + (size_t)row * 1024 + u.pn * 128 + cc;
                    *(u32x4*)dst = w; } }
    }
};
template <class Epi, class Sched, bool ALIGN_EPI = false, bool SP2 = false>
__device__ __forceinline__ void gemm_phase(PG8_LAS unsigned char* lds, const Gemm g, const Sched& S, const Epi& E) {
    int tid_o_ = threadIdx.x; asm volatile("" : "+v"(tid_o_)); const int tid = tid_o_, wid = __builtin_amdgcn_readfirstlane(tid >> 6), lane = tid & 63, wr = wid >> 2, wc = wid & 3, fr = lane & 15, fq = lane >> 4;
    const int K = g.K, nt = K / BK;
    unsigned voffA[2], voffB[2];
#pragma unroll
    for (int i = 0; i < 2; ++i) { int R, C; stage_rc(tid * 16 + i * 8192, R, C); const int Rb = Epi::PERM ? ((R & ~31) + perm32(R & 31)) : R;
        voffA[i] = (unsigned)(R * g.lda + C) * 2u; voffB[i] = (unsigned)(Rb * K + C) * 2u; }
    const size_t kstep = (size_t)(BK * 2);
    const size_t hstepB = (size_t)HALF * K * 2, hstepA = (size_t)HALF * g.lda * 2;
    const size_t tstepA = 2 * hstepA, tstepB = 2 * hstepB;
    const unsigned ldsw = (unsigned)wid * 1024u;
    const int aoff = lds_byte(wr * 64 + fr, fq * 8), boff = lds_byte(wc * 32 + fr, fq * 8);
#define PG8_SA(b, h) (((b) * 2 + (h)) * HTB)
#define PG8_SB(b, h) ((4 + (b) * 2 + (h)) * HTB)
#define PG8_STAGE(bufoff, gbase, voff) do { _Pragma("unroll") for (int _i = 0; _i < 2; ++_i) \
        __builtin_amdgcn_global_load_lds((const unsigned*)((const char*)(gbase) + (voff)[_i]), (PG8_LAS unsigned*)(lds + (bufoff) + ldsw + _i * 8192), 16, 0, 0); } while (0)
#define PG8_LDA(dst, b, h) do { _Pragma("unroll") for (int m = 0; m < 4; ++m) _Pragma("unroll") for (int k = 0; k < 2; ++k) dst[m][k] = *(const PG8_LAS bf16x8*)(lds + PG8_SA(b, h) + aoff + m * 2048 + k * 1024); } while (0)
#define PG8_LDB(dst, b, h) do { _Pragma("unroll") for (int n = 0; n < 2; ++n) _Pragma("unroll") for (int k = 0; k < 2; ++k) dst[n][k] = *(const PG8_LAS bf16x8*)(lds + PG8_SB(b, h) + boff + n * 2048 + k * 1024); } while (0)
#define PG8_MMA(ai, bj, At, Bt) do { __builtin_amdgcn_s_setprio(1); _Pragma("unroll") for (int m = 0; m < 4; ++m) _Pragma("unroll") for (int n = 0; n < 2; ++n) _Pragma("unroll") for (int k = 0; k < 2; ++k) \
        acc[ai][bj][m][n] = __builtin_amdgcn_mfma_f32_16x16x32_bf16(Bt[n][k], At[m][k], acc[ai][bj][m][n], 0, 0, 0); __builtin_amdgcn_s_setprio(0); } while (0)
#define PG8_WAIT_V(n) asm volatile("s_waitcnt vmcnt(" #n ")" ::: "memory")
#define PG8_WAIT_L(n) asm volatile("s_waitcnt lgkmcnt(" #n ")" ::: "memory")
#define PG8_BAR __builtin_amdgcn_s_barrier()
#define PG8_SCHED __builtin_amdgcn_sched_barrier(0)
    Unit cur, nxt; int ui = 0;
    if (!S.next(0, cur)) return;
    f32x4 acc[2][2][4][2];
#pragma unroll
    for (int a = 0; a < 2; ++a)
#pragma unroll
        for (int b = 0; b < 2; ++b)
#pragma unroll
            for (int m = 0; m < 4; ++m)
#pragma unroll
                for (int n = 0; n < 2; ++n) acc[a][b][m][n] = (f32x4){0.f, 0.f, 0.f, 0.f};
    bf16x8 At[4][2], B0[2][2], B1[2][2];
    const char* cA = (const char*)g.A + (size_t)cur.pm * tstepA; const char* cB = (const char*)g.Bt + (size_t)cur.pn * tstepB;
    S.a_ready(cur);
    if constexpr (SP2) {
        PG8_STAGE(PG8_SB(0, 0), cB, voffB); PG8_STAGE(PG8_SB(0, 1), cB + hstepB, voffB); PG8_STAGE(PG8_SA(0, 0), cA, voffA); PG8_STAGE(PG8_SA(0, 1), cA + hstepA, voffA);
        if (wr == 1) PG8_BAR;
        PG8_WAIT_V(2); PG8_BAR;
        PG8_STAGE(PG8_SB(1, 0), cB + kstep, voffB); PG8_STAGE(PG8_SA(1, 0), cA + kstep, voffA); PG8_STAGE(PG8_SB(1, 1), cB + hstepB + kstep, voffB);
        PG8_WAIT_V(6); PG8_BAR;
    } else {
        PG8_STAGE(PG8_SB(0, 0), cB, voffB); PG8_STAGE(PG8_SA(0, 0), cA, voffA); PG8_STAGE(PG8_SB(0, 1), cB + hstepB, voffB); PG8_STAGE(PG8_SA(0, 1), cA + hstepA, voffA);
        if (wr == 1) PG8_BAR;
        PG8_WAIT_V(4); PG8_BAR;
        PG8_STAGE(PG8_SB(1, 0), cB + kstep, voffB); PG8_STAGE(PG8_SA(1, 0), cA + kstep, voffA); PG8_STAGE(PG8_SB(1, 1), cB + hstepB + kstep, voffB);
        PG8_WAIT_V(6); PG8_BAR;
    }
    for (;;) {
        const bool has_next = S.next(ui + 1, nxt);
        const char* nA = has_next ? (const char*)g.A + (size_t)nxt.pm * tstepA : cA; const char* nB = has_next ? (const char*)g.Bt + (size_t)nxt.pn * tstepB : cB;
        for (int t = 0; t < nt; t += 2) {
            const bool last = (t == nt - 2);
            const char* a1 = cA + (size_t)(t + 1) * kstep;
            const char* a2 = last ? nA : cA + (size_t)(t + 2) * kstep; const char* b2 = last ? nB : cB + (size_t)(t + 2) * kstep;
            const char* a3 = a2 + kstep; const char* b3 = b2 + kstep;
            if (last && has_next) S.a_ready(nxt);
            if constexpr (SP2) {
            PG8_LDB(B0, 0, 0); PG8_LDB(B1, 0, 1); PG8_SCHED; PG8_LDA(At, 0, 0); PG8_STAGE(PG8_SA(1, 1), a1 + hstepA, voffA);
            PG8_WAIT_V(8); PG8_WAIT_L(0); PG8_BAR; PG8_MMA(0, 0, At, B0); PG8_MMA(0, 1, At, B1); PG8_BAR; PG8_SCHED;
            PG8_LDA(At, 0, 1); PG8_STAGE(PG8_SB(0, 0), b2, voffB); PG8_STAGE(PG8_SB(0, 1), b2 + hstepB, voffB); PG8_STAGE(PG8_SA(0, 0), a2, voffA);
            PG8_WAIT_V(8); PG8_WAIT_L(0); PG8_BAR; PG8_MMA(1, 0, At, B0); PG8_MMA(1, 1, At, B1); PG8_BAR; PG8_SCHED;
            PG8_LDB(B0, 1, 0); PG8_LDB(B1, 1, 1); PG8_SCHED; PG8_LDA(At, 1, 0); PG8_STAGE(PG8_SA(0, 1), a2 + hstepA, voffA);
            PG8_WAIT_V(8); PG8_WAIT_L(0); PG8_BAR; PG8_MMA(0, 0, At, B0); PG8_MMA(0, 1, At, B1); PG8_BAR; PG8_SCHED;
            PG8_LDA(At, 1, 1); PG8_STAGE(PG8_SB(1, 0), b3, voffB); PG8_STAGE(PG8_SB(1, 1), b3 + hstepB, voffB); PG8_STAGE(PG8_SA(1, 0), a3, voffA);
            PG8_WAIT_V(8); PG8_WAIT_L(0); PG8_BAR; PG8_MMA(1, 0, At, B0); PG8_MMA(1, 1, At, B1); PG8_BAR; PG8_SCHED;
            } else {
            PG8_LDB(B0, 0, 0); PG8_SCHED; PG8_LDA(At, 0, 0); PG8_STAGE(PG8_SA(1, 1), a1 + hstepA, voffA);
            PG8_WAIT_L(8); PG8_BAR; PG8_WAIT_L(0); PG8_MMA(0, 0, At, B0); PG8_BAR; PG8_SCHED;
            PG8_LDB(B1, 0, 1); PG8_STAGE(PG8_SB(0, 0), b2, voffB);
            PG8_BAR; PG8_WAIT_L(0); PG8_MMA(0, 1, At, B1); PG8_BAR;
            PG8_LDA(At, 0, 1); PG8_STAGE(PG8_SA(0, 0), a2, voffA);
            PG8_BAR; PG8_WAIT_L(0); PG8_MMA(1, 0, At, B0); PG8_BAR; PG8_SCHED;
            PG8_STAGE(PG8_SB(0, 1), b2 + hstepB, voffB);
            PG8_WAIT_V(6); PG8_BAR; PG8_MMA(1, 1, At, B1); PG8_BAR;
            PG8_LDB(B0, 1, 0); PG8_SCHED; PG8_LDA(At, 1, 0); PG8_STAGE(PG8_SA(0, 1), a2 + hstepA, voffA);
            PG8_WAIT_L(8); PG8_BAR; PG8_WAIT_L(0); PG8_MMA(0, 0, At, B0); PG8_BAR; PG8_SCHED;
            PG8_LDB(B1, 1, 1); PG8_STAGE(PG8_SB(1, 0), b3, voffB);
            PG8_BAR; PG8_WAIT_L(0); PG8_MMA(0, 1, At, B1); PG8_BAR;
            PG8_LDA(At, 1, 1); PG8_STAGE(PG8_SA(1, 0), a3, voffA);
            PG8_BAR; PG8_WAIT_L(0); PG8_MMA(1, 0, At, B0); PG8_BAR; PG8_SCHED;
            PG8_STAGE(PG8_SB(1, 1), b3 + hstepB, voffB);
            PG8_WAIT_V(6); PG8_BAR; PG8_MMA(1, 1, At, B1); PG8_BAR;
            }
        }
        if constexpr (ALIGN_EPI) { if (wr == 0) PG8_BAR; }
        if constexpr (!Epi::AFTER_DRAIN) { E(acc, cur, wr, wc, fr, fq); S.done(cur); }
        if (!has_next) break;
#pragma unroll
        for (int a = 0; a < 2; ++a)
#pragma unroll
            for (int b = 0; b < 2; ++b)
#pragma unroll
                for (int m = 0; m < 4; ++m)
#pragma unroll
                    for (int n = 0; n < 2; ++n) acc[a][b][m][n] = (f32x4){0.f, 0.f, 0.f, 0.f};
        cur = nxt; cA = nA; cB = nB; ++ui;
        if constexpr (ALIGN_EPI) { if (wr == 1) PG8_BAR; }
    }
    PG8_WAIT_V(0);
    if constexpr (!ALIGN_EPI) { if (wr == 0) PG8_BAR; }
    PG8_BAR;
    if constexpr (Epi::AFTER_DRAIN) { E.fused(acc, cur, wr, wc, fr, fq, lds, wid, lane); S.done(cur); }
#undef PG8_SA
#undef PG8_SB
#undef PG8_STAGE
#undef PG8_LDA
#undef PG8_LDB
#undef PG8_MMA
#undef PG8_WAIT_V
#undef PG8_WAIT_L
#undef PG8_BAR
#undef PG8_SCHED
}
}

constexpr int S = 16384, DM = 2048, DFF = 5632, NGU = 2 * DFF;
constexpr int EIN = 7248, EINP = 7424, OIN = 4416, OINP = 4608;
constexpr float ALPHA = 1.4142135623730951f;
constexpr float LN_EPS = 1e-5f, RMS_EPS = 1e-6f, DIFF_EPS = 1e-5f;
constexpr int NWAVES = 8;
constexpr size_t MiB = 1u << 20;
constexpr size_t WS_CTL = 0, CTL_ZERO_BYTES = 1 * MiB;
constexpr size_t WS_LSE = 1 * MiB;
constexpr size_t WS_WFA = 4 * MiB, WS_WFB = 70 * MiB;
constexpr size_t WF_DOWN_OFF = (size_t)NGU * DM * 2;
constexpr size_t WS_WEIN = 136 * MiB, WS_WOIN = 165 * MiB, WS_WEOUT = 183 * MiB, WS_WOOUT = 191 * MiB, WS_WUQ = 199 * MiB, WS_WUKV = 202 * MiB;
constexpr size_t WS_X = 204 * MiB;
constexpr size_t WS_Y = 268 * MiB;
constexpr size_t WS_HP = 396 * MiB;
constexpr size_t WS_O = 628 * MiB;
constexpr size_t WS_YB = 692 * MiB;
constexpr size_t WS_END = 756 * MiB;
constexpr int CW_BAR = 4096;
constexpr int CW_QCD = 2048;
constexpr int CW_QB = 2112;
constexpr int CW_NRMB = 1088;
constexpr int CW_NEAR = 1152;
constexpr int CW_NRM = 1024;
constexpr int CW_SQQ = 65536, CW_SQKV = 65536 + 16384;
constexpr int RING_OFF = 0, RING_BYTES = 131072;
constexpr int KI_RING_OFF = RING_BYTES;
constexpr int LDSCTL_OFF = RING_BYTES + 16384, MISC_OFF = LDSCTL_OFF + 320;
constexpr int LDS_BYTES = 151552;

#define GAS __attribute__((address_space(1)))
#define LAS __attribute__((address_space(3)))
typedef unsigned short bf16;
typedef unsigned v4u __attribute__((ext_vector_type(4)));
typedef unsigned v2u __attribute__((ext_vector_type(2)));
typedef float f32x4 __attribute__((ext_vector_type(4)));
typedef short bf16x8 __attribute__((ext_vector_type(8)));
typedef GAS unsigned gu32;
#define LDS_WAIT() asm volatile("s_waitcnt lgkmcnt(0)" ::: "memory")
#define VM_WAIT() asm volatile("s_waitcnt vmcnt(0)" ::: "memory")
__device__ __forceinline__ unsigned f2bf(float f) { unsigned u = __builtin_bit_cast(unsigned, f); return (u + 0x7fffu + ((u >> 16) & 1u)) >> 16; }
__device__ __forceinline__ unsigned pk2(float lo, float hi) { return f2bf(lo) | (f2bf(hi) << 16); }
__device__ __forceinline__ float bflo(unsigned w) { return __uint_as_float(w << 16); }
__device__ __forceinline__ float bfhi(unsigned w) { return __uint_as_float(w & 0xffff0000u); }
#define XB_TMO      128
#define XB_XCNT(j)  (256  + 64 * (j))
#define XB_XSUB(j)  (1280 + 64 * (j))
#define XB_XGEN(j)  (2304 + 64 * (j))
#define XB_TOP      3328
#define XB_TOPGEN   3392
#define XCD_BAR_WORDS 3456
#define XB_SPIN_CAP (1u << 18)

__device__ __forceinline__ unsigned xb_ld(unsigned* p)              { return __hip_atomic_load(p, __ATOMIC_RELAXED, __HIP_MEMORY_SCOPE_AGENT); }
__device__ __forceinline__ unsigned xb_add(unsigned* p, unsigned v) { return __hip_atomic_fetch_add(p, v, __ATOMIC_RELAXED, __HIP_MEMORY_SCOPE_AGENT); }
__device__ __forceinline__ unsigned xb_xcc_id() { return (unsigned)__builtin_amdgcn_s_getreg((3 << 11) | 20) & 0xFu; }
#define XB_SPIN(cond, bar) do { unsigned _sp = 0; while (cond) { __builtin_amdgcn_s_sleep(1); \
    if ((++_sp & 255u) == 0u) { if (xb_ld(&(bar)[XB_TMO])) break; if (_sp > XB_SPIN_CAP) { atomicAdd(&(bar)[XB_TMO], 1u); break; } } } } while (0)

struct XcdBarrier {
    unsigned* bar; unsigned x;
    volatile LAS unsigned* st;
};

__device__ __forceinline__ XcdBarrier xcd_barrier_post(unsigned* bar, volatile LAS unsigned* st) {
    XcdBarrier b; b.bar = bar; b.x = xb_xcc_id(); b.st = st;
    if (threadIdx.x == 0) (void)xb_add(&bar[XB_XCNT(b.x)], 1u);
    return b;
}
__device__ __forceinline__ void xcd_barrier_complete(unsigned* bar, unsigned x, unsigned& nloc, unsigned& nx) {
    const unsigned G = gridDim.x * gridDim.y * gridDim.z;
    unsigned sum, cnt, mine, sp = 0u;
    for (;;) {
        sum = 0u; cnt = 0u; mine = 0u;
#pragma unroll
        for (unsigned j = 0; j < 16; ++j) { const unsigned c = xb_ld(&bar[XB_XCNT(j)]); sum += c; cnt += (c > 0u) ? 1u : 0u; mine = (j == x) ? c : mine; }
        if (sum == G) break;
        __builtin_amdgcn_s_sleep(1);
        if ((++sp & 255u) == 0u) { if (xb_ld(&bar[XB_TMO])) break; if (sp > XB_SPIN_CAP) { atomicAdd(&bar[XB_TMO], 1u); break; } }
    }
    nloc = mine > 0u ? mine : 1u; nx = cnt > 0u ? cnt : 1u;
}

__device__ __forceinline__ void xcd_barrier(const XcdBarrier& b) {
    asm volatile("s_waitcnt vmcnt(0)" ::: "memory");
    __syncthreads();
    if (threadIdx.x == 0) {
        unsigned* bar = b.bar;
        __builtin_amdgcn_s_waitcnt(0);
        unsigned nloc = b.st[0], nx = b.st[1];
        if (nloc == 0u) { xcd_barrier_complete(bar, b.x, nloc, nx); b.st[0] = nloc; b.st[1] = nx; }
        const unsigned old = xb_add(&bar[XB_XSUB(b.x)], 1u);
        const unsigned gen = old / nloc;
        if (old + 1u == (gen + 1u) * nloc) {
            __builtin_amdgcn_fence(__ATOMIC_RELEASE, "agent");
            asm volatile("s_waitcnt vmcnt(0)" ::: "memory");
            const unsigned og = xb_add(&bar[XB_TOP], 1u);
            const unsigned tg = og / nx;
            if (og + 1u == (tg + 1u) * nx) xb_add(&bar[XB_TOPGEN], 1u);
            else XB_SPIN(xb_ld(&bar[XB_TOPGEN]) == tg, bar);
            __builtin_amdgcn_fence(__ATOMIC_ACQUIRE, "agent");
            xb_add(&bar[XB_XGEN(b.x)], 1u);
            asm volatile("s_waitcnt vmcnt(0)" ::: "memory");
        } else {
            XB_SPIN(xb_ld(&bar[XB_XGEN(b.x)]) == gen, bar);
            __builtin_amdgcn_fence(__ATOMIC_ACQUIRE, "agent");
            asm volatile("s_waitcnt vmcnt(0)" ::: "memory");
        }
    }
    __syncthreads();
}

namespace fa {
typedef short bf16x8 __attribute__((ext_vector_type(8)));
typedef short s16x4 __attribute__((ext_vector_type(4)));
typedef float f32x16 __attribute__((ext_vector_type(16)));
typedef unsigned u32x4 __attribute__((ext_vector_type(4)));
typedef unsigned u32x2 __attribute__((ext_vector_type(2)));
typedef unsigned short bf16;
#define FA_SBAR() __builtin_amdgcn_sched_barrier(0)
__device__ __forceinline__ int lane_opaque() { int l = (int)__builtin_amdgcn_mbcnt_hi(~0u, __builtin_amdgcn_mbcnt_lo(~0u, 0u)); asm volatile("" : "+v"(l)); return l; }
__device__ __forceinline__ float shx(float v, int m, int l) { return __int_as_float(__builtin_amdgcn_ds_bpermute((l ^ m) << 2, __float_as_int(v))); }
__device__ __forceinline__ int crow(int r, int hi) { return (r & 3) + 8 * (r >> 2) + 4 * hi; }
__device__ __forceinline__ unsigned cvtpk(float lo, float hi) { unsigned r; asm volatile("v_cvt_pk_bf16_f32 %0, %1, %2" : "=v"(r) : "v"(lo), "v"(hi)); return r; }
__device__ __forceinline__ int v_st(int k, int c) { const int kk = (k & ~0xC) | ((k & 4) << 1) | ((k & 8) >> 1); return ((kk >> 3) * 4 + (c >> 5)) * 512 + ((kk & 7) * 32 + (c & 31)) * 2; }
__device__ __forceinline__ int v_rd_base(int lane) { return ((lane & 3) << 3) | (((lane >> 2) & 3) << 6) | (((lane >> 4) & 1) << 5) | (((lane >> 5) & 1) << 8); }
constexpr int v_rd_off(int d0, int ks, int half) { return d0 * 512 + ks * 4096 + half * 2048; }
template <int OFF> __device__ __forceinline__ s16x4 tr_read(int vb) { s16x4 r; asm volatile("ds_read_b64_tr_b16 %0, %1 offset:%2" : "=&v"(r) : "v"(vb), "i"(OFF) : "memory"); return r; }
template <int D0> __device__ __forceinline__ void pv_one(f32x16& od, int vb, bf16x8 pa0, bf16x8 pa1, bf16x8 pa2, bf16x8 pa3) {
    const s16x4 l0 = tr_read<v_rd_off(D0, 0, 0)>(vb), h0 = tr_read<v_rd_off(D0, 0, 1)>(vb), l1 = tr_read<v_rd_off(D0, 1, 0)>(vb), h1 = tr_read<v_rd_off(D0, 1, 1)>(vb);
    const s16x4 l2 = tr_read<v_rd_off(D0, 2, 0)>(vb), h2 = tr_read<v_rd_off(D0, 2, 1)>(vb), l3 = tr_read<v_rd_off(D0, 3, 0)>(vb), h3 = tr_read<v_rd_off(D0, 3, 1)>(vb);
    asm volatile("s_waitcnt lgkmcnt(0)" ::: "memory"); FA_SBAR();
#define FA_PK(L, H) (bf16x8){L[0], L[1], L[2], L[3], H[0], H[1], H[2], H[3]}
    od = __builtin_amdgcn_mfma_f32_32x32x16_bf16(pa0, FA_PK(l0, h0), od, 0, 0, 0);
    od = __builtin_amdgcn_mfma_f32_32x32x16_bf16(pa1, FA_PK(l1, h1), od, 0, 0, 0);
    od = __builtin_amdgcn_mfma_f32_32x32x16_bf16(pa2, FA_PK(l2, h2), od, 0, 0, 0);
    od = __builtin_amdgcn_mfma_f32_32x32x16_bf16(pa3, FA_PK(l3, h3), od, 0, 0, 0);
#undef FA_PK
}
__device__ __forceinline__ void pv_d0(f32x16* o, int vb, bf16x8 pa0, bf16x8 pa1, bf16x8 pa2, bf16x8 pa3) {
    pv_one<0>(o[0], vb, pa0, pa1, pa2, pa3); pv_one<1>(o[1], vb, pa0, pa1, pa2, pa3); pv_one<2>(o[2], vb, pa0, pa1, pa2, pa3); pv_one<3>(o[3], vb, pa0, pa1, pa2, pa3);
}
struct VFrag { s16x4 l0, h0, l1, h1, l2, h2, l3, h3; };
template <int D0> __device__ __forceinline__ void pv_rd(VFrag& f, int vb) {
    f.l0 = tr_read<v_rd_off(D0, 0, 0)>(vb); f.h0 = tr_read<v_rd_off(D0, 0, 1)>(vb); f.l1 = tr_read<v_rd_off(D0, 1, 0)>(vb); f.h1 = tr_read<v_rd_off(D0, 1, 1)>(vb);
    f.l2 = tr_read<v_rd_off(D0, 2, 0)>(vb); f.h2 = tr_read<v_rd_off(D0, 2, 1)>(vb); f.l3 = tr_read<v_rd_off(D0, 3, 0)>(vb); f.h3 = tr_read<v_rd_off(D0, 3, 1)>(vb);
}
__device__ __forceinline__ void pv_mm(f32x16& od, const VFrag& f, bf16x8 pa0, bf16x8 pa1, bf16x8 pa2, bf16x8 pa3) {
#define FA_PK(L, H) (bf16x8){L[0], L[1], L[2], L[3], H[0], H[1], H[2], H[3]}
    od = __builtin_amdgcn_mfma_f32_32x32x16_bf16(pa0, FA_PK(f.l0, f.h0), od, 0, 0, 0);
    od = __builtin_amdgcn_mfma_f32_32x32x16_bf16(pa1, FA_PK(f.l1, f.h1), od, 0, 0, 0);
    od = __builtin_amdgcn_mfma_f32_32x32x16_bf16(pa2, FA_PK(f.l2, f.h2), od, 0, 0, 0);
    od = __builtin_amdgcn_mfma_f32_32x32x16_bf16(pa3, FA_PK(f.l3, f.h3), od, 0, 0, 0);
#undef FA_PK
}
__device__ __forceinline__ void pv_pipe(f32x16* o, int vb, bf16x8 pa0, bf16x8 pa1, bf16x8 pa2, bf16x8 pa3) {
    VFrag fa, fb;
    pv_rd<0>(fa, vb); pv_rd<1>(fb, vb);
    asm volatile("s_waitcnt lgkmcnt(8)" ::: "memory"); FA_SBAR(); pv_mm(o[0], fa, pa0, pa1, pa2, pa3); FA_SBAR();
    pv_rd<2>(fa, vb);
    asm volatile("s_waitcnt lgkmcnt(8)" ::: "memory"); FA_SBAR(); pv_mm(o[1], fb, pa0, pa1, pa2, pa3); FA_SBAR();
    pv_rd<3>(fb, vb);
    asm volatile("s_waitcnt lgkmcnt(8)" ::: "memory"); FA_SBAR(); pv_mm(o[2], fa, pa0, pa1, pa2, pa3); FA_SBAR();
    asm volatile("s_waitcnt lgkmcnt(0)" ::: "memory"); FA_SBAR(); pv_mm(o[3], fb, pa0, pa1, pa2, pa3); FA_SBAR();
}
struct UnitP {
    const bf16* Q; size_t ldq;
    const bf16* K; size_t ldk;
    const bf16* V; size_t ldv;
    int q0;
    int kt0, kt1;
    float sl2;
    float c2;
    const unsigned* mask;
};
constexpr int WIN = 128;
constexpr float THR2 = 11.5f;
template <int DQK, bool WINDOW, bool ALIBI, bool MASK, bool ROPEQ>
__device__ __forceinline__ void attn_unit(const UnitP& U, LAS unsigned char* lds, f32x16 (&o)[4], float& lse2) {
    constexpr int KROWB = DQK * 2, SHM_V = 16384, SHM_K = 64 * KROWB, KOFF = 2 * SHM_V, WSOFF = KOFF + 2 * 64 * 192 * 2;
    constexpr int KCH = DQK / 8, KPT = 64 * KCH / 512, ND0 = DQK / 16;
    int tid_o_ = threadIdx.x; asm volatile("" : "+v"(tid_o_)); const int tid = tid_o_, wid = __builtin_amdgcn_readfirstlane(tid >> 6), lane = tid & 63, r32 = lane & 31, hi = lane >> 5;
    LAS float* wsf = (LAS float*)(lds + WSOFF + wid * 256);
    float m_reg = -1e30f, l_reg = 0.f;
#pragma unroll
    for (int d = 0; d < 4; ++d)
#pragma unroll
        for (int r = 0; r < 16; ++r) o[d][r] = 0.f;
    bf16x8 qr[ND0];
    const int qi = U.q0 + wid * 32 + r32;
    {   const bf16* Qw = U.Q + (size_t)(wid * 32 + r32) * U.ldq + hi * 8;
#pragma unroll
        for (int d0 = 0; d0 < ND0; ++d0) qr[d0] = *(const bf16x8*)(Qw + d0 * 16);
        if constexpr (ROPEQ) {
#pragma unroll
            for (int pb = 0; pb < 2; ++pb) { bf16x8 a = qr[ND0 - 4 + pb], b = qr[ND0 - 2 + pb];
#pragma unroll
                for (int e = 0; e < 8; ++e) { const int fi = pb * 16 + hi * 8 + e; const float inv = __builtin_amdgcn_exp2f(-0.41524101186092029f * (float)fi);
                    const float ang = (float)qi * inv; const float n = rintf(ang * 0.15915494309189535f);
                    float rr = fmaf(-n, 6.2831854820251465f, ang); rr = fmaf(-n, -1.7484555e-07f, rr); const float fr = rr * 0.15915494309189535f;
                    const float sn = __builtin_amdgcn_sinf(fr), cs = __builtin_amdgcn_cosf(fr);
                    const float x1 = __uint_as_float((unsigned)(unsigned short)a[e] << 16), x2 = __uint_as_float((unsigned)(unsigned short)b[e] << 16);
                    const unsigned w = cvtpk(x1 * cs - x2 * sn, x1 * sn + x2 * cs); a[e] = (short)(w & 0xffffu); b[e] = (short)(w >> 16); }
                qr[ND0 - 4 + pb] = a; qr[ND0 - 2 + pb] = b; }
        }
    }
    unsigned kgo[KPT], vgo[2];
#pragma unroll
    for (int i_ = 0; i_ < KPT; ++i_) { const int p_ = (wid + 8 * i_) * 1024 + lane * 16, row_ = p_ / KROWB, wi_ = (p_ % KROWB) ^ ((row_ & 7) << 4); kgo[i_] = (unsigned)((size_t)row_ * U.ldk * 2 + wi_); }
#pragma unroll
    for (int i_ = 0; i_ < 2; ++i_) { const int p_ = (wid + 8 * i_) * 1024 + lane * 16, sub_ = p_ >> 9, rem_ = p_ & 511, kk_ = (sub_ >> 2) * 8 + (rem_ >> 6), k_ = (kk_ & ~0xC) | ((kk_ & 4) << 1) | ((kk_ & 8) >> 1), col_ = (sub_ & 3) * 32 + ((rem_ & 63) >> 1);
        vgo[i_] = (unsigned)(((size_t)k_ * U.ldv + col_) * 2); }
#define FA_DMA(k0_, b_) do { const char* kg_ = (const char*)U.K + (size_t)(k0_) * U.ldk * 2; const char* vg_ = (const char*)U.V + (size_t)(k0_) * U.ldv * 2; \
        _Pragma("unroll") for (int i_ = 0; i_ < KPT; ++i_) __builtin_amdgcn_global_load_lds((const unsigned*)(kg_ + kgo[i_]), (LAS unsigned*)(lds + KOFF + (b_) * SHM_K + (wid + 8 * i_) * 1024), 16, 0, 0); \
        _Pragma("unroll") for (int i_ = 0; i_ < 2; ++i_) __builtin_amdgcn_global_load_lds((const unsigned*)(vg_ + vgo[i_]), (LAS unsigned*)(lds + (b_) * SHM_V + (wid + 8 * i_) * 1024), 16, 0, 0); } while (0)
    const int vb0 = (int)(unsigned)(uintptr_t)lds + v_rd_base(lane);
    const int NT = U.kt1 - U.kt0;
    const int qw0 = U.q0 + wid * 32, qw1 = qw0 + 31;
    u32x2 mw = {0u, 0u}, mwn = {0u, 0u};
    const unsigned* mrow = MASK ? U.mask + (size_t)(wid * 32 + r32) * 512 : nullptr;
    FA_DMA(U.kt0 * 64, 0); if constexpr (MASK) mw = *(const u32x2*)(mrow + U.kt0 * 2);
    asm volatile("s_waitcnt vmcnt(0)" ::: "memory"); __syncthreads();
    for (int jt = 0; jt < NT; ++jt) {
        const int k0 = (U.kt0 + jt) * 64, buf = jt & 1;
        const bool more = jt + 1 < NT;
        if (more) { FA_DMA(k0 + 64, buf ^ 1); if constexpr (MASK) mwn = *(const u32x2*)(mrow + (k0 >> 5) + 2); }
        const bool active = (k0 <= qw1) && (!WINDOW || (k0 + 63 >= qw0 - WIN));
        if (active) {
            f32x16 p0, p1;
#pragma unroll
            for (int r = 0; r < 16; ++r) { p0[r] = 0.f; p1[r] = 0.f; }
            const LAS unsigned char* kb = lds + KOFF + buf * SHM_K + r32 * KROWB; const int lp = (hi * 16) ^ ((r32 & 7) << 4);
            const LAS unsigned char* kq[4] = {kb + lp, kb + (lp ^ 32), kb + (lp ^ 64), kb + (lp ^ 96)};
#pragma unroll
            for (int d0 = 0; d0 < ND0; ++d0) {
                const bf16x8 b0 = *(const LAS bf16x8*)(kq[d0 & 3] + (d0 >> 2) * 128), b1 = *(const LAS bf16x8*)(kq[d0 & 3] + (d0 >> 2) * 128 + 32 * KROWB);
                p0 = __builtin_amdgcn_mfma_f32_32x32x16_bf16(b0, qr[d0], p0, 0, 0, 0);
                p1 = __builtin_amdgcn_mfma_f32_32x32x16_bf16(b1, qr[d0], p1, 0, 0, 0);
                if ((d0 & 3) == 3) FA_SBAR(); }
            const int lim = qi - k0 - 4 * hi;
            const float tb = ALIBI ? U.sl2 * (float)(-lim) : 0.f;
#pragma unroll
            for (int r = 0; r < 16; ++r) { const int c = (r & 3) + 8 * (r >> 2);
                if constexpr (ALIBI) { p0[r] = fmaf(p0[r], U.c2, fmaf((float)c, U.sl2, tb)); p1[r] = fmaf(p1[r], U.c2, fmaf((float)(c + 32), U.sl2, tb)); }
                else { p0[r] *= U.c2; p1[r] *= U.c2; } }
            const bool need_mask = (k0 + 63 > qw0) || (WINDOW && (k0 < qw1 - WIN));
            if (need_mask) {
#pragma unroll
                for (int r = 0; r < 16; ++r) { const int c = (r & 3) + 8 * (r >> 2); const int d0_ = lim - c, d1_ = lim - c - 32;
                    const bool ok0 = WINDOW ? ((unsigned)d0_ <= (unsigned)WIN) : (d0_ >= 0), ok1 = WINDOW ? ((unsigned)d1_ <= (unsigned)WIN) : (d1_ >= 0);
                    p0[r] = ok0 ? p0[r] : -INFINITY; p1[r] = ok1 ? p1[r] : -INFINITY; }
            }
            if constexpr (MASK) { const unsigned w0 = mw.x >> (4 * hi), w1 = mw.y >> (4 * hi);
#pragma unroll
                for (int r = 0; r < 16; ++r) { const int c = (r & 3) + 8 * (r >> 2);
                    const unsigned b0 = (unsigned)((int)(w0 << (31 - c)) >> 31), b1 = (unsigned)((int)(w1 << (31 - c)) >> 31);
                    p0[r] = __uint_as_float((__float_as_uint(p0[r]) & b0) | (0xff800000u & ~b0)); p1[r] = __uint_as_float((__float_as_uint(p1[r]) & b1) | (0xff800000u & ~b1)); }
            }
            FA_SBAR();
            float pmax = p0[0];
#pragma unroll
            for (int r = 1; r < 16; ++r) pmax = fmaxf(pmax, p0[r]);
#pragma unroll
            for (int r = 0; r < 16; ++r) pmax = fmaxf(pmax, p1[r]);
            { auto rr = __builtin_amdgcn_permlane32_swap(__float_as_uint(pmax), __float_as_uint(pmax), false, false); pmax = fmaxf(__uint_as_float(rr[0]), __uint_as_float(rr[1])); }
            float mn, alpha;
            if (__builtin_expect(__all(pmax - m_reg <= THR2), 1)) { mn = m_reg; alpha = 1.f; }
            else { mn = fmaxf(m_reg, pmax); alpha = __builtin_amdgcn_exp2f(m_reg - mn); m_reg = mn; }
            float ps = 0.f;
#pragma unroll
            for (int r = 0; r < 16; ++r) { p0[r] = __builtin_amdgcn_exp2f(p0[r] - mn); p1[r] = __builtin_amdgcn_exp2f(p1[r] - mn); ps += p0[r] + p1[r]; }
            { auto rr = __builtin_amdgcn_permlane32_swap(__float_as_uint(ps), __float_as_uint(ps), false, false); ps = __uint_as_float(rr[0]) + __uint_as_float(rr[1]); }
            l_reg = l_reg * alpha + ps;
            FA_SBAR();
            bf16x8 pa0, pa1, pa2, pa3;
#define FA_PK4(P, BASE, OUT) do { unsigned a0 = cvtpk(P[BASE + 0], P[BASE + 1]), a1 = cvtpk(P[BASE + 2], P[BASE + 3]);   \
    unsigned b0 = cvtpk(P[BASE + 4], P[BASE + 5]), b1 = cvtpk(P[BASE + 6], P[BASE + 7]);                              \
    auto r0 = __builtin_amdgcn_permlane32_swap(a0, b0, false, false); auto r1 = __builtin_amdgcn_permlane32_swap(a1, b1, false, false); \
    u32x4 w = {r0[0], r1[0], r0[1], r1[1]}; OUT = *reinterpret_cast<bf16x8*>(&w); } while (0)
            FA_PK4(p0, 0, pa0); FA_PK4(p0, 8, pa1); FA_PK4(p1, 0, pa2); FA_PK4(p1, 8, pa3);
#undef FA_PK4
            FA_SBAR();
            if (__any(alpha < 1.f)) { if (hi == 0) wsf[r32] = alpha; asm volatile("s_waitcnt lgkmcnt(0)" ::: "memory");
#pragma unroll
                for (int r = 0; r < 16; ++r) { const float al = wsf[crow(r, hi)];
#pragma unroll
                    for (int d = 0; d < 4; ++d) o[d][r] *= al; }
                asm volatile("s_waitcnt lgkmcnt(0)" ::: "memory"); }
            pv_d0(o, vb0 + buf * SHM_V, pa0, pa1, pa2, pa3);
        }
        if (more) { if constexpr (MASK) mw = mwn; }
        asm volatile("s_waitcnt vmcnt(0)" ::: "memory");
        __syncthreads();
    }
    if (hi == 0) wsf[32 + r32] = l_reg; asm volatile("s_waitcnt lgkmcnt(0)" ::: "memory");
#pragma unroll
    for (int r = 0; r < 16; ++r) { const float rl = __builtin_amdgcn_rcpf(wsf[32 + crow(r, hi)]);
#pragma unroll
        for (int d = 0; d < 4; ++d) o[d][r] *= rl; }
    asm volatile("s_waitcnt lgkmcnt(0)" ::: "memory");
    lse2 = m_reg + __builtin_amdgcn_logf(l_reg);
#undef FA_DMA
}
template <int DQK, bool ALIBI, bool MASK, bool ROPEQ>
__device__ __forceinline__ void attn_unit4(const UnitP& U, LAS unsigned char* lds, f32x16 (&o)[4], float& lse2) {
    constexpr int KROWB = DQK * 2, SHM_V = 16384, SHM_K = 64 * KROWB, KOFF = 3 * SHM_V, WSOFF = KOFF + 3 * 64 * 192 * 2, AUGOFF = WSOFF + 2048;
    constexpr int KCH = DQK / 8, KPT = 64 * KCH / 512, ND0 = DQK / 16;
#define FA4_SWZ(row_) ((KROWB == 256) ? (((row_) & 15) << 4) : ((((row_) >> 1) & 7) << 4))
    int tid_o_ = threadIdx.x; asm volatile("" : "+v"(tid_o_)); const int tid = tid_o_, wid = __builtin_amdgcn_readfirstlane(tid >> 6), lane = tid & 63, r32 = lane & 31, hi = lane >> 5;
    LAS float* wsf = (LAS float*)(lds + WSOFF + wid * 256);
    float m_reg = -1e30f, l_reg = 0.f;
#pragma unroll
    for (int d = 0; d < 4; ++d)
#pragma unroll
        for (int r = 0; r < 16; ++r) o[d][r] = 0.f;
    bf16x8 qr[ND0];
    const int qi = U.q0 + wid * 32 + r32;
    {   const bf16* Qw = U.Q + (size_t)(wid * 32 + r32) * U.ldq + hi * 8;
#pragma unroll
        for (int d0 = 0; d0 < ND0; ++d0) qr[d0] = *(const bf16x8*)(Qw + d0 * 16);
        if constexpr (ROPEQ) {
#pragma unroll
            for (int pb = 0; pb < 2; ++pb) { bf16x8 a = qr[ND0 - 4 + pb], b = qr[ND0 - 2 + pb];
#pragma unroll
                for (int e = 0; e < 8; ++e) { const int fi = pb * 16 + hi * 8 + e; const float inv = __builtin_amdgcn_exp2f(-0.41524101186092029f * (float)fi);
                    const float ang = (float)qi * inv; const float n = rintf(ang * 0.15915494309189535f);
                    float rr = fmaf(-n, 6.2831854820251465f, ang); rr = fmaf(-n, -1.7484555e-07f, rr); const float fr = rr * 0.15915494309189535f;
                    const float sn = __builtin_amdgcn_sinf(fr), cs = __builtin_amdgcn_cosf(fr);
                    const float x1 = __uint_as_float((unsigned)(unsigned short)a[e] << 16), x2 = __uint_as_float((unsigned)(unsigned short)b[e] << 16);
                    const unsigned w = cvtpk(x1 * cs - x2 * sn, x1 * sn + x2 * cs); a[e] = (short)(w & 0xffffu); b[e] = (short)(w >> 16); }
                qr[ND0 - 4 + pb] = a; qr[ND0 - 2 + pb] = b; }
        }
    }
    bf16x8 qaug = {0, 0, 0, 0, 0, 0, 0, 0};
    if constexpr (ALIBI) { const float g_ = U.sl2 / U.c2; const unsigned gh_ = (__float_as_uint(g_) + 0x7fffu + ((__float_as_uint(g_) >> 16) & 1u)) & 0xffff0000u; const float gl_ = g_ - __uint_as_float(gh_);
        const unsigned glb_ = (__float_as_uint(gl_) + 0x7fffu + ((__float_as_uint(gl_) >> 16) & 1u)) & 0xffff0000u;
        const unsigned w0_ = (__float_as_uint(-128.f * __uint_as_float(gh_)) >> 16) | (__float_as_uint(-__uint_as_float(gh_)) & 0xffff0000u);
        const unsigned w1_ = (__float_as_uint(-128.f * __uint_as_float(glb_)) >> 16) | (__float_as_uint(-__uint_as_float(glb_)) & 0xffff0000u);
        const u32x4 qa_ = {hi ? 0u : w0_, hi ? 0u : w1_, 0u, 0u}; qaug = *reinterpret_cast<const bf16x8*>(&qa_); }
    const LAS unsigned char* augp = lds + AUGOFF + r32 * 32 + hi * 16;
    unsigned kgo[KPT], vgo[2];
#pragma unroll
    for (int i_ = 0; i_ < KPT; ++i_) { const int p_ = (wid + 8 * i_) * 1024 + lane * 16, row_ = p_ / KROWB, wi_ = (p_ % KROWB) ^ FA4_SWZ(row_); kgo[i_] = (unsigned)((size_t)row_ * U.ldk * 2 + wi_); }
#pragma unroll
    for (int i_ = 0; i_ < 2; ++i_) { const int p_ = (wid + 8 * i_) * 1024 + lane * 16, sub_ = p_ >> 9, rem_ = p_ & 511, kk_ = (sub_ >> 2) * 8 + (rem_ >> 6), k_ = (kk_ & ~0xC) | ((kk_ & 4) << 1) | ((kk_ & 8) >> 1), col_ = (sub_ & 3) * 32 + ((rem_ & 63) >> 1);
        vgo[i_] = (unsigned)(((size_t)k_ * U.ldv + col_) * 2); }
#define FA3_DMA(k0_, kb_, vb_) do { const char* kg_ = (const char*)U.K + (size_t)(k0_) * U.ldk * 2; const char* vg_ = (const char*)U.V + (size_t)(k0_) * U.ldv * 2; \
        _Pragma("unroll") for (int i_ = 0; i_ < KPT; ++i_) __builtin_amdgcn_global_load_lds((const unsigned*)(kg_ + kgo[i_]), (LAS unsigned*)(lds + KOFF + (kb_) * SHM_K + (wid + 8 * i_) * 1024), 16, 0, 0); \
        _Pragma("unroll") for (int i_ = 0; i_ < 2; ++i_) __builtin_amdgcn_global_load_lds((const unsigned*)(vg_ + vgo[i_]), (LAS unsigned*)(lds + (vb_) * SHM_V + (wid + 8 * i_) * 1024), 16, 0, 0); \
        if constexpr (ALIBI) { if (tid < 128) { const int rel_ = U.q0 + 255 - ((k0_) + (tid >> 1)); const unsigned ab_ = (__float_as_uint((float)(rel_ >> 7)) >> 16) | (__float_as_uint((float)(rel_ & 127)) & 0xffff0000u); \
            const unsigned z_ = (tid & 1) ? 0u : ab_; *(LAS u32x4*)(lds + AUGOFF + (kb_) * 2048 + tid * 16) = (u32x4){z_, z_, 0u, 0u}; } } } while (0)
    const int vb0 = (int)(unsigned)(uintptr_t)lds + v_rd_base(lane);
    const int NT = U.kt1 - U.kt0;
    const int qw0 = U.q0 + wid * 32, qw1 = qw0 + 31;
    const int swz_ = FA4_SWZ(r32); const int lp = (hi * 16) ^ (swz_ & 0x70); const int hsw = (KROWB == 256) ? (swz_ & 0x80) : 0;
    const LAS unsigned char* kbase = lds + KOFF + r32 * KROWB;
    const LAS unsigned char* kq0 = kbase + lp; const LAS unsigned char* kq1 = kbase + (lp ^ 32); const LAS unsigned char* kq2 = kbase + (lp ^ 64); const LAS unsigned char* kq3 = kbase + (lp ^ 96);
    bf16x8 pa0, pa1, pa2, pa3;
#define FA3_PK4(P, BASE, OUT) do { unsigned a0 = cvtpk(P[BASE + 0], P[BASE + 1]), a1 = cvtpk(P[BASE + 2], P[BASE + 3]);   \
    unsigned b0 = cvtpk(P[BASE + 4], P[BASE + 5]), b1 = cvtpk(P[BASE + 6], P[BASE + 7]);                              \
    auto r0 = __builtin_amdgcn_permlane32_swap(a0, b0, false, false); auto r1 = __builtin_amdgcn_permlane32_swap(a1, b1, false, false); \
    u32x4 w = {r0[0], r1[0], r0[1], r1[1]}; OUT = *reinterpret_cast<bf16x8*>(&w); } while (0)
#define FA3_SCORE(kb_, k0_, MW) do { f32x16 p0, p1; _Pragma("unroll") for (int r = 0; r < 16; ++r) { p0[r] = 0.f; p1[r] = 0.f; } const int so_ = (kb_) * SHM_K; \
          \
        bf16x8 kfa_[ND0], kfb_[ND0]; bf16x8 a0_ = qaug, a1_ = qaug; \
        _Pragma("unroll") for (int d0 = 0; d0 < ND0 + 2; ++d0) { \
            if (d0 < ND0) { const LAS unsigned char* kp_ = ((d0 & 3) == 0 ? kq0 : (d0 & 3) == 1 ? kq1 : (d0 & 3) == 2 ? kq2 : kq3) + so_ + ((KROWB == 256) ? (((d0 >> 2) * 128) ^ hsw) : (d0 >> 2) * 128); \
                kfa_[d0] = *(const LAS bf16x8*)(kp_); kfb_[d0] = *(const LAS bf16x8*)(kp_ + 32 * KROWB); } \
            if constexpr (ALIBI) { if (d0 == ND0) { a0_ = *(const LAS bf16x8*)(augp + (kb_) * 2048); a1_ = *(const LAS bf16x8*)(augp + (kb_) * 2048 + 1024); } } \
            FA_SBAR(); \
            if (d0 >= 2) { p0 = __builtin_amdgcn_mfma_f32_32x32x16_bf16(kfa_[d0 - 2], qr[d0 - 2], p0, 0, 0, 0); p1 = __builtin_amdgcn_mfma_f32_32x32x16_bf16(kfb_[d0 - 2], qr[d0 - 2], p1, 0, 0, 0); } \
            FA_SBAR(); } \
        if constexpr (ALIBI) { p0 = __builtin_amdgcn_mfma_f32_32x32x16_bf16(a0_, qaug, p0, 0, 0, 0); p1 = __builtin_amdgcn_mfma_f32_32x32x16_bf16(a1_, qaug, p1, 0, 0, 0); } \
        const int lim_ = qi - (k0_) - 4 * hi; \
        if ((k0_) + 63 > qw0) { _Pragma("unroll") for (int r = 0; r < 16; ++r) { const int c = (r & 3) + 8 * (r >> 2); p0[r] = (lim_ - c >= 0) ? p0[r] : -INFINITY; p1[r] = (lim_ - c - 32 >= 0) ? p1[r] : -INFINITY; } } \
        if constexpr (MASK) { const unsigned w0_ = MW.x >> (4 * hi), w1_ = MW.y >> (4 * hi); \
            _Pragma("unroll") for (int r = 0; r < 16; ++r) { const int c = (r & 3) + 8 * (r >> 2); \
                const unsigned b0_ = (unsigned)((int)(w0_ << (31 - c)) >> 31), b1_ = (unsigned)((int)(w1_ << (31 - c)) >> 31); \
                p0[r] = __uint_as_float((__float_as_uint(p0[r]) & b0_) | (0xff800000u & ~b0_)); p1[r] = __uint_as_float((__float_as_uint(p1[r]) & b1_) | (0xff800000u & ~b1_)); } } \
        FA_SBAR(); \
        float pmax_ = p0[0]; \
        _Pragma("unroll") for (int r = 1; r < 16; ++r) pmax_ = fmaxf(pmax_, p0[r]); \
        _Pragma("unroll") for (int r = 0; r < 16; ++r) pmax_ = fmaxf(pmax_, p1[r]); \
        { auto rr = __builtin_amdgcn_permlane32_swap(__float_as_uint(pmax_), __float_as_uint(pmax_), false, false); pmax_ = fmaxf(__uint_as_float(rr[0]), __uint_as_float(rr[1])); } \
        pmax_ *= U.c2; float mn_, alpha_; \
        if (__builtin_expect(__all(pmax_ - m_reg <= THR2), 1)) { mn_ = m_reg; alpha_ = 1.f; } \
        else { mn_ = fmaxf(m_reg, pmax_); alpha_ = __builtin_amdgcn_exp2f(m_reg - mn_); m_reg = mn_; } \
        float ps_ = 0.f; \
        _Pragma("unroll") for (int r = 0; r < 16; ++r) { p0[r] = __builtin_amdgcn_exp2f(fmaf(p0[r], U.c2, -mn_)); p1[r] = __builtin_amdgcn_exp2f(fmaf(p1[r], U.c2, -mn_)); ps_ += p0[r] + p1[r]; } \
        { auto rr = __builtin_amdgcn_permlane32_swap(__float_as_uint(ps_), __float_as_uint(ps_), false, false); ps_ = __uint_as_float(rr[0]) + __uint_as_float(rr[1]); } \
        l_reg = l_reg * alpha_ + ps_; \
        FA_SBAR(); \
        FA3_PK4(p0, 0, pa0); FA3_PK4(p0, 8, pa1); FA3_PK4(p1, 0, pa2); FA3_PK4(p1, 8, pa3); \
        FA_SBAR(); \
        if (__any(alpha_ < 1.f)) { if (hi == 0) wsf[r32] = alpha_; asm volatile("s_waitcnt lgkmcnt(0)" ::: "memory"); \
            _Pragma("unroll") for (int r = 0; r < 16; ++r) { const float al = wsf[crow(r, hi)]; _Pragma("unroll") for (int d = 0; d < 4; ++d) o[d][r] *= al; } \
            asm volatile("s_waitcnt lgkmcnt(0)" ::: "memory"); } } while (0)
    u32x2 mw = {0u, 0u}, mwn = {0u, 0u};
    const unsigned* mrow = MASK ? U.mask + (size_t)(wid * 32 + r32) * 512 : nullptr;
    FA3_DMA(U.kt0 * 64, 0, 0); if constexpr (MASK) mw = *(const u32x2*)(mrow + U.kt0 * 2);
    if (NT > 1) FA3_DMA(U.kt0 * 64 + 64, 1, 1);
    asm volatile("s_waitcnt vmcnt(0)" ::: "memory"); __syncthreads();
    int sl = 0;
#pragma nounroll
    for (int jt = 0; jt < NT; ++jt) {
        const int k0 = (U.kt0 + jt) * 64; const int s2 = sl == 0 ? 2 : sl - 1;
        if constexpr (MASK) { if (jt + 1 < NT) mwn = *(const u32x2*)(mrow + (k0 >> 5) + 2); }
        const bool more2 = jt + 2 < NT;
        if (more2) FA3_DMA(k0 + 128, s2, s2);
        if (k0 <= qw1) { FA3_SCORE(sl, k0, mw); pv_pipe(o, vb0 + sl * SHM_V, pa0, pa1, pa2, pa3); }
        if constexpr (MASK) mw = mwn;
        sl = sl == 2 ? 0 : sl + 1;
        if (more2) asm volatile("s_waitcnt vmcnt(%0)" :: "n"(KPT + 2) : "memory");
        else asm volatile("s_waitcnt vmcnt(0)" ::: "memory");
        __syncthreads();
    }
    if (hi == 0) wsf[32 + r32] = l_reg; asm volatile("s_waitcnt lgkmcnt(0)" ::: "memory");
#pragma unroll
    for (int r = 0; r < 16; ++r) { const float rl = __builtin_amdgcn_rcpf(wsf[32 + crow(r, hi)]);
#pragma unroll
        for (int d = 0; d < 4; ++d) o[d][r] *= rl; }
    asm volatile("s_waitcnt lgkmcnt(0)" ::: "memory");
    lse2 = m_reg + __builtin_amdgcn_logf(l_reg);
#undef FA3_DMA
#undef FA4_SWZ
#undef FA3_PK4
#undef FA3_SCORE
}
__device__ __forceinline__ void store_o_bf16(const f32x16 (&o)[4], bf16* outw, size_t ldo, int r32, int hi) {
    asm volatile("" : "+v"(r32), "+v"(hi));
    const bool odd = r32 & 1; const int lo_ = lane_opaque();
#pragma unroll
    for (int d0 = 0; d0 < 4; ++d0)
#pragma unroll
        for (int rp = 0; rp < 8; ++rp) { const int r0 = 2 * rp, r1 = 2 * rp + 1;
            const float send = odd ? o[d0][r0] : o[d0][r1]; const float recv = shx(send, 1, lo_);
            const unsigned w = odd ? cvtpk(recv, o[d0][r1]) : cvtpk(o[d0][r0], recv);
            const int row = crow(odd ? r1 : r0, hi), col = d0 * 32 + (r32 & ~1);
            *(unsigned*)(outw + (size_t)row * ldo + col) = w; }
}
}
struct Frame {
    LAS unsigned char* lds;
    volatile LAS unsigned* MISC;
    gu32* ctl;
    int tid, lane, wave;
    int vcu, G, gw, NGW;
};
__device__ __forceinline__ float wave_sum(float v) {
    int l = (int)__builtin_amdgcn_mbcnt_hi(~0u, __builtin_amdgcn_mbcnt_lo(~0u, 0u)); asm volatile("" : "+v"(l));
#pragma unroll
    for (int o = 1; o < 64; o <<= 1) v += __int_as_float(__builtin_amdgcn_ds_bpermute((l ^ o) << 2, __float_as_int(v)));
    return v;
}
template <int MODE>
__device__ __forceinline__ void transpose_item(const float* W, int K, int N, int nblk, bf16* WT, const float* kscale, LAS float* scr, int item, int lane) {
    const int kb = item / nblk, nb = item % nblk, k0 = 64 * kb, n0 = 32 * nb;
    const int c4 = 4 * (lane & 7), nl = n0 + c4; const bool inb = nl < N;
    f32x4 v[8];
#pragma unroll
    for (int i = 0; i < 8; ++i) { const int kk = 8 * i + (lane >> 3); v[i] = inb ? *(const GAS f32x4*)(W + (size_t)(k0 + kk) * N + nl) : (f32x4){0.f, 0.f, 0.f, 0.f}; }
#pragma unroll
    for (int i = 0; i < 8; ++i) { const int kk = 8 * i + (lane >> 3); f32x4 x = v[i]; if (kscale) x = x * kscale[k0 + kk];
        LAS float* d = scr + kk * 33 + c4; d[0] = x[0]; d[1] = x[1]; d[2] = x[2]; d[3] = x[3]; }
    LDS_WAIT(); asm volatile("" ::: "memory");
    const int c = lane & 7;
#pragma unroll
    for (int j = 0; j < 4; ++j) { const int n = (lane >> 3) + 8 * j; const LAS float* s = scr + (8 * c) * 33 + n;
        v4u o; o.x = pk2(s[0 * 33], s[1 * 33]); o.y = pk2(s[2 * 33], s[3 * 33]); o.z = pk2(s[4 * 33], s[5 * 33]); o.w = pk2(s[6 * 33], s[7 * 33]);
        const int ng = n0 + n; const int drow = MODE == 0 ? ng : ((ng >> 7) * 256 + (ng & 127) + (MODE == 2 ? 128 : 0));
        *(GAS v4u*)(WT + (size_t)drow * K + k0 + 8 * c) = o; }
    LDS_WAIT(); asm volatile("" ::: "memory");
}
template <int MODE>
__device__ __forceinline__ void convert_weight(Frame& F, const float* W, int K, int N, int Npad, bf16* WT, const float* kscale) {
    LAS float* scr = (LAS float*)(F.lds + RING_OFF + F.wave * 16384);
    const int nblk = Npad / 32, nitems = (K / 64) * nblk;
    for (int it = F.gw; it < nitems; it += F.NGW) transpose_item<MODE>(W, K, N, nblk, WT, kscale, scr, it, F.lane);
}
__device__ __forceinline__ void convert_ffn(Frame& F, const float* wg, const float* wu, const float* wd, unsigned char* dst) {
    convert_weight<1>(F, wg, DM, DFF, DFF, (bf16*)dst, nullptr);
    convert_weight<2>(F, wu, DM, DFF, DFF, (bf16*)dst, nullptr);
    convert_weight<0>(F, wd, DFF, DM, DM, (bf16*)(dst + WF_DOWN_OFF), nullptr);
}
__device__ __forceinline__ void convert_x(Frame& F, const float* x, bf16* X) {
    const size_t n8 = (size_t)S * DM / 8;
    for (size_t i = (size_t)F.gw * 64 + F.lane; i < n8; i += (size_t)F.NGW * 64) {
        const f32x4 a = *(const GAS f32x4*)(x + i * 8), b = *(const GAS f32x4*)(x + i * 8 + 4);
        v4u o; o.x = pk2(a[0], a[1]); o.y = pk2(a[2], a[3]); o.z = pk2(b[0], b[1]); o.w = pk2(b[2], b[3]);
        *(GAS v4u*)(X + i * 8) = o; }
}
__device__ __forceinline__ void scale_x(Frame& F, const bf16* X, float* Y) {
    const size_t n8 = (size_t)S * DM / 8;
    for (size_t i = (size_t)F.gw * 64 + F.lane; i < n8; i += (size_t)F.NGW * 64) {
        const v4u w = *(const GAS v4u*)(X + i * 8);
        f32x4 a = {ALPHA * bflo(w.x), ALPHA * bfhi(w.x), ALPHA * bflo(w.y), ALPHA * bfhi(w.y)}, b = {ALPHA * bflo(w.z), ALPHA * bfhi(w.z), ALPHA * bflo(w.w), ALPHA * bfhi(w.w)};
        *(GAS f32x4*)(Y + i * 8) = a; *(GAS f32x4*)(Y + i * 8 + 4) = b; }
}
template <bool FINAL>
__device__ __forceinline__ void ln_phase(Frame& F, const bf16* Y, const float* g, const float* b, bf16* X, float* out) {
    for (int row = F.gw; row < S; row += F.NGW) {
        const GAS v4u* yr = (const GAS v4u*)(Y + (size_t)row * DM) + F.lane;
        float v[4][8]; float s = 0.f;
#pragma unroll
        for (int j = 0; j < 4; ++j) { const v4u w = yr[64 * j]; v[j][0] = bflo(w.x); v[j][1] = bfhi(w.x); v[j][2] = bflo(w.y); v[j][3] = bfhi(w.y); v[j][4] = bflo(w.z); v[j][5] = bfhi(w.z); v[j][6] = bflo(w.w); v[j][7] = bfhi(w.w);
#pragma unroll
            for (int e = 0; e < 8; ++e) s += v[j][e]; }
        const float mean = wave_sum(s) * (1.f / DM); float s2 = 0.f;
#pragma unroll
        for (int j = 0; j < 4; ++j)
#pragma unroll
            for (int e = 0; e < 8; ++e) { v[j][e] -= mean; s2 += v[j][e] * v[j][e]; }
        const float rstd = 1.f / sqrtf(wave_sum(s2) * (1.f / DM) + LN_EPS);
#pragma unroll
        for (int j = 0; j < 4; ++j) { const int c0 = 8 * (64 * j + F.lane);
            const f32x4 g0 = *(const GAS f32x4*)(g + c0), g1 = *(const GAS f32x4*)(g + c0 + 4), b0 = *(const GAS f32x4*)(b + c0), b1 = *(const GAS f32x4*)(b + c0 + 4);
            f32x4 o0, o1;
#pragma unroll
            for (int e = 0; e < 4; ++e) { o0[e] = v[j][e] * rstd * g0[e] + b0[e]; o1[e] = v[j][4 + e] * rstd * g1[e] + b1[e]; }
            if (FINAL) { *(GAS f32x4*)(out + (size_t)row * DM + c0) = o0; *(GAS f32x4*)(out + (size_t)row * DM + c0 + 4) = o1; }
            else { v4u w; w.x = pk2(o0[0], o0[1]); w.y = pk2(o0[2], o0[3]); w.z = pk2(o1[0], o1[1]); w.w = pk2(o1[2], o1[3]); *(GAS v4u*)(X + (size_t)row * DM + c0) = w; } }
    }
}
constexpr float LOG2E = 1.4426950408889634f;
__device__ __forceinline__ void mixer_a_phase(Frame& F, const bf16* P, bf16* OA, float* LSE) {
    const int wid = F.wave, r32 = F.lane & 31, hi = F.lane >> 5;
    for (int u = F.vcu; u < 1536; u += F.G) {
        const int g = u >> 9, rem = u & 511, h = rem >> 6, j = rem & 63;
        const int dsh = 2 * g, d = 1 << dsh, c = j >> (6 - dsh), blk = j & ((64 >> dsh) - 1), I0 = blk * 256;
        fa::UnitP U; U.ldq = U.ldk = U.ldv = (size_t)d * EINP;
        const bf16* base = P + (size_t)c * EINP + h * 128;
        U.Q = base + (size_t)I0 * U.ldq; U.K = base + 1024; U.V = base + 2048;
        U.q0 = I0; U.kt0 = I0 ? (I0 >> 6) - 2 : 0; U.kt1 = (I0 >> 6) + 4;
        U.sl2 = exp2f(-(float)(h + 1)) * (float)d * LOG2E; U.c2 = 0.08838834764831845f * LOG2E; U.mask = nullptr;
        fa::f32x16 o[4]; float lse2;
        fa::attn_unit<128, true, true, false, false>(U, F.lds, o, lse2);
        const int row0 = I0 + wid * 32;
        fa::store_o_bf16(o, OA + (size_t)g * S * 1024 + ((size_t)row0 * d + c) * 1024 + h * 128, (size_t)d * 1024, r32, hi);
        if (hi == 0) LSE[((size_t)g * S + (size_t)(row0 + r32) * d + c) * 8 + h] = lse2;
    }
}
__device__ __forceinline__ void merge_a(Frame& F, const bf16* OA, const float* LSE, bf16* O) {
    const int h = F.lane >> 3;
    for (int pos = F.gw; pos < S; pos += F.NGW) {
        const float l0 = LSE[((size_t)0 * S + pos) * 8 + h], l1 = LSE[((size_t)1 * S + pos) * 8 + h], l2 = LSE[((size_t)2 * S + pos) * 8 + h];
        const float mx = fmaxf(l0, fmaxf(l1, l2)); float w0 = exp2f(l0 - mx), w1 = exp2f(l1 - mx), w2 = exp2f(l2 - mx); const float inv = 1.f / (w0 + w1 + w2); w0 *= inv; w1 *= inv; w2 *= inv;
#pragma unroll
        for (int hf = 0; hf < 2; ++hf) { const size_t off = (size_t)pos * 1024 + 16 * F.lane + 8 * hf;
            const v4u a = *(const GAS v4u*)(OA + off), b = *(const GAS v4u*)(OA + (size_t)S * 1024 + off), c = *(const GAS v4u*)(OA + (size_t)2 * S * 1024 + off);
            v4u o;
            o.x = pk2(w0 * bflo(a.x) + w1 * bflo(b.x) + w2 * bflo(c.x), w0 * bfhi(a.x) + w1 * bfhi(b.x) + w2 * bfhi(c.x));
            o.y = pk2(w0 * bflo(a.y) + w1 * bflo(b.y) + w2 * bflo(c.y), w0 * bfhi(a.y) + w1 * bfhi(b.y) + w2 * bfhi(c.y));
            o.z = pk2(w0 * bflo(a.z) + w1 * bflo(b.z) + w2 * bflo(c.z), w0 * bfhi(a.z) + w1 * bfhi(b.z) + w2 * bfhi(c.z));
            o.w = pk2(w0 * bflo(a.w) + w1 * bflo(b.w) + w2 * bflo(c.w), w0 * bfhi(a.w) + w1 * bfhi(b.w) + w2 * bfhi(c.w));
            *(GAS v4u*)(O + (size_t)pos * DM + 16 * F.lane + 8 * hf) = o; }
    }
}
typedef float f32x16 __attribute__((ext_vector_type(16)));
__device__ __forceinline__ unsigned okey(float f) { const unsigned u = __float_as_uint(f); return (u & 0x80000000u) ? ~u : (u | 0x80000000u); }
__device__ __forceinline__ int hswz(int w) { return (w & ~31) | ((w ^ (w >> 5)) & 31); }
__device__ __forceinline__ void find_kth(const LAS unsigned* hq, int target, int lane, int& bin, int& above, int& binc) {
    unsigned w[32]; unsigned cl = 0;
#pragma unroll
    for (int i = 0; i < 32; ++i) { w[i] = hq[32 * lane + ((i ^ lane) & 31)]; cl += (w[i] & 0xffffu) + (w[i] >> 16); }
    unsigned suf = cl;
#pragma unroll
    for (int off = 1; off < 64; off <<= 1) { const unsigned t = __shfl_down(suf, off); if (lane + off < 64) suf += t; }
    const unsigned long long bal = __ballot((int)suf >= target);
    if (bal == 0ull) { bin = -1; above = 0; binc = 0; return; }
    const int L = 63 - __clzll((long long)bal);
    int cum = (int)(suf - cl), fb = -1, fab = 0, fc = 0;
#pragma unroll
    for (int i = 31; i >= 0; --i) { const int h16 = (int)(w[i] >> 16), l16 = (int)(w[i] & 0xffffu);
        if (fb < 0) { if (cum + h16 >= target) { fb = 2 * i + 1; fab = cum; fc = h16; } else { cum += h16; if (cum + l16 >= target) { fb = 2 * i; fab = cum; fc = l16; } else cum += l16; } } }
    bin = __shfl(fb, L) + 64 * L; above = __shfl(fab, L); binc = __shfl(fc, L);
}
__device__ __forceinline__ void indexer_unit(const bf16* P, unsigned* MASKB, unsigned* NEARBLK, LAS unsigned char* lds, int unit, int wid, int lane) {
    const int r32 = lane & 31, hi = lane >> 5, wu = unit * 8 + wid, q = 2 * wu + hi;
    LAS unsigned* hist = (LAS unsigned*)(lds + RING_OFF + wid * 16384);
    LAS unsigned char* ring = lds + KI_RING_OFF;
    bf16x8 af[4];
    {   const int jq = (r32 >> 2) & 1, head = (r32 & 3) + 4 * (r32 >> 3);
        const bf16* qrow = P + (size_t)(2 * wu + jq) * EINP + 6144 + head * 64 + hi * 8;
#pragma unroll
        for (int ks = 0; ks < 4; ++ks) af[ks] = *(const bf16x8*)(qrow + ks * 16); }
    float wq[16];
    {   const v4u a = *(const GAS v4u*)(P + (size_t)q * EINP + 7232), b = *(const GAS v4u*)(P + (size_t)q * EINP + 7240);
        wq[0] = bflo(a.x); wq[1] = bfhi(a.x); wq[2] = bflo(a.y); wq[3] = bfhi(a.y); wq[4] = bflo(a.z); wq[5] = bfhi(a.z); wq[6] = bflo(a.w); wq[7] = bfhi(a.w);
        wq[8] = bflo(b.x); wq[9] = bfhi(b.x); wq[10] = bflo(b.y); wq[11] = bfhi(b.y); wq[12] = bflo(b.z); wq[13] = bfhi(b.z); wq[14] = bflo(b.w); wq[15] = bfhi(b.w);
#pragma unroll
        for (int r = 0; r < 16; ++r) wq[r] *= 0.03125f; }
    const int NS = (16 * unit + 16 + 63) >> 6;
    const bool any256 = 16 * unit + 15 >= 255;
    const int prow = wid * 8 + (lane >> 3);
    const char* kgsrc = (const char*)(P + 7168) + (size_t)prow * EINP * 2 + (((lane & 7) * 16) ^ ((prow & 7) << 4));
    const int lp = (hi * 16) ^ ((r32 & 7) << 4);
    const int fo0 = r32 * 128 + lp, fo1 = r32 * 128 + (lp ^ 32), fo2 = r32 * 128 + (lp ^ 64), fo3 = r32 * 128 + (lp ^ 96);
#define IDX_DMA(s_) __builtin_amdgcn_global_load_lds((const unsigned*)(kgsrc + (size_t)(s_) * 64 * EINP * 2), (LAS unsigned*)(ring + ((s_) & 1) * 8192 + wid * 1024), 16, 0, 0)
#define IDX_SCORE2(slot_, keyA_, keyB_) do { const LAS unsigned char* fb_ = ring + (slot_) * 8192; \
        const bf16x8 b00_ = *(const LAS bf16x8*)(fb_ + fo0), b10_ = *(const LAS bf16x8*)(fb_ + 4096 + fo0), b01_ = *(const LAS bf16x8*)(fb_ + fo1), b11_ = *(const LAS bf16x8*)(fb_ + 4096 + fo1); \
        const bf16x8 b02_ = *(const LAS bf16x8*)(fb_ + fo2), b12_ = *(const LAS bf16x8*)(fb_ + 4096 + fo2), b03_ = *(const LAS bf16x8*)(fb_ + fo3), b13_ = *(const LAS bf16x8*)(fb_ + 4096 + fo3); \
        __builtin_amdgcn_sched_barrier(0); \
        f32x16 a0_, a1_; _Pragma("unroll") for (int r = 0; r < 16; ++r) { a0_[r] = 0.f; a1_[r] = 0.f; } \
        a0_ = __builtin_amdgcn_mfma_f32_32x32x16_bf16(af[0], b00_, a0_, 0, 0, 0); a1_ = __builtin_amdgcn_mfma_f32_32x32x16_bf16(af[0], b10_, a1_, 0, 0, 0); \
        a0_ = __builtin_amdgcn_mfma_f32_32x32x16_bf16(af[1], b01_, a0_, 0, 0, 0); a1_ = __builtin_amdgcn_mfma_f32_32x32x16_bf16(af[1], b11_, a1_, 0, 0, 0); \
        a0_ = __builtin_amdgcn_mfma_f32_32x32x16_bf16(af[2], b02_, a0_, 0, 0, 0); a1_ = __builtin_amdgcn_mfma_f32_32x32x16_bf16(af[2], b12_, a1_, 0, 0, 0); \
        a0_ = __builtin_amdgcn_mfma_f32_32x32x16_bf16(af[3], b03_, a0_, 0, 0, 0); a1_ = __builtin_amdgcn_mfma_f32_32x32x16_bf16(af[3], b13_, a1_, 0, 0, 0); \
        __builtin_amdgcn_sched_barrier(0); \
        float s0a_ = 0.f, s0b_ = 0.f, s1a_ = 0.f, s1b_ = 0.f, t0a_ = 0.f, t0b_ = 0.f, t1a_ = 0.f, t1b_ = 0.f; \
        _Pragma("unroll") for (int r = 0; r < 16; r += 2) { s0a_ = fmaf(wq[r], a0_[r], s0a_); s0b_ = fmaf(wq[r + 1], a0_[r + 1], s0b_); s1a_ = fmaf(wq[r], a1_[r], s1a_); s1b_ = fmaf(wq[r + 1], a1_[r + 1], s1b_); \
            t0a_ = fmaf(wq[r], __builtin_fabsf(a0_[r]), t0a_); t0b_ = fmaf(wq[r + 1], __builtin_fabsf(a0_[r + 1]), t0b_); t1a_ = fmaf(wq[r], __builtin_fabsf(a1_[r]), t1a_); t1b_ = fmaf(wq[r + 1], __builtin_fabsf(a1_[r + 1]), t1b_); \
            asm("" : "+v"(t0a_), "+v"(t0b_), "+v"(t1a_), "+v"(t1b_)); }   \
        keyA_ = okey((s0a_ + s0b_) + (t0a_ + t0b_)); keyB_ = okey((s1a_ + s1b_) + (t1a_ + t1b_)); } while (0)
#define IDX_ZERO() do { _Pragma("unroll") for (int i = 0; i < 16; ++i) ((LAS v4u*)hist)[i * 64 + lane] = (v4u){0u, 0u, 0u, 0u}; LDS_WAIT(); } while (0)
#define IDX_PASS(...) do { IDX_DMA(0); \
        for (int s_ = 0; s_ < NS; ++s_) { asm volatile("s_waitcnt vmcnt(0)" ::: "memory"); __builtin_amdgcn_s_barrier(); asm volatile("" ::: "memory"); \
            if (s_ + 1 < NS) IDX_DMA(s_ + 1); \
            unsigned keyA_, keyB_; IDX_SCORE2(s_ & 1, keyA_, keyB_); \
            { const int kt = 2 * s_; const unsigned key32 = keyA_; __VA_ARGS__ } { const int kt = 2 * s_ + 1; const unsigned key32 = keyB_; __VA_ARGS__ } } \
        __builtin_amdgcn_s_barrier(); } while (0)
    IDX_ZERO();
    IDX_PASS({ if (kt * 32 + r32 <= q) { const int bin = (int)(key32 >> 20); __hip_atomic_fetch_add(hist + hi * 2048 + hswz(bin >> 1), 1u << ((bin & 1) * 16), __ATOMIC_RELAXED, __HIP_MEMORY_SCOPE_WORKGROUP); } });
    LDS_WAIT();
    int b0, a0, c0, b1, a1, c1; find_kth(hist, 256, lane, b0, a0, c0); find_kth(hist + 2048, 256, lane, b1, a1, c1);
    const int mybin = hi ? b1 : b0;
    int last0 = 0, last1 = 0;
    constexpr int IDX_CAP = 384;
    volatile LAS unsigned* uflag = (volatile LAS unsigned*)(lds + MISC_OFF + 96);
    if ((b0 >= 0 && c0 > IDX_CAP) || (b1 >= 0 && c1 > IDX_CAP)) { if (lane == 0) *uflag = 1u; }
    LDS_WAIT(); __builtin_amdgcn_s_barrier(); asm volatile("" ::: "memory");
    const bool use_list = any256 && (*uflag == 0u);
    __builtin_amdgcn_s_barrier(); asm volatile("" ::: "memory");
    if (wid == 0 && lane == 0) *uflag = 0u;
    if (use_list) {
        LAS unsigned* rows = hist;
        LAS unsigned long long* lists = (LAS unsigned long long*)((LAS unsigned char*)hist + 4096);
        LAS unsigned* cnt = (LAS unsigned*)((LAS unsigned char*)hist + 4096 + 2 * IDX_CAP * 8);
#pragma unroll
        for (int i = 0; i < 4; ++i) ((LAS v4u*)rows)[i * 64 + lane] = (v4u){0u, 0u, 0u, 0u};
        if (lane < 4) cnt[lane] = 0u;
        LDS_WAIT();
        IDX_PASS({ const bool valid = kt * 32 + r32 <= q; const int bin = (int)(key32 >> 20);
                   const bool defin = valid && (mybin < 0 || bin > mybin); const bool amb = valid && mybin >= 0 && bin == mybin;
                   const unsigned long long bal = __ballot(defin); const unsigned w0_ = (unsigned)bal, w1_ = (unsigned)(bal >> 32);
                   if (w0_) last0 = kt * 32 + 31 - __clz((int)w0_); if (w1_) last1 = kt * 32 + 31 - __clz((int)w1_);
                   if (lane == 0) rows[kt] = w0_; if (lane == 32) rows[512 + kt] = w1_;
                   if (amb) { const unsigned idx = __hip_atomic_fetch_add(cnt + hi, 1u, __ATOMIC_RELAXED, __HIP_MEMORY_SCOPE_WORKGROUP);
                              if (idx < (unsigned)IDX_CAP) lists[hi * IDX_CAP + idx] = ((unsigned long long)key32 << 32) | (unsigned)(kt * 32 + r32); } });
        LDS_WAIT();
#pragma unroll
        for (int j = 0; j < 2; ++j) {
            const int bj = j ? b1 : b0; if (bj < 0) continue;
            const int n = (int)cnt[j] < IDX_CAP ? (int)cnt[j] : IDX_CAP, rsel = 256 - (j ? a1 : a0);
            const LAS unsigned long long* L = lists + j * IDX_CAP;
            for (int i0_ = 0; i0_ < n; i0_ += 64) { const int i = i0_ + lane; const unsigned long long mine = i < n ? L[i] : 0ull; int rank = 0;
                for (int t = 0; t < n; ++t) { const unsigned long long o = L[t];
                    rank += ((unsigned)(o >> 32) > (unsigned)(mine >> 32)) || ((unsigned)(o >> 32) == (unsigned)(mine >> 32) && (unsigned)o < (unsigned)mine) ? 1 : 0; }
                if (i < n && rank < rsel) { const unsigned pos = (unsigned)mine; __hip_atomic_fetch_or(rows + j * 512 + (pos >> 5), 1u << (pos & 31), __ATOMIC_RELAXED, __HIP_MEMORY_SCOPE_WORKGROUP);
                    __hip_atomic_fetch_max(cnt + 2 + j, pos, __ATOMIC_RELAXED, __HIP_MEMORY_SCOPE_WORKGROUP); } }
        }
        LDS_WAIT();
        { const int l0_ = (int)cnt[2], l1_ = (int)cnt[3]; if (l0_ > last0) last0 = l0_; if (l1_ > last1) last1 = l1_; }
#pragma unroll
        for (int i = 0; i < 4; ++i) { const v4u w = ((const LAS v4u*)rows)[i * 64 + lane]; *(GAS v4u*)(MASKB + (size_t)(2 * wu + (i >> 1)) * 512 + (i & 1) * 256 + lane * 4) = w; }
    } else {
        unsigned tau = 0u;
        if (any256) {
            IDX_ZERO();
            IDX_PASS({ if (kt * 32 + r32 <= q && (int)(key32 >> 20) == mybin) { const int bin = (int)((key32 >> 8) & 0xfffu); __hip_atomic_fetch_add(hist + hi * 2048 + hswz(bin >> 1), 1u << ((bin & 1) * 16), __ATOMIC_RELAXED, __HIP_MEMORY_SCOPE_WORKGROUP); } });
            LDS_WAIT();
            int s0 = 0, s1 = 0, t0, t1, u0, u1;
            if (b0 >= 0) find_kth(hist, 256 - a0, lane, s0, t0, u0);
            if (b1 >= 0) find_kth(hist + 2048, 256 - a1, lane, s1, t1, u1);
            const int mysub = hi ? s1 : s0;
            tau = mybin < 0 ? 0u : (((unsigned)mybin << 20) | ((unsigned)(mysub < 0 ? 0 : mysub) << 8));
        }
        IDX_PASS({ const bool sel = (kt * 32 + r32 <= q) && (key32 >= tau); const unsigned long long bal = __ballot(sel);
                   const unsigned w0_ = (unsigned)bal, w1_ = (unsigned)(bal >> 32);
                   if (w0_) last0 = kt * 32 + 31 - __clz((int)w0_); if (w1_) last1 = kt * 32 + 31 - __clz((int)w1_);
                   if (lane == 0) MASKB[(size_t)(2 * wu) * 512 + kt] = w0_;
                   if (lane == 32) MASKB[(size_t)(2 * wu + 1) * 512 + kt] = w1_; });
    }
    if (lane == 0) { const int d0_ = 2 * wu - last0, d1_ = 2 * wu + 1 - last1; atomicMax(NEARBLK + (wu >> 7), (unsigned)(d0_ > d1_ ? d0_ : d1_)); }
#undef IDX_DMA
#undef IDX_SCORE2
#undef IDX_ZERO
#undef IDX_PASS
}
__device__ __forceinline__ void indexer_phase(Frame& F, const bf16* P, unsigned* MASKB, unsigned* NEARBLK) {
    for (int i = 0;; ++i) { const int idx = F.vcu + i * F.G; if (idx >= 1024) break;
        const int seg = idx >> 8, r = idx & 255, unit = (seg & 1) ? (seg * 256 + 255 - r) : (seg * 256 + r);
        indexer_unit(P, MASKB, NEARBLK, F.lds, unit, F.wave, F.lane); }
}
__device__ __forceinline__ void b_norm_bounds(Frame& F, const bf16* P, unsigned* NRM) {
    float mx = 0.f;
    for (int s = F.gw; s < S; s += F.NGW) {
        const v4u* rp = (const v4u*)(P + (size_t)s * EINP + 3072 + 32 * F.lane); float ss = 0.f;
#pragma unroll
        for (int j = 0; j < 4; ++j) { const v4u w = rp[j];
            ss += bflo(w.x) * bflo(w.x) + bfhi(w.x) * bfhi(w.x) + bflo(w.y) * bflo(w.y) + bfhi(w.y) * bfhi(w.y) + bflo(w.z) * bflo(w.z) + bfhi(w.z) * bfhi(w.z) + bflo(w.w) * bflo(w.w) + bfhi(w.w) * bfhi(w.w); }
        ss += __shfl_xor(ss, 1); ss += __shfl_xor(ss, 2); mx = fmaxf(mx, ss); }
    if ((F.lane & 3) == 0) atomicMax(NRM + (F.lane >> 2), __float_as_uint(mx));
}
__device__ __forceinline__ void mixer_b_phase(Frame& F, const bf16* P, const unsigned* MASKB, bf16* O, const unsigned* NRM, const unsigned* NEARBLK, gu32* qctr) {
    const int wid = F.wave, r32 = F.lane & 31, hi = F.lane >> 5;
    for (;;) {
        if (F.tid == 0) F.MISC[16] = __hip_atomic_fetch_add(qctr, 1u, __ATOMIC_RELAXED, __HIP_MEMORY_SCOPE_AGENT);
        __syncthreads(); const int e = (int)F.MISC[16]; __syncthreads();
        if (e >= 512) break;
        const int h = 7 - (e >> 6), qb = 63 - (e & 63);
        fa::UnitP U; U.ldq = U.ldk = U.ldv = (size_t)EINP;
        U.Q = P + (size_t)(qb * 256) * EINP + 3072 + h * 128; U.K = P + 4096 + h * 128; U.V = P + 5120 + h * 128;
        U.q0 = qb * 256; U.kt0 = 0; U.kt1 = (qb + 1) * 4;
        U.sl2 = exp2f(-(float)(h + 1)) * LOG2E; U.c2 = 0.08838834764831845f * LOG2E; U.mask = MASKB + (size_t)(qb * 256) * 512;
        {
            const float B = sqrtf(__uint_as_float(NRM[h]) * __uint_as_float(NRM[8 + h])) * U.c2 * 1.01f;
            const float dmax = (2.f * B + 160.f) / U.sl2 + (float)NEARBLK[qb]; const float kmin = (float)U.q0 - dmax;
            if (kmin > 0.f) U.kt0 = (int)(kmin * (1.f / 64.f)); }
        fa::f32x16 o[4]; float lse2;
        fa::attn_unit4<128, true, true, false>(U, F.lds, o, lse2);
        fa::store_o_bf16(o, O + (size_t)(qb * 256 + wid * 32) * DM + 1024 + h * 128, (size_t)DM, r32, hi);
    }
}
__device__ __forceinline__ void kpe_fill(Frame& F, const bf16* P, bf16* KD) {
    const int i = F.lane & 31, hh = (F.lane >> 5) * 4;
    const float inv = exp2f(-0.41524101186092029f * (float)i);
    for (int s = F.gw; s < S; s += F.NGW) {
        const bf16* kp = P + (size_t)s * OINP + 4352;
        const float x1 = __uint_as_float((unsigned)kp[i] << 16), x2 = __uint_as_float((unsigned)kp[32 + i] << 16);
        const float ang = (float)s * inv; const float n = rintf(ang * 0.15915494309189535f);
        float rr = fmaf(-n, 6.2831854820251465f, ang); rr = fmaf(-n, -1.7484555e-07f, rr); const float fr = rr * 0.15915494309189535f;
        const float sn = __builtin_amdgcn_sinf(fr), cs = __builtin_amdgcn_cosf(fr);
        const bf16 o1 = (bf16)f2bf(x1 * cs - x2 * sn), o2 = (bf16)f2bf(x1 * sn + x2 * cs);
#pragma unroll
        for (int h = 0; h < 4; ++h) { bf16* kd = KD + (size_t)s * 1536 + (hh + h) * 192 + 128; kd[i] = o1; kd[32 + i] = o2; }
    }
}
__device__ __forceinline__ void c_norm_bounds(Frame& F, const bf16* P, unsigned* NRM) {
    float mx = 0.f;
    for (int s = F.gw; s < S; s += F.NGW) {
        const v4u* rp = (const v4u*)(P + (size_t)s * OINP + 32 * F.lane); float ss = 0.f;
#pragma unroll
        for (int j = 0; j < 4; ++j) { const v4u w = rp[j];
            ss += bflo(w.x) * bflo(w.x) + bfhi(w.x) * bfhi(w.x) + bflo(w.y) * bflo(w.y) + bfhi(w.y) * bfhi(w.y) + bflo(w.z) * bflo(w.z) + bfhi(w.z) * bfhi(w.z) + bflo(w.w) * bflo(w.w) + bfhi(w.w) * bfhi(w.w); }
        ss += __shfl_xor(ss, 1); mx = fmaxf(mx, ss); }
    if ((F.lane & 1) == 0) atomicMax(NRM + (F.lane >> 1), __float_as_uint(mx));
}
__device__ __forceinline__ void mixer_c_unit(Frame& F, const bf16* P, float lam, const float* subln_g, float lam_init, float* SCR, bf16* O, const unsigned* NRM, int h, int qb, int ord) {
    const int wid = F.wave, r32 = F.lane & 31, hi = F.lane >> 5;
    {
        int tq_ = F.tid; asm volatile("" : "+v"(tq_));
        f32x4* scr = (f32x4*)(SCR + (((size_t)(ord & 1) * F.G + blockIdx.x) * 512 + tq_) * 64);
        for (int sub = 0; sub < 2; ++sub) {
            fa::UnitP U; U.ldq = U.ldk = U.ldv = (size_t)OINP;
            U.Q = P + (size_t)(qb * 256) * OINP + h * 128 + sub * 64; U.K = P + 1024 + h * 128 + sub * 64; U.V = P + 2048 + h * 128;
            U.q0 = qb * 256; U.kt0 = 0; U.kt1 = (qb + 1) * 4;
            U.sl2 = exp2f(-(float)(h + 1)) * LOG2E; U.c2 = 0.125f * LOG2E; U.mask = nullptr;
            {
                const float B = sqrtf(__uint_as_float(NRM[h * 2 + sub]) * __uint_as_float(NRM[16 + h * 2 + sub])) * U.c2 * 1.01f;
                const float dmax = (2.f * B + 160.f) / U.sl2; const float kmin = (float)U.q0 - dmax;
                if (kmin > 0.f) U.kt0 = (int)(kmin * (1.f / 64.f)); }
            fa::f32x16 o[4]; float lse2;
            fa::attn_unit4<64, true, false, false>(U, F.lds, o, lse2);
            if (sub == 0) {
#pragma unroll
                for (int d = 0; d < 4; ++d)
#pragma unroll
                    for (int k = 0; k < 4; ++k) scr[d * 4 + k] = (f32x4){o[d][4 * k], o[d][4 * k + 1], o[d][4 * k + 2], o[d][4 * k + 3]};
            } else {
                float ss[16]; const int lo_ = fa::lane_opaque();
#pragma unroll
                for (int r = 0; r < 16; ++r) ss[r] = 0.f;
#pragma unroll
                for (int d = 0; d < 4; ++d)
#pragma unroll
                    for (int k = 0; k < 4; ++k) { const f32x4 s1 = scr[d * 4 + k];
#pragma unroll
                        for (int e2 = 0; e2 < 4; ++e2) { const int r = 4 * k + e2; const float v = s1[e2] - lam * o[d][r]; o[d][r] = v; ss[r] += v * v; } }
#pragma unroll
                for (int r = 0; r < 16; ++r) { float t = ss[r]; t += fa::shx(t, 1, lo_); t += fa::shx(t, 2, lo_); t += fa::shx(t, 4, lo_); t += fa::shx(t, 8, lo_); t += fa::shx(t, 16, lo_);
                    ss[r] = (1.0f - lam_init) / sqrtf(t * (1.0f / 128.0f) + DIFF_EPS); }
#pragma unroll
                for (int d = 0; d < 4; ++d) { const float gcol = subln_g[d * 32 + r32];
#pragma unroll
                    for (int r = 0; r < 16; ++r) o[d][r] *= ss[r] * gcol; }
                fa::store_o_bf16(o, O + (size_t)(qb * 256 + wid * 32) * DM + h * 128, (size_t)DM, r32, hi);
            }
        }
    }
}
__device__ __forceinline__ void mixer_d_unit(Frame& F, const bf16* QF, const bf16* KD, const bf16* VD, bf16* O, int h, int qb) {
    const int wid = F.wave, r32 = F.lane & 31, hi = F.lane >> 5;
    {
        fa::UnitP U; U.ldq = 1536; U.ldk = 1536; U.ldv = 1024;
        U.Q = QF + (size_t)(qb * 256) * 1536 + h * 192; U.K = KD + h * 192; U.V = VD + h * 128;
        U.q0 = qb * 256; U.kt0 = 0; U.kt1 = (qb + 1) * 4;
        U.sl2 = 0.f; U.c2 = 0.07216878364870322f * LOG2E; U.mask = nullptr;
        fa::f32x16 o[4]; float lse2;
        fa::attn_unit4<192, false, false, true>(U, F.lds, o, lse2);
        fa::store_o_bf16(o, O + (size_t)(qb * 256 + wid * 32) * DM + 1024 + h * 128, (size_t)DM, r32, hi);
    }
}
__device__ __forceinline__ void mixer_cd_phase(Frame& F, const bf16* P, const float* lam_p, const float* subln_g, float lam_init, float* SCR, const unsigned* NRM,
                                               const bf16* QF, const bf16* KD, const bf16* VD, bf16* O, gu32* qctr) {
    const float lam = expf(wave_sum(lam_p[F.lane] * lam_p[64 + F.lane])) - expf(wave_sum(lam_p[128 + F.lane] * lam_p[192 + F.lane])) + lam_init;
    int ord = 0;
    for (;;) {
        if (F.tid == 0) F.MISC[16] = __hip_atomic_fetch_add(qctr, 1u, __ATOMIC_RELAXED, __HIP_MEMORY_SCOPE_AGENT);
        __syncthreads(); const int e = (int)F.MISC[16]; __syncthreads();
        if (e >= 1024) break;
        const int idx = e >> 1;
        if ((e & 1) == 0) { mixer_c_unit(F, P, lam, subln_g, lam_init, SCR, O, NRM, 7 - (idx >> 6), 63 - (idx & 63), ord); ++ord; }
        else mixer_d_unit(F, QF, KD, VD, O, idx & 7, 63 - (idx >> 3));
    }
}
struct Args { const float* in[16]; float* out; unsigned char* ws; };
#define GRID_BAR() do { xcd_barrier(bar); int t_ = threadIdx.x; asm volatile("" : "+v"(t_)); F.tid = t_; F.lane = t_ & 63; } while (0)

#define FFN_PHASES(WF)                                                                                                           \
    {   pg8::Gemm g{X, (const bf16*)(WF), S, NGU, DM, DM}; pg8::StaticOrder So; So.init(S, NGU, F.G, (int)blockIdx.x);            \
        pg8::EpiSwiglu E{H, DFF};                                                                                                 \
        pg8::gemm_phase<pg8::EpiSwiglu, pg8::StaticOrder, true, true>(F.lds + RING_OFF, g, So, E); }                              \
    GRID_BAR();                                                                                                                   \
    {   pg8::Gemm g{H, (const bf16*)((WF) + WF_DOWN_OFF), S, DM, DFF, DFF}; pg8::StaticOrder So; So.init(S, DM, F.G, (int)blockIdx.x); \
        pg8::EpiResid E{X, Y, DM, ALPHA, 0.5f};                                                                                   \
        pg8::gemm_phase<pg8::EpiResid, pg8::StaticOrder, true, true>(F.lds + RING_OFF, g, So, E); }                               \
    GRID_BAR();

__global__ void __launch_bounds__(NWAVES * 64, 2) fwd_kernel(Args args) {
    extern __shared__ __attribute__((aligned(16))) unsigned char lds[];
    Frame F;
    F.lds = (LAS unsigned char*)lds;
    F.MISC = (volatile LAS unsigned*)(F.lds + MISC_OFF);
    F.tid = threadIdx.x; F.lane = F.tid & 63; F.wave = __builtin_amdgcn_readfirstlane(F.tid >> 6);
    F.G = gridDim.x; { const int bx = blockIdx.x; F.vcu = (F.G % 8 == 0) ? (bx % 8) * (F.G / 8) + bx / 8 : bx; }
    F.gw = F.vcu * NWAVES + F.wave; F.NGW = F.G * NWAVES;
    unsigned char* ws = args.ws;
    F.ctl = (gu32*)(ws + WS_CTL);
    for (int u = F.tid; u < (LDS_BYTES - LDSCTL_OFF) / 4; u += NWAVES * 64) ((LAS unsigned*)(F.lds + LDSCTL_OFF))[u] = 0u;
    __syncthreads();
    XcdBarrier bar = xcd_barrier_post((unsigned*)(F.ctl + CW_BAR), F.MISC + 8);

    const float* x_in = args.in[0];
    const float* w_gate = args.in[1]; const float* w_up = args.in[2]; const float* w_down = args.in[3];
    const float* ln_g = args.in[4]; const float* ln_b = args.in[5];
    bf16* X = (bf16*)(ws + WS_X); bf16* Y = (bf16*)(ws + WS_YB); bf16* H = (bf16*)(ws + WS_HP);
    bf16* P = (bf16*)(ws + WS_HP); bf16* O = (bf16*)(ws + WS_O);
    bf16* OA = (bf16*)(ws + WS_Y); unsigned* MASKB = (unsigned*)(ws + WS_Y + 96 * MiB); float* LSE = (float*)(ws + WS_LSE);
    bf16* QF = (bf16*)(ws + WS_Y); bf16* KD = (bf16*)(ws + WS_Y + 48 * MiB); bf16* VD = (bf16*)(ws + WS_Y + 96 * MiB);
    float* SQQ = (float*)(ws + (size_t)CW_SQQ * 4); float* SQKV = (float*)(ws + (size_t)CW_SQKV * 4);
    unsigned char* WFA = ws + WS_WFA; unsigned char* WFB = ws + WS_WFB;
    constexpr size_t GSZ = (size_t)DM * DFF;

    convert_ffn(F, w_gate + 0 * GSZ, w_up + 0 * GSZ, w_down + 0 * GSZ, WFA);
    convert_ffn(F, w_gate + 1 * GSZ, w_up + 1 * GSZ, w_down + 1 * GSZ, WFB);
    convert_weight<0>(F, args.in[6], DM, EIN, EINP, (bf16*)(ws + WS_WEIN), nullptr);
    convert_weight<0>(F, args.in[7], DM, DM, DM, (bf16*)(ws + WS_WEOUT), nullptr);
    convert_weight<0>(F, args.in[8], DM, OIN, OINP, (bf16*)(ws + WS_WOIN), nullptr);
    convert_weight<0>(F, args.in[9], DM, DM, DM, (bf16*)(ws + WS_WOOUT), nullptr);
    convert_weight<0>(F, args.in[14], 768, 1536, 1536, (bf16*)(ws + WS_WUQ), args.in[12]);
    convert_weight<0>(F, args.in[15], 512, 2048, 2048, (bf16*)(ws + WS_WUKV), args.in[13]);
    convert_x(F, x_in, X);
    GRID_BAR();
    FFN_PHASES(WFA)
    ln_phase<false>(F, Y, ln_g + 0 * DM, ln_b + 0 * DM, X, nullptr);
    convert_ffn(F, w_gate + 2 * GSZ, w_up + 2 * GSZ, w_down + 2 * GSZ, WFA);
    GRID_BAR();
    {
        pg8::Gemm g{X, (const bf16*)(ws + WS_WEIN), S, EINP, DM, DM}; pg8::StaticOrder So; So.init(S, EINP, F.G, (int)blockIdx.x);
        pg8::EpiBf16 E{P, EINP, nullptr, 0, 0, nullptr, 0, 0};
        pg8::gemm_phase<pg8::EpiBf16, pg8::StaticOrder, true, true>(F.lds + RING_OFF, g, So, E); }
    GRID_BAR();
    mixer_a_phase(F, P, OA, LSE);
    __syncthreads();
    indexer_phase(F, P, MASKB, (unsigned*)(F.ctl + CW_NEAR));
    b_norm_bounds(F, P, (unsigned*)(F.ctl + CW_NRMB));
    GRID_BAR();
    merge_a(F, OA, LSE, O);
    mixer_b_phase(F, P, MASKB, O, (const unsigned*)(F.ctl + CW_NRMB), (const unsigned*)(F.ctl + CW_NEAR), F.ctl + CW_QB);
    GRID_BAR();
    {
        pg8::Gemm g{O, (const bf16*)(ws + WS_WEOUT), S, DM, DM, DM}; pg8::StaticOrder So; So.init(S, DM, F.G, (int)blockIdx.x);
        pg8::EpiResid E{X, Y, DM, ALPHA, 1.0f};
        pg8::gemm_phase<pg8::EpiResid, pg8::StaticOrder, true, true>(F.lds + RING_OFF, g, So, E); }
    GRID_BAR();
    ln_phase<false>(F, Y, ln_g + 1 * DM, ln_b + 1 * DM, X, nullptr);
    GRID_BAR();
    FFN_PHASES(WFB)
    ln_phase<false>(F, Y, ln_g + 2 * DM, ln_b + 2 * DM, X, nullptr);
    convert_ffn(F, w_gate + 3 * GSZ, w_up + 3 * GSZ, w_down + 3 * GSZ, WFB);
    GRID_BAR();
    FFN_PHASES(WFA)
    ln_phase<false>(F, Y, ln_g + 3 * DM, ln_b + 3 * DM, X, nullptr);
    GRID_BAR();
    {
        pg8::Gemm g{X, (const bf16*)(ws + WS_WOIN), S, OINP, DM, DM}; pg8::StaticOrder So; So.init(S, OINP, F.G, (int)blockIdx.x);
        pg8::EpiBf16 E{P, OINP, SQQ, 12, 15, SQKV, 15, 17};
        pg8::gemm_phase<pg8::EpiBf16, pg8::StaticOrder, true, true>(F.lds + RING_OFF, g, So, E); }
    GRID_BAR();
    {
        pg8::Gemm g{P + 3072, (const bf16*)(ws + WS_WUQ), S, 1536, 768, OINP}; pg8::StaticOrder So; So.init(S, 1536, F.G, (int)blockIdx.x);
        pg8::EpiScaleRow E{QF, 1536, SQQ, 1.0f / 768.0f, RMS_EPS};
        pg8::gemm_phase<pg8::EpiScaleRow, pg8::StaticOrder, true, true>(F.lds + RING_OFF, g, So, E); }
    {   pg8::Gemm g{P + 3840, (const bf16*)(ws + WS_WUKV), S, 2048, 512, OINP}; pg8::StaticOrder So; So.init(S, 2048, F.G, (int)blockIdx.x);
        pg8::EpiUkv E{KD, VD, SQKV, 1.0f / 512.0f, RMS_EPS};
        pg8::gemm_phase<pg8::EpiUkv, pg8::StaticOrder, true, true>(F.lds + RING_OFF, g, So, E); }
    kpe_fill(F, P, KD);
    c_norm_bounds(F, P, (unsigned*)(F.ctl + CW_NRM));
    GRID_BAR();
    mixer_cd_phase(F, P, args.in[10], args.in[11], 0.35550906759096874f, (float*)(ws + WS_HP + 160 * MiB), (const unsigned*)(F.ctl + CW_NRM), QF, KD, VD, O, F.ctl + CW_QCD);
    GRID_BAR();
    {
        pg8::Gemm g{O, (const bf16*)(ws + WS_WOOUT), S, DM, DM, DM}; pg8::StaticOrder So; So.init(S, DM, F.G, (int)blockIdx.x);
        pg8::EpiResid E{X, Y, DM, ALPHA, 1.0f};
        pg8::gemm_phase<pg8::EpiResid, pg8::StaticOrder, true, true>(F.lds + RING_OFF, g, So, E); }
    GRID_BAR();
    ln_phase<false>(F, Y, ln_g + 4 * DM, ln_b + 4 * DM, X, nullptr);
    GRID_BAR();
    FFN_PHASES(WFB)
    ln_phase<true>(F, Y, ln_g + 5 * DM, ln_b + 5 * DM, nullptr, args.out);
}

extern "C" void kernel_launch(void* const* d_in, const int* in_sizes, int n_in, void* d_out, int out_size, void* d_ws, size_t ws_size, hipStream_t stream) {
    static int grid = 0;
    if (grid == 0) {
        if (n_in != 16 || in_sizes[0] != S * DM || out_size != S * DM || ws_size < WS_END) { fprintf(stderr, "kernel_launch: unexpected shapes (n_in %d, in0 %d, out %d, ws %zu < %zu)\n", n_in, n_in > 0 ? in_sizes[0] : -1, out_size, ws_size, (size_t)WS_END); grid = -1; return; }
        int dev = 0, cus = 0, per_cu = 0;
        if (hipGetDevice(&dev) != hipSuccess || hipDeviceGetAttribute(&cus, hipDeviceAttributeMultiprocessorCount, dev) != hipSuccess) { grid = -1; return; }
        if (hipFuncSetAttribute((const void*)fwd_kernel, hipFuncAttributeMaxDynamicSharedMemorySize, LDS_BYTES) != hipSuccess) { fprintf(stderr, "kernel_launch: hipFuncSetAttribute failed\n"); grid = -1; return; }
        if (hipOccupancyMaxActiveBlocksPerMultiprocessor(&per_cu, (const void*)fwd_kernel, NWAVES * 64, LDS_BYTES) != hipSuccess || per_cu < 1)
            fprintf(stderr, "kernel_launch: occupancy query reports %d workgroups per CU\n", per_cu);
        (void)hipGetLastError();
        grid = cus;
    }
    if (grid < 0) return;
    if (hipMemsetAsync((char*)d_ws + WS_CTL, 0, CTL_ZERO_BYTES, stream) != hipSuccess) return;
    Args a{};
    for (int i = 0; i < 16; ++i) a.in[i] = (const float*)d_in[i];
    a.out = (float*)d_out; a.ws = (unsigned char*)d_ws;
    hipLaunchKernelGGL(fwd_kernel, dim3(grid), dim3(NWAVES * 64), LDS_BYTES, stream, a);
}
```

```cpp
#include <hip/hip_runtime.h>
#include <cstdio>
#include <cstdint>
#include <cmath>
namespace pg8 {
#define PG8_LAS __attribute__((address_space(3)))
typedef unsigned short bf16_t;
typedef short bf16x8 __attribute__((ext_vector_type(8)));
typedef float f32x4 __attribute__((ext_vector_type(4)));
typedef unsigned u32x4 __attribute__((ext_vector_type(4)));
constexpr int BM = 256, BK = 64, HALF = 128, HTB = HALF * BK * 2  , STAGE_BYTES = 8 * HTB, NXCD = 8, WGM = 8;

__host__ __device__ __forceinline__ int lds_byte(int r, int c) { const int st = (r >> 4) * 2 + (c >> 5), rr = r & 15, cc = c & 31, ob = rr * 64 + cc * 2; return st * 1024 + (ob ^ (((ob >> 9) & 1) << 5)); }
__host__ __device__ __forceinline__ void stage_rc(int b, int& R, int& C) { const int st = b / 1024, sb = b % 1024, swz = sb ^ (((sb >> 9) & 1) << 5); R = (st >> 1) * 16 + swz / 64; C = (st & 1) * 32 + (swz % 64) / 2; }
__host__ __device__ __forceinline__ int perm32(int rho) { const int n = rho >> 4, i = rho & 15; return 8 * (i >> 2) + 4 * n + (i & 3); }

struct Unit { int pm, pn; };
struct Gemm { const bf16_t* A; const bf16_t* Bt; int M, N, K, lda; };

struct StaticOrder {
    int nM, nN, nwg, G, c;
    __host__ __device__ void init(int M, int N, int G_, int c_) { nM = M / BM; nN = N / BM; nwg = nM * nN; G = G_; c = c_; }
    __host__ __device__ bool next(int i, Unit& u) const {
        const long L = (long)i * G + c; if (L >= nwg) return false;
        int wgid = (int)L; { const int q = nwg / NXCD, r = nwg % NXCD, xcd = wgid % NXCD, off = wgid / NXCD; wgid = (xcd < r ? xcd * (q + 1) : r * (q + 1) + (xcd - r) * q) + off; }
        const int nig = WGM * nN, gid = wgid / nig, fm = gid * WGM, gsz = (nM - fm) < WGM ? (nM - fm) : WGM;
        u.pm = fm + ((wgid % nig) % gsz); u.pn = (wgid % nig) / gsz; return true;
    }
    __device__ __forceinline__ void a_ready(const Unit&) const {}
    __device__ __forceinline__ void done(const Unit&) const {}
};
__device__ __forceinline__ unsigned cvt_pk_bf16(float lo, float hi) { unsigned r; asm volatile("v_cvt_pk_bf16_f32 %0, %1, %2" : "=v"(r) : "v"(lo), "v"(hi)); return r; }
__device__ __forceinline__ float bf_lo(unsigned w) { return __uint_as_float(w << 16); }
__device__ __forceinline__ float bf_hi(unsigned w) { return __uint_as_float(w & 0xffff0000u); }
typedef unsigned u32x2 __attribute__((ext_vector_type(2)));
__device__ __forceinline__ float silu_f(float x) { return x * __builtin_amdgcn_rcpf(1.0f + __builtin_amdgcn_exp2f(-1.4426950408889634f * x)); }

struct EpiSwiglu {
    static constexpr bool PERM = true, AFTER_DRAIN = false;
    bf16_t* H; int ldh;
    __device__ __forceinline__ void operator()(const f32x4 (&acc)[2][2][4][2], const Unit& u, int wr, int wc, int fr, int fq) const {
        const int row0 = u.pm * BM + wr * 64 + fr, col0 = u.pn * HALF + wc * 32 + 8 * fq;
#pragma unroll
        for (int ai = 0; ai < 2; ++ai)
#pragma unroll
            for (int m = 0; m < 4; ++m) {
                const f32x4 g0 = acc[ai][0][m][0], g1 = acc[ai][0][m][1], u0 = acc[ai][1][m][0], u1 = acc[ai][1][m][1];
                u32x4 w;
                w.x = cvt_pk_bf16(silu_f(g0[0]) * u0[0], silu_f(g0[1]) * u0[1]); w.y = cvt_pk_bf16(silu_f(g0[2]) * u0[2], silu_f(g0[3]) * u0[3]);
                w.z = cvt_pk_bf16(silu_f(g1[0]) * u1[0], silu_f(g1[1]) * u1[1]); w.w = cvt_pk_bf16(silu_f(g1[2]) * u1[2], silu_f(g1[3]) * u1[3]);
                *(u32x4*)(H + (size_t)(row0 + ai * HALF + m * 16) * ldh + col0) = w;
            }
    }
};
struct EpiResid {
    static constexpr bool PERM = true, AFTER_DRAIN = false;
    const bf16_t* X; bf16_t* Y; int ldc; float alpha, w;
    __device__ __forceinline__ void operator()(const f32x4 (&acc)[2][2][4][2], const Unit& u, int wr, int wc, int fr, int fq) const {
        const int row0 = u.pm * BM + wr * 64 + fr, col0 = u.pn * BM + wc * 32 + 8 * fq;
#pragma unroll
        for (int ai = 0; ai < 2; ++ai)
#pragma unroll
            for (int m = 0; m < 4; ++m) { const size_t ro = (size_t)(row0 + ai * HALF + m * 16) * ldc + col0;
#pragma unroll
                for (int bj = 0; bj < 2; ++bj) { const size_t off = ro + bj * HALF; const u32x4 xw = *(const u32x4*)(X + off); const f32x4 a0 = acc[ai][bj][m][0], a1 = acc[ai][bj][m][1];
                    u32x4 y;
                    y.x = cvt_pk_bf16(alpha * bf_lo(xw.x) + w * a0[0], alpha * bf_hi(xw.x) + w * a0[1]); y.y = cvt_pk_bf16(alpha * bf_lo(xw.y) + w * a0[2], alpha * bf_hi(xw.y) + w * a0[3]);
                    y.z = cvt_pk_bf16(alpha * bf_lo(xw.z) + w * a1[0], alpha * bf_hi(xw.z) + w * a1[1]); y.w = cvt_pk_bf16(alpha * bf_lo(xw.w) + w * a1[2], alpha * bf_hi(xw.w) + w * a1[3]);
                    *(u32x4*)(Y + off) = y; } }
    }
};
struct EpiBf16 {
    static constexpr bool PERM = true, AFTER_DRAIN = false;
    bf16_t* O; int ldc; float* sqA; int a_lo, a_hi; float* sqB; int b_lo, b_hi;
    __device__ __forceinline__ void operator()(const f32x4 (&acc)[2][2][4][2], const Unit& u, int wr, int wc, int fr, int fq) const {
        const int row0 = u.pm * BM + wr * 64 + fr, col0 = u.pn * BM + wc * 32 + 8 * fq;
        float* sq = (u.pn >= a_lo && u.pn < a_hi) ? sqA : ((u.pn >= b_lo && u.pn < b_hi) ? sqB : nullptr);
#pragma unroll
        for (int ai = 0; ai < 2; ++ai)
#pragma unroll
            for (int m = 0; m < 4; ++m) { bf16_t* rowp = O + (size_t)(row0 + ai * HALF + m * 16) * ldc + col0; float ss = 0.f;
#pragma unroll
                for (int bj = 0; bj < 2; ++bj) { const f32x4 v0 = acc[ai][bj][m][0], v1 = acc[ai][bj][m][1];
                    ss += (v0[0] * v0[0] + v0[1] * v0[1]) + (v0[2] * v0[2] + v0[3] * v0[3]) + (v1[0] * v1[0] + v1[1] * v1[1]) + (v1[2] * v1[2] + v1[3] * v1[3]);
                    u32x4 w; w.x = cvt_pk_bf16(v0[0], v0[1]); w.y = cvt_pk_bf16(v0[2], v0[3]); w.z = cvt_pk_bf16(v1[0], v1[1]); w.w = cvt_pk_bf16(v1[2], v1[3]);
                    *(u32x4*)(rowp + bj * HALF) = w; }
                if (sq) { ss += __shfl_xor(ss, 16); ss += __shfl_xor(ss, 32); if (fq == 0) atomicAdd(sq + row0 + ai * HALF + m * 16, ss); }
            }
    }
};
struct EpiScaleRow {
    static constexpr bool PERM = true, AFTER_DRAIN = false;
    bf16_t* O; int ldc; const float* sq; float invn, eps;
    __device__ __forceinline__ void operator()(const f32x4 (&acc)[2][2][4][2], const Unit& u, int wr, int wc, int fr, int fq) const {
        const int row0 = u.pm * BM + wr * 64 + fr, col0 = u.pn * BM + wc * 32 + 8 * fq;
#pragma unroll
        for (int ai = 0; ai < 2; ++ai)
#pragma unroll
            for (int m = 0; m < 4; ++m) { const int row = row0 + ai * HALF + m * 16; const float rs = 1.0f / sqrtf(sq[row] * invn + eps); bf16_t* rowp = O + (size_t)row * ldc + col0;
#pragma unroll
                for (int bj = 0; bj < 2; ++bj) { const f32x4 v0 = acc[ai][bj][m][0] * rs, v1 = acc[ai][bj][m][1] * rs;
                    u32x4 w; w.x = cvt_pk_bf16(v0[0], v0[1]); w.y = cvt_pk_bf16(v0[2], v0[3]); w.z = cvt_pk_bf16(v1[0], v1[1]); w.w = cvt_pk_bf16(v1[2], v1[3]);
                    *(u32x4*)(rowp + bj * HALF) = w; } }
    }
};
struct EpiUkv {
    static constexpr bool PERM = true, AFTER_DRAIN = false;
    bf16_t* KD; bf16_t* VD; const float* sq; float invn, eps;
    __device__ __forceinline__ void operator()(const f32x4 (&acc)[2][2][4][2], const Unit& u, int wr, int wc, int fr, int fq) const {
        const int row0 = u.pm * BM + wr * 64 + fr, cc = wc * 32 + 8 * fq;
#pragma unroll
        for (int ai = 0; ai < 2; ++ai)
#pragma unroll
            for (int m = 0; m < 4; ++m) { const int row = row0 + ai * HALF + m * 16; const float rs = 1.0f / sqrtf(sq[row] * invn + eps);
#pragma unroll
                for (int bj = 0; bj < 2; ++bj) { const f32x4 v0 = acc[ai][bj][m][0] * rs, v1 = acc[ai][bj][m][1] * rs;
                    u32x4 w; w.x = cvt_pk_bf16(v0[0], v0[1]); w.y = cvt_pk_bf16(v0[2], v0[3]); w.z = cvt_pk_bf16(v1[0], v1[1]); w.w = cvt_pk_bf16(v1[2], v1[3]);
                    bf16_t* dst = bj == 0 ? KD + (size_t)row * 1536 + u.pn * 192 + cc : VD + (size_t)row * 1024 + u.pn * 128 + cc;
                    *(u32x4*)dst = w; } }
    }
};
template <class Epi, class Sched, bool ALIGN_EPI = false, bool SP2 = false>
__device__ __forceinline__ void gemm_phase(PG8_LAS unsigned char* lds, const Gemm g, const Sched& S, const Epi& E) {
    int tid_o_ = threadIdx.x; asm volatile("" : "+v"(tid_o_)); const int tid = tid_o_, wid = __builtin_amdgcn_readfirstlane(tid >> 6), lane = tid & 63, wr = wid >> 2, wc = wid & 3, fr = lane & 15, fq = lane >> 4;
    const int K = g.K, nt = K / BK;
    unsigned voffA[2], voffB[2];
#pragma unroll
    for (int i = 0; i < 2; ++i) { int R, C; stage_rc(tid * 16 + i * 8192, R, C); const int Rb = Epi::PERM ? ((R & ~31) + perm32(R & 31)) : R;
        voffA[i] = (unsigned)(R * g.lda + C) * 2u; voffB[i] = (unsigned)(Rb * K + C) * 2u; }
    const size_t kstep = (size_t)(BK * 2);
    const size_t hstepB = (size_t)HALF * K * 2, hstepA = (size_t)HALF * g.lda * 2;
    const size_t tstepA = 2 * hstepA, tstepB = 2 * hstepB;
    const unsigned ldsw = (unsigned)wid * 1024u;
    const int aoff = lds_byte(wr * 64 + fr, fq * 8), boff = lds_byte(wc * 32 + fr, fq * 8);
#define PG8_SA(b, h) (((b) * 2 + (h)) * HTB)
#define PG8_SB(b, h) ((4 + (b) * 2 + (h)) * HTB)
#define PG8_STAGE(bufoff, gbase, voff) do { _Pragma("unroll") for (int _i = 0; _i < 2; ++_i) \
        __builtin_amdgcn_global_load_lds((const unsigned*)((const char*)(gbase) + (voff)[_i]), (PG8_LAS unsigned*)(lds + (bufoff) + ldsw + _i * 8192), 16, 0, 0); } while (0)
#define PG8_LDA(dst, b, h) do { _Pragma("unroll") for (int m = 0; m < 4; ++m) _Pragma("unroll") for (int k = 0; k < 2; ++k) dst[m][k] = *(const PG8_LAS bf16x8*)(lds + PG8_SA(b, h) + aoff + m * 2048 + k * 1024); } while (0)
#define PG8_LDB(dst, b, h) do { _Pragma("unroll") for (int n = 0; n < 2; ++n) _Pragma("unroll") for (int k = 0; k < 2; ++k) dst[n][k] = *(const PG8_LAS bf16x8*)(lds + PG8_SB(b, h) + boff + n * 2048 + k * 1024); } while (0)
#define PG8_MMA(ai, bj, At, Bt) do { __builtin_amdgcn_s_setprio(1); _Pragma("unroll") for (int m = 0; m < 4; ++m) _Pragma("unroll") for (int n = 0; n < 2; ++n) _Pragma("unroll") for (int k = 0; k < 2; ++k) \
        acc[ai][bj][m][n] = __builtin_amdgcn_mfma_f32_16x16x32_bf16(Bt[n][k], At[m][k], acc[ai][bj][m][n], 0, 0, 0); __builtin_amdgcn_s_setprio(0); } while (0)
#define PG8_WAIT_V(n) asm volatile("s_waitcnt vmcnt(" #n ")" ::: "memory")
#define PG8_WAIT_L(n) asm volatile("s_waitcnt lgkmcnt(" #n ")" ::: "memory")
#define PG8_BAR __builtin_amdgcn_s_barrier()
#define PG8_SCHED __builtin_amdgcn_sched_barrier(0)
    Unit cur, nxt; int ui = 0;
    if (!S.next(0, cur)) return;
    f32x4 acc[2][2][4][2];
#pragma unroll
    for (int a = 0; a < 2; ++a)
#pragma unroll
        for (int b = 0; b < 2; ++b)
#pragma unroll
            for (int m = 0; m < 4; ++m)
#pragma unroll
                for (int n = 0; n < 2; ++n) acc[a][b][m][n] = (f32x4){0.f, 0.f, 0.f, 0.f};
    bf16x8 At[4][2], B0[2][2], B1[2][2];
    const char* cA = (const char*)g.A + (size_t)cur.pm * tstepA; const char* cB = (const char*)g.Bt + (size_t)cur.pn * tstepB;
    S.a_ready(cur);
    if constexpr (SP2) {
        PG8_STAGE(PG8_SB(0, 0), cB, voffB); PG8_STAGE(PG8_SB(0, 1), cB + hstepB, voffB); PG8_STAGE(PG8_SA(0, 0), cA, voffA); PG8_STAGE(PG8_SA(0, 1), cA + hstepA, voffA);
        if (wr == 1) PG8_BAR;
        PG8_WAIT_V(2); PG8_BAR;
        PG8_STAGE(PG8_SB(1, 0), cB + kstep, voffB); PG8_STAGE(PG8_SA(1, 0), cA + kstep, voffA); PG8_STAGE(PG8_SB(1, 1), cB + hstepB + kstep, voffB);
        PG8_WAIT_V(6); PG8_BAR;
    } else {
        PG8_STAGE(PG8_SB(0, 0), cB, voffB); PG8_STAGE(PG8_SA(0, 0), cA, voffA); PG8_STAGE(PG8_SB(0, 1), cB + hstepB, voffB); PG8_STAGE(PG8_SA(0, 1), cA + hstepA, voffA);
        if (wr == 1) PG8_BAR;
        PG8_WAIT_V(4); PG8_BAR;
        PG8_STAGE(PG8_SB(1, 0), cB + kstep, voffB); PG8_STAGE(PG8_SA(1, 0), cA + kstep, voffA); PG8_STAGE(PG8_SB(1, 1), cB + hstepB + kstep, voffB);
        PG8_WAIT_V(6); PG8_BAR;
    }
    for (;;) {
        const bool has_next = S.next(ui + 1, nxt);
        const char* nA = has_next ? (const char*)g.A + (size_t)nxt.pm * tstepA : cA; const char* nB = has_next ? (const char*)g.Bt + (size_t)nxt.pn * tstepB : cB;
        for (int t = 0; t < nt; t += 2) {
            const bool last = (t == nt - 2);
            const char* a1 = cA + (size_t)(t + 1) * kstep;
            const char* a2 = last ? nA : cA + (size_t)(t + 2) * kstep; const char* b2 = last ? nB : cB + (size_t)(t + 2) * kstep;
            const char* a3 = a2 + kstep; const char* b3 = b2 + kstep;
            if (last && has_next) S.a_ready(nxt);
            if constexpr (SP2) {
            PG8_LDB(B0, 0, 0); PG8_LDB(B1, 0, 1); PG8_SCHED; PG8_LDA(At, 0, 0); PG8_STAGE(PG8_SA(1, 1), a1 + hstepA, voffA);
            PG8_WAIT_V(8); PG8_WAIT_L(0); PG8_BAR; PG8_MMA(0, 0, At, B0); PG8_MMA(0, 1, At, B1); PG8_BAR; PG8_SCHED;
            PG8_LDA(At, 0, 1); PG8_STAGE(PG8_SB(0, 0), b2, voffB); PG8_STAGE(PG8_SB(0, 1), b2 + hstepB, voffB); PG8_STAGE(PG8_SA(0, 0), a2, voffA);
            PG8_WAIT_V(8); PG8_WAIT_L(0); PG8_BAR; PG8_MMA(1, 0, At, B0); PG8_MMA(1, 1, At, B1); PG8_BAR; PG8_SCHED;
            PG8_LDB(B0, 1, 0); PG8_LDB(B1, 1, 1); PG8_SCHED; PG8_LDA(At, 1, 0); PG8_STAGE(PG8_SA(0, 1), a2 + hstepA, voffA);
            PG8_WAIT_V(8); PG8_WAIT_L(0); PG8_BAR; PG8_MMA(0, 0, At, B0); PG8_MMA(0, 1, At, B1); PG8_BAR; PG8_SCHED;
            PG8_LDA(At, 1, 1); PG8_STAGE(PG8_SB(1, 0), b3, voffB); PG8_STAGE(PG8_SB(1, 1), b3 + hstepB, voffB); PG8_STAGE(PG8_SA(1, 0), a3, voffA);
            PG8_WAIT_V(8); PG8_WAIT_L(0); PG8_BAR; PG8_MMA(1, 0, At, B0); PG8_MMA(1, 1, At, B1); PG8_BAR; PG8_SCHED;
            } else {
            PG8_LDB(B0, 0, 0); PG8_SCHED; PG8_LDA(At, 0, 0); PG8_STAGE(PG8_SA(1, 1), a1 + hstepA, voffA);
            PG8_WAIT_L(8); PG8_BAR; PG8_WAIT_L(0); PG8_MMA(0, 0, At, B0); PG8_BAR; PG8_SCHED;
            PG8_LDB(B1, 0, 1); PG8_STAGE(PG8_SB(0, 0), b2, voffB);
            PG8_BAR; PG8_WAIT_L(0); PG8_MMA(0, 1, At, B1); PG8_BAR;
            PG8_LDA(At, 0, 1); PG8_STAGE(PG8_SA(0, 0), a2, voffA);
            PG8_BAR; PG8_WAIT_L(0); PG8_MMA(1, 0, At, B0); PG8_BAR; PG8_SCHED;
            PG8_STAGE(PG8_SB(0, 1), b2 + hstepB, voffB);
            PG8_WAIT_V(6); PG8_BAR; PG8_MMA(1, 1, At, B1); PG8_BAR;
            PG8_LDB(B0, 1, 0); PG8_SCHED; PG8_LDA(At, 1, 0); PG8_STAGE(PG8_SA(0, 1), a2 + hstepA, voffA);
            PG8_WAIT_L(8); PG8_BAR; PG8_WAIT_L(0); PG8_MMA(0, 0, At, B0); PG8_BAR; PG8_SCHED;
            PG8_LDB(B1, 1, 1); PG8_STAGE(PG8_SB(1, 0), b3, voffB);
            PG8_BAR; PG8_WAIT_L(0); PG8_MMA(0, 1, At, B1); PG8_BAR;
            PG8_LDA(At, 1, 1); PG8_STAGE(PG8_SA(1, 0), a3, voffA);
            PG8_BAR; PG8_WAIT_L(0); PG8_MMA(1, 0, At, B0); PG8_BAR; PG8_SCHED;
            PG8_STAGE(PG8_SB(1, 1), b3 + hstepB, voffB);
            PG8_WAIT_V(6); PG8_BAR; PG8_MMA(1, 1, At, B1); PG8_BAR;
            }
        }
        if constexpr (ALIGN_EPI) { if (wr == 0) PG8_BAR; }
        if constexpr (!Epi::AFTER_DRAIN) { E(acc, cur, wr, wc, fr, fq); S.done(cur); }
        if (!has_next) break;
#pragma unroll
        for (int a = 0; a < 2; ++a)
#pragma unroll
            for (int b = 0; b < 2; ++b)
#pragma unroll
                for (int m = 0; m < 4; ++m)
#pragma unroll
                    for (int n = 0; n < 2; ++n) acc[a][b][m][n] = (f32x4){0.f, 0.f, 0.f, 0.f};
        cur = nxt; cA = nA; cB = nB; ++ui;
        if constexpr (ALIGN_EPI) { if (wr == 1) PG8_BAR; }
    }
    PG8_WAIT_V(0);
    if constexpr (!ALIGN_EPI) { if (wr == 0) PG8_BAR; }
    PG8_BAR;
    if constexpr (Epi::AFTER_DRAIN) { E.fused(acc, cur, wr, wc, fr, fq, lds, wid, lane); S.done(cur); }
#undef PG8_SA
#undef PG8_SB
#undef PG8_STAGE
#undef PG8_LDA
#undef PG8_LDB
#undef PG8_MMA
#undef PG8_WAIT_V
#undef PG8_WAIT_L
#undef PG8_BAR
#undef PG8_SCHED
}
}

constexpr int S = 16384, DM = 2048, DFF = 5632, NGU = 2 * DFF;
constexpr int EIN = 7248, EINP = 7424, OIN = 4416, OINP = 4608;
constexpr float ALPHA = 1.4142135623730951f;
constexpr float LN_EPS = 1e-5f, RMS_EPS = 1e-6f, DIFF_EPS = 1e-5f;
constexpr int NWAVES = 8;
constexpr size_t MiB = 1u << 20;
constexpr size_t WS_CTL = 0, CTL_ZERO_BYTES = 1 * MiB;
constexpr size_t WS_LSE = 1 * MiB;
constexpr size_t WS_WFA = 4 * MiB, WS_WFB = 70 * MiB;
constexpr size_t WF_DOWN_OFF = (size_t)NGU * DM * 2;
constexpr size_t WS_WEIN = 136 * MiB, WS_WOIN = 165 * MiB, WS_WEOUT = 183 * MiB, WS_WOOUT = 191 * MiB, WS_WUQ = 199 * MiB, WS_WUKV = 202 * MiB;
constexpr size_t WS_X = 204 * MiB;
constexpr size_t WS_Y = 268 * MiB;
constexpr size_t WS_HP = 396 * MiB;
constexpr size_t WS_O = 628 * MiB;
constexpr size_t WS_YB = 692 * MiB;
constexpr size_t WS_END = 756 * MiB;
constexpr int CW_BAR = 4096;
constexpr int CW_QCD = 2048;
constexpr int CW_QB = 2112;
constexpr int CW_NRMB = 1088;
constexpr int CW_NEAR = 1152;
constexpr int CW_NRM = 1024;
constexpr int CW_SQQ = 65536, CW_SQKV = 65536 + 16384;
constexpr int RING_OFF = 0, RING_BYTES = 131072;
constexpr int KI_RING_OFF = RING_BYTES;
constexpr int LDSCTL_OFF = RING_BYTES + 16384, MISC_OFF = LDSCTL_OFF + 320;
constexpr int LDS_BYTES = 151552;

#define GAS __attribute__((address_space(1)))
#define LAS __attribute__((address_space(3)))
typedef unsigned short bf16;
typedef unsigned v4u __attribute__((ext_vector_type(4)));
typedef unsigned v2u __attribute__((ext_vector_type(2)));
typedef float f32x4 __attribute__((ext_vector_type(4)));
typedef short bf16x8 __attribute__((ext_vector_type(8)));
typedef GAS unsigned gu32;
#define LDS_WAIT() asm volatile("s_waitcnt lgkmcnt(0)" ::: "memory")
#define VM_WAIT() asm volatile("s_waitcnt vmcnt(0)" ::: "memory")
__device__ __forceinline__ unsigned f2bf(float f) { unsigned u = __builtin_bit_cast(unsigned, f); return (u + 0x7fffu + ((u >> 16) & 1u)) >> 16; }
__device__ __forceinline__ unsigned pk2(float lo, float hi) { return f2bf(lo) | (f2bf(hi) << 16); }
__device__ __forceinline__ float bflo(unsigned w) { return __uint_as_float(w << 16); }
__device__ __forceinline__ float bfhi(unsigned w) { return __uint_as_float(w & 0xffff0000u); }
#define XB_TMO      128
#define XB_XCNT(j)  (256  + 64 * (j))
#define XB_XSUB(j)  (1280 + 64 * (j))
#define XB_XGEN(j)  (2304 + 64 * (j))
#define XB_TOP      3328
#define XB_TOPGEN   3392
#define XCD_BAR_WORDS 3456
#define XB_SPIN_CAP (1u << 18)

__device__ __forceinline__ unsigned xb_ld(unsigned* p)              { return __hip_atomic_load(p, __ATOMIC_RELAXED, __HIP_MEMORY_SCOPE_AGENT); }
__device__ __forceinline__ unsigned xb_add(unsigned* p, unsigned v) { return __hip_atomic_fetch_add(p, v, __ATOMIC_RELAXED, __HIP_MEMORY_SCOPE_AGENT); }
__device__ __forceinline__ unsigned xb_xcc_id() { return (unsigned)__builtin_amdgcn_s_getreg((3 << 11) | 20) & 0xFu; }
#define XB_SPIN(cond, bar) do { unsigned _sp = 0; while (cond) { __builtin_amdgcn_s_sleep(1); \
    if ((++_sp & 255u) == 0u) { if (xb_ld(&(bar)[XB_TMO])) break; if (_sp > XB_SPIN_CAP) { atomicAdd(&(bar)[XB_TMO], 1u); break; } } } } while (0)

struct XcdBarrier {
    unsigned* bar; unsigned x;
    volatile LAS unsigned* st;
};

__device__ __forceinline__ XcdBarrier xcd_barrier_post(unsigned* bar, volatile LAS unsigned* st) {
    XcdBarrier b; b.bar = bar; b.x = xb_xcc_id(); b.st = st;
    if (threadIdx.x == 0) (void)xb_add(&bar[XB_XCNT(b.x)], 1u);
    return b;
}
__device__ __forceinline__ void xcd_barrier_complete(unsigned* bar, unsigned x, unsigned& nloc, unsigned& nx) {
    const unsigned G = gridDim.x * gridDim.y * gridDim.z;
    unsigned sum, cnt, mine, sp = 0u;
    for (;;) {
        sum = 0u; cnt = 0u; mine = 0u;
#pragma unroll
        for (unsigned j = 0; j < 16; ++j) { const unsigned c = xb_ld(&bar[XB_XCNT(j)]); sum += c; cnt += (c > 0u) ? 1u : 0u; mine = (j == x) ? c : mine; }
        if (sum == G) break;
        __builtin_amdgcn_s_sleep(1);
        if ((++sp & 255u) == 0u) { if (xb_ld(&bar[XB_TMO])) break; if (sp > XB_SPIN_CAP) { atomicAdd(&bar[XB_TMO], 1u); break; } }
    }
    nloc = mine > 0u ? mine : 1u; nx = cnt > 0u ? cnt : 1u;
}

__device__ __forceinline__ void xcd_barrier(const XcdBarrier& b) {
    asm volatile("s_waitcnt vmcnt(0)" ::: "memory");
    __syncthreads();
    if (threadIdx.x == 0) {
        unsigned* bar = b.bar;
        __builtin_amdgcn_s_waitcnt(0);
        unsigned nloc = b.st[0], nx = b.st[1];
        if (nloc == 0u) { xcd_barrier_complete(bar, b.x, nloc, nx); b.st[0] = nloc; b.st[1] = nx; }
        const unsigned old = xb_add(&bar[XB_XSUB(b.x)], 1u);
        const unsigned gen = old / nloc;
        if (old + 1u == (gen + 1u) * nloc) {
            __builtin_amdgcn_fence(__ATOMIC_RELEASE, "agent");
            asm volatile("s_waitcnt vmcnt(0)" ::: "memory");
            const unsigned og = xb_add(&bar[XB_TOP], 1u);
            const unsigned tg = og / nx;
            if (og + 1u == (tg + 1u) * nx) xb_add(&bar[XB_TOPGEN], 1u);
            else XB_SPIN(xb_ld(&bar[XB_TOPGEN]) == tg, bar);
            __builtin_amdgcn_fence(__ATOMIC_ACQUIRE, "agent");
            xb_add(&bar[XB_XGEN(b.x)], 1u);
            asm volatile("s_waitcnt vmcnt(0)" ::: "memory");
        } else {
            XB_SPIN(xb_ld(&bar[XB_XGEN(b.x)]) == gen, bar);
            __builtin_amdgcn_fence(__ATOMIC_ACQUIRE, "agent");
            asm volatile("s_waitcnt vmcnt(0)" ::: "memory");
        }
    }
    __syncthreads();
}

namespace fa {
typedef short bf16x8 __attribute__((ext_vector_type(8)));
typedef short s16x4 __attribute__((ext_vector_type(4)));
typedef float f32x16 __attribute__((ext_vector_type(16)));
typedef unsigned u32x4 __attribute__((ext_vector_type(4)));
typedef unsigned u32x2 __attribute__((ext_vector_type(2)));
typedef unsigned short bf16;
#define FA_SBAR() __builtin_amdgcn_sched_barrier(0)
__device__ __forceinline__ int lane_opaque() { int l = (int)__builtin_amdgcn_mbcnt_hi(~0u, __builtin_amdgcn_mbcnt_lo(~0u, 0u)); asm volatile("" : "+v"(l)); return l; }
__device__ __forceinline__ float shx(float v, int m, int l) { return __int_as_float(__builtin_amdgcn_ds_bpermute((l ^ m) << 2, __float_as_int(v))); }
__device__ __forceinline__ int crow(int r, int hi) { return (r & 3) + 8 * (r >> 2) + 4 * hi; }
__device__ __forceinline__ unsigned cvtpk(float lo, float hi) { unsigned r; asm volatile("v_cvt_pk_bf16_f32 %0, %1, %2" : "=v"(r) : "v"(lo), "v"(hi)); return r; }
__device__ __forceinline__ int v_st(int k, int c) { const int kk = (k & ~0xC) | ((k & 4) << 1) | ((k & 8) >> 1); return ((kk >> 3) * 4 + (c >> 5)) * 512 + ((kk & 7) * 32 + (c & 31)) * 2; }
__device__ __forceinline__ int v_rd_base(int lane) { return ((lane & 3) << 3) | (((lane >> 2) & 3) << 6) | (((lane >> 4) & 1) << 5) | (((lane >> 5) & 1) << 8); }
constexpr int v_rd_off(int d0, int ks, int half) { return d0 * 512 + ks * 4096 + half * 2048; }
template <int OFF> __device__ __forceinline__ s16x4 tr_read(int vb) { s16x4 r; asm volatile("ds_read_b64_tr_b16 %0, %1 offset:%2" : "=&v"(r) : "v"(vb), "i"(OFF) : "memory"); return r; }
template <int D0> __device__ __forceinline__ void pv_one(f32x16& od, int vb, bf16x8 pa0, bf16x8 pa1, bf16x8 pa2, bf16x8 pa3) {
    const s16x4 l0 = tr_read<v_rd_off(D0, 0, 0)>(vb), h0 = tr_read<v_rd_off(D0, 0, 1)>(vb), l1 = tr_read<v_rd_off(D0, 1, 0)>(vb), h1 = tr_read<v_rd_off(D0, 1, 1)>(vb);
    const s16x4 l2 = tr_read<v_rd_off(D0, 2, 0)>(vb), h2 = tr_read<v_rd_off(D0, 2, 1)>(vb), l3 = tr_read<v_rd_off(D0, 3, 0)>(vb), h3 = tr_read<v_rd_off(D0, 3, 1)>(vb);
    asm volatile("s_waitcnt lgkmcnt(0)" ::: "memory"); FA_SBAR();
#define FA_PK(L, H) (bf16x8){L[0], L[1], L[2], L[3], H[0], H[1], H[2], H[3]}
    od = __builtin_amdgcn_mfma_f32_32x32x16_bf16(pa0, FA_PK(l0, h0), od, 0, 0, 0);
    od = __builtin_amdgcn_mfma_f32_32x32x16_bf16(pa1, FA_PK(l1, h1), od, 0, 0, 0);
    od = __builtin_amdgcn_mfma_f32_32x32x16_bf16(pa2, FA_PK(l2, h2), od, 0, 0, 0);
    od = __builtin_amdgcn_mfma_f32_32x32x16_bf16(pa3, FA_PK(l3, h3), od, 0, 0, 0);
#undef FA_PK
}
__device__ __forceinline__ void pv_d0(f32x16* o, int vb, bf16x8 pa0, bf16x8 pa1, bf16x8 pa2, bf16x8 pa3) {
    pv_one<0>(o[0], vb, pa0, pa1, pa2, pa3); pv_one<1>(o[1], vb, pa0, pa1, pa2, pa3); pv_one<2>(o[2], vb, pa0, pa1, pa2, pa3); pv_one<3>(o[3], vb, pa0, pa1, pa2, pa3);
}
struct VFrag { s16x4 l0, h0, l1, h1, l2, h2, l3, h3; };
template <int D0> __device__ __forceinline__ void pv_rd(VFrag& f, int vb) {
    f.l0 = tr_read<v_rd_off(D0, 0, 0)>(vb); f.h0 = tr_read<v_rd_off(D0, 0, 1)>(vb); f.l1 = tr_read<v_rd_off(D0, 1, 0)>(vb); f.h1 = tr_read<v_rd_off(D0, 1, 1)>(vb);
    f.l2 = tr_read<v_rd_off(D0, 2, 0)>(vb); f.h2 = tr_read<v_rd_off(D0, 2, 1)>(vb); f.l3 = tr_read<v_rd_off(D0, 3, 0)>(vb); f.h3 = tr_read<v_rd_off(D0, 3, 1)>(vb);
}
__device__ __forceinline__ void pv_mm(f32x16& od, const VFrag& f, bf16x8 pa0, bf16x8 pa1, bf16x8 pa2, bf16x8 pa3) {
#define FA_PK(L, H) (bf16x8){L[0], L[1], L[2], L[3], H[0], H[1], H[2], H[3]}
    od = __builtin_amdgcn_mfma_f32_32x32x16_bf16(pa0, FA_PK(f.l0, f.h0), od, 0, 0, 0);
    od = __builtin_amdgcn_mfma_f32_32x32x16_bf16(pa1, FA_PK(f.l1, f.h1), od, 0, 0, 0);
    od = __builtin_amdgcn_mfma_f32_32x32x16_bf16(pa2, FA_PK(f.l2, f.h2), od, 0, 0, 0);
    od = __builtin_amdgcn_mfma_f32_32x32x16_bf16(pa3, FA_PK(f.l3, f.h3), od, 0, 0, 0);
#undef FA_PK
}
__device__ __forceinline__ void pv_pipe(f32x16* o, int vb, bf16x8 pa0, bf16x8 pa1, bf16x8 pa2, bf16x8 pa3) {
    VFrag fa, fb;
    pv_rd<0>(fa, vb); pv_rd<1>(fb, vb);
    asm volatile("s_waitcnt lgkmcnt(8)" ::: "memory"); FA_SBAR(); pv_mm(o[0], fa, pa0, pa1, pa2, pa3); FA_SBAR();
    pv_rd<2>(fa, vb);
    asm volatile("s_waitcnt lgkmcnt(8)" ::: "memory"); FA_SBAR(); pv_mm(o[1], fb, pa0, pa1, pa2, pa3); FA_SBAR();
    pv_rd<3>(fb, vb);
    asm volatile("s_waitcnt lgkmcnt(8)" ::: "memory"); FA_SBAR(); pv_mm(o[2], fa, pa0, pa1, pa2, pa3); FA_SBAR();
    asm volatile("s_waitcnt lgkmcnt(0)" ::: "memory"); FA_SBAR(); pv_mm(o[3], fb, pa0, pa1, pa2, pa3); FA_SBAR();
}
struct UnitP {
    const bf16* Q; size_t ldq;
    const bf16* K; size_t ldk;
    const bf16* V; size_t ldv;
    int q0;
    int kt0, kt1;
    float sl2;
    float c2;
    const unsigned* mask;
};
constexpr int WIN = 128;
constexpr float THR2 = 11.5f;
template <int DQK, bool WINDOW, bool ALIBI, bool MASK, bool ROPEQ>
__device__ __forceinline__ void attn_unit(const UnitP& U, LAS unsigned char* lds, f32x16 (&o)[4], float& lse2) {
    constexpr int KROWB = DQK * 2, SHM_V = 16384, SHM_K = 64 * KROWB, KOFF = 2 * SHM_V, WSOFF = KOFF + 2 * 64 * 192 * 2;
    constexpr int KCH = DQK / 8, KPT = 64 * KCH / 512, ND0 = DQK / 16;
    int tid_o_ = threadIdx.x; asm volatile("" : "+v"(tid_o_)); const int tid = tid_o_, wid = __builtin_amdgcn_readfirstlane(tid >> 6), lane = tid & 63, r32 = lane & 31, hi = lane >> 5;
    LAS float* wsf = (LAS float*)(lds + WSOFF + wid * 256);
    float m_reg = -1e30f, l_reg = 0.f;
#pragma unroll
    for (int d = 0; d < 4; ++d)
#pragma unroll
        for (int r = 0; r < 16; ++r) o[d][r] = 0.f;
    bf16x8 qr[ND0];
    const int qi = U.q0 + wid * 32 + r32;
    {   const bf16* Qw = U.Q + (size_t)(wid * 32 + r32) * U.ldq + hi * 8;
#pragma unroll
        for (int d0 = 0; d0 < ND0; ++d0) qr[d0] = *(const bf16x8*)(Qw + d0 * 16);
        if constexpr (ROPEQ) {
#pragma unroll
            for (int pb = 0; pb < 2; ++pb) { bf16x8 a = qr[ND0 - 4 + pb], b = qr[ND0 - 2 + pb];
#pragma unroll
                for (int e = 0; e < 8; ++e) { const int fi = pb * 16 + hi * 8 + e; const float inv = __builtin_amdgcn_exp2f(-0.41524101186092029f * (float)fi);
                    const float ang = (float)qi * inv; const float n = rintf(ang * 0.15915494309189535f);
                    float rr = fmaf(-n, 6.2831854820251465f, ang); rr = fmaf(-n, -1.7484555e-07f, rr); const float fr = rr * 0.15915494309189535f;
                    const float sn = __builtin_amdgcn_sinf(fr), cs = __builtin_amdgcn_cosf(fr);
                    const float x1 = __uint_as_float((unsigned)(unsigned short)a[e] << 16), x2 = __uint_as_float((unsigned)(unsigned short)b[e] << 16);
                    const unsigned w = cvtpk(x1 * cs - x2 * sn, x1 * sn + x2 * cs); a[e] = (short)(w & 0xffffu); b[e] = (short)(w >> 16); }
                qr[ND0 - 4 + pb] = a; qr[ND0 - 2 + pb] = b; }
        }
    }
    unsigned kgo[KPT], vgo[2];
#pragma unroll
    for (int i_ = 0; i_ < KPT; ++i_) { const int p_ = (wid + 8 * i_) * 1024 + lane * 16, row_ = p_ / KROWB, wi_ = (p_ % KROWB) ^ ((row_ & 7) << 4); kgo[i_] = (unsigned)((size_t)row_ * U.ldk * 2 + wi_); }
#pragma unroll
    for (int i_ = 0; i_ < 2; ++i_) { const int p_ = (wid + 8 * i_) * 1024 + lane * 16, sub_ = p_ >> 9, rem_ = p_ & 511, kk_ = (sub_ >> 2) * 8 + (rem_ >> 6), k_ = (kk_ & ~0xC) | ((kk_ & 4) << 1) | ((kk_ & 8) >> 1), col_ = (sub_ & 3) * 32 + ((rem_ & 63) >> 1);
        vgo[i_] = (unsigned)(((size_t)k_ * U.ldv + col_) * 2); }
#define FA_DMA(k0_, b_) do { const char* kg_ = (const char*)U.K + (size_t)(k0_) * U.ldk * 2; const char* vg_ = (const char*)U.V + (size_t)(k0_) * U.ldv * 2; \
        _Pragma("unroll") for (int i_ = 0; i_ < KPT; ++i_) __builtin_amdgcn_global_load_lds((const unsigned*)(kg_ + kgo[i_]), (LAS unsigned*)(lds + KOFF + (b_) * SHM_K + (wid + 8 * i_) * 1024), 16, 0, 0); \
        _Pragma("unroll") for (int i_ = 0; i_ < 2; ++i_) __builtin_amdgcn_global_load_lds((const unsigned*)(vg_ + vgo[i_]), (LAS unsigned*)(lds + (b_) * SHM_V + (wid + 8 * i_) * 1024), 16, 0, 0); } while (0)
    const int vb0 = (int)(unsigned)(uintptr_t)lds + v_rd_base(lane);
    const int NT = U.kt1 - U.kt0;
    const int qw0 = U.q0 + wid * 32, qw1 = qw0 + 31;
    u32x2 mw = {0u, 0u}, mwn = {0u, 0u};
    const unsigned* mrow = MASK ? U.mask + (size_t)(wid * 32 + r32) * 512 : nullptr;
    FA_DMA(U.kt0 * 64, 0); if constexpr (MASK) mw = *(const u32x2*)(mrow + U.kt0 * 2);
    asm volatile("s_waitcnt vmcnt(0)" ::: "memory"); __syncthreads();
    for (int jt = 0; jt < NT; ++jt) {
        const int k0 = (U.kt0 + jt) * 64, buf = jt & 1;
        const bool more = jt + 1 < NT;
        if (more) { FA_DMA(k0 + 64, buf ^ 1); if constexpr (MASK) mwn = *(const u32x2*)(mrow + (k0 >> 5) + 2); }
        const bool active = (k0 <= qw1) && (!WINDOW || (k0 + 63 >= qw0 - WIN));
        if (active) {
            f32x16 p0, p1;
#pragma unroll
            for (int r = 0; r < 16; ++r) { p0[r] = 0.f; p1[r] = 0.f; }
            const LAS unsigned char* kb = lds + KOFF + buf * SHM_K + r32 * KROWB; const int lp = (hi * 16) ^ ((r32 & 7) << 4);
            const LAS unsigned char* kq[4] = {kb + lp, kb + (lp ^ 32), kb + (lp ^ 64), kb + (lp ^ 96)};
#pragma unroll
            for (int d0 = 0; d0 < ND0; ++d0) {
                const bf16x8 b0 = *(const LAS bf16x8*)(kq[d0 & 3] + (d0 >> 2) * 128), b1 = *(const LAS bf16x8*)(kq[d0 & 3] + (d0 >> 2) * 128 + 32 * KROWB);
                p0 = __builtin_amdgcn_mfma_f32_32x32x16_bf16(b0, qr[d0], p0, 0, 0, 0);
                p1 = __builtin_amdgcn_mfma_f32_32x32x16_bf16(b1, qr[d0], p1, 0, 0, 0);
                if ((d0 & 3) == 3) FA_SBAR(); }
            const int lim = qi - k0 - 4 * hi;
            const float tb = ALIBI ? U.sl2 * (float)(-lim) : 0.f;
#pragma unroll
            for (int r = 0; r < 16; ++r) { const int c = (r & 3) + 8 * (r >> 2);
                if constexpr (ALIBI) { p0[r] = fmaf(p0[r], U.c2, fmaf((float)c, U.sl2, tb)); p1[r] = fmaf(p1[r], U.c2, fmaf((float)(c + 32), U.sl2, tb)); }
                else { p0[r] *= U.c2; p1[r] *= U.c2; } }
            const bool need_mask = (k0 + 63 > qw0) || (WINDOW && (k0 < qw1 - WIN));
            if (need_mask) {
#pragma unroll
                for (int r = 0; r < 16; ++r) { const int c = (r & 3) + 8 * (r >> 2); const int d0_ = lim - c, d1_ = lim - c - 32;
                    const bool ok0 = WINDOW ? ((unsigned)d0_ <= (unsigned)WIN) : (d0_ >= 0), ok1 = WINDOW ? ((unsigned)d1_ <= (unsigned)WIN) : (d1_ >= 0);
                    p0[r] = ok0 ? p0[r] : -INFINITY; p1[r] = ok1 ? p1[r] : -INFINITY; }
            }
            if constexpr (MASK) { const unsigned w0 = mw.x >> (4 * hi), w1 = mw.y >> (4 * hi);
#pragma unroll
                for (int r = 0; r < 16; ++r) { const int c = (r & 3) + 8 * (r >> 2);
                    const unsigned b0 = (unsigned)((int)(w0 << (31 - c)) >> 31), b1 = (unsigned)((int)(w1 << (31 - c)) >> 31);
                    p0[r] = __uint_as_float((__float_as_uint(p0[r]) & b0) | (0xff800000u & ~b0)); p1[r] = __uint_as_float((__float_as_uint(p1[r]) & b1) | (0xff800000u & ~b1)); }
            }
            FA_SBAR();
            float pmax = p0[0];
#pragma unroll
            for (int r = 1; r < 16; ++r) pmax = fmaxf(pmax, p0[r]);
#pragma unroll
            for (int r = 0; r < 16; ++r) pmax = fmaxf(pmax, p1[r]);
            { auto rr = __builtin_amdgcn_permlane32_swap(__float_as_uint(pmax), __float_as_uint(pmax), false, false); pmax = fmaxf(__uint_as_float(rr[0]), __uint_as_float(rr[1])); }
            float mn, alpha;
            if (__builtin_expect(__all(pmax - m_reg <= THR2), 1)) { mn = m_reg; alpha = 1.f; }
            else { mn = fmaxf(m_reg, pmax); alpha = __builtin_amdgcn_exp2f(m_reg - mn); m_reg = mn; }
            float ps = 0.f;
#pragma unroll
            for (int r = 0; r < 16; ++r) { p0[r] = __builtin_amdgcn_exp2f(p0[r] - mn); p1[r] = __builtin_amdgcn_exp2f(p1[r] - mn); ps += p0[r] + p1[r]; }
            { auto rr = __builtin_amdgcn_permlane32_swap(__float_as_uint(ps), __float_as_uint(ps), false, false); ps = __uint_as_float(rr[0]) + __uint_as_float(rr[1]); }
            l_reg = l_reg * alpha + ps;
            FA_SBAR();
            bf16x8 pa0, pa1, pa2, pa3;
#define FA_PK4(P, BASE, OUT) do { unsigned a0 = cvtpk(P[BASE + 0], P[BASE + 1]), a1 = cvtpk(P[BASE + 2], P[BASE + 3]);   \
    unsigned b0 = cvtpk(P[BASE + 4], P[BASE + 5]), b1 = cvtpk(P[BASE + 6], P[BASE + 7]);                              \
    auto r0 = __builtin_amdgcn_permlane32_swap(a0, b0, false, false); auto r1 = __builtin_amdgcn_permlane32_swap(a1, b1, false, false); \
    u32x4 w = {r0[0], r1[0], r0[1], r1[1]}; OUT = *reinterpret_cast<bf16x8*>(&w); } while (0)
            FA_PK4(p0, 0, pa0); FA_PK4(p0, 8, pa1); FA_PK4(p1, 0, pa2); FA_PK4(p1, 8, pa3);
#undef FA_PK4
            FA_SBAR();
            if (__any(alpha < 1.f)) { if (hi == 0) wsf[r32] = alpha; asm volatile("s_waitcnt lgkmcnt(0)" ::: "memory");
#pragma unroll
                for (int r = 0; r < 16; ++r) { const float al = wsf[crow(r, hi)];
#pragma unroll
                    for (int d = 0; d < 4; ++d) o[d][r] *= al; }
                asm volatile("s_waitcnt lgkmcnt(0)" ::: "memory"); }
            pv_d0(o, vb0 + buf * SHM_V, pa0, pa1, pa2, pa3);
        }
        if (more) { if constexpr (MASK) mw = mwn; }
        asm volatile("s_waitcnt vmcnt(0)" ::: "memory");
        __syncthreads();
    }
    if (hi == 0) wsf[32 + r32] = l_reg; asm volatile("s_waitcnt lgkmcnt(0)" ::: "memory");
#pragma unroll
    for (int r = 0; r < 16; ++r) { const float rl = __builtin_amdgcn_rcpf(wsf[32 + crow(r, hi)]);
#pragma unroll
        for (int d = 0; d < 4; ++d) o[d][r] *= rl; }
    asm volatile("s_waitcnt lgkmcnt(0)" ::: "memory");
    lse2 = m_reg + __builtin_amdgcn_logf(l_reg);
#undef FA_DMA
}
template <int DQK, bool ALIBI, bool MASK, bool ROPEQ>
__device__ __forceinline__ void attn_unit4(const UnitP& U, LAS unsigned char* lds, f32x16 (&o)[4], float& lse2) {
    constexpr int KROWB = DQK * 2, SHM_V = 16384, SHM_K = 64 * KROWB, KOFF = 3 * SHM_V, WSOFF = KOFF + 3 * 64 * 192 * 2, AUGOFF = WSOFF + 2048;
    constexpr int KCH = DQK / 8, KPT = 64 * KCH / 512, ND0 = DQK / 16;
#define FA4_SWZ(row_) ((KROWB == 256) ? (((row_) & 15) << 4) : ((((row_) >> 1) & 7) << 4))
    int tid_o_ = threadIdx.x; asm volatile("" : "+v"(tid_o_)); const int tid = tid_o_, wid = __builtin_amdgcn_readfirstlane(tid >> 6), lane = tid & 63, r32 = lane & 31, hi = lane >> 5;
    LAS float* wsf = (LAS float*)(lds + WSOFF + wid * 256);
    float m_reg = -1e30f, l_reg = 0.f;
#pragma unroll
    for (int d = 0; d < 4; ++d)
#pragma unroll
        for (int r = 0; r < 16; ++r) o[d][r] = 0.f;
    bf16x8 qr[ND0];
    const int qi = U.q0 + wid * 32 + r32;
    {   const bf16* Qw = U.Q + (size_t)(wid * 32 + r32) * U.ldq + hi * 8;
#pragma unroll
        for (int d0 = 0; d0 < ND0; ++d0) qr[d0] = *(const bf16x8*)(Qw + d0 * 16);
        if constexpr (ROPEQ) {
#pragma unroll
            for (int pb = 0; pb < 2; ++pb) { bf16x8 a = qr[ND0 - 4 + pb], b = qr[ND0 - 2 + pb];
#pragma unroll
                for (int e = 0; e < 8; ++e) { const int fi = pb * 16 + hi * 8 + e; const float inv = __builtin_amdgcn_exp2f(-0.41524101186092029f * (float)fi);
                    const float ang = (float)qi * inv; const float n = rintf(ang * 0.15915494309189535f);
                    float rr = fmaf(-n, 6.2831854820251465f, ang); rr = fmaf(-n, -1.7484555e-07f, rr); const float fr = rr * 0.15915494309189535f;
                    const float sn = __builtin_amdgcn_sinf(fr), cs = __builtin_amdgcn_cosf(fr);
                    const float x1 = __uint_as_float((unsigned)(unsigned short)a[e] << 16), x2 = __uint_as_float((unsigned)(unsigned short)b[e] << 16);
                    const unsigned w = cvtpk(x1 * cs - x2 * sn, x1 * sn + x2 * cs); a[e] = (short)(w & 0xffffu); b[e] = (short)(w >> 16); }
                qr[ND0 - 4 + pb] = a; qr[ND0 - 2 + pb] = b; }
        }
    }
    bf16x8 qaug = {0, 0, 0, 0, 0, 0, 0, 0};
    if constexpr (ALIBI) { const float g_ = U.sl2 / U.c2; const unsigned gh_ = (__float_as_uint(g_) + 0x7fffu + ((__float_as_uint(g_) >> 16) & 1u)) & 0xffff0000u; const float gl_ = g_ - __uint_as_float(gh_);
        const unsigned glb_ = (__float_as_uint(gl_) + 0x7fffu + ((__float_as_uint(gl_) >> 16) & 1u)) & 0xffff0000u;
        const unsigned w0_ = (__float_as_uint(-128.f * __uint_as_float(gh_)) >> 16) | (__float_as_uint(-__uint_as_float(gh_)) & 0xffff0000u);
        const unsigned w1_ = (__float_as_uint(-128.f * __uint_as_float(glb_)) >> 16) | (__float_as_uint(-__uint_as_float(glb_)) & 0xffff0000u);
        const u32x4 qa_ = {hi ? 0u : w0_, hi ? 0u : w1_, 0u, 0u}; qaug = *reinterpret_cast<const bf16x8*>(&qa_); }
    const LAS unsigned char* augp = lds + AUGOFF + r32 * 32 + hi * 16;
    unsigned kgo[KPT], vgo[2];
#pragma unroll
    for (int i_ = 0; i_ < KPT; ++i_) { const int p_ = (wid + 8 * i_) * 1024 + lane * 16, row_ = p_ / KROWB, wi_ = (p_ % KROWB) ^ FA4_SWZ(row_); kgo[i_] = (unsigned)((size_t)row_ * U.ldk * 2 + wi_); }
#pragma unroll
    for (int i_ = 0; i_ < 2; ++i_) { const int p_ = (wid + 8 * i_) * 1024 + lane * 16, sub_ = p_ >> 9, rem_ = p_ & 511, kk_ = (sub_ >> 2) * 8 + (rem_ >> 6), k_ = (kk_ & ~0xC) | ((kk_ & 4) << 1) | ((kk_ & 8) >> 1), col_ = (sub_ & 3) * 32 + ((rem_ & 63) >> 1);
        vgo[i_] = (unsigned)(((size_t)k_ * U.ldv + col_) * 2); }
#define FA3_DMA(k0_, kb_, vb_) do { const char* kg_ = (const char*)U.K + (size_t)(k0_) * U.ldk * 2; const char* vg_ = (const char*)U.V + (size_t)(k0_) * U.ldv * 2; \
        _Pragma("unroll") for (int i_ = 0; i_ < KPT; ++i_) __builtin_amdgcn_global_load_lds((const unsigned*)(kg_ + kgo[i_]), (LAS unsigned*)(lds + KOFF + (kb_) * SHM_K + (wid + 8 * i_) * 1024), 16, 0, 0); \
        _Pragma("unroll") for (int i_ = 0; i_ < 2; ++i_) __builtin_amdgcn_global_load_lds((const unsigned*)(vg_ + vgo[i_]), (LAS unsigned*)(lds + (vb_) * SHM_V + (wid + 8 * i_) * 1024), 16, 0, 0); \
        if constexpr (ALIBI) { if (tid < 128) { const int rel_ = U.q0 + 255 - ((k0_) + (tid >> 1)); const unsigned ab_ = (__float_as_uint((float)(rel_ >> 7)) >> 16) | (__float_as_uint((float)(rel_ & 127)) & 0xffff0000u); \
            const unsigned z_ = (tid & 1) ? 0u : ab_; *(LAS u32x4*)(lds + AUGOFF + (kb_) * 2048 + tid * 16) = (u32x4){z_, z_, 0u, 0u}; } } } while (0)
    const int vb0 = (int)(unsigned)(uintptr_t)lds + v_rd_base(lane);
    const int NT = U.kt1 - U.kt0;
    const int qw0 = U.q0 + wid * 32, qw1 = qw0 + 31;
    const int swz_ = FA4_SWZ(r32); const int lp = (hi * 16) ^ (swz_ & 0x70); const int hsw = (KROWB == 256) ? (swz_ & 0x80) : 0;
    const LAS unsigned char* kbase = lds + KOFF + r32 * KROWB;
    const LAS unsigned char* kq0 = kbase + lp; const LAS unsigned char* kq1 = kbase + (lp ^ 32); const LAS unsigned char* kq2 = kbase + (lp ^ 64); const LAS unsigned char* kq3 = kbase + (lp ^ 96);
    bf16x8 pa0, pa1, pa2, pa3;
#define FA3_PK4(P, BASE, OUT) do { unsigned a0 = cvtpk(P[BASE + 0], P[BASE + 1]), a1 = cvtpk(P[BASE + 2], P[BASE + 3]);   \
    unsigned b0 = cvtpk(P[BASE + 4], P[BASE + 5]), b1 = cvtpk(P[BASE + 6], P[BASE + 7]);                              \
    auto r0 = __builtin_amdgcn_permlane32_swap(a0, b0, false, false); auto r1 = __builtin_amdgcn_permlane32_swap(a1, b1, false, false); \
    u32x4 w = {r0[0], r1[0], r0[1], r1[1]}; OUT = *reinterpret_cast<bf16x8*>(&w); } while (0)
#define FA3_SCORE(kb_, k0_, MW) do { f32x16 p0, p1; _Pragma("unroll") for (int r = 0; r < 16; ++r) { p0[r] = 0.f; p1[r] = 0.f; } const int so_ = (kb_) * SHM_K; \
          \
        bf16x8 kfa_[ND0], kfb_[ND0]; bf16x8 a0_ = qaug, a1_ = qaug; \
        _Pragma("unroll") for (int d0 = 0; d0 < ND0 + 2; ++d0) { \
            if (d0 < ND0) { const LAS unsigned char* kp_ = ((d0 & 3) == 0 ? kq0 : (d0 & 3) == 1 ? kq1 : (d0 & 3) == 2 ? kq2 : kq3) + so_ + ((KROWB == 256) ? (((d0 >> 2) * 128) ^ hsw) : (d0 >> 2) * 128); \
                kfa_[d0] = *(const LAS bf16x8*)(kp_); kfb_[d0] = *(const LAS bf16x8*)(kp_ + 32 * KROWB); } \
            if constexpr (ALIBI) { if (d0 == ND0) { a0_ = *(const LAS bf16x8*)(augp + (kb_) * 2048); a1_ = *(const LAS bf16x8*)(augp + (kb_) * 2048 + 1024); } } \
            FA_SBAR(); \
            if (d0 >= 2) { p0 = __builtin_amdgcn_mfma_f32_32x32x16_bf16(kfa_[d0 - 2], qr[d0 - 2], p0, 0, 0, 0); p1 = __builtin_amdgcn_mfma_f32_32x32x16_bf16(kfb_[d0 - 2], qr[d0 - 2], p1, 0, 0, 0); } \
            FA_SBAR(); } \
        if constexpr (ALIBI) { p0 = __builtin_amdgcn_mfma_f32_32x32x16_bf16(a0_, qaug, p0, 0, 0, 0); p1 = __builtin_amdgcn_mfma_f32_32x32x16_bf16(a1_, qaug, p1, 0, 0, 0); } \
        const int lim_ = qi - (k0_) - 4 * hi; \
        if ((k0_) + 63 > qw0) { _Pragma("unroll") for (int r = 0; r < 16; ++r) { const int c = (r & 3) + 8 * (r >> 2); p0[r] = (lim_ - c >= 0) ? p0[r] : -INFINITY; p1[r] = (lim_ - c - 32 >= 0) ? p1[r] : -INFINITY; } } \
        if constexpr (MASK) { const unsigned w0_ = MW.x >> (4 * hi), w1_ = MW.y >> (4 * hi); \
            _Pragma("unroll") for (int r = 0; r < 16; ++r) { const int c = (r & 3) + 8 * (r >> 2); \
                const unsigned b0_ = (unsigned)((int)(w0_ << (31 - c)) >> 31), b1_ = (unsigned)((int)(w1_ << (31 - c)) >> 31); \
                p0[r] = __uint_as_float((__float_as_uint(p0[r]) & b0_) | (0xff800000u & ~b0_)); p1[r] = __uint_as_float((__float_as_uint(p1[r]) & b1_) | (0xff800000u & ~b1_)); } } \
        FA_SBAR(); \
        float pmax_ = p0[0]; \
        _Pragma("unroll") for (int r = 1; r < 16; ++r) pmax_ = fmaxf(pmax_, p0[r]); \
        _Pragma("unroll") for (int r = 0; r < 16; ++r) pmax_ = fmaxf(pmax_, p1[r]); \
        { auto rr = __builtin_amdgcn_permlane32_swap(__float_as_uint(pmax_), __float_as_uint(pmax_), false, false); pmax_ = fmaxf(__uint_as_float(rr[0]), __uint_as_float(rr[1])); } \
        pmax_ *= U.c2; float mn_, alpha_; \
        if (__builtin_expect(__all(pmax_ - m_reg <= THR2), 1)) { mn_ = m_reg; alpha_ = 1.f; } \
        else { mn_ = fmaxf(m_reg, pmax_); alpha_ = __builtin_amdgcn_exp2f(m_reg - mn_); m_reg = mn_; } \
        float ps_ = 0.f; \
        _Pragma("unroll") for (int r = 0; r < 16; ++r) { p0[r] = __builtin_amdgcn_exp2f(fmaf(p0[r], U.c2, -mn_)); p1[r] = __builtin_amdgcn_exp2f(fmaf(p1[r], U.c2, -mn_)); ps_ += p0[r] + p1[r]; } \
        { auto rr = __builtin_amdgcn_permlane32_swap(__float_as_uint(ps_), __float_as_uint(ps_), false, false); ps_ = __uint_as_float(rr[0]) + __uint_as_float(rr[1]); } \
        l_reg = l_reg * alpha_ + ps_; \
        FA_SBAR(); \
        FA3_PK4(p0, 0, pa0); FA3_PK4(p0, 8, pa1); FA3_PK4(p1, 0, pa2); FA3_PK4(p1, 8, pa3); \
        FA_SBAR(); \
        if (__any(alpha_ < 1.f)) { if (hi == 0) wsf[r32] = alpha_; asm volatile("s_waitcnt lgkmcnt(0)" ::: "memory"); \
            _Pragma("unroll") for (int r = 0; r < 16; ++r) { const float al = wsf[crow(r, hi)]; _Pragma("unroll") for (int d = 0; d < 4; ++d) o[d][r] *= al; } \
            asm volatile("s_waitcnt lgkmcnt(0)" ::: "memory"); } } while (0)
    u32x2 mw = {0u, 0u}, mwn = {0u, 0u};
    const unsigned* mrow = MASK ? U.mask + (size_t)(wid * 32 + r32) * 512 : nullptr;
    FA3_DMA(U.kt0 * 64, 0, 0); if constexpr (MASK) mw = *(const u32x2*)(mrow + U.kt0 * 2);
    if (NT > 1) FA3_DMA(U.kt0 * 64 + 64, 1, 1);
    asm volatile("s_waitcnt vmcnt(0)" ::: "memory"); __syncthreads();
    int sl = 0;
#pragma nounroll
    for (int jt = 0; jt < NT; ++jt) {
        const int k0 = (U.kt0 + jt) * 64; const int s2 = sl == 0 ? 2 : sl - 1;
        if constexpr (MASK) { if (jt + 1 < NT) mwn = *(const u32x2*)(mrow + (k0 >> 5) + 2); }
        const bool more2 = jt + 2 < NT;
        if (more2) FA3_DMA(k0 + 128, s2, s2);
        if (k0 <= qw1) { FA3_SCORE(sl, k0, mw); pv_pipe(o, vb0 + sl * SHM_V, pa0, pa1, pa2, pa3); }
        if constexpr (MASK) mw = mwn;
        sl = sl == 2 ? 0 : sl + 1;
        if (more2) asm volatile("s_waitcnt vmcnt(%0)" :: "n"(KPT + 2) : "memory");
        else asm volatile("s_waitcnt vmcnt(0)" ::: "memory");
        __syncthreads();
    }
    if (hi == 0) wsf[32 + r32] = l_reg; asm volatile("s_waitcnt lgkmcnt(0)" ::: "memory");
#pragma unroll
    for (int r = 0; r < 16; ++r) { const float rl = __builtin_amdgcn_rcpf(wsf[32 + crow(r, hi)]);
#pragma unroll
        for (int d = 0; d < 4; ++d) o[d][r] *= rl; }
    asm volatile("s_waitcnt lgkmcnt(0)" ::: "memory");
    lse2 = m_reg + __builtin_amdgcn_logf(l_reg);
#undef FA3_DMA
#undef FA4_SWZ
#undef FA3_PK4
#undef FA3_SCORE
}
__device__ __forceinline__ void store_o_bf16(const f32x16 (&o)[4], bf16* outw, size_t ldo, int r32, int hi) {
    asm volatile("" : "+v"(r32), "+v"(hi));
    const bool odd = r32 & 1; const int lo_ = lane_opaque();
#pragma unroll
    for (int d0 = 0; d0 < 4; ++d0)
#pragma unroll
        for (int rp = 0; rp < 8; ++rp) { const int r0 = 2 * rp, r1 = 2 * rp + 1;
            float e0_ = o[d0][r0], e1_ = o[d0][r1]; asm("" : "+v"(e0_), "+v"(e1_));
            const float send = odd ? e0_ : e1_; const float recv = shx(send, 1, lo_);
            const unsigned w = odd ? cvtpk(recv, e1_) : cvtpk(e0_, recv);
            const int row = crow(odd ? r1 : r0, hi), col = d0 * 32 + (r32 & ~1);
            *(unsigned*)(outw + (size_t)row * ldo + col) = w; }
}
}
struct Frame {
    LAS unsigned char* lds;
    volatile LAS unsigned* MISC;
    gu32* ctl;
    int tid, lane, wave;
    int vcu, G, gw, NGW;
};
__device__ __forceinline__ float wave_sum(float v) {
    int l = (int)__builtin_amdgcn_mbcnt_hi(~0u, __builtin_amdgcn_mbcnt_lo(~0u, 0u)); asm volatile("" : "+v"(l));
#pragma unroll
    for (int o = 1; o < 64; o <<= 1) v += __int_as_float(__builtin_amdgcn_ds_bpermute((l ^ o) << 2, __float_as_int(v)));
    return v;
}
template <int MODE>
__device__ __forceinline__ void transpose_item(const float* W, int K, int N, int nblk, bf16* WT, const float* kscale, LAS float* scr, int item, int lane) {
    const int kb = item / nblk, nb = item % nblk, k0 = 64 * kb, n0 = 32 * nb;
    const int c4 = 4 * (lane & 7), nl = n0 + c4; const bool inb = nl < N;
    f32x4 v[8];
#pragma unroll
    for (int i = 0; i < 8; ++i) { const int kk = 8 * i + (lane >> 3); v[i] = inb ? *(const GAS f32x4*)(W + (size_t)(k0 + kk) * N + nl) : (f32x4){0.f, 0.f, 0.f, 0.f}; }
#pragma unroll
    for (int i = 0; i < 8; ++i) { const int kk = 8 * i + (lane >> 3); f32x4 x = v[i]; if (kscale) x = x * kscale[k0 + kk];
        LAS float* d = scr + kk * 33 + c4; d[0] = x[0]; d[1] = x[1]; d[2] = x[2]; d[3] = x[3]; }
    LDS_WAIT(); asm volatile("" ::: "memory");
    const int c = lane & 7;
#pragma unroll
    for (int j = 0; j < 4; ++j) { const int n = (lane >> 3) + 8 * j; const LAS float* s = scr + (8 * c) * 33 + n;
        v4u o; o.x = pk2(s[0 * 33], s[1 * 33]); o.y = pk2(s[2 * 33], s[3 * 33]); o.z = pk2(s[4 * 33], s[5 * 33]); o.w = pk2(s[6 * 33], s[7 * 33]);
        const int ng = n0 + n; const int drow = MODE == 0 ? ng : ((ng >> 7) * 256 + (ng & 127) + (MODE == 2 ? 128 : 0));
        *(GAS v4u*)(WT + (size_t)drow * K + k0 + 8 * c) = o; }
    LDS_WAIT(); asm volatile("" ::: "memory");
}
template <int MODE>
__device__ __forceinline__ void convert_weight(Frame& F, const float* W, int K, int N, int Npad, bf16* WT, const float* kscale) {
    LAS float* scr = (LAS float*)(F.lds + RING_OFF + F.wave * 16384);
    const int nblk = Npad / 32, nitems = (K / 64) * nblk;
    for (int it = F.gw; it < nitems; it += F.NGW) transpose_item<MODE>(W, K, N, nblk, WT, kscale, scr, it, F.lane);
}
__device__ __forceinline__ void convert_ffn(Frame& F, const float* wg, const float* wu, const float* wd, unsigned char* dst) {
    convert_weight<1>(F, wg, DM, DFF, DFF, (bf16*)dst, nullptr);
    convert_weight<2>(F, wu, DM, DFF, DFF, (bf16*)dst, nullptr);
    convert_weight<0>(F, wd, DFF, DM, DM, (bf16*)(dst + WF_DOWN_OFF), nullptr);
}
__device__ __forceinline__ void convert_x(Frame& F, const float* x, bf16* X) {
    const size_t n8 = (size_t)S * DM / 8;
    for (size_t i = (size_t)F.gw * 64 + F.lane; i < n8; i += (size_t)F.NGW * 64) {
        const f32x4 a = *(const GAS f32x4*)(x + i * 8), b = *(const GAS f32x4*)(x + i * 8 + 4);
        v4u o; o.x = pk2(a[0], a[1]); o.y = pk2(a[2], a[3]); o.z = pk2(b[0], b[1]); o.w = pk2(b[2], b[3]);
        *(GAS v4u*)(X + i * 8) = o; }
}
__device__ __forceinline__ void scale_x(Frame& F, const bf16* X, float* Y) {
    const size_t n8 = (size_t)S * DM / 8;
    for (size_t i = (size_t)F.gw * 64 + F.lane; i < n8; i += (size_t)F.NGW * 64) {
        const v4u w = *(const GAS v4u*)(X + i * 8);
        f32x4 a = {ALPHA * bflo(w.x), ALPHA * bfhi(w.x), ALPHA * bflo(w.y), ALPHA * bfhi(w.y)}, b = {ALPHA * bflo(w.z), ALPHA * bfhi(w.z), ALPHA * bflo(w.w), ALPHA * bfhi(w.w)};
        *(GAS f32x4*)(Y + i * 8) = a; *(GAS f32x4*)(Y + i * 8 + 4) = b; }
}
template <bool FINAL>
__device__ __forceinline__ void ln_phase(Frame& F, const bf16* Y, const float* g, const float* b, bf16* X, float* out) {
    for (int row = F.gw; row < S; row += F.NGW) {
        const GAS v4u* yr = (const GAS v4u*)(Y + (size_t)row * DM) + F.lane;
        float v[4][8]; float s = 0.f;
#pragma unroll
        for (int j = 0; j < 4; ++j) { const v4u w = yr[64 * j]; v[j][0] = bflo(w.x); v[j][1] = bfhi(w.x); v[j][2] = bflo(w.y); v[j][3] = bfhi(w.y); v[j][4] = bflo(w.z); v[j][5] = bfhi(w.z); v[j][6] = bflo(w.w); v[j][7] = bfhi(w.w);
#pragma unroll
            for (int e = 0; e < 8; ++e) s += v[j][e]; }
        const float mean = wave_sum(s) * (1.f / DM); float s2 = 0.f;
#pragma unroll
        for (int j = 0; j < 4; ++j)
#pragma unroll
            for (int e = 0; e < 8; ++e) { v[j][e] -= mean; s2 += v[j][e] * v[j][e]; }
        const float rstd = 1.f / sqrtf(wave_sum(s2) * (1.f / DM) + LN_EPS);
#pragma unroll
        for (int j = 0; j < 4; ++j) { const int c0 = 8 * (64 * j + F.lane);
            const f32x4 g0 = *(const GAS f32x4*)(g + c0), g1 = *(const GAS f32x4*)(g + c0 + 4), b0 = *(const GAS f32x4*)(b + c0), b1 = *(const GAS f32x4*)(b + c0 + 4);
            f32x4 o0, o1;
#pragma unroll
            for (int e = 0; e < 4; ++e) { o0[e] = v[j][e] * rstd * g0[e] + b0[e]; o1[e] = v[j][4 + e] * rstd * g1[e] + b1[e]; }
            if (FINAL) { *(GAS f32x4*)(out + (size_t)row * DM + c0) = o0; *(GAS f32x4*)(out + (size_t)row * DM + c0 + 4) = o1; }
            else { v4u w; w.x = pk2(o0[0], o0[1]); w.y = pk2(o0[2], o0[3]); w.z = pk2(o1[0], o1[1]); w.w = pk2(o1[2], o1[3]); *(GAS v4u*)(X + (size_t)row * DM + c0) = w; } }
    }
}
constexpr float LOG2E = 1.4426950408889634f;
__device__ __forceinline__ void mixer_a_phase(Frame& F, const bf16* P, bf16* OA, float* LSE) {
    const int wid = F.wave, r32 = F.lane & 31, hi = F.lane >> 5;
    for (int u = F.vcu; u < 1536; u += F.G) {
        const int g = u >> 9, rem = u & 511, h = rem >> 6, j = rem & 63;
        const int dsh = 2 * g, d = 1 << dsh, c = j >> (6 - dsh), blk = j & ((64 >> dsh) - 1), I0 = blk * 256;
        fa::UnitP U; U.ldq = U.ldk = U.ldv = (size_t)d * EINP;
        const bf16* base = P + (size_t)c * EINP + h * 128;
        U.Q = base + (size_t)I0 * U.ldq; U.K = base + 1024; U.V = base + 2048;
        U.q0 = I0; U.kt0 = I0 ? (I0 >> 6) - 2 : 0; U.kt1 = (I0 >> 6) + 4;
        U.sl2 = exp2f(-(float)(h + 1)) * (float)d * LOG2E; U.c2 = 0.08838834764831845f * LOG2E; U.mask = nullptr;
        fa::f32x16 o[4]; float lse2;
        fa::attn_unit<128, true, true, false, false>(U, F.lds, o, lse2);
        const int row0 = I0 + wid * 32;
        fa::store_o_bf16(o, OA + (size_t)g * S * 1024 + ((size_t)row0 * d + c) * 1024 + h * 128, (size_t)d * 1024, r32, hi);
        if (hi == 0) LSE[((size_t)g * S + (size_t)(row0 + r32) * d + c) * 8 + h] = lse2;
    }
}
__device__ __forceinline__ void merge_a(Frame& F, const bf16* OA, const float* LSE, bf16* O) {
    const int h = F.lane >> 3;
    for (int pos = F.gw; pos < S; pos += F.NGW) {
        const float l0 = LSE[((size_t)0 * S + pos) * 8 + h], l1 = LSE[((size_t)1 * S + pos) * 8 + h], l2 = LSE[((size_t)2 * S + pos) * 8 + h];
        const float mx = fmaxf(l0, fmaxf(l1, l2)); float w0 = exp2f(l0 - mx), w1 = exp2f(l1 - mx), w2 = exp2f(l2 - mx); const float inv = 1.f / (w0 + w1 + w2); w0 *= inv; w1 *= inv; w2 *= inv;
#pragma unroll
        for (int hf = 0; hf < 2; ++hf) { const size_t off = (size_t)pos * 1024 + 16 * F.lane + 8 * hf;
            const v4u a = *(const GAS v4u*)(OA + off), b = *(const GAS v4u*)(OA + (size_t)S * 1024 + off), c = *(const GAS v4u*)(OA + (size_t)2 * S * 1024 + off);
            v4u o;
            o.x = pk2(w0 * bflo(a.x) + w1 * bflo(b.x) + w2 * bflo(c.x), w0 * bfhi(a.x) + w1 * bfhi(b.x) + w2 * bfhi(c.x));
            o.y = pk2(w0 * bflo(a.y) + w1 * bflo(b.y) + w2 * bflo(c.y), w0 * bfhi(a.y) + w1 * bfhi(b.y) + w2 * bfhi(c.y));
            o.z = pk2(w0 * bflo(a.z) + w1 * bflo(b.z) + w2 * bflo(c.z), w0 * bfhi(a.z) + w1 * bfhi(b.z) + w2 * bfhi(c.z));
            o.w = pk2(w0 * bflo(a.w) + w1 * bflo(b.w) + w2 * bflo(c.w), w0 * bfhi(a.w) + w1 * bfhi(b.w) + w2 * bfhi(c.w));
            *(GAS v4u*)(O + (size_t)pos * DM + 16 * F.lane + 8 * hf) = o; }
    }
}
typedef float f32x16 __attribute__((ext_vector_type(16)));
__device__ __forceinline__ unsigned okey(float f) { const unsigned u = __float_as_uint(f); return (u & 0x80000000u) ? ~u : (u | 0x80000000u); }
__device__ __forceinline__ int hswz(int w) { return (w & ~31) | ((w ^ (w >> 5)) & 31); }
__device__ __forceinline__ void find_kth(const LAS unsigned* hq, int target, int lane, int& bin, int& above, int& binc) {
    unsigned w[32]; unsigned cl = 0;
#pragma unroll
    for (int i = 0; i < 32; ++i) { w[i] = hq[32 * lane + ((i ^ lane) & 31)]; cl += (w[i] & 0xffffu) + (w[i] >> 16); }
    unsigned suf = cl;
#pragma unroll
    for (int off = 1; off < 64; off <<= 1) { const unsigned t = __shfl_down(suf, off); if (lane + off < 64) suf += t; }
    const unsigned long long bal = __ballot((int)suf >= target);
    if (bal == 0ull) { bin = -1; above = 0; binc = 0; return; }
    const int L = 63 - __clzll((long long)bal);
    int cum = (int)(suf - cl), fb = -1, fab = 0, fc = 0;
#pragma unroll
    for (int i = 31; i >= 0; --i) { const int h16 = (int)(w[i] >> 16), l16 = (int)(w[i] & 0xffffu);
        if (fb < 0) { if (cum + h16 >= target) { fb = 2 * i + 1; fab = cum; fc = h16; } else { cum += h16; if (cum + l16 >= target) { fb = 2 * i; fab = cum; fc = l16; } else cum += l16; } } }
    bin = __shfl(fb, L) + 64 * L; above = __shfl(fab, L); binc = __shfl(fc, L);
}
__device__ __forceinline__ void indexer_unit(const bf16* P, unsigned* MASKB, unsigned* NEARBLK, LAS unsigned char* lds, int unit, int wid, int lane) {
    const int r32 = lane & 31, hi = lane >> 5, wu = unit * 8 + wid, q = 2 * wu + hi;
    LAS unsigned* hist = (LAS unsigned*)(lds + RING_OFF + wid * 16384);
    LAS unsigned char* ring = lds + KI_RING_OFF;
    bf16x8 af[4];
    {   const int jq = (r32 >> 2) & 1, head = (r32 & 3) + 4 * (r32 >> 3);
        const bf16* qrow = P + (size_t)(2 * wu + jq) * EINP + 6144 + head * 64 + hi * 8;
#pragma unroll
        for (int ks = 0; ks < 4; ++ks) af[ks] = *(const bf16x8*)(qrow + ks * 16); }
    float wq[16];
    {   const v4u a = *(const GAS v4u*)(P + (size_t)q * EINP + 7232), b = *(const GAS v4u*)(P + (size_t)q * EINP + 7240);
        wq[0] = bflo(a.x); wq[1] = bfhi(a.x); wq[2] = bflo(a.y); wq[3] = bfhi(a.y); wq[4] = bflo(a.z); wq[5] = bfhi(a.z); wq[6] = bflo(a.w); wq[7] = bfhi(a.w);
        wq[8] = bflo(b.x); wq[9] = bfhi(b.x); wq[10] = bflo(b.y); wq[11] = bfhi(b.y); wq[12] = bflo(b.z); wq[13] = bfhi(b.z); wq[14] = bflo(b.w); wq[15] = bfhi(b.w);
#pragma unroll
        for (int r = 0; r < 16; ++r) wq[r] *= 0.03125f; }
    const int NS = (16 * unit + 16 + 63) >> 6;
    const bool any256 = 16 * unit + 15 >= 255;
    const int prow = wid * 8 + (lane >> 3);
    const char* kgsrc = (const char*)(P + 7168) + (size_t)prow * EINP * 2 + (((lane & 7) * 16) ^ ((prow & 7) << 4));
    const int lp = (hi * 16) ^ ((r32 & 7) << 4);
    const int fo0 = r32 * 128 + lp, fo1 = r32 * 128 + (lp ^ 32), fo2 = r32 * 128 + (lp ^ 64), fo3 = r32 * 128 + (lp ^ 96);
#define IDX_DMA(s_) __builtin_amdgcn_global_load_lds((const unsigned*)(kgsrc + (size_t)(s_) * 64 * EINP * 2), (LAS unsigned*)(ring + ((s_) & 1) * 8192 + wid * 1024), 16, 0, 0)
#define IDX_SCORE2(slot_, keyA_, keyB_) do { const LAS unsigned char* fb_ = ring + (slot_) * 8192; \
        const bf16x8 b00_ = *(const LAS bf16x8*)(fb_ + fo0), b10_ = *(const LAS bf16x8*)(fb_ + 4096 + fo0), b01_ = *(const LAS bf16x8*)(fb_ + fo1), b11_ = *(const LAS bf16x8*)(fb_ + 4096 + fo1); \
        const bf16x8 b02_ = *(const LAS bf16x8*)(fb_ + fo2), b12_ = *(const LAS bf16x8*)(fb_ + 4096 + fo2), b03_ = *(const LAS bf16x8*)(fb_ + fo3), b13_ = *(const LAS bf16x8*)(fb_ + 4096 + fo3); \
        __builtin_amdgcn_sched_barrier(0); \
        f32x16 a0_, a1_; _Pragma("unroll") for (int r = 0; r < 16; ++r) { a0_[r] = 0.f; a1_[r] = 0.f; } \
        a0_ = __builtin_amdgcn_mfma_f32_32x32x16_bf16(af[0], b00_, a0_, 0, 0, 0); a1_ = __builtin_amdgcn_mfma_f32_32x32x16_bf16(af[0], b10_, a1_, 0, 0, 0); \
        a0_ = __builtin_amdgcn_mfma_f32_32x32x16_bf16(af[1], b01_, a0_, 0, 0, 0); a1_ = __builtin_amdgcn_mfma_f32_32x32x16_bf16(af[1], b11_, a1_, 0, 0, 0); \
        a0_ = __builtin_amdgcn_mfma_f32_32x32x16_bf16(af[2], b02_, a0_, 0, 0, 0); a1_ = __builtin_amdgcn_mfma_f32_32x32x16_bf16(af[2], b12_, a1_, 0, 0, 0); \
        a0_ = __builtin_amdgcn_mfma_f32_32x32x16_bf16(af[3], b03_, a0_, 0, 0, 0); a1_ = __builtin_amdgcn_mfma_f32_32x32x16_bf16(af[3], b13_, a1_, 0, 0, 0); \
        __builtin_amdgcn_sched_barrier(0); \
        float s0a_ = 0.f, s0b_ = 0.f, s1a_ = 0.f, s1b_ = 0.f, t0a_ = 0.f, t0b_ = 0.f, t1a_ = 0.f, t1b_ = 0.f; \
        _Pragma("unroll") for (int r = 0; r < 16; r += 2) { s0a_ = fmaf(wq[r], a0_[r], s0a_); s0b_ = fmaf(wq[r + 1], a0_[r + 1], s0b_); s1a_ = fmaf(wq[r], a1_[r], s1a_); s1b_ = fmaf(wq[r + 1], a1_[r + 1], s1b_); \
            t0a_ = fmaf(wq[r], __builtin_fabsf(a0_[r]), t0a_); t0b_ = fmaf(wq[r + 1], __builtin_fabsf(a0_[r + 1]), t0b_); t1a_ = fmaf(wq[r], __builtin_fabsf(a1_[r]), t1a_); t1b_ = fmaf(wq[r + 1], __builtin_fabsf(a1_[r + 1]), t1b_); \
            asm("" : "+v"(t0a_), "+v"(t0b_), "+v"(t1a_), "+v"(t1b_)); }   \
        keyA_ = okey((s0a_ + s0b_) + (t0a_ + t0b_)); keyB_ = okey((s1a_ + s1b_) + (t1a_ + t1b_)); } while (0)
#define IDX_ZERO() do { _Pragma("unroll") for (int i = 0; i < 16; ++i) ((LAS v4u*)hist)[i * 64 + lane] = (v4u){0u, 0u, 0u, 0u}; LDS_WAIT(); } while (0)
#define IDX_PASS(...) do { IDX_DMA(0); \
        for (int s_ = 0; s_ < NS; ++s_) { asm volatile("s_waitcnt vmcnt(0)" ::: "memory"); __builtin_amdgcn_s_barrier(); asm volatile("" ::: "memory"); \
            if (s_ + 1 < NS) IDX_DMA(s_ + 1); \
            unsigned keyA_, keyB_; IDX_SCORE2(s_ & 1, keyA_, keyB_); \
            { const int kt = 2 * s_; const unsigned key32 = keyA_; __VA_ARGS__ } { const int kt = 2 * s_ + 1; const unsigned key32 = keyB_; __VA_ARGS__ } } \
        __builtin_amdgcn_s_barrier(); } while (0)
    IDX_ZERO();
    IDX_PASS({ if (kt * 32 + r32 <= q) { const int bin = (int)(key32 >> 20); __hip_atomic_fetch_add(hist + hi * 2048 + hswz(bin >> 1), 1u << ((bin & 1) * 16), __ATOMIC_RELAXED, __HIP_MEMORY_SCOPE_WORKGROUP); } });
    LDS_WAIT();
    int b0, a0, c0, b1, a1, c1; find_kth(hist, 256, lane, b0, a0, c0); find_kth(hist + 2048, 256, lane, b1, a1, c1);
    const int mybin = hi ? b1 : b0;
    int last0 = 0, last1 = 0;
    constexpr int IDX_CAP = 384;
    volatile LAS unsigned* uflag = (volatile LAS unsigned*)(lds + MISC_OFF + 96);
    if ((b0 >= 0 && c0 > IDX_CAP) || (b1 >= 0 && c1 > IDX_CAP)) { if (lane == 0) *uflag = 1u; }
    LDS_WAIT(); __builtin_amdgcn_s_barrier(); asm volatile("" ::: "memory");
    const bool use_list = any256 && (*uflag == 0u);
    __builtin_amdgcn_s_barrier(); asm volatile("" ::: "memory");
    if (wid == 0 && lane == 0) *uflag = 0u;
    if (use_list) {
        LAS unsigned* rows = hist;
        LAS unsigned long long* lists = (LAS unsigned long long*)((LAS unsigned char*)hist + 4096);
        LAS unsigned* cnt = (LAS unsigned*)((LAS unsigned char*)hist + 4096 + 2 * IDX_CAP * 8);
#pragma unroll
        for (int i = 0; i < 4; ++i) ((LAS v4u*)rows)[i * 64 + lane] = (v4u){0u, 0u, 0u, 0u};
        if (lane < 4) cnt[lane] = 0u;
        LDS_WAIT();
        IDX_PASS({ const bool valid = kt * 32 + r32 <= q; const int bin = (int)(key32 >> 20);
                   const bool defin = valid && (mybin < 0 || bin > mybin); const bool amb = valid && mybin >= 0 && bin == mybin;
                   const unsigned long long bal = __ballot(defin); const unsigned w0_ = (unsigned)bal, w1_ = (unsigned)(bal >> 32);
                   if (w0_) last0 = kt * 32 + 31 - __clz((int)w0_); if (w1_) last1 = kt * 32 + 31 - __clz((int)w1_);
                   if (lane == 0) rows[kt] = w0_; if (lane == 32) rows[512 + kt] = w1_;
                   if (amb) { const unsigned idx = __hip_atomic_fetch_add(cnt + hi, 1u, __ATOMIC_RELAXED, __HIP_MEMORY_SCOPE_WORKGROUP);
                              if (idx < (unsigned)IDX_CAP) lists[hi * IDX_CAP + idx] = ((unsigned long long)key32 << 32) | (unsigned)(kt * 32 + r32); } });
        LDS_WAIT();
#pragma unroll
        for (int j = 0; j < 2; ++j) {
            const int bj = j ? b1 : b0; if (bj < 0) continue;
            const int n = (int)cnt[j] < IDX_CAP ? (int)cnt[j] : IDX_CAP, rsel = 256 - (j ? a1 : a0);
            const LAS unsigned long long* L = lists + j * IDX_CAP;
            for (int i0_ = 0; i0_ < n; i0_ += 64) { const int i = i0_ + lane; const unsigned long long mine = i < n ? L[i] : 0ull; int rank = 0;
                for (int t = 0; t < n; ++t) { const unsigned long long o = L[t];
                    rank += ((unsigned)(o >> 32) > (unsigned)(mine >> 32)) || ((unsigned)(o >> 32) == (unsigned)(mine >> 32) && (unsigned)o < (unsigned)mine) ? 1 : 0; }
                if (i < n && rank < rsel) { const unsigned pos = (unsigned)mine; __hip_atomic_fetch_or(rows + j * 512 + (pos >> 5), 1u << (pos & 31), __ATOMIC_RELAXED, __HIP_MEMORY_SCOPE_WORKGROUP);
                    __hip_atomic_fetch_max(cnt + 2 + j, pos, __ATOMIC_RELAXED, __HIP_MEMORY_SCOPE_WORKGROUP); } }
        }
        LDS_WAIT();
        { const int l0_ = (int)cnt[2], l1_ = (int)cnt[3]; if (l0_ > last0) last0 = l0_; if (l1_ > last1) last1 = l1_; }
#pragma unroll
        for (int i = 0; i < 4; ++i) { const v4u w = ((const LAS v4u*)rows)[i * 64 + lane]; *(GAS v4u*)(MASKB + (size_t)(2 * wu + (i >> 1)) * 512 + (i & 1) * 256 + lane * 4) = w; }
    } else {
        unsigned tau = 0u;
        if (any256) {
            IDX_ZERO();
            IDX_PASS({ if (kt * 32 + r32 <= q && (int)(key32 >> 20) == mybin) { const int bin = (int)((key32 >> 8) & 0xfffu); __hip_atomic_fetch_add(hist + hi * 2048 + hswz(bin >> 1), 1u << ((bin & 1) * 16), __ATOMIC_RELAXED, __HIP_MEMORY_SCOPE_WORKGROUP); } });
            LDS_WAIT();
            int s0 = 0, s1 = 0, t0, t1, u0, u1;
            if (b0 >= 0) find_kth(hist, 256 - a0, lane, s0, t0, u0);
            if (b1 >= 0) find_kth(hist + 2048, 256 - a1, lane, s1, t1, u1);
            const int mysub = hi ? s1 : s0;
            tau = mybin < 0 ? 0u : (((unsigned)mybin << 20) | ((unsigned)(mysub < 0 ? 0 : mysub) << 8));
        }
        IDX_PASS({ const bool sel = (kt * 32 + r32 <= q) && (key32 >= tau); const unsigned long long bal = __ballot(sel);
                   const unsigned w0_ = (unsigned)bal, w1_ = (unsigned)(bal >> 32);
                   if (w0_) last0 = kt * 32 + 31 - __clz((int)w0_); if (w1_) last1 = kt * 32 + 31 - __clz((int)w1_);
                   if (lane == 0) MASKB[(size_t)(2 * wu) * 512 + kt] = w0_;
                   if (lane == 32) MASKB[(size_t)(2 * wu + 1) * 512 + kt] = w1_; });
    }
    if (lane == 0) { const int d0_ = 2 * wu - last0, d1_ = 2 * wu + 1 - last1; atomicMax(NEARBLK + (wu >> 7), (unsigned)(d0_ > d1_ ? d0_ : d1_)); }
#undef IDX_DMA
#undef IDX_SCORE2
#undef IDX_ZERO
#undef IDX_PASS
}
__device__ __forceinline__ void indexer_phase(Frame& F, const bf16* P, unsigned* MASKB, unsigned* NEARBLK) {
    for (int i = 0;; ++i) { const int idx = F.vcu + i * F.G; if (idx >= 1024) break;
        const int seg = idx >> 8, r = idx & 255, unit = (seg & 1) ? (seg * 256 + 255 - r) : (seg * 256 + r);
        indexer_unit(P, MASKB, NEARBLK, F.lds, unit, F.wave, F.lane); }
}
__device__ __forceinline__ void b_norm_bounds(Frame& F, const bf16* P, unsigned* NRM) {
    float mx = 0.f;
    for (int s = F.gw; s < S; s += F.NGW) {
        const v4u* rp = (const v4u*)(P + (size_t)s * EINP + 3072 + 32 * F.lane); float ss = 0.f;
#pragma unroll
        for (int j = 0; j < 4; ++j) { const v4u w = rp[j];
            ss += bflo(w.x) * bflo(w.x) + bfhi(w.x) * bfhi(w.x) + bflo(w.y) * bflo(w.y) + bfhi(w.y) * bfhi(w.y) + bflo(w.z) * bflo(w.z) + bfhi(w.z) * bfhi(w.z) + bflo(w.w) * bflo(w.w) + bfhi(w.w) * bfhi(w.w); }
        ss += __shfl_xor(ss, 1); ss += __shfl_xor(ss, 2); mx = fmaxf(mx, ss); }
    if ((F.lane & 3) == 0) atomicMax(NRM + (F.lane >> 2), __float_as_uint(mx));
}
__device__ __forceinline__ void mixer_b_phase(Frame& F, const bf16* P, const unsigned* MASKB, bf16* O, const unsigned* NRM, const unsigned* NEARBLK, gu32* qctr) {
    const int wid = F.wave, r32 = F.lane & 31, hi = F.lane >> 5;
    for (;;) {
        if (F.tid == 0) F.MISC[16] = __hip_atomic_fetch_add(qctr, 1u, __ATOMIC_RELAXED, __HIP_MEMORY_SCOPE_AGENT);
        __syncthreads(); const int e = (int)F.MISC[16]; __syncthreads();
        if (e >= 512) break;
        const int h = 7 - (e >> 6), qb = 63 - (e & 63);
        fa::UnitP U; U.ldq = U.ldk = U.ldv = (size_t)EINP;
        U.Q = P + (size_t)(qb * 256) * EINP + 3072 + h * 128; U.K = P + 4096 + h * 128; U.V = P + 5120 + h * 128;
        U.q0 = qb * 256; U.kt0 = 0; U.kt1 = (qb + 1) * 4;
        U.sl2 = exp2f(-(float)(h + 1)) * LOG2E; U.c2 = 0.08838834764831845f * LOG2E; U.mask = MASKB + (size_t)(qb * 256) * 512;
        {
            const float B = sqrtf(__uint_as_float(NRM[h]) * __uint_as_float(NRM[8 + h])) * U.c2 * 1.01f;
            const float dmax = (2.f * B + 160.f) / U.sl2 + (float)NEARBLK[qb]; const float kmin = (float)U.q0 - dmax;
            if (kmin > 0.f) U.kt0 = (int)(kmin * (1.f / 64.f)); }
        fa::f32x16 o[4]; float lse2;
        fa::attn_unit4<128, true, true, false>(U, F.lds, o, lse2);
        fa::store_o_bf16(o, O + (size_t)(qb * 256 + wid * 32) * DM + 1024 + h * 128, (size_t)DM, r32, hi);
    }
}
__device__ __forceinline__ void kpe_fill(Frame& F, const bf16* P, bf16* KD) {
    const int h = F.lane >> 3, c = F.lane & 7, cc = c & 3;
    float inv[8];
#pragma unroll
    for (int e = 0; e < 8; ++e) inv[e] = exp2f(-0.41524101186092029f * (float)(8 * cc + e));
    for (int s = F.gw; s < S; s += F.NGW) {
        const bf16* kp = P + (size_t)s * OINP + 4352;
        const v4u a = *(const GAS v4u*)(kp + 8 * cc), b = *(const GAS v4u*)(kp + 32 + 8 * cc);
        const float x1[8] = {bflo(a.x), bfhi(a.x), bflo(a.y), bfhi(a.y), bflo(a.z), bfhi(a.z), bflo(a.w), bfhi(a.w)};
        const float x2[8] = {bflo(b.x), bfhi(b.x), bflo(b.y), bfhi(b.y), bflo(b.z), bfhi(b.z), bflo(b.w), bfhi(b.w)};
        float o[8];
#pragma unroll
        for (int e = 0; e < 8; ++e) { const float ang = (float)s * inv[e]; const float n = rintf(ang * 0.15915494309189535f);
            float rr = fmaf(-n, 6.2831854820251465f, ang); rr = fmaf(-n, -1.7484555e-07f, rr); const float fr = rr * 0.15915494309189535f;
            const float sn = __builtin_amdgcn_sinf(fr), cs = __builtin_amdgcn_cosf(fr);
            o[e] = c < 4 ? x1[e] * cs - x2[e] * sn : x1[e] * sn + x2[e] * cs; }
        v4u w; w.x = pk2(o[0], o[1]); w.y = pk2(o[2], o[3]); w.z = pk2(o[4], o[5]); w.w = pk2(o[6], o[7]);
        *(GAS v4u*)(KD + (size_t)s * 1536 + h * 192 + 128 + 8 * c) = w;
    }
}
__device__ __forceinline__ void c_norm_bounds(Frame& F, const bf16* P, unsigned* NRM) {
    float mx = 0.f;
    for (int s = F.gw; s < S; s += F.NGW) {
        const v4u* rp = (const v4u*)(P + (size_t)s * OINP + 32 * F.lane); float ss = 0.f;
#pragma unroll
        for (int j = 0; j < 4; ++j) { const v4u w = rp[j];
            ss += bflo(w.x) * bflo(w.x) + bfhi(w.x) * bfhi(w.x) + bflo(w.y) * bflo(w.y) + bfhi(w.y) * bfhi(w.y) + bflo(w.z) * bflo(w.z) + bfhi(w.z) * bfhi(w.z) + bflo(w.w) * bflo(w.w) + bfhi(w.w) * bfhi(w.w); }
        ss += __shfl_xor(ss, 1); mx = fmaxf(mx, ss); }
    if ((F.lane & 1) == 0) atomicMax(NRM + (F.lane >> 1), __float_as_uint(mx));
}
__device__ __forceinline__ void mixer_c_unit(Frame& F, const bf16* P, float lam, const float* subln_g, float lam_init, float* SCR, bf16* O, const unsigned* NRM, int h, int qb, int ord) {
    const int wid = F.wave, r32 = F.lane & 31, hi = F.lane >> 5;
    {
        int tq_ = F.tid; asm volatile("" : "+v"(tq_));
        f32x4* scr = (f32x4*)(SCR + (((size_t)(ord & 1) * F.G + blockIdx.x) * 512 + tq_) * 64);
        for (int sub = 0; sub < 2; ++sub) {
            fa::UnitP U; U.ldq = U.ldk = U.ldv = (size_t)OINP;
            U.Q = P + (size_t)(qb * 256) * OINP + h * 128 + sub * 64; U.K = P + 1024 + h * 128 + sub * 64; U.V = P + 2048 + h * 128;
            U.q0 = qb * 256; U.kt0 = 0; U.kt1 = (qb + 1) * 4;
            U.sl2 = exp2f(-(float)(h + 1)) * LOG2E; U.c2 = 0.125f * LOG2E; U.mask = nullptr;
            {
                const float B = sqrtf(__uint_as_float(NRM[h * 2 + sub]) * __uint_as_float(NRM[16 + h * 2 + sub])) * U.c2 * 1.01f;
                const float dmax = (2.f * B + 160.f) / U.sl2; const float kmin = (float)U.q0 - dmax;
                if (kmin > 0.f) U.kt0 = (int)(kmin * (1.f / 64.f)); }
            fa::f32x16 o[4]; float lse2;
            fa::attn_unit4<64, true, false, false>(U, F.lds, o, lse2);
            if (sub == 0) {
#pragma unroll
                for (int d = 0; d < 4; ++d)
#pragma unroll
                    for (int k = 0; k < 4; ++k) scr[d * 4 + k] = (f32x4){o[d][4 * k], o[d][4 * k + 1], o[d][4 * k + 2], o[d][4 * k + 3]};
            } else {
                float ss[16]; const int lo_ = fa::lane_opaque();
#pragma unroll
                for (int r = 0; r < 16; ++r) ss[r] = 0.f;
#pragma unroll
                for (int d = 0; d < 4; ++d)
#pragma unroll
                    for (int k = 0; k < 4; ++k) { const f32x4 s1 = scr[d * 4 + k];
#pragma unroll
                        for (int e2 = 0; e2 < 4; ++e2) { const int r = 4 * k + e2; const float v = s1[e2] - lam * o[d][r]; o[d][r] = v; ss[r] += v * v; } }
#pragma unroll
                for (int r = 0; r < 16; ++r) { float t = ss[r]; t += fa::shx(t, 1, lo_); t += fa::shx(t, 2, lo_); t += fa::shx(t, 4, lo_); t += fa::shx(t, 8, lo_); t += fa::shx(t, 16, lo_);
                    ss[r] = (1.0f - lam_init) / sqrtf(t * (1.0f / 128.0f) + DIFF_EPS); }
#pragma unroll
                for (int d = 0; d < 4; ++d) { const float gcol = subln_g[d * 32 + r32];
#pragma unroll
                    for (int r = 0; r < 16; ++r) o[d][r] *= ss[r] * gcol; }
                fa::store_o_bf16(o, O + (size_t)(qb * 256 + wid * 32) * DM + h * 128, (size_t)DM, r32, hi);
            }
        }
    }
}
__device__ __forceinline__ void mixer_d_unit(Frame& F, const bf16* QF, const bf16* KD, const bf16* VD, bf16* O, int h, int qb) {
    const int wid = F.wave, r32 = F.lane & 31, hi = F.lane >> 5;
    {
        fa::UnitP U; U.ldq = 1536; U.ldk = 1536; U.ldv = 1024;
        U.Q = QF + (size_t)(qb * 256) * 1536 + h * 192; U.K = KD + h * 192; U.V = VD + h * 128;
        U.q0 = qb * 256; U.kt0 = 0; U.kt1 = (qb + 1) * 4;
        U.sl2 = 0.f; U.c2 = 0.07216878364870322f * LOG2E; U.mask = nullptr;
        fa::f32x16 o[4]; float lse2;
        fa::attn_unit4<192, false, false, true>(U, F.lds, o, lse2);
        fa::store_o_bf16(o, O + (size_t)(qb * 256 + wid * 32) * DM + 1024 + h * 128, (size_t)DM, r32, hi);
    }
}
__device__ __forceinline__ void mixer_cd_phase(Frame& F, const bf16* P, const float* lam_p, const float* subln_g, float lam_init, float* SCR, const unsigned* NRM,
                                               const bf16* QF, const bf16* KD, const bf16* VD, bf16* O, gu32* qctr) {
    const float lam = expf(wave_sum(lam_p[F.lane] * lam_p[64 + F.lane])) - expf(wave_sum(lam_p[128 + F.lane] * lam_p[192 + F.lane])) + lam_init;
    int ord = 0;
    for (;;) {
        if (F.tid == 0) F.MISC[16] = __hip_atomic_fetch_add(qctr, 1u, __ATOMIC_RELAXED, __HIP_MEMORY_SCOPE_AGENT);
        __syncthreads(); const int e = (int)F.MISC[16]; __syncthreads();
        if (e >= 1024) break;
        const int idx = e >> 1;
        if ((e & 1) == 0) { mixer_c_unit(F, P, lam, subln_g, lam_init, SCR, O, NRM, 7 - (idx >> 6), 63 - (idx & 63), ord); ++ord; }
        else mixer_d_unit(F, QF, KD, VD, O, idx & 7, 63 - (idx >> 3));
    }
}
struct Args { const float* in[16]; float* out; unsigned char* ws; };
#define GRID_BAR() do { xcd_barrier(bar); int t_ = threadIdx.x; asm volatile("" : "+v"(t_)); F.tid = t_; F.lane = t_ & 63; } while (0)

#define FFN_PHASES(WF)                                                                                                           \
    {   pg8::Gemm g{X, (const bf16*)(WF), S, NGU, DM, DM}; pg8::StaticOrder So; So.init(S, NGU, F.G, (int)blockIdx.x);            \
        pg8::EpiSwiglu E{H, DFF};                                                                                                 \
        pg8::gemm_phase<pg8::EpiSwiglu, pg8::StaticOrder, true, true>(F.lds + RING_OFF, g, So, E); }                              \
    GRID_BAR();                                                                                                                   \
    {   pg8::Gemm g{H, (const bf16*)((WF) + WF_DOWN_OFF), S, DM, DFF, DFF}; pg8::StaticOrder So; So.init(S, DM, F.G, (int)blockIdx.x); \
        pg8::EpiResid E{X, Y, DM, ALPHA, 0.5f};                                                                                   \
        pg8::gemm_phase<pg8::EpiResid, pg8::StaticOrder, true, true>(F.lds + RING_OFF, g, So, E); }                               \
    GRID_BAR();

__global__ void __launch_bounds__(NWAVES * 64, 2) fwd_kernel(Args args) {
    extern __shared__ __attribute__((aligned(16))) unsigned char lds[];
    Frame F;
    F.lds = (LAS unsigned char*)lds;
    F.MISC = (volatile LAS unsigned*)(F.lds + MISC_OFF);
    F.tid = threadIdx.x; F.lane = F.tid & 63; F.wave = __builtin_amdgcn_readfirstlane(F.tid >> 6);
    F.G = gridDim.x; { const int bx = blockIdx.x; F.vcu = (F.G % 8 == 0) ? (bx % 8) * (F.G / 8) + bx / 8 : bx; }
    F.gw = F.vcu * NWAVES + F.wave; F.NGW = F.G * NWAVES;
    unsigned char* ws = args.ws;
    F.ctl = (gu32*)(ws + WS_CTL);
    for (int u = F.tid; u < (LDS_BYTES - LDSCTL_OFF) / 4; u += NWAVES * 64) ((LAS unsigned*)(F.lds + LDSCTL_OFF))[u] = 0u;
    __syncthreads();
    XcdBarrier bar = xcd_barrier_post((unsigned*)(F.ctl + CW_BAR), F.MISC + 8);

    const float* x_in = args.in[0];
    const float* w_gate = args.in[1]; const float* w_up = args.in[2]; const float* w_down = args.in[3];
    const float* ln_g = args.in[4]; const float* ln_b = args.in[5];
    bf16* X = (bf16*)(ws + WS_X); bf16* Y = (bf16*)(ws + WS_YB); bf16* H = (bf16*)(ws + WS_HP);
    bf16* P = (bf16*)(ws + WS_HP); bf16* O = (bf16*)(ws + WS_O);
    bf16* OA = (bf16*)(ws + WS_Y); unsigned* MASKB = (unsigned*)(ws + WS_Y + 96 * MiB); float* LSE = (float*)(ws + WS_LSE);
    bf16* QF = (bf16*)(ws + WS_Y); bf16* KD = (bf16*)(ws + WS_Y + 48 * MiB); bf16* VD = (bf16*)(ws + WS_Y + 96 * MiB);
    float* SQQ = (float*)(ws + (size_t)CW_SQQ * 4); float* SQKV = (float*)(ws + (size_t)CW_SQKV * 4);
    unsigned char* WFA = ws + WS_WFA; unsigned char* WFB = ws + WS_WFB;
    constexpr size_t GSZ = (size_t)DM * DFF;

    convert_ffn(F, w_gate + 0 * GSZ, w_up + 0 * GSZ, w_down + 0 * GSZ, WFA);
    convert_ffn(F, w_gate + 1 * GSZ, w_up + 1 * GSZ, w_down + 1 * GSZ, WFB);
    convert_weight<0>(F, args.in[6], DM, EIN, EINP, (bf16*)(ws + WS_WEIN), nullptr);
    convert_weight<0>(F, args.in[7], DM, DM, DM, (bf16*)(ws + WS_WEOUT), nullptr);
    convert_weight<0>(F, args.in[8], DM, OIN, OINP, (bf16*)(ws + WS_WOIN), nullptr);
    convert_weight<0>(F, args.in[9], DM, DM, DM, (bf16*)(ws + WS_WOOUT), nullptr);
    convert_weight<0>(F, args.in[14], 768, 1536, 1536, (bf16*)(ws + WS_WUQ), args.in[12]);
    convert_weight<0>(F, args.in[15], 512, 2048, 2048, (bf16*)(ws + WS_WUKV), args.in[13]);
    convert_x(F, x_in, X);
    GRID_BAR();
    FFN_PHASES(WFA)
    ln_phase<false>(F, Y, ln_g + 0 * DM, ln_b + 0 * DM, X, nullptr);
    convert_ffn(F, w_gate + 2 * GSZ, w_up + 2 * GSZ, w_down + 2 * GSZ, WFA);
    GRID_BAR();
    {
        pg8::Gemm g{X, (const bf16*)(ws + WS_WEIN), S, EINP, DM, DM}; pg8::StaticOrder So; So.init(S, EINP, F.G, (int)blockIdx.x);
        pg8::EpiBf16 E{P, EINP, nullptr, 0, 0, nullptr, 0, 0};
        pg8::gemm_phase<pg8::EpiBf16, pg8::StaticOrder, true, true>(F.lds + RING_OFF, g, So, E); }
    GRID_BAR();
    mixer_a_phase(F, P, OA, LSE);
    __syncthreads();
    indexer_phase(F, P, MASKB, (unsigned*)(F.ctl + CW_NEAR));
    b_norm_bounds(F, P, (unsigned*)(F.ctl + CW_NRMB));
    GRID_BAR();
    merge_a(F, OA, LSE, O);
    mixer_b_phase(F, P, MASKB, O, (const unsigned*)(F.ctl + CW_NRMB), (const unsigned*)(F.ctl + CW_NEAR), F.ctl + CW_QB);
    GRID_BAR();
    {
        pg8::Gemm g{O, (const bf16*)(ws + WS_WEOUT), S, DM, DM, DM}; pg8::StaticOrder So; So.init(S, DM, F.G, (int)blockIdx.x);
        pg8::EpiResid E{X, Y, DM, ALPHA, 1.0f};
        pg8::gemm_phase<pg8::EpiResid, pg8::StaticOrder, true, true>(F.lds + RING_OFF, g, So, E); }
    GRID_BAR();
    ln_phase<false>(F, Y, ln_g + 1 * DM, ln_b + 1 * DM, X, nullptr);
    GRID_BAR();
    FFN_PHASES(WFB)
    ln_phase<false>(F, Y, ln_g + 2 * DM, ln_b + 2 * DM, X, nullptr);
    convert_ffn(F, w_gate + 3 * GSZ, w_up + 3 * GSZ, w_down + 3 * GSZ, WFB);
    GRID_BAR();
    FFN_PHASES(WFA)
    ln_phase<false>(F, Y, ln_g + 3 * DM, ln_b + 3 * DM, X, nullptr);
    GRID_BAR();
    {
        pg8::Gemm g{X, (const bf16*)(ws + WS_WOIN), S, OINP, DM, DM}; pg8::StaticOrder So; So.init(S, OINP, F.G, (int)blockIdx.x);
        pg8::EpiBf16 E{P, OINP, SQQ, 12, 15, SQKV, 15, 17};
        pg8::gemm_phase<pg8::EpiBf16, pg8::StaticOrder, true, true>(F.lds + RING_OFF, g, So, E); }
    GRID_BAR();
    {
        pg8::Gemm g{P + 3072, (const bf16*)(ws + WS_WUQ), S, 1536, 768, OINP}; pg8::StaticOrder So; So.init(S, 1536, F.G, (int)blockIdx.x);
        pg8::EpiScaleRow E{QF, 1536, SQQ, 1.0f / 768.0f, RMS_EPS};
        pg8::gemm_phase<pg8::EpiScaleRow, pg8::StaticOrder, true, true>(F.lds + RING_OFF, g, So, E); }
    {   pg8::Gemm g{P + 3840, (const bf16*)(ws + WS_WUKV), S, 2048, 512, OINP}; pg8::StaticOrder So; So.init(S, 2048, F.G, (int)blockIdx.x);
        pg8::EpiUkv E{KD, VD, SQKV, 1.0f / 512.0f, RMS_EPS};
        pg8::gemm_phase<pg8::EpiUkv, pg8::StaticOrder, true, true>(F.lds + RING_OFF, g, So, E); }
    kpe_fill(F, P, KD);
    c_norm_bounds(F, P, (unsigned*)(F.ctl + CW_NRM));
    GRID_BAR();
    mixer_cd_phase(F, P, args.in[10], args.in[11], 0.35550906759096874f, (float*)(ws + WS_HP + 160 * MiB), (const unsigned*)(F.ctl + CW_NRM), QF, KD, VD, O, F.ctl + CW_QCD);
    GRID_BAR();
    {
        pg8::Gemm g{O, (const bf16*)(ws + WS_WOOUT), S, DM, DM, DM}; pg8::StaticOrder So; So.init(S, DM, F.G, (int)blockIdx.x);
        pg8::EpiResid E{X, Y, DM, ALPHA, 1.0f};
        pg8::gemm_phase<pg8::EpiResid, pg8::StaticOrder, true, true>(F.lds + RING_OFF, g, So, E); }
    GRID_BAR();
    ln_phase<false>(F, Y, ln_g + 4 * DM, ln_b + 4 * DM, X, nullptr);
    GRID_BAR();
    FFN_PHASES(WFB)
    ln_phase<true>(F, Y, ln_g + 5 * DM, ln_b + 5 * DM, nullptr, args.out);
}

extern "C" void kernel_launch(void* const* d_in, const int* in_sizes, int n_in, void* d_out, int out_size, void* d_ws, size_t ws_size, hipStream_t stream) {
    static int grid = 0;
    if (grid == 0) {
        if (n_in != 16 || in_sizes[0] != S * DM || out_size != S * DM || ws_size < WS_END) { fprintf(stderr, "kernel_launch: unexpected shapes (n_in %d, in0 %d, out %d, ws %zu < %zu)\n", n_in, n_in > 0 ? in_sizes[0] : -1, out_size, ws_size, (size_t)WS_END); grid = -1; return; }
        int dev = 0, cus = 0, per_cu = 0;
        if (hipGetDevice(&dev) != hipSuccess || hipDeviceGetAttribute(&cus, hipDeviceAttributeMultiprocessorCount, dev) != hipSuccess) { grid = -1; return; }
        if (hipFuncSetAttribute((const void*)fwd_kernel, hipFuncAttributeMaxDynamicSharedMemorySize, LDS_BYTES) != hipSuccess) { fprintf(stderr, "kernel_launch: hipFuncSetAttribute failed\n"); grid = -1; return; }
        if (hipOccupancyMaxActiveBlocksPerMultiprocessor(&per_cu, (const void*)fwd_kernel, NWAVES * 64, LDS_BYTES) != hipSuccess || per_cu < 1)
            fprintf(stderr, "kernel_launch: occupancy query reports %d workgroups per CU\n", per_cu);
        (void)hipGetLastError();
        grid = cus;
    }
    if (grid < 0) return;
    if (hipMemsetAsync((char*)d_ws + WS_CTL, 0, CTL_ZERO_BYTES, stream) != hipSuccess) return;
    Args a{};
    for (int i = 0; i < 16; ++i) a.in[i] = (const float*)d_in[i];
    a.out = (float*)d_out; a.ws = (unsigned char*)d_ws;
    hipLaunchKernelGGL(fwd_kernel, dim3(grid), dim3(NWAVES * 64), LDS_BYTES, stream, a);
}
```

```cpp
#include <hip/hip_runtime.h>
#include <cstdio>
#include <cstdint>
#include <cmath>
namespace pg8 {
#define PG8_LAS __attribute__((address_space(3)))
typedef unsigned short bf16_t;
typedef short bf16x8 __attribute__((ext_vector_type(8)));
typedef float f32x4 __attribute__((ext_vector_type(4)));
typedef unsigned u32x4 __attribute__((ext_vector_type(4)));
constexpr int BM = 256, BK = 64, HALF = 128, HTB = HALF * BK * 2  , STAGE_BYTES = 8 * HTB, NXCD = 8, WGM = 4;

__host__ __device__ __forceinline__ int lds_byte(int r, int c) { const int st = (r >> 4) * 2 + (c >> 5), rr = r & 15, cc = c & 31, ob = rr * 64 + cc * 2; return st * 1024 + (ob ^ (((ob >> 9) & 1) << 5)); }
__host__ __device__ __forceinline__ void stage_rc(int b, int& R, int& C) { const int st = b / 1024, sb = b % 1024, swz = sb ^ (((sb >> 9) & 1) << 5); R = (st >> 1) * 16 + swz / 64; C = (st & 1) * 32 + (swz % 64) / 2; }
__host__ __device__ __forceinline__ int perm32(int rho) { const int n = rho >> 4, i = rho & 15; return 8 * (i >> 2) + 4 * n + (i & 3); }

struct Unit { int pm, pn; };
struct Gemm { const bf16_t* A; const bf16_t* Bt; int M, N, K, lda; };

struct StaticOrder {
    int nM, nN, nwg, G, c;
    __host__ __device__ void init(int M, int N, int G_, int c_) { nM = M / BM; nN = N / BM; nwg = nM * nN; G = G_; c = c_; }
    __host__ __device__ bool next(int i, Unit& u) const {
        const long L = (long)i * G + c; if (L >= nwg) return false;
        int wgid = (int)L; { const int q = nwg / NXCD, r = nwg % NXCD, xcd = wgid % NXCD, off = wgid / NXCD; wgid = (xcd < r ? xcd * (q + 1) : r * (q + 1) + (xcd - r) * q) + off; }
        const int nig = WGM * nN, gid = wgid / nig, fm = gid * WGM, gsz = (nM - fm) < WGM ? (nM - fm) : WGM;
        u.pm = fm + ((wgid % nig) % gsz); u.pn = (wgid % nig) / gsz; return true;
    }
    __device__ __forceinline__ void a_ready(const Unit&) const {}
    __device__ __forceinline__ void done(const Unit&) const {}
};
__device__ __forceinline__ unsigned cvt_pk_bf16(float lo, float hi) { unsigned r; asm volatile("v_cvt_pk_bf16_f32 %0, %1, %2" : "=v"(r) : "v"(lo), "v"(hi)); return r; }
__device__ __forceinline__ float bf_lo(unsigned w) { return __uint_as_float(w << 16); }
__device__ __forceinline__ float bf_hi(unsigned w) { return __uint_as_float(w & 0xffff0000u); }
typedef unsigned u32x2 __attribute__((ext_vector_type(2)));
__device__ __forceinline__ float silu_f(float x) { return x * __builtin_amdgcn_rcpf(1.0f + __builtin_amdgcn_exp2f(-1.4426950408889634f * x)); }

struct EpiSwiglu {
    static constexpr bool PERM = true, AFTER_DRAIN = false;
    bf16_t* H; int ldh;
    __device__ __forceinline__ void operator()(const f32x4 (&acc)[2][2][4][2], const Unit& u, int wr, int wc, int fr, int fq) const {
        const int row0 = u.pm * BM + wr * 64 + fr, col0 = u.pn * HALF + wc * 32 + 8 * fq;
#pragma unroll
        for (int ai = 0; ai < 2; ++ai)
#pragma unroll
            for (int m = 0; m < 4; ++m) {
                const f32x4 g0 = acc[ai][0][m][0], g1 = acc[ai][0][m][1], u0 = acc[ai][1][m][0], u1 = acc[ai][1][m][1];
                u32x4 w;
                w.x = cvt_pk_bf16(silu_f(g0[0]) * u0[0], silu_f(g0[1]) * u0[1]); w.y = cvt_pk_bf16(silu_f(g0[2]) * u0[2], silu_f(g0[3]) * u0[3]);
                w.z = cvt_pk_bf16(silu_f(g1[0]) * u1[0], silu_f(g1[1]) * u1[1]); w.w = cvt_pk_bf16(silu_f(g1[2]) * u1[2], silu_f(g1[3]) * u1[3]);
                *(u32x4*)(H + (size_t)(row0 + ai * HALF + m * 16) * ldh + col0) = w;
            }
    }
};
struct EpiResid {
    static constexpr bool PERM = true, AFTER_DRAIN = false;
    const bf16_t* X; bf16_t* Y; int ldc; float alpha, w;
    __device__ __forceinline__ void operator()(const f32x4 (&acc)[2][2][4][2], const Unit& u, int wr, int wc, int fr, int fq) const {
        const int row0 = u.pm * BM + wr * 64 + fr, col0 = u.pn * BM + wc * 32 + 8 * fq;
#pragma unroll
        for (int ai = 0; ai < 2; ++ai)
#pragma unroll
            for (int m = 0; m < 4; ++m) { const size_t ro = (size_t)(row0 + ai * HALF + m * 16) * ldc + col0;
#pragma unroll
                for (int bj = 0; bj < 2; ++bj) { const size_t off = ro + bj * HALF; const u32x4 xw = *(const u32x4*)(X + off); const f32x4 a0 = acc[ai][bj][m][0], a1 = acc[ai][bj][m][1];
                    u32x4 y;
                    y.x = cvt_pk_bf16(alpha * bf_lo(xw.x) + w * a0[0], alpha * bf_hi(xw.x) + w * a0[1]); y.y = cvt_pk_bf16(alpha * bf_lo(xw.y) + w * a0[2], alpha * bf_hi(xw.y) + w * a0[3]);
                    y.z = cvt_pk_bf16(alpha * bf_lo(xw.z) + w * a1[0], alpha * bf_hi(xw.z) + w * a1[1]); y.w = cvt_pk_bf16(alpha * bf_lo(xw.w) + w * a1[2], alpha * bf_hi(xw.w) + w * a1[3]);
                    *(u32x4*)(Y + off) = y; } }
    }
};
struct EpiBf16 {
    static constexpr bool PERM = true, AFTER_DRAIN = false;
    bf16_t* O; int ldc; float* sqA; int a_lo, a_hi; float* sqB; int b_lo, b_hi;
    __device__ __forceinline__ void operator()(const f32x4 (&acc)[2][2][4][2], const Unit& u, int wr, int wc, int fr, int fq) const {
        const int row0 = u.pm * BM + wr * 64 + fr, col0 = u.pn * BM + wc * 32 + 8 * fq;
        float* sq = (u.pn >= a_lo && u.pn < a_hi) ? sqA : ((u.pn >= b_lo && u.pn < b_hi) ? sqB : nullptr);
#pragma unroll
        for (int ai = 0; ai < 2; ++ai)
#pragma unroll
            for (int m = 0; m < 4; ++m) { bf16_t* rowp = O + (size_t)(row0 + ai * HALF + m * 16) * ldc + col0; float ss = 0.f;
#pragma unroll
                for (int bj = 0; bj < 2; ++bj) { const f32x4 v0 = acc[ai][bj][m][0], v1 = acc[ai][bj][m][1];
                    ss += (v0[0] * v0[0] + v0[1] * v0[1]) + (v0[2] * v0[2] + v0[3] * v0[3]) + (v1[0] * v1[0] + v1[1] * v1[1]) + (v1[2] * v1[2] + v1[3] * v1[3]);
                    u32x4 w; w.x = cvt_pk_bf16(v0[0], v0[1]); w.y = cvt_pk_bf16(v0[2], v0[3]); w.z = cvt_pk_bf16(v1[0], v1[1]); w.w = cvt_pk_bf16(v1[2], v1[3]);
                    *(u32x4*)(rowp + bj * HALF) = w; }
                if (sq) { ss += __shfl_xor(ss, 16); ss += __shfl_xor(ss, 32); if (fq == 0) atomicAdd(sq + row0 + ai * HALF + m * 16, ss); }
            }
    }
};
struct EpiScaleRow {
    static constexpr bool PERM = true, AFTER_DRAIN = false;
    bf16_t* O; int ldc; const float* sq; float invn, eps;
    __device__ __forceinline__ void operator()(const f32x4 (&acc)[2][2][4][2], const Unit& u, int wr, int wc, int fr, int fq) const {
        const int row0 = u.pm * BM + wr * 64 + fr, col0 = u.pn * BM + wc * 32 + 8 * fq;
#pragma unroll
        for (int ai = 0; ai < 2; ++ai)
#pragma unroll
            for (int m = 0; m < 4; ++m) { const int row = row0 + ai * HALF + m * 16; const float rs = 1.0f / sqrtf(sq[row] * invn + eps); bf16_t* rowp = O + (size_t)row * ldc + col0;
#pragma unroll
                for (int bj = 0; bj < 2; ++bj) { const f32x4 v0 = acc[ai][bj][m][0] * rs, v1 = acc[ai][bj][m][1] * rs;
                    u32x4 w; w.x = cvt_pk_bf16(v0[0], v0[1]); w.y = cvt_pk_bf16(v0[2], v0[3]); w.z = cvt_pk_bf16(v1[0], v1[1]); w.w = cvt_pk_bf16(v1[2], v1[3]);
                    *(u32x4*)(rowp + bj * HALF) = w; } }
    }
};
struct EpiUkv {
    static constexpr bool PERM = true, AFTER_DRAIN = false;
    bf16_t* KD; bf16_t* VD; const float* sq; float invn, eps;
    __device__ __forceinline__ void operator()(const f32x4 (&acc)[2][2][4][2], const Unit& u, int wr, int wc, int fr, int fq) const {
        const int row0 = u.pm * BM + wr * 64 + fr, cc = wc * 32 + 8 * fq;
#pragma unroll
        for (int ai = 0; ai < 2; ++ai)
#pragma unroll
            for (int m = 0; m < 4; ++m) { const int row = row0 + ai * HALF + m * 16; const float rs = 1.0f / sqrtf(sq[row] * invn + eps);
#pragma unroll
                for (int bj = 0; bj < 2; ++bj) { const f32x4 v0 = acc[ai][bj][m][0] * rs, v1 = acc[ai][bj][m][1] * rs;
                    u32x4 w; w.x = cvt_pk_bf16(v0[0], v0[1]); w.y = cvt_pk_bf16(v0[2], v0[3]); w.z = cvt_pk_bf16(v1[0], v1[1]); w.w = cvt_pk_bf16(v1[2], v1[3]);
                    bf16_t* dst = bj == 0 ? KD + (size_t)row * 1536 + u.pn * 192 + cc : VD + (size_t)row * 1024 + u.pn * 128 + cc;
                    *(u32x4*)dst = w; } }
    }
};
template <class Epi, class Sched, bool ALIGN_EPI = false, bool SP2 = false>
__device__ __forceinline__ void gemm_phase(PG8_LAS unsigned char* lds, const Gemm g, const Sched& S, const Epi& E) {
    int tid_o_ = threadIdx.x; asm volatile("" : "+v"(tid_o_)); const int tid = tid_o_, wid = __builtin_amdgcn_readfirstlane(tid >> 6), lane = tid & 63, wr = wid >> 2, wc = wid & 3, fr = lane & 15, fq = lane >> 4;
    const int K = g.K, nt = K / BK;
    unsigned voffA[2], voffB[2];
#pragma unroll
    for (int i = 0; i < 2; ++i) { int R, C; stage_rc(tid * 16 + i * 8192, R, C); const int Rb = Epi::PERM ? ((R & ~31) + perm32(R & 31)) : R;
        voffA[i] = (unsigned)(R * g.lda + C) * 2u; voffB[i] = (unsigned)(Rb * K + C) * 2u; }
    const size_t kstep = (size_t)(BK * 2);
    const size_t hstepB = (size_t)HALF * K * 2, hstepA = (size_t)HALF * g.lda * 2;
    const size_t tstepA = 2 * hstepA, tstepB = 2 * hstepB;
    const unsigned ldsw = (unsigned)wid * 1024u;
    const int aoff = lds_byte(wr * 64 + fr, fq * 8), boff = lds_byte(wc * 32 + fr, fq * 8);
#define PG8_SA(b, h) (((b) * 2 + (h)) * HTB)
#define PG8_SB(b, h) ((4 + (b) * 2 + (h)) * HTB)
#define PG8_STAGE(bufoff, gbase, voff) do { _Pragma("unroll") for (int _i = 0; _i < 2; ++_i) \
        __builtin_amdgcn_global_load_lds((const unsigned*)((const char*)(gbase) + (voff)[_i]), (PG8_LAS unsigned*)(lds + (bufoff) + ldsw + _i * 8192), 16, 0, 0); } while (0)
#define PG8_LDA(dst, b, h) do { _Pragma("unroll") for (int m = 0; m < 4; ++m) _Pragma("unroll") for (int k = 0; k < 2; ++k) dst[m][k] = *(const PG8_LAS bf16x8*)(lds + PG8_SA(b, h) + aoff + m * 2048 + k * 1024); } while (0)
#define PG8_LDB(dst, b, h) do { _Pragma("unroll") for (int n = 0; n < 2; ++n) _Pragma("unroll") for (int k = 0; k < 2; ++k) dst[n][k] = *(const PG8_LAS bf16x8*)(lds + PG8_SB(b, h) + boff + n * 2048 + k * 1024); } while (0)
#define PG8_MMA(ai, bj, At, Bt) do { __builtin_amdgcn_s_setprio(1); _Pragma("unroll") for (int m = 0; m < 4; ++m) _Pragma("unroll") for (int n = 0; n < 2; ++n) _Pragma("unroll") for (int k = 0; k < 2; ++k) \
        acc[ai][bj][m][n] = __builtin_amdgcn_mfma_f32_16x16x32_bf16(Bt[n][k], At[m][k], acc[ai][bj][m][n], 0, 0, 0); __builtin_amdgcn_s_setprio(0); } while (0)
#define PG8_WAIT_V(n) asm volatile("s_waitcnt vmcnt(" #n ")" ::: "memory")
#define PG8_WAIT_L(n) asm volatile("s_waitcnt lgkmcnt(" #n ")" ::: "memory")
#define PG8_BAR __builtin_amdgcn_s_barrier()
#define PG8_SCHED __builtin_amdgcn_sched_barrier(0)
    Unit cur, nxt; int ui = 0;
    if (!S.next(0, cur)) return;
    f32x4 acc[2][2][4][2];
#pragma unroll
    for (int a = 0; a < 2; ++a)
#pragma unroll
        for (int b = 0; b < 2; ++b)
#pragma unroll
            for (int m = 0; m < 4; ++m)
#pragma unroll
                for (int n = 0; n < 2; ++n) acc[a][b][m][n] = (f32x4){0.f, 0.f, 0.f, 0.f};
    bf16x8 At[4][2], B0[2][2], B1[2][2];
    const char* cA = (const char*)g.A + (size_t)cur.pm * tstepA; const char* cB = (const char*)g.Bt + (size_t)cur.pn * tstepB;
    S.a_ready(cur);
    if constexpr (SP2) {
        PG8_STAGE(PG8_SB(0, 0), cB, voffB); PG8_STAGE(PG8_SB(0, 1), cB + hstepB, voffB); PG8_STAGE(PG8_SA(0, 0), cA, voffA); PG8_STAGE(PG8_SA(0, 1), cA + hstepA, voffA);
        if (wr == 1) PG8_BAR;
        PG8_WAIT_V(2); PG8_BAR;
        PG8_STAGE(PG8_SB(1, 0), cB + kstep, voffB); PG8_STAGE(PG8_SA(1, 0), cA + kstep, voffA); PG8_STAGE(PG8_SB(1, 1), cB + hstepB + kstep, voffB);
        PG8_WAIT_V(6); PG8_BAR;
    } else {
        PG8_STAGE(PG8_SB(0, 0), cB, voffB); PG8_STAGE(PG8_SA(0, 0), cA, voffA); PG8_STAGE(PG8_SB(0, 1), cB + hstepB, voffB); PG8_STAGE(PG8_SA(0, 1), cA + hstepA, voffA);
        if (wr == 1) PG8_BAR;
        PG8_WAIT_V(4); PG8_BAR;
        PG8_STAGE(PG8_SB(1, 0), cB + kstep, voffB); PG8_STAGE(PG8_SA(1, 0), cA + kstep, voffA); PG8_STAGE(PG8_SB(1, 1), cB + hstepB + kstep, voffB);
        PG8_WAIT_V(6); PG8_BAR;
    }
    for (;;) {
        const bool has_next = S.next(ui + 1, nxt);
        const char* nA = has_next ? (const char*)g.A + (size_t)nxt.pm * tstepA : cA; const char* nB = has_next ? (const char*)g.Bt + (size_t)nxt.pn * tstepB : cB;
        for (int t = 0; t < nt; t += 2) {
            const bool last = (t == nt - 2);
            const char* a1 = cA + (size_t)(t + 1) * kstep;
            const char* a2 = last ? nA : cA + (size_t)(t + 2) * kstep; const char* b2 = last ? nB : cB + (size_t)(t + 2) * kstep;
            const char* a3 = a2 + kstep; const char* b3 = b2 + kstep;
            if (last && has_next) S.a_ready(nxt);
            if constexpr (SP2) {
            PG8_LDB(B0, 0, 0); PG8_LDB(B1, 0, 1); PG8_SCHED; PG8_LDA(At, 0, 0); PG8_STAGE(PG8_SA(1, 1), a1 + hstepA, voffA);
            PG8_WAIT_V(8); PG8_WAIT_L(0); PG8_BAR; PG8_MMA(0, 0, At, B0); PG8_MMA(0, 1, At, B1); PG8_BAR; PG8_SCHED;
            PG8_LDA(At, 0, 1); PG8_STAGE(PG8_SB(0, 0), b2, voffB); PG8_STAGE(PG8_SB(0, 1), b2 + hstepB, voffB); PG8_STAGE(PG8_SA(0, 0), a2, voffA);
            PG8_WAIT_V(8); PG8_WAIT_L(0); PG8_BAR; PG8_MMA(1, 0, At, B0); PG8_MMA(1, 1, At, B1); PG8_BAR; PG8_SCHED;
            PG8_LDB(B0, 1, 0); PG8_LDB(B1, 1, 1); PG8_SCHED; PG8_LDA(At, 1, 0); PG8_STAGE(PG8_SA(0, 1), a2 + hstepA, voffA);
            PG8_WAIT_V(8); PG8_WAIT_L(0); PG8_BAR; PG8_MMA(0, 0, At, B0); PG8_MMA(0, 1, At, B1); PG8_BAR; PG8_SCHED;
            PG8_LDA(At, 1, 1); PG8_STAGE(PG8_SB(1, 0), b3, voffB); PG8_STAGE(PG8_SB(1, 1), b3 + hstepB, voffB); PG8_STAGE(PG8_SA(1, 0), a3, voffA);
            PG8_WAIT_V(8); PG8_WAIT_L(0); PG8_BAR; PG8_MMA(1, 0, At, B0); PG8_MMA(1, 1, At, B1); PG8_BAR; PG8_SCHED;
            } else {
            PG8_LDB(B0, 0, 0); PG8_SCHED; PG8_LDA(At, 0, 0); PG8_STAGE(PG8_SA(1, 1), a1 + hstepA, voffA);
            PG8_WAIT_L(8); PG8_BAR; PG8_WAIT_L(0); PG8_MMA(0, 0, At, B0); PG8_BAR; PG8_SCHED;
            PG8_LDB(B1, 0, 1); PG8_STAGE(PG8_SB(0, 0), b2, voffB);
            PG8_BAR; PG8_WAIT_L(0); PG8_MMA(0, 1, At, B1); PG8_BAR;
            PG8_LDA(At, 0, 1); PG8_STAGE(PG8_SA(0, 0), a2, voffA);
            PG8_BAR; PG8_WAIT_L(0); PG8_MMA(1, 0, At, B0); PG8_BAR; PG8_SCHED;
            PG8_STAGE(PG8_SB(0, 1), b2 + hstepB, voffB);
            PG8_WAIT_V(6); PG8_BAR; PG8_MMA(1, 1, At, B1); PG8_BAR;
            PG8_LDB(B0, 1, 0); PG8_SCHED; PG8_LDA(At, 1, 0); PG8_STAGE(PG8_SA(0, 1), a2 + hstepA, voffA);
            PG8_WAIT_L(8); PG8_BAR; PG8_WAIT_L(0); PG8_MMA(0, 0, At, B0); PG8_BAR; PG8_SCHED;
            PG8_LDB(B1, 1, 1); PG8_STAGE(PG8_SB(1, 0), b3, voffB);
            PG8_BAR; PG8_WAIT_L(0); PG8_MMA(0, 1, At, B1); PG8_BAR;
            PG8_LDA(At, 1, 1); PG8_STAGE(PG8_SA(1, 0), a3, voffA);
            PG8_BAR; PG8_WAIT_L(0); PG8_MMA(1, 0, At, B0); PG8_BAR; PG8_SCHED;
            PG8_STAGE(PG8_SB(1, 1), b3 + hstepB, voffB);
            PG8_WAIT_V(6); PG8_BAR; PG8_MMA(1, 1, At, B1); PG8_BAR;
            }
        }
        if constexpr (ALIGN_EPI) { if (wr == 0) PG8_BAR; }
        if constexpr (!Epi::AFTER_DRAIN) { E(acc, cur, wr, wc, fr, fq); S.done(cur); }
        if (!has_next) break;
#pragma unroll
        for (int a = 0; a < 2; ++a)
#pragma unroll
            for (int b = 0; b < 2; ++b)
#pragma unroll
                for (int m = 0; m < 4; ++m)
#pragma unroll
                    for (int n = 0; n < 2; ++n) acc[a][b][m][n] = (f32x4){0.f, 0.f, 0.f, 0.f};
        cur = nxt; cA = nA; cB = nB; ++ui;
        if constexpr (ALIGN_EPI) { if (wr == 1) PG8_BAR; }
    }
    PG8_WAIT_V(0);
    if constexpr (!ALIGN_EPI) { if (wr == 0) PG8_BAR; }
    PG8_BAR;
    if constexpr (Epi::AFTER_DRAIN) { E.fused(acc, cur, wr, wc, fr, fq, lds, wid, lane); S.done(cur); }
#undef PG8_SA
#undef PG8_SB
#undef PG8_STAGE
#undef PG8_LDA
#undef PG8_LDB
#undef PG8_MMA
#undef PG8_WAIT_V
#undef PG8_WAIT_L
#undef PG8_BAR
#undef PG8_SCHED
}
}

constexpr int S = 16384, DM = 2048, DFF = 5632, NGU = 2 * DFF;
constexpr int EIN = 7248, EINP = 7424, OIN = 4416, OINP = 4608;
constexpr float ALPHA = 1.4142135623730951f;
constexpr float LN_EPS = 1e-5f, RMS_EPS = 1e-6f, DIFF_EPS = 1e-5f;
constexpr int NWAVES = 8;
constexpr size_t MiB = 1u << 20;
constexpr size_t WS_CTL = 0, CTL_ZERO_BYTES = 1 * MiB;
constexpr size_t WS_LSE = 1 * MiB;
constexpr size_t WS_WFA = 4 * MiB, WS_WFB = 70 * MiB;
constexpr size_t WF_DOWN_OFF = (size_t)NGU * DM * 2;
constexpr size_t WS_WEIN = 136 * MiB, WS_WOIN = 165 * MiB, WS_WEOUT = 183 * MiB, WS_WOOUT = 191 * MiB, WS_WUQ = 199 * MiB, WS_WUKV = 202 * MiB;
constexpr size_t WS_X = 204 * MiB;
constexpr size_t WS_Y = 268 * MiB;
constexpr size_t WS_HP = 396 * MiB;
constexpr size_t WS_O = 628 * MiB;
constexpr size_t WS_YB = 692 * MiB;
constexpr size_t WS_END = 756 * MiB;
constexpr int CW_BAR = 4096;
constexpr int CW_QCD = 2048;
constexpr int CW_QB = 2112;
constexpr int CW_NRMB = 1088;
constexpr int CW_NEAR = 1152;
constexpr int CW_NRM = 1024;
constexpr int CW_SQQ = 65536, CW_SQKV = 65536 + 16384;
constexpr int RING_OFF = 0, RING_BYTES = 131072;
constexpr int KI_RING_OFF = RING_BYTES;
constexpr int LDSCTL_OFF = RING_BYTES + 16384, MISC_OFF = LDSCTL_OFF + 320;
constexpr int LDS_BYTES = 151552;

#define GAS __attribute__((address_space(1)))
#define LAS __attribute__((address_space(3)))
typedef unsigned short bf16;
typedef unsigned v4u __attribute__((ext_vector_type(4)));
typedef unsigned v2u __attribute__((ext_vector_type(2)));
typedef float f32x4 __attribute__((ext_vector_type(4)));
typedef short bf16x8 __attribute__((ext_vector_type(8)));
typedef GAS unsigned gu32;
#define LDS_WAIT() asm volatile("s_waitcnt lgkmcnt(0)" ::: "memory")
#define VM_WAIT() asm volatile("s_waitcnt vmcnt(0)" ::: "memory")
__device__ __forceinline__ unsigned f2bf(float f) { unsigned u = __builtin_bit_cast(unsigned, f); return (u + 0x7fffu + ((u >> 16) & 1u)) >> 16; }
__device__ __forceinline__ unsigned pk2(float lo, float hi) { return f2bf(lo) | (f2bf(hi) << 16); }
__device__ __forceinline__ float bflo(unsigned w) { return __uint_as_float(w << 16); }
__device__ __forceinline__ float bfhi(unsigned w) { return __uint_as_float(w & 0xffff0000u); }
#define XB_TMO      128
#define XB_XCNT(j)  (256  + 64 * (j))
#define XB_XSUB(j)  (1280 + 64 * (j))
#define XB_XGEN(j)  (2304 + 64 * (j))
#define XB_TOP      3328
#define XB_TOPGEN   3392
#define XCD_BAR_WORDS 3456
#define XB_SPIN_CAP (1u << 18)

__device__ __forceinline__ unsigned xb_ld(unsigned* p)              { return __hip_atomic_load(p, __ATOMIC_RELAXED, __HIP_MEMORY_SCOPE_AGENT); }
__device__ __forceinline__ unsigned xb_add(unsigned* p, unsigned v) { return __hip_atomic_fetch_add(p, v, __ATOMIC_RELAXED, __HIP_MEMORY_SCOPE_AGENT); }
__device__ __forceinline__ unsigned xb_xcc_id() { return (unsigned)__builtin_amdgcn_s_getreg((3 << 11) | 20) & 0xFu; }
#define XB_SPIN(cond, bar) do { unsigned _sp = 0; while (cond) { __builtin_amdgcn_s_sleep(1); \
    if ((++_sp & 255u) == 0u) { if (xb_ld(&(bar)[XB_TMO])) break; if (_sp > XB_SPIN_CAP) { atomicAdd(&(bar)[XB_TMO], 1u); break; } } } } while (0)

struct XcdBarrier {
    unsigned* bar; unsigned x;
    volatile LAS unsigned* st;
};

__device__ __forceinline__ XcdBarrier xcd_barrier_post(unsigned* bar, volatile LAS unsigned* st) {
    XcdBarrier b; b.bar = bar; b.x = xb_xcc_id(); b.st = st;
    if (threadIdx.x == 0) (void)xb_add(&bar[XB_XCNT(b.x)], 1u);
    return b;
}
__device__ __forceinline__ void xcd_barrier_complete(unsigned* bar, unsigned x, unsigned& nloc, unsigned& nx) {
    const unsigned G = gridDim.x * gridDim.y * gridDim.z;
    unsigned sum, cnt, mine, sp = 0u;
    for (;;) {
        sum = 0u; cnt = 0u; mine = 0u;
#pragma unroll
        for (unsigned j = 0; j < 16; ++j) { const unsigned c = xb_ld(&bar[XB_XCNT(j)]); sum += c; cnt += (c > 0u) ? 1u : 0u; mine = (j == x) ? c : mine; }
        if (sum == G) break;
        __builtin_amdgcn_s_sleep(1);
        if ((++sp & 255u) == 0u) { if (xb_ld(&bar[XB_TMO])) break; if (sp > XB_SPIN_CAP) { atomicAdd(&bar[XB_TMO], 1u); break; } }
    }
    nloc = mine > 0u ? mine : 1u; nx = cnt > 0u ? cnt : 1u;
}

__device__ __forceinline__ void xcd_barrier(const XcdBarrier& b) {
    asm volatile("s_waitcnt vmcnt(0)" ::: "memory");
    __syncthreads();
    if (threadIdx.x == 0) {
        unsigned* bar = b.bar;
        __builtin_amdgcn_s_waitcnt(0);
        unsigned nloc = b.st[0], nx = b.st[1];
        if (nloc == 0u) { xcd_barrier_complete(bar, b.x, nloc, nx); b.st[0] = nloc; b.st[1] = nx; }
        const unsigned old = xb_add(&bar[XB_XSUB(b.x)], 1u);
        const unsigned gen = old / nloc;
        if (old + 1u == (gen + 1u) * nloc) {
            __builtin_amdgcn_fence(__ATOMIC_RELEASE, "agent");
            asm volatile("s_waitcnt vmcnt(0)" ::: "memory");
            const unsigned og = xb_add(&bar[XB_TOP], 1u);
            const unsigned tg = og / nx;
            if (og + 1u == (tg + 1u) * nx) xb_add(&bar[XB_TOPGEN], 1u);
            else XB_SPIN(xb_ld(&bar[XB_TOPGEN]) == tg, bar);
            __builtin_amdgcn_fence(__ATOMIC_ACQUIRE, "agent");
            xb_add(&bar[XB_XGEN(b.x)], 1u);
            asm volatile("s_waitcnt vmcnt(0)" ::: "memory");
        } else {
            XB_SPIN(xb_ld(&bar[XB_XGEN(b.x)]) == gen, bar);
            __builtin_amdgcn_fence(__ATOMIC_ACQUIRE, "agent");
            asm volatile("s_waitcnt vmcnt(0)" ::: "memory");
        }
    }
    __syncthreads();
}

namespace fa {
typedef short bf16x8 __attribute__((ext_vector_type(8)));
typedef short s16x4 __attribute__((ext_vector_type(4)));
typedef float f32x16 __attribute__((ext_vector_type(16)));
typedef unsigned u32x4 __attribute__((ext_vector_type(4)));
typedef unsigned u32x2 __attribute__((ext_vector_type(2)));
typedef unsigned short bf16;
#define FA_SBAR() __builtin_amdgcn_sched_barrier(0)
__device__ __forceinline__ int lane_opaque() { int l = (int)__builtin_amdgcn_mbcnt_hi(~0u, __builtin_amdgcn_mbcnt_lo(~0u, 0u)); asm volatile("" : "+v"(l)); return l; }
__device__ __forceinline__ float shx(float v, int m, int l) { return __int_as_float(__builtin_amdgcn_ds_bpermute((l ^ m) << 2, __float_as_int(v))); }
__device__ __forceinline__ int crow(int r, int hi) { return (r & 3) + 8 * (r >> 2) + 4 * hi; }
__device__ __forceinline__ unsigned cvtpk(float lo, float hi) { unsigned r; asm volatile("v_cvt_pk_bf16_f32 %0, %1, %2" : "=v"(r) : "v"(lo), "v"(hi)); return r; }
__device__ __forceinline__ int v_st(int k, int c) { const int kk = (k & ~0xC) | ((k & 4) << 1) | ((k & 8) >> 1); return ((kk >> 3) * 4 + (c >> 5)) * 512 + ((kk & 7) * 32 + (c & 31)) * 2; }
__device__ __forceinline__ int v_rd_base(int lane) { return ((lane & 3) << 3) | (((lane >> 2) & 3) << 6) | (((lane >> 4) & 1) << 5) | (((lane >> 5) & 1) << 8); }
constexpr int v_rd_off(int d0, int ks, int half) { return d0 * 512 + ks * 4096 + half * 2048; }
template <int OFF> __device__ __forceinline__ s16x4 tr_read(int vb) { s16x4 r; asm volatile("ds_read_b64_tr_b16 %0, %1 offset:%2" : "=&v"(r) : "v"(vb), "i"(OFF) : "memory"); return r; }
template <int D0> __device__ __forceinline__ void pv_one(f32x16& od, int vb, bf16x8 pa0, bf16x8 pa1, bf16x8 pa2, bf16x8 pa3) {
    const s16x4 l0 = tr_read<v_rd_off(D0, 0, 0)>(vb), h0 = tr_read<v_rd_off(D0, 0, 1)>(vb), l1 = tr_read<v_rd_off(D0, 1, 0)>(vb), h1 = tr_read<v_rd_off(D0, 1, 1)>(vb);
    const s16x4 l2 = tr_read<v_rd_off(D0, 2, 0)>(vb), h2 = tr_read<v_rd_off(D0, 2, 1)>(vb), l3 = tr_read<v_rd_off(D0, 3, 0)>(vb), h3 = tr_read<v_rd_off(D0, 3, 1)>(vb);
    asm volatile("s_waitcnt lgkmcnt(0)" ::: "memory"); FA_SBAR();
#define FA_PK(L, H) (bf16x8){L[0], L[1], L[2], L[3], H[0], H[1], H[2], H[3]}
    od = __builtin_amdgcn_mfma_f32_32x32x16_bf16(pa0, FA_PK(l0, h0), od, 0, 0, 0);
    od = __builtin_amdgcn_mfma_f32_32x32x16_bf16(pa1, FA_PK(l1, h1), od, 0, 0, 0);
    od = __builtin_amdgcn_mfma_f32_32x32x16_bf16(pa2, FA_PK(l2, h2), od, 0, 0, 0);
    od = __builtin_amdgcn_mfma_f32_32x32x16_bf16(pa3, FA_PK(l3, h3), od, 0, 0, 0);
#undef FA_PK
}
__device__ __forceinline__ void pv_d0(f32x16* o, int vb, bf16x8 pa0, bf16x8 pa1, bf16x8 pa2, bf16x8 pa3) {
    pv_one<0>(o[0], vb, pa0, pa1, pa2, pa3); pv_one<1>(o[1], vb, pa0, pa1, pa2, pa3); pv_one<2>(o[2], vb, pa0, pa1, pa2, pa3); pv_one<3>(o[3], vb, pa0, pa1, pa2, pa3);
}
struct VFrag { s16x4 l0, h0, l1, h1, l2, h2, l3, h3; };
template <int D0> __device__ __forceinline__ void pv_rd(VFrag& f, int vb) {
    f.l0 = tr_read<v_rd_off(D0, 0, 0)>(vb); f.h0 = tr_read<v_rd_off(D0, 0, 1)>(vb); f.l1 = tr_read<v_rd_off(D0, 1, 0)>(vb); f.h1 = tr_read<v_rd_off(D0, 1, 1)>(vb);
    f.l2 = tr_read<v_rd_off(D0, 2, 0)>(vb); f.h2 = tr_read<v_rd_off(D0, 2, 1)>(vb); f.l3 = tr_read<v_rd_off(D0, 3, 0)>(vb); f.h3 = tr_read<v_rd_off(D0, 3, 1)>(vb);
}
__device__ __forceinline__ void pv_mm(f32x16& od, const VFrag& f, bf16x8 pa0, bf16x8 pa1, bf16x8 pa2, bf16x8 pa3) {
#define FA_PK(L, H) (bf16x8){L[0], L[1], L[2], L[3], H[0], H[1], H[2], H[3]}
    od = __builtin_amdgcn_mfma_f32_32x32x16_bf16(pa0, FA_PK(f.l0, f.h0), od, 0, 0, 0);
    od = __builtin_amdgcn_mfma_f32_32x32x16_bf16(pa1, FA_PK(f.l1, f.h1), od, 0, 0, 0);
    od = __builtin_amdgcn_mfma_f32_32x32x16_bf16(pa2, FA_PK(f.l2, f.h2), od, 0, 0, 0);
    od = __builtin_amdgcn_mfma_f32_32x32x16_bf16(pa3, FA_PK(f.l3, f.h3), od, 0, 0, 0);
#undef FA_PK
}
__device__ __forceinline__ void pv_pipe(f32x16* o, int vb, bf16x8 pa0, bf16x8 pa1, bf16x8 pa2, bf16x8 pa3) {
    VFrag fa, fb;
    pv_rd<0>(fa, vb); pv_rd<1>(fb, vb);
    asm volatile("s_waitcnt lgkmcnt(8)" ::: "memory"); FA_SBAR(); pv_mm(o[0], fa, pa0, pa1, pa2, pa3); FA_SBAR();
    pv_rd<2>(fa, vb);
    asm volatile("s_waitcnt lgkmcnt(8)" ::: "memory"); FA_SBAR(); pv_mm(o[1], fb, pa0, pa1, pa2, pa3); FA_SBAR();
    pv_rd<3>(fb, vb);
    asm volatile("s_waitcnt lgkmcnt(8)" ::: "memory"); FA_SBAR(); pv_mm(o[2], fa, pa0, pa1, pa2, pa3); FA_SBAR();
    asm volatile("s_waitcnt lgkmcnt(0)" ::: "memory"); FA_SBAR(); pv_mm(o[3], fb, pa0, pa1, pa2, pa3); FA_SBAR();
}
struct UnitP {
    const bf16* Q; size_t ldq;
    const bf16* K; size_t ldk;
    const bf16* V; size_t ldv;
    int q0;
    int kt0, kt1;
    float sl2;
    float c2;
    const unsigned* mask;
};
constexpr int WIN = 128;
constexpr float THR2 = 11.5f;
template <int DQK, bool WINDOW, bool ALIBI, bool MASK, bool ROPEQ>
__device__ __forceinline__ void attn_unit(const UnitP& U, LAS unsigned char* lds, f32x16 (&o)[4], float& lse2) {
    constexpr int KROWB = DQK * 2, SHM_V = 16384, SHM_K = 64 * KROWB, KOFF = 2 * SHM_V, WSOFF = KOFF + 2 * 64 * 192 * 2;
    constexpr int KCH = DQK / 8, KPT = 64 * KCH / 512, ND0 = DQK / 16;
    int tid_o_ = threadIdx.x; asm volatile("" : "+v"(tid_o_)); const int tid = tid_o_, wid = __builtin_amdgcn_readfirstlane(tid >> 6), lane = tid & 63, r32 = lane & 31, hi = lane >> 5;
    LAS float* wsf = (LAS float*)(lds + WSOFF + wid * 256);
    float m_reg = -1e30f, l_reg = 0.f;
#pragma unroll
    for (int d = 0; d < 4; ++d)
#pragma unroll
        for (int r = 0; r < 16; ++r) o[d][r] = 0.f;
    bf16x8 qr[ND0];
    const int qi = U.q0 + wid * 32 + r32;
    {   const bf16* Qw = U.Q + (size_t)(wid * 32 + r32) * U.ldq + hi * 8;
#pragma unroll
        for (int d0 = 0; d0 < ND0; ++d0) qr[d0] = *(const bf16x8*)(Qw + d0 * 16);
        if constexpr (ROPEQ) {
#pragma unroll
            for (int pb = 0; pb < 2; ++pb) { bf16x8 a = qr[ND0 - 4 + pb], b = qr[ND0 - 2 + pb];
#pragma unroll
                for (int e = 0; e < 8; ++e) { const int fi = pb * 16 + hi * 8 + e; const float inv = __builtin_amdgcn_exp2f(-0.41524101186092029f * (float)fi);
                    const float ang = (float)qi * inv; const float n = rintf(ang * 0.15915494309189535f);
                    float rr = fmaf(-n, 6.2831854820251465f, ang); rr = fmaf(-n, -1.7484555e-07f, rr); const float fr = rr * 0.15915494309189535f;
                    const float sn = __builtin_amdgcn_sinf(fr), cs = __builtin_amdgcn_cosf(fr);
                    const float x1 = __uint_as_float((unsigned)(unsigned short)a[e] << 16), x2 = __uint_as_float((unsigned)(unsigned short)b[e] << 16);
                    const unsigned w = cvtpk(x1 * cs - x2 * sn, x1 * sn + x2 * cs); a[e] = (short)(w & 0xffffu); b[e] = (short)(w >> 16); }
                qr[ND0 - 4 + pb] = a; qr[ND0 - 2 + pb] = b; }
        }
    }
    unsigned kgo[KPT], vgo[2];
#pragma unroll
    for (int i_ = 0; i_ < KPT; ++i_) { const int p_ = (wid + 8 * i_) * 1024 + lane * 16, row_ = p_ / KROWB, wi_ = (p_ % KROWB) ^ ((row_ & 7) << 4); kgo[i_] = (unsigned)((size_t)row_ * U.ldk * 2 + wi_); }
#pragma unroll
    for (int i_ = 0; i_ < 2; ++i_) { const int p_ = (wid + 8 * i_) * 1024 + lane * 16, sub_ = p_ >> 9, rem_ = p_ & 511, kk_ = (sub_ >> 2) * 8 + (rem_ >> 6), k_ = (kk_ & ~0xC) | ((kk_ & 4) << 1) | ((kk_ & 8) >> 1), col_ = (sub_ & 3) * 32 + ((rem_ & 63) >> 1);
        vgo[i_] = (unsigned)(((size_t)k_ * U.ldv + col_) * 2); }
#define FA_DMA(k0_, b_) do { const char* kg_ = (const char*)U.K + (size_t)(k0_) * U.ldk * 2; const char* vg_ = (const char*)U.V + (size_t)(k0_) * U.ldv * 2; \
        _Pragma("unroll") for (int i_ = 0; i_ < KPT; ++i_) __builtin_amdgcn_global_load_lds((const unsigned*)(kg_ + kgo[i_]), (LAS unsigned*)(lds + KOFF + (b_) * SHM_K + (wid + 8 * i_) * 1024), 16, 0, 0); \
        _Pragma("unroll") for (int i_ = 0; i_ < 2; ++i_) __builtin_amdgcn_global_load_lds((const unsigned*)(vg_ + vgo[i_]), (LAS unsigned*)(lds + (b_) * SHM_V + (wid + 8 * i_) * 1024), 16, 0, 0); } while (0)
    const int vb0 = (int)(unsigned)(uintptr_t)lds + v_rd_base(lane);
    const int NT = U.kt1 - U.kt0;
    const int qw0 = U.q0 + wid * 32, qw1 = qw0 + 31;
    u32x2 mw = {0u, 0u}, mwn = {0u, 0u};
    const unsigned* mrow = MASK ? U.mask + (size_t)(wid * 32 + r32) * 512 : nullptr;
    FA_DMA(U.kt0 * 64, 0); if constexpr (MASK) mw = *(const u32x2*)(mrow + U.kt0 * 2);
    asm volatile("s_waitcnt vmcnt(0)" ::: "memory"); __syncthreads();
    for (int jt = 0; jt < NT; ++jt) {
        const int k0 = (U.kt0 + jt) * 64, buf = jt & 1;
        const bool more = jt + 1 < NT;
        if (more) { FA_DMA(k0 + 64, buf ^ 1); if constexpr (MASK) mwn = *(const u32x2*)(mrow + (k0 >> 5) + 2); }
        const bool active = (k0 <= qw1) && (!WINDOW || (k0 + 63 >= qw0 - WIN));
        if (active) {
            f32x16 p0, p1;
#pragma unroll
            for (int r = 0; r < 16; ++r) { p0[r] = 0.f; p1[r] = 0.f; }
            const LAS unsigned char* kb = lds + KOFF + buf * SHM_K + r32 * KROWB; const int lp = (hi * 16) ^ ((r32 & 7) << 4);
            const LAS unsigned char* kq[4] = {kb + lp, kb + (lp ^ 32), kb + (lp ^ 64), kb + (lp ^ 96)};
#pragma unroll
            for (int d0 = 0; d0 < ND0; ++d0) {
                const bf16x8 b0 = *(const LAS bf16x8*)(kq[d0 & 3] + (d0 >> 2) * 128), b1 = *(const LAS bf16x8*)(kq[d0 & 3] + (d0 >> 2) * 128 + 32 * KROWB);
                p0 = __builtin_amdgcn_mfma_f32_32x32x16_bf16(b0, qr[d0], p0, 0, 0, 0);
                p1 = __builtin_amdgcn_mfma_f32_32x32x16_bf16(b1, qr[d0], p1, 0, 0, 0);
                if ((d0 & 3) == 3) FA_SBAR(); }
            const int lim = qi - k0 - 4 * hi;
            const float tb = ALIBI ? U.sl2 * (float)(-lim) : 0.f;
#pragma unroll
            for (int r = 0; r < 16; ++r) { const int c = (r & 3) + 8 * (r >> 2);
                if constexpr (ALIBI) { p0[r] = fmaf(p0[r], U.c2, fmaf((float)c, U.sl2, tb)); p1[r] = fmaf(p1[r], U.c2, fmaf((float)(c + 32), U.sl2, tb)); }
                else { p0[r] *= U.c2; p1[r] *= U.c2; } }
            const bool need_mask = (k0 + 63 > qw0) || (WINDOW && (k0 < qw1 - WIN));
            if (need_mask) {
#pragma unroll
                for (int r = 0; r < 16; ++r) { const int c = (r & 3) + 8 * (r >> 2); const int d0_ = lim - c, d1_ = lim - c - 32;
                    const bool ok0 = WINDOW ? ((unsigned)d0_ <= (unsigned)WIN) : (d0_ >= 0), ok1 = WINDOW ? ((unsigned)d1_ <= (unsigned)WIN) : (d1_ >= 0);
                    p0[r] = ok0 ? p0[r] : -INFINITY; p1[r] = ok1 ? p1[r] : -INFINITY; }
            }
            if constexpr (MASK) { const unsigned w0 = mw.x >> (4 * hi), w1 = mw.y >> (4 * hi);
#pragma unroll
                for (int r = 0; r < 16; ++r) { const int c = (r & 3) + 8 * (r >> 2);
                    const unsigned b0 = (unsigned)((int)(w0 << (31 - c)) >> 31), b1 = (unsigned)((int)(w1 << (31 - c)) >> 31);
                    p0[r] = __uint_as_float((__float_as_uint(p0[r]) & b0) | (0xff800000u & ~b0)); p1[r] = __uint_as_float((__float_as_uint(p1[r]) & b1) | (0xff800000u & ~b1)); }
            }
            FA_SBAR();
            float pmax = p0[0];
#pragma unroll
            for (int r = 1; r < 16; ++r) pmax = fmaxf(pmax, p0[r]);
#pragma unroll
            for (int r = 0; r < 16; ++r) pmax = fmaxf(pmax, p1[r]);
            { auto rr = __builtin_amdgcn_permlane32_swap(__float_as_uint(pmax), __float_as_uint(pmax), false, false); pmax = fmaxf(__uint_as_float(rr[0]), __uint_as_float(rr[1])); }
            float mn, alpha;
            if (__builtin_expect(__all(pmax - m_reg <= THR2), 1)) { mn = m_reg; alpha = 1.f; }
            else { mn = fmaxf(m_reg, pmax); alpha = __builtin_amdgcn_exp2f(m_reg - mn); m_reg = mn; }
            float ps = 0.f;
#pragma unroll
            for (int r = 0; r < 16; ++r) { p0[r] = __builtin_amdgcn_exp2f(p0[r] - mn); p1[r] = __builtin_amdgcn_exp2f(p1[r] - mn); ps += p0[r] + p1[r]; }
            { auto rr = __builtin_amdgcn_permlane32_swap(__float_as_uint(ps), __float_as_uint(ps), false, false); ps = __uint_as_float(rr[0]) + __uint_as_float(rr[1]); }
            l_reg = l_reg * alpha + ps;
            FA_SBAR();
            bf16x8 pa0, pa1, pa2, pa3;
#define FA_PK4(P, BASE, OUT) do { unsigned a0 = cvtpk(P[BASE + 0], P[BASE + 1]), a1 = cvtpk(P[BASE + 2], P[BASE + 3]);   \
    unsigned b0 = cvtpk(P[BASE + 4], P[BASE + 5]), b1 = cvtpk(P[BASE + 6], P[BASE + 7]);                              \
    auto r0 = __builtin_amdgcn_permlane32_swap(a0, b0, false, false); auto r1 = __builtin_amdgcn_permlane32_swap(a1, b1, false, false); \
    u32x4 w = {r0[0], r1[0], r0[1], r1[1]}; OUT = *reinterpret_cast<bf16x8*>(&w); } while (0)
            FA_PK4(p0, 0, pa0); FA_PK4(p0, 8, pa1); FA_PK4(p1, 0, pa2); FA_PK4(p1, 8, pa3);
#undef FA_PK4
            FA_SBAR();
            if (__any(alpha < 1.f)) { if (hi == 0) wsf[r32] = alpha; asm volatile("s_waitcnt lgkmcnt(0)" ::: "memory");
#pragma unroll
                for (int r = 0; r < 16; ++r) { const float al = wsf[crow(r, hi)];
#pragma unroll
                    for (int d = 0; d < 4; ++d) o[d][r] *= al; }
                asm volatile("s_waitcnt lgkmcnt(0)" ::: "memory"); }
            pv_d0(o, vb0 + buf * SHM_V, pa0, pa1, pa2, pa3);
        }
        if (more) { if constexpr (MASK) mw = mwn; }
        asm volatile("s_waitcnt vmcnt(0)" ::: "memory");
        __syncthreads();
    }
    if (hi == 0) wsf[32 + r32] = l_reg; asm volatile("s_waitcnt lgkmcnt(0)" ::: "memory");
#pragma unroll
    for (int r = 0; r < 16; ++r) { const float rl = __builtin_amdgcn_rcpf(wsf[32 + crow(r, hi)]);
#pragma unroll
        for (int d = 0; d < 4; ++d) o[d][r] *= rl; }
    asm volatile("s_waitcnt lgkmcnt(0)" ::: "memory");
    lse2 = m_reg + __builtin_amdgcn_logf(l_reg);
#undef FA_DMA
}
template <int DQK, bool ALIBI, bool MASK, bool ROPEQ>
__device__ __forceinline__ void attn_unit4(const UnitP& U, LAS unsigned char* lds, f32x16 (&o)[4], float& lse2) {
    constexpr int KROWB = DQK * 2, SHM_V = 16384, SHM_K = 64 * KROWB, KOFF = 3 * SHM_V, WSOFF = KOFF + 3 * 64 * 192 * 2, AUGOFF = WSOFF + 2048;
    constexpr int KCH = DQK / 8, KPT = 64 * KCH / 512, ND0 = DQK / 16;
#define FA4_SWZ(row_) ((KROWB == 256) ? (((row_) & 15) << 4) : ((((row_) >> 1) & 7) << 4))
    int tid_o_ = threadIdx.x; asm volatile("" : "+v"(tid_o_)); const int tid = tid_o_, wid = __builtin_amdgcn_readfirstlane(tid >> 6), lane = tid & 63, r32 = lane & 31, hi = lane >> 5;
    LAS float* wsf = (LAS float*)(lds + WSOFF + wid * 256);
    float m_reg = -1e30f, l_reg = 0.f;
#pragma unroll
    for (int d = 0; d < 4; ++d)
#pragma unroll
        for (int r = 0; r < 16; ++r) o[d][r] = 0.f;
    bf16x8 qr[ND0];
    const int qi = U.q0 + wid * 32 + r32;
    {   const bf16* Qw = U.Q + (size_t)(wid * 32 + r32) * U.ldq + hi * 8;
#pragma unroll
        for (int d0 = 0; d0 < ND0; ++d0) qr[d0] = *(const bf16x8*)(Qw + d0 * 16);
        if constexpr (ROPEQ) {
#pragma unroll
            for (int pb = 0; pb < 2; ++pb) { bf16x8 a = qr[ND0 - 4 + pb], b = qr[ND0 - 2 + pb];
#pragma unroll
                for (int e = 0; e < 8; ++e) { const int fi = pb * 16 + hi * 8 + e; const float inv = __builtin_amdgcn_exp2f(-0.41524101186092029f * (float)fi);
                    const float ang = (float)qi * inv; const float n = rintf(ang * 0.15915494309189535f);
                    float rr = fmaf(-n, 6.2831854820251465f, ang); rr = fmaf(-n, -1.7484555e-07f, rr); const float fr = rr * 0.15915494309189535f;
                    const float sn = __builtin_amdgcn_sinf(fr), cs = __builtin_amdgcn_cosf(fr);
                    const float x1 = __uint_as_float((unsigned)(unsigned short)a[e] << 16), x2 = __uint_as_float((unsigned)(unsigned short)b[e] << 16);
                    const unsigned w = cvtpk(x1 * cs - x2 * sn, x1 * sn + x2 * cs); a[e] = (short)(w & 0xffffu); b[e] = (short)(w >> 16); }
                qr[ND0 - 4 + pb] = a; qr[ND0 - 2 + pb] = b; }
        }
    }
    bf16x8 qaug = {0, 0, 0, 0, 0, 0, 0, 0};
    if constexpr (ALIBI) { const float g_ = U.sl2 / U.c2; const unsigned gh_ = (__float_as_uint(g_) + 0x7fffu + ((__float_as_uint(g_) >> 16) & 1u)) & 0xffff0000u; const float gl_ = g_ - __uint_as_float(gh_);
        const unsigned glb_ = (__float_as_uint(gl_) + 0x7fffu + ((__float_as_uint(gl_) >> 16) & 1u)) & 0xffff0000u;
        const unsigned w0_ = (__float_as_uint(-128.f * __uint_as_float(gh_)) >> 16) | (__float_as_uint(-__uint_as_float(gh_)) & 0xffff0000u);
        const unsigned w1_ = (__float_as_uint(-128.f * __uint_as_float(glb_)) >> 16) | (__float_as_uint(-__uint_as_float(glb_)) & 0xffff0000u);
        const u32x4 qa_ = {hi ? 0u : w0_, hi ? 0u : w1_, 0u, 0u}; qaug = *reinterpret_cast<const bf16x8*>(&qa_); }
    const LAS unsigned char* augp = lds + AUGOFF + r32 * 32 + hi * 16;
    unsigned kgo[KPT], vgo[2];
#pragma unroll
    for (int i_ = 0; i_ < KPT; ++i_) { const int p_ = (wid + 8 * i_) * 1024 + lane * 16, row_ = p_ / KROWB, wi_ = (p_ % KROWB) ^ FA4_SWZ(row_); kgo[i_] = (unsigned)((size_t)row_ * U.ldk * 2 + wi_); }
#pragma unroll
    for (int i_ = 0; i_ < 2; ++i_) { const int p_ = (wid + 8 * i_) * 1024 + lane * 16, sub_ = p_ >> 9, rem_ = p_ & 511, kk_ = (sub_ >> 2) * 8 + (rem_ >> 6), k_ = (kk_ & ~0xC) | ((kk_ & 4) << 1) | ((kk_ & 8) >> 1), col_ = (sub_ & 3) * 32 + ((rem_ & 63) >> 1);
        vgo[i_] = (unsigned)(((size_t)k_ * U.ldv + col_) * 2); }
#define FA3_DMA(k0_, kb_, vb_) do { const char* kg_ = (const char*)U.K + (size_t)(k0_) * U.ldk * 2; const char* vg_ = (const char*)U.V + (size_t)(k0_) * U.ldv * 2; \
        _Pragma("unroll") for (int i_ = 0; i_ < KPT; ++i_) __builtin_amdgcn_global_load_lds((const unsigned*)(kg_ + kgo[i_]), (LAS unsigned*)(lds + KOFF + (kb_) * SHM_K + (wid + 8 * i_) * 1024), 16, 0, 0); \
        _Pragma("unroll") for (int i_ = 0; i_ < 2; ++i_) __builtin_amdgcn_global_load_lds((const unsigned*)(vg_ + vgo[i_]), (LAS unsigned*)(lds + (vb_) * SHM_V + (wid + 8 * i_) * 1024), 16, 0, 0); \
        if constexpr (ALIBI) { if (tid < 128) { const int rel_ = U.q0 + 255 - ((k0_) + (tid >> 1)); const unsigned ab_ = (__float_as_uint((float)(rel_ >> 7)) >> 16) | (__float_as_uint((float)(rel_ & 127)) & 0xffff0000u); \
            const unsigned z_ = (tid & 1) ? 0u : ab_; *(LAS u32x4*)(lds + AUGOFF + (kb_) * 2048 + tid * 16) = (u32x4){z_, z_, 0u, 0u}; } } } while (0)
    const int vb0 = (int)(unsigned)(uintptr_t)lds + v_rd_base(lane);
    const int NT = U.kt1 - U.kt0;
    const int qw0 = U.q0 + wid * 32, qw1 = qw0 + 31;
    const int swz_ = FA4_SWZ(r32); const int lp = (hi * 16) ^ (swz_ & 0x70); const int hsw = (KROWB == 256) ? (swz_ & 0x80) : 0;
    const LAS unsigned char* kbase = lds + KOFF + r32 * KROWB;
    const LAS unsigned char* kq0 = kbase + lp; const LAS unsigned char* kq1 = kbase + (lp ^ 32); const LAS unsigned char* kq2 = kbase + (lp ^ 64); const LAS unsigned char* kq3 = kbase + (lp ^ 96);
    bf16x8 pa0, pa1, pa2, pa3;
#define FA3_PK4(P, BASE, OUT) do { unsigned a0 = cvtpk(P[BASE + 0], P[BASE + 1]), a1 = cvtpk(P[BASE + 2], P[BASE + 3]);   \
    unsigned b0 = cvtpk(P[BASE + 4], P[BASE + 5]), b1 = cvtpk(P[BASE + 6], P[BASE + 7]);                              \
    auto r0 = __builtin_amdgcn_permlane32_swap(a0, b0, false, false); auto r1 = __builtin_amdgcn_permlane32_swap(a1, b1, false, false); \
    u32x4 w = {r0[0], r1[0], r0[1], r1[1]}; OUT = *reinterpret_cast<bf16x8*>(&w); } while (0)
#define FA3_SCORE(kb_, k0_, MW) do { f32x16 p0, p1; _Pragma("unroll") for (int r = 0; r < 16; ++r) { p0[r] = 0.f; p1[r] = 0.f; } const int so_ = (kb_) * SHM_K; \
          \
        bf16x8 kfa_[ND0], kfb_[ND0]; bf16x8 a0_ = qaug, a1_ = qaug; \
        _Pragma("unroll") for (int d0 = 0; d0 < ND0 + 2; ++d0) { \
            if (d0 < ND0) { const LAS unsigned char* kp_ = ((d0 & 3) == 0 ? kq0 : (d0 & 3) == 1 ? kq1 : (d0 & 3) == 2 ? kq2 : kq3) + so_ + ((KROWB == 256) ? (((d0 >> 2) * 128) ^ hsw) : (d0 >> 2) * 128); \
                kfa_[d0] = *(const LAS bf16x8*)(kp_); kfb_[d0] = *(const LAS bf16x8*)(kp_ + 32 * KROWB); } \
            if constexpr (ALIBI) { if (d0 == ND0) { a0_ = *(const LAS bf16x8*)(augp + (kb_) * 2048); a1_ = *(const LAS bf16x8*)(augp + (kb_) * 2048 + 1024); } } \
            FA_SBAR(); \
            if (d0 >= 2) { p0 = __builtin_amdgcn_mfma_f32_32x32x16_bf16(kfa_[d0 - 2], qr[d0 - 2], p0, 0, 0, 0); p1 = __builtin_amdgcn_mfma_f32_32x32x16_bf16(kfb_[d0 - 2], qr[d0 - 2], p1, 0, 0, 0); } \
            FA_SBAR(); } \
        if constexpr (ALIBI) { p0 = __builtin_amdgcn_mfma_f32_32x32x16_bf16(a0_, qaug, p0, 0, 0, 0); p1 = __builtin_amdgcn_mfma_f32_32x32x16_bf16(a1_, qaug, p1, 0, 0, 0); } \
        const int lim_ = qi - (k0_) - 4 * hi; \
        if ((k0_) + 63 > qw0) { _Pragma("unroll") for (int r = 0; r < 16; ++r) { const int c = (r & 3) + 8 * (r >> 2); p0[r] = (lim_ - c >= 0) ? p0[r] : -INFINITY; p1[r] = (lim_ - c - 32 >= 0) ? p1[r] : -INFINITY; } } \
        if constexpr (MASK) { const unsigned w0_ = MW.x >> (4 * hi), w1_ = MW.y >> (4 * hi); \
            _Pragma("unroll") for (int r = 0; r < 16; ++r) { const int c = (r & 3) + 8 * (r >> 2); \
                const unsigned b0_ = (unsigned)((int)(w0_ << (31 - c)) >> 31), b1_ = (unsigned)((int)(w1_ << (31 - c)) >> 31); \
                p0[r] = __uint_as_float((__float_as_uint(p0[r]) & b0_) | (0xff800000u & ~b0_)); p1[r] = __uint_as_float((__float_as_uint(p1[r]) & b1_) | (0xff800000u & ~b1_)); } } \
        FA_SBAR(); \
        float pmax_ = p0[0]; \
        _Pragma("unroll") for (int r = 1; r < 16; ++r) pmax_ = fmaxf(pmax_, p0[r]); \
        _Pragma("unroll") for (int r = 0; r < 16; ++r) pmax_ = fmaxf(pmax_, p1[r]); \
        { auto rr = __builtin_amdgcn_permlane32_swap(__float_as_uint(pmax_), __float_as_uint(pmax_), false, false); pmax_ = fmaxf(__uint_as_float(rr[0]), __uint_as_float(rr[1])); } \
        pmax_ *= U.c2; float mn_, alpha_; \
        if (__builtin_expect(__all(pmax_ - m_reg <= THR2), 1)) { mn_ = m_reg; alpha_ = 1.f; } \
        else { mn_ = fmaxf(m_reg, pmax_); alpha_ = __builtin_amdgcn_exp2f(m_reg - mn_); m_reg = mn_; } \
        float ps_ = 0.f; \
        _Pragma("unroll") for (int r = 0; r < 16; ++r) { p0[r] = __builtin_amdgcn_exp2f(fmaf(p0[r], U.c2, -mn_)); p1[r] = __builtin_amdgcn_exp2f(fmaf(p1[r], U.c2, -mn_)); ps_ += p0[r] + p1[r]; } \
        { auto rr = __builtin_amdgcn_permlane32_swap(__float_as_uint(ps_), __float_as_uint(ps_), false, false); ps_ = __uint_as_float(rr[0]) + __uint_as_float(rr[1]); } \
        l_reg = l_reg * alpha_ + ps_; \
        FA_SBAR(); \
        FA3_PK4(p0, 0, pa0); FA3_PK4(p0, 8, pa1); FA3_PK4(p1, 0, pa2); FA3_PK4(p1, 8, pa3); \
        FA_SBAR(); \
        if (__any(alpha_ < 1.f)) { if (hi == 0) wsf[r32] = alpha_; asm volatile("s_waitcnt lgkmcnt(0)" ::: "memory"); \
            _Pragma("unroll") for (int r = 0; r < 16; ++r) { const float al = wsf[crow(r, hi)]; _Pragma("unroll") for (int d = 0; d < 4; ++d) o[d][r] *= al; } \
            asm volatile("s_waitcnt lgkmcnt(0)" ::: "memory"); } } while (0)
    u32x2 mw = {0u, 0u}, mwn = {0u, 0u};
    const unsigned* mrow = MASK ? U.mask + (size_t)(wid * 32 + r32) * 512 : nullptr;
    FA3_DMA(U.kt0 * 64, 0, 0); if constexpr (MASK) mw = *(const u32x2*)(mrow + U.kt0 * 2);
    if (NT > 1) FA3_DMA(U.kt0 * 64 + 64, 1, 1);
    asm volatile("s_waitcnt vmcnt(0)" ::: "memory"); __syncthreads();
    int sl = 0;
#pragma nounroll
    for (int jt = 0; jt < NT; ++jt) {
        const int k0 = (U.kt0 + jt) * 64; const int s2 = sl == 0 ? 2 : sl - 1;
        if constexpr (MASK) { if (jt + 1 < NT) mwn = *(const u32x2*)(mrow + (k0 >> 5) + 2); }
        const bool more2 = jt + 2 < NT;
        if (more2) FA3_DMA(k0 + 128, s2, s2);
        if (k0 <= qw1) { FA3_SCORE(sl, k0, mw); pv_pipe(o, vb0 + sl * SHM_V, pa0, pa1, pa2, pa3); }
        if constexpr (MASK) mw = mwn;
        sl = sl == 2 ? 0 : sl + 1;
        if (more2) asm volatile("s_waitcnt vmcnt(%0)" :: "n"(KPT + 2) : "memory");
        else asm volatile("s_waitcnt vmcnt(0)" ::: "memory");
        __syncthreads();
    }
    if (hi == 0) wsf[32 + r32] = l_reg; asm volatile("s_waitcnt lgkmcnt(0)" ::: "memory");
#pragma unroll
    for (int r = 0; r < 16; ++r) { const float rl = __builtin_amdgcn_rcpf(wsf[32 + crow(r, hi)]);
#pragma unroll
        for (int d = 0; d < 4; ++d) o[d][r] *= rl; }
    asm volatile("s_waitcnt lgkmcnt(0)" ::: "memory");
    lse2 = m_reg + __builtin_amdgcn_logf(l_reg);
#undef FA3_DMA
#undef FA4_SWZ
#undef FA3_PK4
#undef FA3_SCORE
}
__device__ __forceinline__ void store_o_bf16(const f32x16 (&o)[4], bf16* outw, size_t ldo, int r32, int hi) {
    asm volatile("" : "+v"(r32), "+v"(hi));
    const bool odd = r32 & 1; const int lo_ = lane_opaque();
#pragma unroll
    for (int d0 = 0; d0 < 4; ++d0)
#pragma unroll
        for (int rp = 0; rp < 8; ++rp) { const int r0 = 2 * rp, r1 = 2 * rp + 1;
            float e0_ = o[d0][r0], e1_ = o[d0][r1]; asm("" : "+v"(e0_), "+v"(e1_));
            const float send = odd ? e0_ : e1_; const float recv = shx(send, 1, lo_);
            const unsigned w = odd ? cvtpk(recv, e1_) : cvtpk(e0_, recv);
            const int row = crow(odd ? r1 : r0, hi), col = d0 * 32 + (r32 & ~1);
            *(unsigned*)(outw + (size_t)row * ldo + col) = w; }
}
}
struct Frame {
    LAS unsigned char* lds;
    volatile LAS unsigned* MISC;
    gu32* ctl;
    int tid, lane, wave;
    int vcu, G, gw, NGW;
};
__device__ __forceinline__ float wave_sum(float v) {
    int l = (int)__builtin_amdgcn_mbcnt_hi(~0u, __builtin_amdgcn_mbcnt_lo(~0u, 0u)); asm volatile("" : "+v"(l));
#pragma unroll
    for (int o = 1; o < 64; o <<= 1) v += __int_as_float(__builtin_amdgcn_ds_bpermute((l ^ o) << 2, __float_as_int(v)));
    return v;
}
template <int MODE>
__device__ __forceinline__ void transpose_item(const float* W, int K, int N, int nblk, bf16* WT, const float* kscale, LAS float* scr, int item, int lane) {
    const int kb = item / nblk, nb = item % nblk, k0 = 64 * kb, n0 = 32 * nb;
    const int c4 = 4 * (lane & 7), nl = n0 + c4; const bool inb = nl < N;
    f32x4 v[8];
#pragma unroll
    for (int i = 0; i < 8; ++i) { const int kk = 8 * i + (lane >> 3); v[i] = inb ? *(const GAS f32x4*)(W + (size_t)(k0 + kk) * N + nl) : (f32x4){0.f, 0.f, 0.f, 0.f}; }
#pragma unroll
    for (int i = 0; i < 8; ++i) { const int kk = 8 * i + (lane >> 3); f32x4 x = v[i]; if (kscale) x = x * kscale[k0 + kk];
        LAS float* d = scr + kk * 33 + c4; d[0] = x[0]; d[1] = x[1]; d[2] = x[2]; d[3] = x[3]; }
    LDS_WAIT(); asm volatile("" ::: "memory");
    const int c = lane & 7;
#pragma unroll
    for (int j = 0; j < 4; ++j) { const int n = (lane >> 3) + 8 * j; const LAS float* s = scr + (8 * c) * 33 + n;
        v4u o; o.x = pk2(s[0 * 33], s[1 * 33]); o.y = pk2(s[2 * 33], s[3 * 33]); o.z = pk2(s[4 * 33], s[5 * 33]); o.w = pk2(s[6 * 33], s[7 * 33]);
        const int ng = n0 + n; const int drow = MODE == 0 ? ng : ((ng >> 7) * 256 + (ng & 127) + (MODE == 2 ? 128 : 0));
        *(GAS v4u*)(WT + (size_t)drow * K + k0 + 8 * c) = o; }
    LDS_WAIT(); asm volatile("" ::: "memory");
}
template <int MODE>
__device__ __forceinline__ void convert_weight(Frame& F, const float* W, int K, int N, int Npad, bf16* WT, const float* kscale) {
    LAS float* scr = (LAS float*)(F.lds + RING_OFF + F.wave * 16384);
    const int nblk = Npad / 32, nitems = (K / 64) * nblk;
    for (int it = F.gw; it < nitems; it += F.NGW) transpose_item<MODE>(W, K, N, nblk, WT, kscale, scr, it, F.lane);
}
__device__ __forceinline__ void convert_ffn(Frame& F, const float* wg, const float* wu, const float* wd, unsigned char* dst) {
    convert_weight<1>(F, wg, DM, DFF, DFF, (bf16*)dst, nullptr);
    convert_weight<2>(F, wu, DM, DFF, DFF, (bf16*)dst, nullptr);
    convert_weight<0>(F, wd, DFF, DM, DM, (bf16*)(dst + WF_DOWN_OFF), nullptr);
}
__device__ __forceinline__ void convert_x(Frame& F, const float* x, bf16* X) {
    const size_t n8 = (size_t)S * DM / 8;
    for (size_t i = (size_t)F.gw * 64 + F.lane; i < n8; i += (size_t)F.NGW * 64) {
        const f32x4 a = *(const GAS f32x4*)(x + i * 8), b = *(const GAS f32x4*)(x + i * 8 + 4);
        v4u o; o.x = pk2(a[0], a[1]); o.y = pk2(a[2], a[3]); o.z = pk2(b[0], b[1]); o.w = pk2(b[2], b[3]);
        *(GAS v4u*)(X + i * 8) = o; }
}
__device__ __forceinline__ void scale_x(Frame& F, const bf16* X, float* Y) {
    const size_t n8 = (size_t)S * DM / 8;
    for (size_t i = (size_t)F.gw * 64 + F.lane; i < n8; i += (size_t)F.NGW * 64) {
        const v4u w = *(const GAS v4u*)(X + i * 8);
        f32x4 a = {ALPHA * bflo(w.x), ALPHA * bfhi(w.x), ALPHA * bflo(w.y), ALPHA * bfhi(w.y)}, b = {ALPHA * bflo(w.z), ALPHA * bfhi(w.z), ALPHA * bflo(w.w), ALPHA * bfhi(w.w)};
        *(GAS f32x4*)(Y + i * 8) = a; *(GAS f32x4*)(Y + i * 8 + 4) = b; }
}
template <bool FINAL>
__device__ __forceinline__ void ln_phase(Frame& F, const bf16* Y, const float* g, const float* b, bf16* X, float* out) {
    for (int row = F.gw; row < S; row += F.NGW) {
        const GAS v4u* yr = (const GAS v4u*)(Y + (size_t)row * DM) + F.lane;
        float v[4][8]; float s = 0.f;
#pragma unroll
        for (int j = 0; j < 4; ++j) { const v4u w = yr[64 * j]; v[j][0] = bflo(w.x); v[j][1] = bfhi(w.x); v[j][2] = bflo(w.y); v[j][3] = bfhi(w.y); v[j][4] = bflo(w.z); v[j][5] = bfhi(w.z); v[j][6] = bflo(w.w); v[j][7] = bfhi(w.w);
#pragma unroll
            for (int e = 0; e < 8; ++e) s += v[j][e]; }
        const float mean = wave_sum(s) * (1.f / DM); float s2 = 0.f;
#pragma unroll
        for (int j = 0; j < 4; ++j)
#pragma unroll
            for (int e = 0; e < 8; ++e) { v[j][e] -= mean; s2 += v[j][e] * v[j][e]; }
        const float rstd = 1.f / sqrtf(wave_sum(s2) * (1.f / DM) + LN_EPS);
#pragma unroll
        for (int j = 0; j < 4; ++j) { const int c0 = 8 * (64 * j + F.lane);
            const f32x4 g0 = *(const GAS f32x4*)(g + c0), g1 = *(const GAS f32x4*)(g + c0 + 4), b0 = *(const GAS f32x4*)(b + c0), b1 = *(const GAS f32x4*)(b + c0 + 4);
            f32x4 o0, o1;
#pragma unroll
            for (int e = 0; e < 4; ++e) { o0[e] = v[j][e] * rstd * g0[e] + b0[e]; o1[e] = v[j][4 + e] * rstd * g1[e] + b1[e]; }
            if (FINAL) { *(GAS f32x4*)(out + (size_t)row * DM + c0) = o0; *(GAS f32x4*)(out + (size_t)row * DM + c0 + 4) = o1; }
            else { v4u w; w.x = pk2(o0[0], o0[1]); w.y = pk2(o0[2], o0[3]); w.z = pk2(o1[0], o1[1]); w.w = pk2(o1[2], o1[3]); *(GAS v4u*)(X + (size_t)row * DM + c0) = w; } }
    }
}
constexpr float LOG2E = 1.4426950408889634f;
__device__ __forceinline__ void mixer_a_phase(Frame& F, const bf16* P, bf16* OA, float* LSE) {
    const int wid = F.wave, r32 = F.lane & 31, hi = F.lane >> 5;
    for (int u = F.vcu; u < 1536; u += F.G) {
        const int g = u >> 9, rem = u & 511, h = rem >> 6, j = rem & 63;
        const int dsh = 2 * g, d = 1 << dsh, c = j >> (6 - dsh), blk = j & ((64 >> dsh) - 1), I0 = blk * 256;
        fa::UnitP U; U.ldq = U.ldk = U.ldv = (size_t)d * EINP;
        const bf16* base = P + (size_t)c * EINP + h * 128;
        U.Q = base + (size_t)I0 * U.ldq; U.K = base + 1024; U.V = base + 2048;
        U.q0 = I0; U.kt0 = I0 ? (I0 >> 6) - 2 : 0; U.kt1 = (I0 >> 6) + 4;
        U.sl2 = exp2f(-(float)(h + 1)) * (float)d * LOG2E; U.c2 = 0.08838834764831845f * LOG2E; U.mask = nullptr;
        fa::f32x16 o[4]; float lse2;
        fa::attn_unit<128, true, true, false, false>(U, F.lds, o, lse2);
        const int row0 = I0 + wid * 32;
        fa::store_o_bf16(o, OA + (size_t)g * S * 1024 + ((size_t)row0 * d + c) * 1024 + h * 128, (size_t)d * 1024, r32, hi);
        if (hi == 0) LSE[((size_t)g * S + (size_t)(row0 + r32) * d + c) * 8 + h] = lse2;
    }
}
__device__ __forceinline__ void merge_a(Frame& F, const bf16* OA, const float* LSE, bf16* O) {
    const int h = F.lane >> 3;
    for (int pos = F.gw; pos < S; pos += F.NGW) {
        const float l0 = LSE[((size_t)0 * S + pos) * 8 + h], l1 = LSE[((size_t)1 * S + pos) * 8 + h], l2 = LSE[((size_t)2 * S + pos) * 8 + h];
        const float mx = fmaxf(l0, fmaxf(l1, l2)); float w0 = exp2f(l0 - mx), w1 = exp2f(l1 - mx), w2 = exp2f(l2 - mx); const float inv = 1.f / (w0 + w1 + w2); w0 *= inv; w1 *= inv; w2 *= inv;
#pragma unroll
        for (int hf = 0; hf < 2; ++hf) { const size_t off = (size_t)pos * 1024 + 16 * F.lane + 8 * hf;
            const v4u a = *(const GAS v4u*)(OA + off), b = *(const GAS v4u*)(OA + (size_t)S * 1024 + off), c = *(const GAS v4u*)(OA + (size_t)2 * S * 1024 + off);
            v4u o;
            o.x = pk2(w0 * bflo(a.x) + w1 * bflo(b.x) + w2 * bflo(c.x), w0 * bfhi(a.x) + w1 * bfhi(b.x) + w2 * bfhi(c.x));
            o.y = pk2(w0 * bflo(a.y) + w1 * bflo(b.y) + w2 * bflo(c.y), w0 * bfhi(a.y) + w1 * bfhi(b.y) + w2 * bfhi(c.y));
            o.z = pk2(w0 * bflo(a.z) + w1 * bflo(b.z) + w2 * bflo(c.z), w0 * bfhi(a.z) + w1 * bfhi(b.z) + w2 * bfhi(c.z));
            o.w = pk2(w0 * bflo(a.w) + w1 * bflo(b.w) + w2 * bflo(c.w), w0 * bfhi(a.w) + w1 * bfhi(b.w) + w2 * bfhi(c.w));
            *(GAS v4u*)(O + (size_t)pos * DM + 16 * F.lane + 8 * hf) = o; }
    }
}
typedef float f32x16 __attribute__((ext_vector_type(16)));
__device__ __forceinline__ unsigned okey(float f) { const unsigned u = __float_as_uint(f); return (u & 0x80000000u) ? ~u : (u | 0x80000000u); }
__device__ __forceinline__ int hswz(int w) { return (w & ~31) | ((w ^ (w >> 5)) & 31); }
__device__ __forceinline__ void find_kth(const LAS unsigned* hq, int target, int lane, int& bin, int& above, int& binc) {
    unsigned w[32]; unsigned cl = 0;
#pragma unroll
    for (int i = 0; i < 32; ++i) { w[i] = hq[32 * lane + ((i ^ lane) & 31)]; cl += (w[i] & 0xffffu) + (w[i] >> 16); }
    unsigned suf = cl;
#pragma unroll
    for (int off = 1; off < 64; off <<= 1) { const unsigned t = __shfl_down(suf, off); if (lane + off < 64) suf += t; }
    const unsigned long long bal = __ballot((int)suf >= target);
    if (bal == 0ull) { bin = -1; above = 0; binc = 0; return; }
    const int L = 63 - __clzll((long long)bal);
    int cum = (int)(suf - cl), fb = -1, fab = 0, fc = 0;
#pragma unroll
    for (int i = 31; i >= 0; --i) { const int h16 = (int)(w[i] >> 16), l16 = (int)(w[i] & 0xffffu);
        if (fb < 0) { if (cum + h16 >= target) { fb = 2 * i + 1; fab = cum; fc = h16; } else { cum += h16; if (cum + l16 >= target) { fb = 2 * i; fab = cum; fc = l16; } else cum += l16; } } }
    bin = __shfl(fb, L) + 64 * L; above = __shfl(fab, L); binc = __shfl(fc, L);
}
__device__ __forceinline__ void indexer_unit(const bf16* P, unsigned* MASKB, unsigned* NEARBLK, LAS unsigned char* lds, int unit, int wid, int lane) {
    const int r32 = lane & 31, hi = lane >> 5, wu = unit * 8 + wid, q = 2 * wu + hi;
    LAS unsigned* hist = (LAS unsigned*)(lds + RING_OFF + wid * 16384);
    LAS unsigned char* ring = lds + KI_RING_OFF;
    bf16x8 af[4];
    {   const int jq = (r32 >> 2) & 1, head = (r32 & 3) + 4 * (r32 >> 3);
        const bf16* qrow = P + (size_t)(2 * wu + jq) * EINP + 6144 + head * 64 + hi * 8;
#pragma unroll
        for (int ks = 0; ks < 4; ++ks) af[ks] = *(const bf16x8*)(qrow + ks * 16); }
    float wq[16];
    {   const v4u a = *(const GAS v4u*)(P + (size_t)q * EINP + 7232), b = *(const GAS v4u*)(P + (size_t)q * EINP + 7240);
        wq[0] = bflo(a.x); wq[1] = bfhi(a.x); wq[2] = bflo(a.y); wq[3] = bfhi(a.y); wq[4] = bflo(a.z); wq[5] = bfhi(a.z); wq[6] = bflo(a.w); wq[7] = bfhi(a.w);
        wq[8] = bflo(b.x); wq[9] = bfhi(b.x); wq[10] = bflo(b.y); wq[11] = bfhi(b.y); wq[12] = bflo(b.z); wq[13] = bfhi(b.z); wq[14] = bflo(b.w); wq[15] = bfhi(b.w);
#pragma unroll
        for (int r = 0; r < 16; ++r) wq[r] *= 0.03125f; }
    const int NS = (16 * unit + 16 + 63) >> 6;
    const bool any256 = 16 * unit + 15 >= 255;
    const int prow = wid * 8 + (lane >> 3);
    const char* kgsrc = (const char*)(P + 7168) + (size_t)prow * EINP * 2 + (((lane & 7) * 16) ^ ((prow & 7) << 4));
    const int lp = (hi * 16) ^ ((r32 & 7) << 4);
    const int fo0 = r32 * 128 + lp, fo1 = r32 * 128 + (lp ^ 32), fo2 = r32 * 128 + (lp ^ 64), fo3 = r32 * 128 + (lp ^ 96);
#define IDX_DMA(s_) __builtin_amdgcn_global_load_lds((const unsigned*)(kgsrc + (size_t)(s_) * 64 * EINP * 2), (LAS unsigned*)(ring + ((s_) & 1) * 8192 + wid * 1024), 16, 0, 0)
#define IDX_SCORE2(slot_, keyA_, keyB_) do { const LAS unsigned char* fb_ = ring + (slot_) * 8192; \
        const bf16x8 b00_ = *(const LAS bf16x8*)(fb_ + fo0), b10_ = *(const LAS bf16x8*)(fb_ + 4096 + fo0), b01_ = *(const LAS bf16x8*)(fb_ + fo1), b11_ = *(const LAS bf16x8*)(fb_ + 4096 + fo1); \
        const bf16x8 b02_ = *(const LAS bf16x8*)(fb_ + fo2), b12_ = *(const LAS bf16x8*)(fb_ + 4096 + fo2), b03_ = *(const LAS bf16x8*)(fb_ + fo3), b13_ = *(const LAS bf16x8*)(fb_ + 4096 + fo3); \
        __builtin_amdgcn_sched_barrier(0); \
        f32x16 a0_, a1_; _Pragma("unroll") for (int r = 0; r < 16; ++r) { a0_[r] = 0.f; a1_[r] = 0.f; } \
        a0_ = __builtin_amdgcn_mfma_f32_32x32x16_bf16(af[0], b00_, a0_, 0, 0, 0); a1_ = __builtin_amdgcn_mfma_f32_32x32x16_bf16(af[0], b10_, a1_, 0, 0, 0); \
        a0_ = __builtin_amdgcn_mfma_f32_32x32x16_bf16(af[1], b01_, a0_, 0, 0, 0); a1_ = __builtin_amdgcn_mfma_f32_32x32x16_bf16(af[1], b11_, a1_, 0, 0, 0); \
        a0_ = __builtin_amdgcn_mfma_f32_32x32x16_bf16(af[2], b02_, a0_, 0, 0, 0); a1_ = __builtin_amdgcn_mfma_f32_32x32x16_bf16(af[2], b12_, a1_, 0, 0, 0); \
        a0_ = __builtin_amdgcn_mfma_f32_32x32x16_bf16(af[3], b03_, a0_, 0, 0, 0); a1_ = __builtin_amdgcn_mfma_f32_32x32x16_bf16(af[3], b13_, a1_, 0, 0, 0); \
        __builtin_amdgcn_sched_barrier(0); \
        float s0a_ = 0.f, s0b_ = 0.f, s1a_ = 0.f, s1b_ = 0.f, t0a_ = 0.f, t0b_ = 0.f, t1a_ = 0.f, t1b_ = 0.f; \
        _Pragma("unroll") for (int r = 0; r < 16; r += 2) { s0a_ = fmaf(wq[r], a0_[r], s0a_); s0b_ = fmaf(wq[r + 1], a0_[r + 1], s0b_); s1a_ = fmaf(wq[r], a1_[r], s1a_); s1b_ = fmaf(wq[r + 1], a1_[r + 1], s1b_); \
            t0a_ = fmaf(wq[r], __builtin_fabsf(a0_[r]), t0a_); t0b_ = fmaf(wq[r + 1], __builtin_fabsf(a0_[r + 1]), t0b_); t1a_ = fmaf(wq[r], __builtin_fabsf(a1_[r]), t1a_); t1b_ = fmaf(wq[r + 1], __builtin_fabsf(a1_[r + 1]), t1b_); \
            asm("" : "+v"(t0a_), "+v"(t0b_), "+v"(t1a_), "+v"(t1b_)); }   \
        keyA_ = okey((s0a_ + s0b_) + (t0a_ + t0b_)); keyB_ = okey((s1a_ + s1b_) + (t1a_ + t1b_)); } while (0)
#define IDX_ZERO() do { _Pragma("unroll") for (int i = 0; i < 16; ++i) ((LAS v4u*)hist)[i * 64 + lane] = (v4u){0u, 0u, 0u, 0u}; LDS_WAIT(); } while (0)
#define IDX_PASS(...) do { IDX_DMA(0); \
        for (int s_ = 0; s_ < NS; ++s_) { asm volatile("s_waitcnt vmcnt(0)" ::: "memory"); __builtin_amdgcn_s_barrier(); asm volatile("" ::: "memory"); \
            if (s_ + 1 < NS) IDX_DMA(s_ + 1); \
            unsigned keyA_, keyB_; IDX_SCORE2(s_ & 1, keyA_, keyB_); \
            { const int kt = 2 * s_; const unsigned key32 = keyA_; __VA_ARGS__ } { const int kt = 2 * s_ + 1; const unsigned key32 = keyB_; __VA_ARGS__ } } \
        __builtin_amdgcn_s_barrier(); } while (0)
    IDX_ZERO();
    IDX_PASS({ if (kt * 32 + r32 <= q) { const int bin = (int)(key32 >> 20); __hip_atomic_fetch_add(hist + hi * 2048 + hswz(bin >> 1), 1u << ((bin & 1) * 16), __ATOMIC_RELAXED, __HIP_MEMORY_SCOPE_WORKGROUP); } });
    LDS_WAIT();
    int b0, a0, c0, b1, a1, c1; find_kth(hist, 256, lane, b0, a0, c0); find_kth(hist + 2048, 256, lane, b1, a1, c1);
    const int mybin = hi ? b1 : b0;
    int last0 = 0, last1 = 0;
    constexpr int IDX_CAP = 384;
    volatile LAS unsigned* uflag = (volatile LAS unsigned*)(lds + MISC_OFF + 96);
    if ((b0 >= 0 && c0 > IDX_CAP) || (b1 >= 0 && c1 > IDX_CAP)) { if (lane == 0) *uflag = 1u; }
    LDS_WAIT(); __builtin_amdgcn_s_barrier(); asm volatile("" ::: "memory");
    const bool use_list = any256 && (*uflag == 0u);
    __builtin_amdgcn_s_barrier(); asm volatile("" ::: "memory");
    if (wid == 0 && lane == 0) *uflag = 0u;
    if (use_list) {
        LAS unsigned* rows = hist;
        LAS unsigned long long* lists = (LAS unsigned long long*)((LAS unsigned char*)hist + 4096);
        LAS unsigned* cnt = (LAS unsigned*)((LAS unsigned char*)hist + 4096 + 2 * IDX_CAP * 8);
#pragma unroll
        for (int i = 0; i < 4; ++i) ((LAS v4u*)rows)[i * 64 + lane] = (v4u){0u, 0u, 0u, 0u};
        if (lane < 4) cnt[lane] = 0u;
        LDS_WAIT();
        IDX_PASS({ const bool valid = kt * 32 + r32 <= q; const int bin = (int)(key32 >> 20);
                   const bool defin = valid && (mybin < 0 || bin > mybin); const bool amb = valid && mybin >= 0 && bin == mybin;
                   const unsigned long long bal = __ballot(defin); const unsigned w0_ = (unsigned)bal, w1_ = (unsigned)(bal >> 32);
                   if (w0_) last0 = kt * 32 + 31 - __clz((int)w0_); if (w1_) last1 = kt * 32 + 31 - __clz((int)w1_);
                   if (lane == 0) rows[kt] = w0_; if (lane == 32) rows[512 + kt] = w1_;
                   if (amb) { const unsigned idx = __hip_atomic_fetch_add(cnt + hi, 1u, __ATOMIC_RELAXED, __HIP_MEMORY_SCOPE_WORKGROUP);
                              if (idx < (unsigned)IDX_CAP) lists[hi * IDX_CAP + idx] = ((unsigned long long)key32 << 32) | (unsigned)(kt * 32 + r32); } });
        LDS_WAIT();
#pragma unroll
        for (int j = 0; j < 2; ++j) {
            const int bj = j ? b1 : b0; if (bj < 0) continue;
            const int n = (int)cnt[j] < IDX_CAP ? (int)cnt[j] : IDX_CAP, rsel = 256 - (j ? a1 : a0);
            const LAS unsigned long long* L = lists + j * IDX_CAP;
            for (int i0_ = 0; i0_ < n; i0_ += 64) { const int i = i0_ + lane; const unsigned long long mine = i < n ? L[i] : 0ull; int rank = 0;
                for (int t = 0; t < n; ++t) { const unsigned long long o = L[t];
                    rank += ((unsigned)(o >> 32) > (unsigned)(mine >> 32)) || ((unsigned)(o >> 32) == (unsigned)(mine >> 32) && (unsigned)o < (unsigned)mine) ? 1 : 0; }
                if (i < n && rank < rsel) { const unsigned pos = (unsigned)mine; __hip_atomic_fetch_or(rows + j * 512 + (pos >> 5), 1u << (pos & 31), __ATOMIC_RELAXED, __HIP_MEMORY_SCOPE_WORKGROUP);
                    __hip_atomic_fetch_max(cnt + 2 + j, pos, __ATOMIC_RELAXED, __HIP_MEMORY_SCOPE_WORKGROUP); } }
        }
        LDS_WAIT();
        { const int l0_ = (int)cnt[2], l1_ = (int)cnt[3]; if (l0_ > last0) last0 = l0_; if (l1_ > last1) last1 = l1_; }
#pragma unroll
        for (int i = 0; i < 4; ++i) { const v4u w = ((const LAS v4u*)rows)[i * 64 + lane]; *(GAS v4u*)(MASKB + (size_t)(2 * wu + (i >> 1)) * 512 + (i & 1) * 256 + lane * 4) = w; }
    } else {
        unsigned tau = 0u;
        if (any256) {
            IDX_ZERO();
            IDX_PASS({ if (kt * 32 + r32 <= q && (int)(key32 >> 20) == mybin) { const int bin = (int)((key32 >> 8) & 0xfffu); __hip_atomic_fetch_add(hist + hi * 2048 + hswz(bin >> 1), 1u << ((bin & 1) * 16), __ATOMIC_RELAXED, __HIP_MEMORY_SCOPE_WORKGROUP); } });
            LDS_WAIT();
            int s0 = 0, s1 = 0, t0, t1, u0, u1;
            if (b0 >= 0) find_kth(hist, 256 - a0, lane, s0, t0, u0);
            if (b1 >= 0) find_kth(hist + 2048, 256 - a1, lane, s1, t1, u1);
            const int mysub = hi ? s1 : s0;
            tau = mybin < 0 ? 0u : (((unsigned)mybin << 20) | ((unsigned)(mysub < 0 ? 0 : mysub) << 8));
        }
        IDX_PASS({ const bool sel = (kt * 32 + r32 <= q) && (key32 >= tau); const unsigned long long bal = __ballot(sel);
                   const unsigned w0_ = (unsigned)bal, w1_ = (unsigned)(bal >> 32);
                   if (w0_) last0 = kt * 32 + 31 - __clz((int)w0_); if (w1_) last1 = kt * 32 + 31 - __clz((int)w1_);
                   if (lane == 0) MASKB[(size_t)(2 * wu) * 512 + kt] = w0_;
                   if (lane == 32) MASKB[(size_t)(2 * wu + 1) * 512 + kt] = w1_; });
    }
    if (lane == 0) { const int d0_ = 2 * wu - last0, d1_ = 2 * wu + 1 - last1; atomicMax(NEARBLK + (wu >> 7), (unsigned)(d0_ > d1_ ? d0_ : d1_)); }
#undef IDX_DMA
#undef IDX_SCORE2
#undef IDX_ZERO
#undef IDX_PASS
}
__device__ __forceinline__ void indexer_phase(Frame& F, const bf16* P, unsigned* MASKB, unsigned* NEARBLK) {
    for (int i = 0;; ++i) { const int idx = F.vcu + i * F.G; if (idx >= 1024) break;
        const int seg = idx >> 8, r = idx & 255, unit = (seg & 1) ? (seg * 256 + 255 - r) : (seg * 256 + r);
        indexer_unit(P, MASKB, NEARBLK, F.lds, unit, F.wave, F.lane); }
}
__device__ __forceinline__ void b_norm_bounds(Frame& F, const bf16* P, unsigned* NRM) {
    float mx = 0.f;
    for (int s = F.gw; s < S; s += F.NGW) {
        const v4u* rp = (const v4u*)(P + (size_t)s * EINP + 3072 + 32 * F.lane); float ss = 0.f;
#pragma unroll
        for (int j = 0; j < 4; ++j) { const v4u w = rp[j];
            ss += bflo(w.x) * bflo(w.x) + bfhi(w.x) * bfhi(w.x) + bflo(w.y) * bflo(w.y) + bfhi(w.y) * bfhi(w.y) + bflo(w.z) * bflo(w.z) + bfhi(w.z) * bfhi(w.z) + bflo(w.w) * bflo(w.w) + bfhi(w.w) * bfhi(w.w); }
        ss += __shfl_xor(ss, 1); ss += __shfl_xor(ss, 2); mx = fmaxf(mx, ss); }
    if ((F.lane & 3) == 0) atomicMax(NRM + (F.lane >> 2), __float_as_uint(mx));
}
__device__ __forceinline__ void mixer_b_phase(Frame& F, const bf16* P, const unsigned* MASKB, bf16* O, const unsigned* NRM, const unsigned* NEARBLK, gu32* qctr) {
    const int wid = F.wave, r32 = F.lane & 31, hi = F.lane >> 5;
    for (;;) {
        if (F.tid == 0) F.MISC[16] = __hip_atomic_fetch_add(qctr, 1u, __ATOMIC_RELAXED, __HIP_MEMORY_SCOPE_AGENT);
        __syncthreads(); const int e = (int)F.MISC[16]; __syncthreads();
        if (e >= 512) break;
        const int h = 7 - (e >> 6), qb = 63 - (e & 63);
        fa::UnitP U; U.ldq = U.ldk = U.ldv = (size_t)EINP;
        U.Q = P + (size_t)(qb * 256) * EINP + 3072 + h * 128; U.K = P + 4096 + h * 128; U.V = P + 5120 + h * 128;
        U.q0 = qb * 256; U.kt0 = 0; U.kt1 = (qb + 1) * 4;
        U.sl2 = exp2f(-(float)(h + 1)) * LOG2E; U.c2 = 0.08838834764831845f * LOG2E; U.mask = MASKB + (size_t)(qb * 256) * 512;
        {
            const float B = sqrtf(__uint_as_float(NRM[h]) * __uint_as_float(NRM[8 + h])) * U.c2 * 1.01f;
            const float dmax = (2.f * B + 160.f) / U.sl2 + (float)NEARBLK[qb]; const float kmin = (float)U.q0 - dmax;
            if (kmin > 0.f) U.kt0 = (int)(kmin * (1.f / 64.f)); }
        fa::f32x16 o[4]; float lse2;
        fa::attn_unit4<128, true, true, false>(U, F.lds, o, lse2);
        fa::store_o_bf16(o, O + (size_t)(qb * 256 + wid * 32) * DM + 1024 + h * 128, (size_t)DM, r32, hi);
    }
}
__device__ __forceinline__ void kpe_fill(Frame& F, const bf16* P, bf16* KD) {
    const int h = F.lane >> 3, c = F.lane & 7, cc = c & 3;
    float inv[8];
#pragma unroll
    for (int e = 0; e < 8; ++e) inv[e] = exp2f(-0.41524101186092029f * (float)(8 * cc + e));
    for (int s = F.gw; s < S; s += F.NGW) {
        const bf16* kp = P + (size_t)s * OINP + 4352;
        const v4u a = *(const GAS v4u*)(kp + 8 * cc), b = *(const GAS v4u*)(kp + 32 + 8 * cc);
        const float x1[8] = {bflo(a.x), bfhi(a.x), bflo(a.y), bfhi(a.y), bflo(a.z), bfhi(a.z), bflo(a.w), bfhi(a.w)};
        const float x2[8] = {bflo(b.x), bfhi(b.x), bflo(b.y), bfhi(b.y), bflo(b.z), bfhi(b.z), bflo(b.w), bfhi(b.w)};
        float o[8];
#pragma unroll
        for (int e = 0; e < 8; ++e) { const float ang = (float)s * inv[e]; const float n = rintf(ang * 0.15915494309189535f);
            float rr = fmaf(-n, 6.2831854820251465f, ang); rr = fmaf(-n, -1.7484555e-07f, rr); const float fr = rr * 0.15915494309189535f;
            const float sn = __builtin_amdgcn_sinf(fr), cs = __builtin_amdgcn_cosf(fr);
            o[e] = c < 4 ? x1[e] * cs - x2[e] * sn : x1[e] * sn + x2[e] * cs; }
        v4u w; w.x = pk2(o[0], o[1]); w.y = pk2(o[2], o[3]); w.z = pk2(o[4], o[5]); w.w = pk2(o[6], o[7]);
        *(GAS v4u*)(KD + (size_t)s * 1536 + h * 192 + 128 + 8 * c) = w;
    }
}
__device__ __forceinline__ void c_norm_bounds(Frame& F, const bf16* P, unsigned* NRM) {
    float mx = 0.f;
    for (int s = F.gw; s < S; s += F.NGW) {
        const v4u* rp = (const v4u*)(P + (size_t)s * OINP + 32 * F.lane); float ss = 0.f;
#pragma unroll
        for (int j = 0; j < 4; ++j) { const v4u w = rp[j];
            ss += bflo(w.x) * bflo(w.x) + bfhi(w.x) * bfhi(w.x) + bflo(w.y) * bflo(w.y) + bfhi(w.y) * bfhi(w.y) + bflo(w.z) * bflo(w.z) + bfhi(w.z) * bfhi(w.z) + bflo(w.w) * bflo(w.w) + bfhi(w.w) * bfhi(w.w); }
        ss += __shfl_xor(ss, 1); mx = fmaxf(mx, ss); }
    if ((F.lane & 1) == 0) atomicMax(NRM + (F.lane >> 1), __float_as_uint(mx));
}
__device__ __forceinline__ void mixer_c_unit(Frame& F, const bf16* P, float lam, const float* subln_g, float lam_init, float* SCR, bf16* O, const unsigned* NRM, int h, int qb, int ord) {
    const int wid = F.wave, r32 = F.lane & 31, hi = F.lane >> 5;
    {
        int tq_ = F.tid; asm volatile("" : "+v"(tq_));
        f32x4* scr = (f32x4*)(SCR + (((size_t)(ord & 1) * F.G + blockIdx.x) * 512 + tq_) * 64);
        for (int sub = 0; sub < 2; ++sub) {
            fa::UnitP U; U.ldq = U.ldk = U.ldv = (size_t)OINP;
            U.Q = P + (size_t)(qb * 256) * OINP + h * 128 + sub * 64; U.K = P + 1024 + h * 128 + sub * 64; U.V = P + 2048 + h * 128;
            U.q0 = qb * 256; U.kt0 = 0; U.kt1 = (qb + 1) * 4;
            U.sl2 = exp2f(-(float)(h + 1)) * LOG2E; U.c2 = 0.125f * LOG2E; U.mask = nullptr;
            {
                const float B = sqrtf(__uint_as_float(NRM[h * 2 + sub]) * __uint_as_float(NRM[16 + h * 2 + sub])) * U.c2 * 1.01f;
                const float dmax = (2.f * B + 160.f) / U.sl2; const float kmin = (float)U.q0 - dmax;
                if (kmin > 0.f) U.kt0 = (int)(kmin * (1.f / 64.f)); }
            fa::f32x16 o[4]; float lse2;
            fa::attn_unit4<64, true, false, false>(U, F.lds, o, lse2);
            if (sub == 0) {
#pragma unroll
                for (int d = 0; d < 4; ++d)
#pragma unroll
                    for (int k = 0; k < 4; ++k) scr[d * 4 + k] = (f32x4){o[d][4 * k], o[d][4 * k + 1], o[d][4 * k + 2], o[d][4 * k + 3]};
            } else {
                float ss[16]; const int lo_ = fa::lane_opaque();
#pragma unroll
                for (int r = 0; r < 16; ++r) ss[r] = 0.f;
#pragma unroll
                for (int d = 0; d < 4; ++d)
#pragma unroll
                    for (int k = 0; k < 4; ++k) { const f32x4 s1 = scr[d * 4 + k];
#pragma unroll
                        for (int e2 = 0; e2 < 4; ++e2) { const int r = 4 * k + e2; const float v = s1[e2] - lam * o[d][r]; o[d][r] = v; ss[r] += v * v; } }
#pragma unroll
                for (int r = 0; r < 16; ++r) { float t = ss[r]; t += fa::shx(t, 1, lo_); t += fa::shx(t, 2, lo_); t += fa::shx(t, 4, lo_); t += fa::shx(t, 8, lo_); t += fa::shx(t, 16, lo_);
                    ss[r] = (1.0f - lam_init) / sqrtf(t * (1.0f / 128.0f) + DIFF_EPS); }
#pragma unroll
                for (int d = 0; d < 4; ++d) { const float gcol = subln_g[d * 32 + r32];
#pragma unroll
                    for (int r = 0; r < 16; ++r) o[d][r] *= ss[r] * gcol; }
                fa::store_o_bf16(o, O + (size_t)(qb * 256 + wid * 32) * DM + h * 128, (size_t)DM, r32, hi);
            }
        }
    }
}
__device__ __forceinline__ void mixer_d_unit(Frame& F, const bf16* QF, const bf16* KD, const bf16* VD, bf16* O, int h, int qb) {
    const int wid = F.wave, r32 = F.lane & 31, hi = F.lane >> 5;
    {
        fa::UnitP U; U.ldq = 1536; U.ldk = 1536; U.ldv = 1024;
        U.Q = QF + (size_t)(qb * 256) * 1536 + h * 192; U.K = KD + h * 192; U.V = VD + h * 128;
        U.q0 = qb * 256; U.kt0 = 0; U.kt1 = (qb + 1) * 4;
        U.sl2 = 0.f; U.c2 = 0.07216878364870322f * LOG2E; U.mask = nullptr;
        fa::f32x16 o[4]; float lse2;
        fa::attn_unit4<192, false, false, true>(U, F.lds, o, lse2);
        fa::store_o_bf16(o, O + (size_t)(qb * 256 + wid * 32) * DM + 1024 + h * 128, (size_t)DM, r32, hi);
    }
}
__device__ __forceinline__ void mixer_cd_phase(Frame& F, const bf16* P, const float* lam_p, const float* subln_g, float lam_init, float* SCR, const unsigned* NRM,
                                               const bf16* QF, const bf16* KD, const bf16* VD, bf16* O, gu32* qctr) {
    const float lam = expf(wave_sum(lam_p[F.lane] * lam_p[64 + F.lane])) - expf(wave_sum(lam_p[128 + F.lane] * lam_p[192 + F.lane])) + lam_init;
    int ord = 0;
    for (;;) {
        if (F.tid == 0) F.MISC[16] = __hip_atomic_fetch_add(qctr, 1u, __ATOMIC_RELAXED, __HIP_MEMORY_SCOPE_AGENT);
        __syncthreads(); const int e = (int)F.MISC[16]; __syncthreads();
        if (e >= 1024) break;
        const int idx = e >> 1;
        if ((e & 1) == 0) { mixer_c_unit(F, P, lam, subln_g, lam_init, SCR, O, NRM, 7 - (idx >> 6), 63 - (idx & 63), ord); ++ord; }
        else mixer_d_unit(F, QF, KD, VD, O, idx & 7, 63 - (idx >> 3));
    }
}
struct Args { const float* in[16]; float* out; unsigned char* ws; };
#define GRID_BAR() do { xcd_barrier(bar); int t_ = threadIdx.x; asm volatile("" : "+v"(t_)); F.tid = t_; F.lane = t_ & 63; } while (0)

#define FFN_PHASES(WF)                                                                                                           \
    {   pg8::Gemm g{X, (const bf16*)(WF), S, NGU, DM, DM}; pg8::StaticOrder So; So.init(S, NGU, F.G, (int)blockIdx.x);            \
        pg8::EpiSwiglu E{H, DFF};                                                                                                 \
        pg8::gemm_phase<pg8::EpiSwiglu, pg8::StaticOrder, true, true>(F.lds + RING_OFF, g, So, E); }                              \
    GRID_BAR();                                                                                                                   \
    {   pg8::Gemm g{H, (const bf16*)((WF) + WF_DOWN_OFF), S, DM, DFF, DFF}; pg8::StaticOrder So; So.init(S, DM, F.G, (int)blockIdx.x); \
        pg8::EpiResid E{X, Y, DM, ALPHA, 0.5f};                                                                                   \
        pg8::gemm_phase<pg8::EpiResid, pg8::StaticOrder, true, true>(F.lds + RING_OFF, g, So, E); }                               \
    GRID_BAR();

__global__ void __launch_bounds__(NWAVES * 64, 2) fwd_kernel(Args args) {
    extern __shared__ __attribute__((aligned(16))) unsigned char lds[];
    Frame F;
    F.lds = (LAS unsigned char*)lds;
    F.MISC = (volatile LAS unsigned*)(F.lds + MISC_OFF);
    F.tid = threadIdx.x; F.lane = F.tid & 63; F.wave = __builtin_amdgcn_readfirstlane(F.tid >> 6);
    F.G = gridDim.x; { const int bx = blockIdx.x; F.vcu = (F.G % 8 == 0) ? (bx % 8) * (F.G / 8) + bx / 8 : bx; }
    F.gw = F.vcu * NWAVES + F.wave; F.NGW = F.G * NWAVES;
    unsigned char* ws = args.ws;
    F.ctl = (gu32*)(ws + WS_CTL);
    for (int u = F.tid; u < (LDS_BYTES - LDSCTL_OFF) / 4; u += NWAVES * 64) ((LAS unsigned*)(F.lds + LDSCTL_OFF))[u] = 0u;
    __syncthreads();
    XcdBarrier bar = xcd_barrier_post((unsigned*)(F.ctl + CW_BAR), F.MISC + 8);

    const float* x_in = args.in[0];
    const float* w_gate = args.in[1]; const float* w_up = args.in[2]; const float* w_down = args.in[3];
    const float* ln_g = args.in[4]; const float* ln_b = args.in[5];
    bf16* X = (bf16*)(ws + WS_X); bf16* Y = (bf16*)(ws + WS_YB); bf16* H = (bf16*)(ws + WS_HP);
    bf16* P = (bf16*)(ws + WS_HP); bf16* O = (bf16*)(ws + WS_O);
    bf16* OA = (bf16*)(ws + WS_Y); unsigned* MASKB = (unsigned*)(ws + WS_Y + 96 * MiB); float* LSE = (float*)(ws + WS_LSE);
    bf16* QF = (bf16*)(ws + WS_Y); bf16* KD = (bf16*)(ws + WS_Y + 48 * MiB); bf16* VD = (bf16*)(ws + WS_Y + 96 * MiB);
    float* SQQ = (float*)(ws + (size_t)CW_SQQ * 4); float* SQKV = (float*)(ws + (size_t)CW_SQKV * 4);
    unsigned char* WFA = ws + WS_WFA; unsigned char* WFB = ws + WS_WFB;
    constexpr size_t GSZ = (size_t)DM * DFF;

    convert_ffn(F, w_gate + 0 * GSZ, w_up + 0 * GSZ, w_down + 0 * GSZ, WFA);
    convert_ffn(F, w_gate + 1 * GSZ, w_up + 1 * GSZ, w_down + 1 * GSZ, WFB);
    convert_weight<0>(F, args.in[6], DM, EIN, EINP, (bf16*)(ws + WS_WEIN), nullptr);
    convert_weight<0>(F, args.in[7], DM, DM, DM, (bf16*)(ws + WS_WEOUT), nullptr);
    convert_weight<0>(F, args.in[8], DM, OIN, OINP, (bf16*)(ws + WS_WOIN), nullptr);
    convert_weight<0>(F, args.in[9], DM, DM, DM, (bf16*)(ws + WS_WOOUT), nullptr);
    convert_weight<0>(F, args.in[14], 768, 1536, 1536, (bf16*)(ws + WS_WUQ), args.in[12]);
    convert_weight<0>(F, args.in[15], 512, 2048, 2048, (bf16*)(ws + WS_WUKV), args.in[13]);
    convert_x(F, x_in, X);
    GRID_BAR();
    FFN_PHASES(WFA)
    ln_phase<false>(F, Y, ln_g + 0 * DM, ln_b + 0 * DM, X, nullptr);
    convert_ffn(F, w_gate + 2 * GSZ, w_up + 2 * GSZ, w_down + 2 * GSZ, WFA);
    GRID_BAR();
    {
        pg8::Gemm g{X, (const bf16*)(ws + WS_WEIN), S, EINP, DM, DM}; pg8::StaticOrder So; So.init(S, EINP, F.G, (int)blockIdx.x);
        pg8::EpiBf16 E{P, EINP, nullptr, 0, 0, nullptr, 0, 0};
        pg8::gemm_phase<pg8::EpiBf16, pg8::StaticOrder, true, true>(F.lds + RING_OFF, g, So, E); }
    GRID_BAR();
    mixer_a_phase(F, P, OA, LSE);
    __syncthreads();
    indexer_phase(F, P, MASKB, (unsigned*)(F.ctl + CW_NEAR));
    b_norm_bounds(F, P, (unsigned*)(F.ctl + CW_NRMB));
    GRID_BAR();
    merge_a(F, OA, LSE, O);
    mixer_b_phase(F, P, MASKB, O, (const unsigned*)(F.ctl + CW_NRMB), (const unsigned*)(F.ctl + CW_NEAR), F.ctl + CW_QB);
    GRID_BAR();
    {
        pg8::Gemm g{O, (const bf16*)(ws + WS_WEOUT), S, DM, DM, DM}; pg8::StaticOrder So; So.init(S, DM, F.G, (int)blockIdx.x);
        pg8::EpiResid E{X, Y, DM, ALPHA, 1.0f};
        pg8::gemm_phase<pg8::EpiResid, pg8::StaticOrder, true, true>(F.lds + RING_OFF, g, So, E); }
    GRID_BAR();
    ln_phase<false>(F, Y, ln_g + 1 * DM, ln_b + 1 * DM, X, nullptr);
    GRID_BAR();
    FFN_PHASES(WFB)
    ln_phase<false>(F, Y, ln_g + 2 * DM, ln_b + 2 * DM, X, nullptr);
    convert_ffn(F, w_gate + 3 * GSZ, w_up + 3 * GSZ, w_down + 3 * GSZ, WFB);
    GRID_BAR();
    FFN_PHASES(WFA)
    ln_phase<false>(F, Y, ln_g + 3 * DM, ln_b + 3 * DM, X, nullptr);
    GRID_BAR();
    {
        pg8::Gemm g{X, (const bf16*)(ws + WS_WOIN), S, OINP, DM, DM}; pg8::StaticOrder So; So.init(S, OINP, F.G, (int)blockIdx.x);
        pg8::EpiBf16 E{P, OINP, SQQ, 12, 15, SQKV, 15, 17};
        pg8::gemm_phase<pg8::EpiBf16, pg8::StaticOrder, true, true>(F.lds + RING_OFF, g, So, E); }
    GRID_BAR();
    {
        pg8::Gemm g{P + 3072, (const bf16*)(ws + WS_WUQ), S, 1536, 768, OINP}; pg8::StaticOrder So; So.init(S, 1536, F.G, (int)blockIdx.x);
        pg8::EpiScaleRow E{QF, 1536, SQQ, 1.0f / 768.0f, RMS_EPS};
        pg8::gemm_phase<pg8::EpiScaleRow, pg8::StaticOrder, true, true>(F.lds + RING_OFF, g, So, E); }
    {   pg8::Gemm g{P + 3840, (const bf16*)(ws + WS_WUKV), S, 2048, 512, OINP}; pg8::StaticOrder So; So.init(S, 2048, F.G, (int)blockIdx.x);
        pg8::EpiUkv E{KD, VD, SQKV, 1.0f / 512.0f, RMS_EPS};
        pg8::gemm_phase<pg8::EpiUkv, pg8::StaticOrder, true, true>(F.lds + RING_OFF, g, So, E); }
    kpe_fill(F, P, KD);
    c_norm_bounds(F, P, (unsigned*)(F.ctl + CW_NRM));
    GRID_BAR();
    mixer_cd_phase(F, P, args.in[10], args.in[11], 0.35550906759096874f, (float*)(ws + WS_HP + 160 * MiB), (const unsigned*)(F.ctl + CW_NRM), QF, KD, VD, O, F.ctl + CW_QCD);
    GRID_BAR();
    {
        pg8::Gemm g{O, (const bf16*)(ws + WS_WOOUT), S, DM, DM, DM}; pg8::StaticOrder So; So.init(S, DM, F.G, (int)blockIdx.x);
        pg8::EpiResid E{X, Y, DM, ALPHA, 1.0f};
        pg8::gemm_phase<pg8::EpiResid, pg8::StaticOrder, true, true>(F.lds + RING_OFF, g, So, E); }
    GRID_BAR();
    ln_phase<false>(F, Y, ln_g + 4 * DM, ln_b + 4 * DM, X, nullptr);
    GRID_BAR();
    FFN_PHASES(WFB)
    ln_phase<true>(F, Y, ln_g + 5 * DM, ln_b + 5 * DM, nullptr, args.out);
}

extern "C" void kernel_launch(void* const* d_in, const int* in_sizes, int n_in, void* d_out, int out_size, void* d_ws, size_t ws_size, hipStream_t stream) {
    static int grid = 0;
    if (grid == 0) {
        if (n_in != 16 || in_sizes[0] != S * DM || out_size != S * DM || ws_size < WS_END) { fprintf(stderr, "kernel_launch: unexpected shapes (n_in %d, in0 %d, out %d, ws %zu < %zu)\n", n_in, n_in > 0 ? in_sizes[0] : -1, out_size, ws_size, (size_t)WS_END); grid = -1; return; }
        int dev = 0, cus = 0, per_cu = 0;
        if (hipGetDevice(&dev) != hipSuccess || hipDeviceGetAttribute(&cus, hipDeviceAttributeMultiprocessorCount, dev) != hipSuccess) { grid = -1; return; }
        if (hipFuncSetAttribute((const void*)fwd_kernel, hipFuncAttributeMaxDynamicSharedMemorySize, LDS_BYTES) != hipSuccess) { fprintf(stderr, "kernel_launch: hipFuncSetAttribute failed\n"); grid = -1; return; }
        if (hipOccupancyMaxActiveBlocksPerMultiprocessor(&per_cu, (const void*)fwd_kernel, NWAVES * 64, LDS_BYTES) != hipSuccess || per_cu < 1)
            fprintf(stderr, "kernel_launch: occupancy query reports %d workgroups per CU\n", per_cu);
        (void)hipGetLastError();
        grid = cus;
    }
    if (grid < 0) return;
    if (hipMemsetAsync((char*)d_ws + WS_CTL, 0, CTL_ZERO_BYTES, stream) != hipSuccess) return;
    Args a{};
    for (int i = 0; i < 16; ++i) a.in[i] = (const float*)d_in[i];
    a.out = (float*)d_out; a.ws = (unsigned char*)d_ws;
    hipLaunchKernelGGL(fwd_kernel, dim3(grid), dim3(NWAVES * 64), LDS_BYTES, stream, a);
}
```

```cpp
#include <hip/hip_runtime.h>
#include <cstdio>
#include <cstdint>
#include <cmath>
namespace pg8 {
#define PG8_LAS __attribute__((address_space(3)))
typedef unsigned short bf16_t;
typedef short bf16x8 __attribute__((ext_vector_type(8)));
typedef float f32x4 __attribute__((ext_vector_type(4)));
typedef unsigned u32x4 __attribute__((ext_vector_type(4)));
constexpr int BM = 256, BK = 64, HALF = 128, HTB = HALF * BK * 2  , STAGE_BYTES = 8 * HTB, NXCD = 8, WGM = 4;

__host__ __device__ __forceinline__ int lds_byte(int r, int c) { const int st = (r >> 4) * 2 + (c >> 5), rr = r & 15, cc = c & 31, ob = rr * 64 + cc * 2; return st * 1024 + (ob ^ (((ob >> 9) & 1) << 5)); }
__host__ __device__ __forceinline__ void stage_rc(int b, int& R, int& C) { const int st = b / 1024, sb = b % 1024, swz = sb ^ (((sb >> 9) & 1) << 5); R = (st >> 1) * 16 + swz / 64; C = (st & 1) * 32 + (swz % 64) / 2; }
__host__ __device__ __forceinline__ int perm32(int rho) { const int n = rho >> 4, i = rho & 15; return 8 * (i >> 2) + 4 * n + (i & 3); }

struct Unit { int pm, pn; };
struct Gemm { const bf16_t* A; const bf16_t* Bt; int M, N, K, lda; };

struct StaticOrder {
    int nM, nN, nwg, G, c;
    __host__ __device__ void init(int M, int N, int G_, int c_) { nM = M / BM; nN = N / BM; nwg = nM * nN; G = G_; c = c_; }
    __host__ __device__ bool next(int i, Unit& u) const {
        const long L = (long)i * G + c; if (L >= nwg) return false;
        int wgid = (int)L; { const int q = nwg / NXCD, r = nwg % NXCD, xcd = wgid % NXCD, off = wgid / NXCD; wgid = (xcd < r ? xcd * (q + 1) : r * (q + 1) + (xcd - r) * q) + off; }
        const int nig = WGM * nN, gid = wgid / nig, fm = gid * WGM, gsz = (nM - fm) < WGM ? (nM - fm) : WGM;
        u.pm = fm + ((wgid % nig) % gsz); u.pn = (wgid % nig) / gsz; return true;
    }
    __device__ __forceinline__ void a_ready(const Unit&) const {}
    __device__ __forceinline__ void done(const Unit&) const {}
};
__device__ __forceinline__ unsigned cvt_pk_bf16(float lo, float hi) { unsigned r; asm volatile("v_cvt_pk_bf16_f32 %0, %1, %2" : "=v"(r) : "v"(lo), "v"(hi)); return r; }
__device__ __forceinline__ float bf_lo(unsigned w) { return __uint_as_float(w << 16); }
__device__ __forceinline__ float bf_hi(unsigned w) { return __uint_as_float(w & 0xffff0000u); }
typedef unsigned u32x2 __attribute__((ext_vector_type(2)));
__device__ __forceinline__ float silu_f(float x) { return x * __builtin_amdgcn_rcpf(1.0f + __builtin_amdgcn_exp2f(-1.4426950408889634f * x)); }

struct EpiSwiglu {
    static constexpr bool PERM = true, AFTER_DRAIN = false;
    bf16_t* H; int ldh;
    __device__ __forceinline__ void operator()(const f32x4 (&acc)[2][2][4][2], const Unit& u, int wr, int wc, int fr, int fq) const {
        const int row0 = u.pm * BM + wr * 64 + fr, col0 = u.pn * HALF + wc * 32 + 8 * fq;
#pragma unroll
        for (int ai = 0; ai < 2; ++ai)
#pragma unroll
            for (int m = 0; m < 4; ++m) {
                const f32x4 g0 = acc[ai][0][m][0], g1 = acc[ai][0][m][1], u0 = acc[ai][1][m][0], u1 = acc[ai][1][m][1];
                u32x4 w;
                w.x = cvt_pk_bf16(silu_f(g0[0]) * u0[0], silu_f(g0[1]) * u0[1]); w.y = cvt_pk_bf16(silu_f(g0[2]) * u0[2], silu_f(g0[3]) * u0[3]);
                w.z = cvt_pk_bf16(silu_f(g1[0]) * u1[0], silu_f(g1[1]) * u1[1]); w.w = cvt_pk_bf16(silu_f(g1[2]) * u1[2], silu_f(g1[3]) * u1[3]);
                *(u32x4*)(H + (size_t)(row0 + ai * HALF + m * 16) * ldh + col0) = w;
            }
    }
};
struct EpiResid {
    static constexpr bool PERM = true, AFTER_DRAIN = false;
    const bf16_t* X; bf16_t* Y; int ldc; float alpha, w;
    __device__ __forceinline__ void operator()(const f32x4 (&acc)[2][2][4][2], const Unit& u, int wr, int wc, int fr, int fq) const {
        const int row0 = u.pm * BM + wr * 64 + fr, col0 = u.pn * BM + wc * 32 + 8 * fq;
#pragma unroll
        for (int ai = 0; ai < 2; ++ai)
#pragma unroll
            for (int m = 0; m < 4; ++m) { const size_t ro = (size_t)(row0 + ai * HALF + m * 16) * ldc + col0;
#pragma unroll
                for (int bj = 0; bj < 2; ++bj) { const size_t off = ro + bj * HALF; const u32x4 xw = *(const u32x4*)(X + off); const f32x4 a0 = acc[ai][bj][m][0], a1 = acc[ai][bj][m][1];
                    u32x4 y;
                    y.x = cvt_pk_bf16(alpha * bf_lo(xw.x) + w * a0[0], alpha * bf_hi(xw.x) + w * a0[1]); y.y = cvt_pk_bf16(alpha * bf_lo(xw.y) + w * a0[2], alpha * bf_hi(xw.y) + w * a0[3]);
                    y.z = cvt_pk_bf16(alpha * bf_lo(xw.z) + w * a1[0], alpha * bf_hi(xw.z) + w * a1[1]); y.w = cvt_pk_bf16(alpha * bf_lo(xw.w) + w * a1[2], alpha * bf_hi(xw.w) + w * a1[3]);
                    *(u32x4*)(Y + off) = y; } }
    }
};
struct EpiBf16 {
    static constexpr bool PERM = true, AFTER_DRAIN = false;
    bf16_t* O; int ldc; float* sqA; int a_lo, a_hi; float* sqB; int b_lo, b_hi;
    __device__ __forceinline__ void operator()(const f32x4 (&acc)[2][2][4][2], const Unit& u, int wr, int wc, int fr, int fq) const {
        const int row0 = u.pm * BM + wr * 64 + fr, col0 = u.pn * BM + wc * 32 + 8 * fq;
        float* sq = (u.pn >= a_lo && u.pn < a_hi) ? sqA : ((u.pn >= b_lo && u.pn < b_hi) ? sqB : nullptr);
#pragma unroll
        for (int ai = 0; ai < 2; ++ai)
#pragma unroll
            for (int m = 0; m < 4; ++m) { bf16_t* rowp = O + (size_t)(row0 + ai * HALF + m * 16) * ldc + col0; float ss = 0.f;
#pragma unroll
                for (int bj = 0; bj < 2; ++bj) { const f32x4 v0 = acc[ai][bj][m][0], v1 = acc[ai][bj][m][1];
                    ss += (v0[0] * v0[0] + v0[1] * v0[1]) + (v0[2] * v0[2] + v0[3] * v0[3]) + (v1[0] * v1[0] + v1[1] * v1[1]) + (v1[2] * v1[2] + v1[3] * v1[3]);
                    u32x4 w; w.x = cvt_pk_bf16(v0[0], v0[1]); w.y = cvt_pk_bf16(v0[2], v0[3]); w.z = cvt_pk_bf16(v1[0], v1[1]); w.w = cvt_pk_bf16(v1[2], v1[3]);
                    *(u32x4*)(rowp + bj * HALF) = w; }
                if (sq) { ss += __shfl_xor(ss, 16); ss += __shfl_xor(ss, 32); if (fq == 0) atomicAdd(sq + row0 + ai * HALF + m * 16, ss); }
            }
    }
};
struct EpiScaleRow {
    static constexpr bool PERM = true, AFTER_DRAIN = false;
    bf16_t* O; int ldc; const float* sq; float invn, eps;
    __device__ __forceinline__ void operator()(const f32x4 (&acc)[2][2][4][2], const Unit& u, int wr, int wc, int fr, int fq) const {
        const int row0 = u.pm * BM + wr * 64 + fr, col0 = u.pn * BM + wc * 32 + 8 * fq;
#pragma unroll
        for (int ai = 0; ai < 2; ++ai)
#pragma unroll
            for (int m = 0; m < 4; ++m) { const int row = row0 + ai * HALF + m * 16; const float rs = 1.0f / sqrtf(sq[row] * invn + eps); bf16_t* rowp = O + (size_t)row * ldc + col0;
#pragma unroll
                for (int bj = 0; bj < 2; ++bj) { const f32x4 v0 = acc[ai][bj][m][0] * rs, v1 = acc[ai][bj][m][1] * rs;
                    u32x4 w; w.x = cvt_pk_bf16(v0[0], v0[1]); w.y = cvt_pk_bf16(v0[2], v0[3]); w.z = cvt_pk_bf16(v1[0], v1[1]); w.w = cvt_pk_bf16(v1[2], v1[3]);
                    *(u32x4*)(rowp + bj * HALF) = w; } }
    }
};
struct EpiUkv {
    static constexpr bool PERM = true, AFTER_DRAIN = false;
    bf16_t* KD; bf16_t* VD; const float* sq; float invn, eps;
    __device__ __forceinline__ void operator()(const f32x4 (&acc)[2][2][4][2], const Unit& u, int wr, int wc, int fr, int fq) const {
        const int row0 = u.pm * BM + wr * 64 + fr, cc = wc * 32 + 8 * fq;
#pragma unroll
        for (int ai = 0; ai < 2; ++ai)
#pragma unroll
            for (int m = 0; m < 4; ++m) { const int row = row0 + ai * HALF + m * 16; const float rs = 1.0f / sqrtf(sq[row] * invn + eps);
#pragma unroll
                for (int bj = 0; bj < 2; ++bj) { const f32x4 v0 = acc[ai][bj][m][0] * rs, v1 = acc[ai][bj][m][1] * rs;
                    u32x4 w; w.x = cvt_pk_bf16(v0[0], v0[1]); w.y = cvt_pk_bf16(v0[2], v0[3]); w.z = cvt_pk_bf16(v1[0], v1[1]); w.w = cvt_pk_bf16(v1[2], v1[3]);
                    bf16_t* dst = bj == 0 ? KD + (size_t)row * 1536 + u.pn * 192 + cc : VD + (size_t)row * 1024 + u.pn * 128 + cc;
                    *(u32x4*)dst = w; } }
    }
};
template <class Epi, class Sched, bool ALIGN_EPI = false, bool SP2 = false>
__device__ __forceinline__ void gemm_phase(PG8_LAS unsigned char* lds, const Gemm g, const Sched& S, const Epi& E) {
    int tid_o_ = threadIdx.x; asm volatile("" : "+v"(tid_o_)); const int tid = tid_o_, wid = __builtin_amdgcn_readfirstlane(tid >> 6), lane = tid & 63, wr = wid >> 2, wc = wid & 3, fr = lane & 15, fq = lane >> 4;
    const int K = g.K, nt = K / BK;
    unsigned voffA[2], voffB[2];
#pragma unroll
    for (int i = 0; i < 2; ++i) { int R, C; stage_rc(tid * 16 + i * 8192, R, C); const int Rb = Epi::PERM ? ((R & ~31) + perm32(R & 31)) : R;
        voffA[i] = (unsigned)(R * g.lda + C) * 2u; voffB[i] = (unsigned)(Rb * K + C) * 2u; }
    const size_t kstep = (size_t)(BK * 2);
    const size_t hstepB = (size_t)HALF * K * 2, hstepA = (size_t)HALF * g.lda * 2;
    const size_t tstepA = 2 * hstepA, tstepB = 2 * hstepB;
    const unsigned ldsw = (unsigned)wid * 1024u;
    const int aoff = lds_byte(wr * 64 + fr, fq * 8), boff = lds_byte(wc * 32 + fr, fq * 8);
#define PG8_SA(b, h) (((b) * 2 + (h)) * HTB)
#define PG8_SB(b, h) ((4 + (b) * 2 + (h)) * HTB)
#define PG8_STAGE(bufoff, gbase, voff) do { _Pragma("unroll") for (int _i = 0; _i < 2; ++_i) \
        __builtin_amdgcn_global_load_lds((const unsigned*)((const char*)(gbase) + (voff)[_i]), (PG8_LAS unsigned*)(lds + (bufoff) + ldsw + _i * 8192), 16, 0, 0); } while (0)
#define PG8_LDA(dst, b, h) do { _Pragma("unroll") for (int m = 0; m < 4; ++m) _Pragma("unroll") for (int k = 0; k < 2; ++k) dst[m][k] = *(const PG8_LAS bf16x8*)(lds + PG8_SA(b, h) + aoff + m * 2048 + k * 1024); } while (0)
#define PG8_LDB(dst, b, h) do { _Pragma("unroll") for (int n = 0; n < 2; ++n) _Pragma("unroll") for (int k = 0; k < 2; ++k) dst[n][k] = *(const PG8_LAS bf16x8*)(lds + PG8_SB(b, h) + boff + n * 2048 + k * 1024); } while (0)
#define PG8_MMA(ai, bj, At, Bt) do { __builtin_amdgcn_s_setprio(1); _Pragma("unroll") for (int m = 0; m < 4; ++m) _Pragma("unroll") for (int n = 0; n < 2; ++n) _Pragma("unroll") for (int k = 0; k < 2; ++k) \
        acc[ai][bj][m][n] = __builtin_amdgcn_mfma_f32_16x16x32_bf16(Bt[n][k], At[m][k], acc[ai][bj][m][n], 0, 0, 0); __builtin_amdgcn_s_setprio(0); } while (0)
#define PG8_WAIT_V(n) asm volatile("s_waitcnt vmcnt(" #n ")" ::: "memory")
#define PG8_WAIT_L(n) asm volatile("s_waitcnt lgkmcnt(" #n ")" ::: "memory")
#define PG8_BAR __builtin_amdgcn_s_barrier()
#define PG8_SCHED __builtin_amdgcn_sched_barrier(0)
    Unit cur, nxt; int ui = 0;
    if (!S.next(0, cur)) return;
    f32x4 acc[2][2][4][2];
#pragma unroll
    for (int a = 0; a < 2; ++a)
#pragma unroll
        for (int b = 0; b < 2; ++b)
#pragma unroll
            for (int m = 0; m < 4; ++m)
#pragma unroll
                for (int n = 0; n < 2; ++n) acc[a][b][m][n] = (f32x4){0.f, 0.f, 0.f, 0.f};
    bf16x8 At[4][2], B0[2][2], B1[2][2];
    const char* cA = (const char*)g.A + (size_t)cur.pm * tstepA; const char* cB = (const char*)g.Bt + (size_t)cur.pn * tstepB;
    S.a_ready(cur);
    if constexpr (SP2) {
        PG8_STAGE(PG8_SB(0, 0), cB, voffB); PG8_STAGE(PG8_SB(0, 1), cB + hstepB, voffB); PG8_STAGE(PG8_SA(0, 0), cA, voffA); PG8_STAGE(PG8_SA(0, 1), cA + hstepA, voffA);
        if (wr == 1) PG8_BAR;
        PG8_WAIT_V(2); PG8_BAR;
        PG8_STAGE(PG8_SB(1, 0), cB + kstep, voffB); PG8_STAGE(PG8_SA(1, 0), cA + kstep, voffA); PG8_STAGE(PG8_SB(1, 1), cB + hstepB + kstep, voffB);
        PG8_WAIT_V(6); PG8_BAR;
    } else {
        PG8_STAGE(PG8_SB(0, 0), cB, voffB); PG8_STAGE(PG8_SA(0, 0), cA, voffA); PG8_STAGE(PG8_SB(0, 1), cB + hstepB, voffB); PG8_STAGE(PG8_SA(0, 1), cA + hstepA, voffA);
        if (wr == 1) PG8_BAR;
        PG8_WAIT_V(4); PG8_BAR;
        PG8_STAGE(PG8_SB(1, 0), cB + kstep, voffB); PG8_STAGE(PG8_SA(1, 0), cA + kstep, voffA); PG8_STAGE(PG8_SB(1, 1), cB + hstepB + kstep, voffB);
        PG8_WAIT_V(6); PG8_BAR;
    }
    for (;;) {
        const bool has_next = S.next(ui + 1, nxt);
        const char* nA = has_next ? (const char*)g.A + (size_t)nxt.pm * tstepA : cA; const char* nB = has_next ? (const char*)g.Bt + (size_t)nxt.pn * tstepB : cB;
        for (int t = 0; t < nt; t += 2) {
            const bool last = (t == nt - 2);
            const char* a1 = cA + (size_t)(t + 1) * kstep;
            const char* a2 = last ? nA : cA + (size_t)(t + 2) * kstep; const char* b2 = last ? nB : cB + (size_t)(t + 2) * kstep;
            const char* a3 = a2 + kstep; const char* b3 = b2 + kstep;
            if (last && has_next) S.a_ready(nxt);
            if constexpr (SP2) {
            PG8_LDB(B0, 0, 0); PG8_LDB(B1, 0, 1); PG8_SCHED; PG8_LDA(At, 0, 0); PG8_STAGE(PG8_SA(1, 1), a1 + hstepA, voffA);
            PG8_WAIT_V(8); PG8_WAIT_L(0); PG8_BAR; PG8_MMA(0, 0, At, B0); PG8_MMA(0, 1, At, B1); PG8_BAR; PG8_SCHED;
            PG8_LDA(At, 0, 1); PG8_STAGE(PG8_SB(0, 0), b2, voffB); PG8_STAGE(PG8_SB(0, 1), b2 + hstepB, voffB); PG8_STAGE(PG8_SA(0, 0), a2, voffA);
            PG8_WAIT_V(8); PG8_WAIT_L(0); PG8_BAR; PG8_MMA(1, 0, At, B0); PG8_MMA(1, 1, At, B1); PG8_BAR; PG8_SCHED;
            PG8_LDB(B0, 1, 0); PG8_LDB(B1, 1, 1); PG8_SCHED; PG8_LDA(At, 1, 0); PG8_STAGE(PG8_SA(0, 1), a2 + hstepA, voffA);
            PG8_WAIT_V(8); PG8_WAIT_L(0); PG8_BAR; PG8_MMA(0, 0, At, B0); PG8_MMA(0, 1, At, B1); PG8_BAR; PG8_SCHED;
            PG8_LDA(At, 1, 1); PG8_STAGE(PG8_SB(1, 0), b3, voffB); PG8_STAGE(PG8_SB(1, 1), b3 + hstepB, voffB); PG8_STAGE(PG8_SA(1, 0), a3, voffA);
            PG8_WAIT_V(8); PG8_WAIT_L(0); PG8_BAR; PG8_MMA(1, 0, At, B0); PG8_MMA(1, 1, At, B1); PG8_BAR; PG8_SCHED;
            } else {
            PG8_LDB(B0, 0, 0); PG8_SCHED; PG8_LDA(At, 0, 0); PG8_STAGE(PG8_SA(1, 1), a1 + hstepA, voffA);
            PG8_WAIT_L(8); PG8_BAR; PG8_WAIT_L(0); PG8_MMA(0, 0, At, B0); PG8_BAR; PG8_SCHED;
            PG8_LDB(B1, 0, 1); PG8_STAGE(PG8_SB(0, 0), b2, voffB);
            PG8_BAR; PG8_WAIT_L(0); PG8_MMA(0, 1, At, B1); PG8_BAR;
            PG8_LDA(At, 0, 1); PG8_STAGE(PG8_SA(0, 0), a2, voffA);
            PG8_BAR; PG8_WAIT_L(0); PG8_MMA(1, 0, At, B0); PG8_BAR; PG8_SCHED;
            PG8_STAGE(PG8_SB(0, 1), b2 + hstepB, voffB);
            PG8_WAIT_V(6); PG8_BAR; PG8_MMA(1, 1, At, B1); PG8_BAR;
            PG8_LDB(B0, 1, 0); PG8_SCHED; PG8_LDA(At, 1, 0); PG8_STAGE(PG8_SA(0, 1), a2 + hstepA, voffA);
            PG8_WAIT_L(8); PG8_BAR; PG8_WAIT_L(0); PG8_MMA(0, 0, At, B0); PG8_BAR; PG8_SCHED;
            PG8_LDB(B1, 1, 1); PG8_STAGE(PG8_SB(1, 0), b3, voffB);
            PG8_BAR; PG8_WAIT_L(0); PG8_MMA(0, 1, At, B1); PG8_BAR;
            PG8_LDA(At, 1, 1); PG8_STAGE(PG8_SA(1, 0), a3, voffA);
            PG8_BAR; PG8_WAIT_L(0); PG8_MMA(1, 0, At, B0); PG8_BAR; PG8_SCHED;
            PG8_STAGE(PG8_SB(1, 1), b3 + hstepB, voffB);
            PG8_WAIT_V(6); PG8_BAR; PG8_MMA(1, 1, At, B1); PG8_BAR;
            }
        }
        if constexpr (ALIGN_EPI) { if (wr == 0) PG8_BAR; }
        if constexpr (!Epi::AFTER_DRAIN) { E(acc, cur, wr, wc, fr, fq); S.done(cur); }
        if (!has_next) break;
#pragma unroll
        for (int a = 0; a < 2; ++a)
#pragma unroll
            for (int b = 0; b < 2; ++b)
#pragma unroll
                for (int m = 0; m < 4; ++m)
#pragma unroll
                    for (int n = 0; n < 2; ++n) acc[a][b][m][n] = (f32x4){0.f, 0.f, 0.f, 0.f};
        cur = nxt; cA = nA; cB = nB; ++ui;
        if constexpr (ALIGN_EPI) { if (wr == 1) PG8_BAR; }
    }
    PG8_WAIT_V(0);
    if constexpr (!ALIGN_EPI) { if (wr == 0) PG8_BAR; }
    PG8_BAR;
    if constexpr (Epi::AFTER_DRAIN) { E.fused(acc, cur, wr, wc, fr, fq, lds, wid, lane); S.done(cur); }
#undef PG8_SA
#undef PG8_SB
#undef PG8_STAGE
#undef PG8_LDA
#undef PG8_LDB
#undef PG8_MMA
#undef PG8_WAIT_V
#undef PG8_WAIT_L
#undef PG8_BAR
#undef PG8_SCHED
}
}

constexpr int S = 16384, DM = 2048, DFF = 5632, NGU = 2 * DFF;
constexpr int EIN = 7248, EINP = 7424, OIN = 4416, OINP = 4608;
constexpr float ALPHA = 1.4142135623730951f;
constexpr float LN_EPS = 1e-5f, RMS_EPS = 1e-6f, DIFF_EPS = 1e-5f;
constexpr int NWAVES = 8;
constexpr size_t MiB = 1u << 20;
constexpr size_t WS_CTL = 0, CTL_ZERO_BYTES = 512 * 1024;
constexpr size_t WS_LSE = 1 * MiB;
constexpr size_t WS_WFA = 4 * MiB, WS_WFB = 70 * MiB;
constexpr size_t WF_DOWN_OFF = (size_t)NGU * DM * 2;
constexpr size_t WS_WEIN = 136 * MiB, WS_WOIN = 165 * MiB, WS_WEOUT = 183 * MiB, WS_WOOUT = 191 * MiB, WS_WUQ = 199 * MiB, WS_WUKV = 202 * MiB;
constexpr size_t WS_X = 204 * MiB;
constexpr size_t WS_Y = 268 * MiB;
constexpr size_t WS_HP = 396 * MiB;
constexpr size_t WS_O = 628 * MiB;
constexpr size_t WS_YB = 692 * MiB;
constexpr size_t WS_END = 756 * MiB;
constexpr int CW_BAR = 4096;
constexpr int CW_QCD = 2048;
constexpr int CW_QB = 2112;
constexpr int CW_NRMB = 1088;
constexpr int CW_NEAR = 1152;
constexpr int CW_NRM = 1024;
constexpr int CW_SQQ = 65536, CW_SQKV = 65536 + 16384;
constexpr int RING_OFF = 0, RING_BYTES = 131072;
constexpr int KI_RING_OFF = RING_BYTES;
constexpr int LDSCTL_OFF = RING_BYTES + 16384, MISC_OFF = LDSCTL_OFF + 320;
constexpr int LDS_BYTES = 151552;

#define GAS __attribute__((address_space(1)))
#define LAS __attribute__((address_space(3)))
typedef unsigned short bf16;
typedef unsigned v4u __attribute__((ext_vector_type(4)));
typedef unsigned v2u __attribute__((ext_vector_type(2)));
typedef float f32x4 __attribute__((ext_vector_type(4)));
typedef short bf16x8 __attribute__((ext_vector_type(8)));
typedef GAS unsigned gu32;
#define LDS_WAIT() asm volatile("s_waitcnt lgkmcnt(0)" ::: "memory")
#define VM_WAIT() asm volatile("s_waitcnt vmcnt(0)" ::: "memory")
__device__ __forceinline__ unsigned f2bf(float f) { unsigned u = __builtin_bit_cast(unsigned, f); return (u + 0x7fffu + ((u >> 16) & 1u)) >> 16; }
__device__ __forceinline__ unsigned pk2(float lo, float hi) { return f2bf(lo) | (f2bf(hi) << 16); }
__device__ __forceinline__ float bflo(unsigned w) { return __uint_as_float(w << 16); }
__device__ __forceinline__ float bfhi(unsigned w) { return __uint_as_float(w & 0xffff0000u); }
#define XB_TMO      128
#define XB_XCNT(j)  (256  + 64 * (j))
#define XB_XSUB(j)  (1280 + 64 * (j))
#define XB_XGEN(j)  (2304 + 64 * (j))
#define XB_TOP      3328
#define XB_TOPGEN   3392
#define XCD_BAR_WORDS 3456
#define XB_SPIN_CAP (1u << 18)

__device__ __forceinline__ unsigned xb_ld(unsigned* p)              { return __hip_atomic_load(p, __ATOMIC_RELAXED, __HIP_MEMORY_SCOPE_AGENT); }
__device__ __forceinline__ unsigned xb_add(unsigned* p, unsigned v) { return __hip_atomic_fetch_add(p, v, __ATOMIC_RELAXED, __HIP_MEMORY_SCOPE_AGENT); }
__device__ __forceinline__ unsigned xb_xcc_id() { return (unsigned)__builtin_amdgcn_s_getreg((3 << 11) | 20) & 0xFu; }
#define XB_SPIN(cond, bar) do { unsigned _sp = 0; while (cond) { __builtin_amdgcn_s_sleep(1); \
    if ((++_sp & 255u) == 0u) { if (xb_ld(&(bar)[XB_TMO])) break; if (_sp > XB_SPIN_CAP) { atomicAdd(&(bar)[XB_TMO], 1u); break; } } } } while (0)

struct XcdBarrier {
    unsigned* bar; unsigned x;
    volatile LAS unsigned* st;
};

__device__ __forceinline__ XcdBarrier xcd_barrier_post(unsigned* bar, volatile LAS unsigned* st) {
    XcdBarrier b; b.bar = bar; b.x = xb_xcc_id(); b.st = st;
    if (threadIdx.x == 0) (void)xb_add(&bar[XB_XCNT(b.x)], 1u);
    return b;
}
__device__ __forceinline__ void xcd_barrier_complete(unsigned* bar, unsigned x, unsigned& nloc, unsigned& nx) {
    const unsigned G = gridDim.x * gridDim.y * gridDim.z;
    unsigned sum, cnt, mine, sp = 0u;
    for (;;) {
        sum = 0u; cnt = 0u; mine = 0u;
#pragma unroll
        for (unsigned j = 0; j < 16; ++j) { const unsigned c = xb_ld(&bar[XB_XCNT(j)]); sum += c; cnt += (c > 0u) ? 1u : 0u; mine = (j == x) ? c : mine; }
        if (sum == G) break;
        __builtin_amdgcn_s_sleep(1);
        if ((++sp & 255u) == 0u) { if (xb_ld(&bar[XB_TMO])) break; if (sp > XB_SPIN_CAP) { atomicAdd(&bar[XB_TMO], 1u); break; } }
    }
    nloc = mine > 0u ? mine : 1u; nx = cnt > 0u ? cnt : 1u;
}

__device__ __forceinline__ void xcd_barrier(const XcdBarrier& b) {
    asm volatile("s_waitcnt vmcnt(0)" ::: "memory");
    __syncthreads();
    if (threadIdx.x == 0) {
        unsigned* bar = b.bar;
        __builtin_amdgcn_s_waitcnt(0);
        unsigned nloc = b.st[0], nx = b.st[1];
        if (nloc == 0u) { xcd_barrier_complete(bar, b.x, nloc, nx); b.st[0] = nloc; b.st[1] = nx; }
        const unsigned old = xb_add(&bar[XB_XSUB(b.x)], 1u);
        const unsigned gen = old / nloc;
        if (old + 1u == (gen + 1u) * nloc) {
            __builtin_amdgcn_fence(__ATOMIC_RELEASE, "agent");
            asm volatile("s_waitcnt vmcnt(0)" ::: "memory");
            const unsigned og = xb_add(&bar[XB_TOP], 1u);
            const unsigned tg = og / nx;
            if (og + 1u == (tg + 1u) * nx) xb_add(&bar[XB_TOPGEN], 1u);
            else XB_SPIN(xb_ld(&bar[XB_TOPGEN]) == tg, bar);
            __builtin_amdgcn_fence(__ATOMIC_ACQUIRE, "agent");
            xb_add(&bar[XB_XGEN(b.x)], 1u);
            asm volatile("s_waitcnt vmcnt(0)" ::: "memory");
        } else {
            XB_SPIN(xb_ld(&bar[XB_XGEN(b.x)]) == gen, bar);
            __builtin_amdgcn_fence(__ATOMIC_ACQUIRE, "agent");
            asm volatile("s_waitcnt vmcnt(0)" ::: "memory");
        }
    }
    __syncthreads();
}

namespace fa {
typedef short bf16x8 __attribute__((ext_vector_type(8)));
typedef short s16x4 __attribute__((ext_vector_type(4)));
typedef float f32x16 __attribute__((ext_vector_type(16)));
typedef unsigned u32x4 __attribute__((ext_vector_type(4)));
typedef unsigned u32x2 __attribute__((ext_vector_type(2)));
typedef unsigned short bf16;
#define FA_SBAR() __builtin_amdgcn_sched_barrier(0)
__device__ __forceinline__ int lane_opaque() { int l = (int)__builtin_amdgcn_mbcnt_hi(~0u, __builtin_amdgcn_mbcnt_lo(~0u, 0u)); asm volatile("" : "+v"(l)); return l; }
__device__ __forceinline__ float shx(float v, int m, int l) { return __int_as_float(__builtin_amdgcn_ds_bpermute((l ^ m) << 2, __float_as_int(v))); }
__device__ __forceinline__ int crow(int r, int hi) { return (r & 3) + 8 * (r >> 2) + 4 * hi; }
__device__ __forceinline__ unsigned cvtpk(float lo, float hi) { unsigned r; asm volatile("v_cvt_pk_bf16_f32 %0, %1, %2" : "=v"(r) : "v"(lo), "v"(hi)); return r; }
__device__ __forceinline__ int v_st(int k, int c) { const int kk = (k & ~0xC) | ((k & 4) << 1) | ((k & 8) >> 1); return ((kk >> 3) * 4 + (c >> 5)) * 512 + ((kk & 7) * 32 + (c & 31)) * 2; }
__device__ __forceinline__ int v_rd_base(int lane) { return ((lane & 3) << 3) | (((lane >> 2) & 3) << 6) | (((lane >> 4) & 1) << 5) | (((lane >> 5) & 1) << 8); }
constexpr int v_rd_off(int d0, int ks, int half) { return d0 * 512 + ks * 4096 + half * 2048; }
template <int OFF> __device__ __forceinline__ s16x4 tr_read(int vb) { s16x4 r; asm volatile("ds_read_b64_tr_b16 %0, %1 offset:%2" : "=&v"(r) : "v"(vb), "i"(OFF) : "memory"); return r; }
template <int D0> __device__ __forceinline__ void pv_one(f32x16& od, int vb, bf16x8 pa0, bf16x8 pa1, bf16x8 pa2, bf16x8 pa3) {
    const s16x4 l0 = tr_read<v_rd_off(D0, 0, 0)>(vb), h0 = tr_read<v_rd_off(D0, 0, 1)>(vb), l1 = tr_read<v_rd_off(D0, 1, 0)>(vb), h1 = tr_read<v_rd_off(D0, 1, 1)>(vb);
    const s16x4 l2 = tr_read<v_rd_off(D0, 2, 0)>(vb), h2 = tr_read<v_rd_off(D0, 2, 1)>(vb), l3 = tr_read<v_rd_off(D0, 3, 0)>(vb), h3 = tr_read<v_rd_off(D0, 3, 1)>(vb);
    asm volatile("s_waitcnt lgkmcnt(0)" ::: "memory"); FA_SBAR();
#define FA_PK(L, H) (bf16x8){L[0], L[1], L[2], L[3], H[0], H[1], H[2], H[3]}
    od = __builtin_amdgcn_mfma_f32_32x32x16_bf16(pa0, FA_PK(l0, h0), od, 0, 0, 0);
    od = __builtin_amdgcn_mfma_f32_32x32x16_bf16(pa1, FA_PK(l1, h1), od, 0, 0, 0);
    od = __builtin_amdgcn_mfma_f32_32x32x16_bf16(pa2, FA_PK(l2, h2), od, 0, 0, 0);
    od = __builtin_amdgcn_mfma_f32_32x32x16_bf16(pa3, FA_PK(l3, h3), od, 0, 0, 0);
#undef FA_PK
}
__device__ __forceinline__ void pv_d0(f32x16* o, int vb, bf16x8 pa0, bf16x8 pa1, bf16x8 pa2, bf16x8 pa3) {
    pv_one<0>(o[0], vb, pa0, pa1, pa2, pa3); pv_one<1>(o[1], vb, pa0, pa1, pa2, pa3); pv_one<2>(o[2], vb, pa0, pa1, pa2, pa3); pv_one<3>(o[3], vb, pa0, pa1, pa2, pa3);
}
struct VFrag { s16x4 l0, h0, l1, h1, l2, h2, l3, h3; };
template <int D0> __device__ __forceinline__ void pv_rd(VFrag& f, int vb) {
    f.l0 = tr_read<v_rd_off(D0, 0, 0)>(vb); f.h0 = tr_read<v_rd_off(D0, 0, 1)>(vb); f.l1 = tr_read<v_rd_off(D0, 1, 0)>(vb); f.h1 = tr_read<v_rd_off(D0, 1, 1)>(vb);
    f.l2 = tr_read<v_rd_off(D0, 2, 0)>(vb); f.h2 = tr_read<v_rd_off(D0, 2, 1)>(vb); f.l3 = tr_read<v_rd_off(D0, 3, 0)>(vb); f.h3 = tr_read<v_rd_off(D0, 3, 1)>(vb);
}
__device__ __forceinline__ void pv_mm(f32x16& od, const VFrag& f, bf16x8 pa0, bf16x8 pa1, bf16x8 pa2, bf16x8 pa3) {
#define FA_PK(L, H) (bf16x8){L[0], L[1], L[2], L[3], H[0], H[1], H[2], H[3]}
    od = __builtin_amdgcn_mfma_f32_32x32x16_bf16(pa0, FA_PK(f.l0, f.h0), od, 0, 0, 0);
    od = __builtin_amdgcn_mfma_f32_32x32x16_bf16(pa1, FA_PK(f.l1, f.h1), od, 0, 0, 0);
    od = __builtin_amdgcn_mfma_f32_32x32x16_bf16(pa2, FA_PK(f.l2, f.h2), od, 0, 0, 0);
    od = __builtin_amdgcn_mfma_f32_32x32x16_bf16(pa3, FA_PK(f.l3, f.h3), od, 0, 0, 0);
#undef FA_PK
}
__device__ __forceinline__ void pv_pipe(f32x16* o, int vb, bf16x8 pa0, bf16x8 pa1, bf16x8 pa2, bf16x8 pa3) {
    VFrag fa, fb;
    pv_rd<0>(fa, vb); pv_rd<1>(fb, vb);
    asm volatile("s_waitcnt lgkmcnt(8)" ::: "memory"); FA_SBAR(); pv_mm(o[0], fa, pa0, pa1, pa2, pa3); FA_SBAR();
    pv_rd<2>(fa, vb);
    asm volatile("s_waitcnt lgkmcnt(8)" ::: "memory"); FA_SBAR(); pv_mm(o[1], fb, pa0, pa1, pa2, pa3); FA_SBAR();
    pv_rd<3>(fb, vb);
    asm volatile("s_waitcnt lgkmcnt(8)" ::: "memory"); FA_SBAR(); pv_mm(o[2], fa, pa0, pa1, pa2, pa3); FA_SBAR();
    asm volatile("s_waitcnt lgkmcnt(0)" ::: "memory"); FA_SBAR(); pv_mm(o[3], fb, pa0, pa1, pa2, pa3); FA_SBAR();
}
struct UnitP {
    const bf16* Q; size_t ldq;
    const bf16* K; size_t ldk;
    const bf16* V; size_t ldv;
    int q0;
    int kt0, kt1;
    float sl2;
    float c2;
    const unsigned* mask;
};
constexpr int WIN = 128;
constexpr float THR2 = 11.5f;
template <int DQK, bool WINDOW, bool ALIBI, bool MASK, bool ROPEQ>
__device__ __forceinline__ void attn_unit(const UnitP& U, LAS unsigned char* lds, f32x16 (&o)[4], float& lse2) {
    constexpr int KROWB = DQK * 2, SHM_V = 16384, SHM_K = 64 * KROWB, KOFF = 2 * SHM_V, WSOFF = KOFF + 2 * 64 * 192 * 2;
    constexpr int KCH = DQK / 8, KPT = 64 * KCH / 512, ND0 = DQK / 16;
    int tid_o_ = threadIdx.x; asm volatile("" : "+v"(tid_o_)); const int tid = tid_o_, wid = __builtin_amdgcn_readfirstlane(tid >> 6), lane = tid & 63, r32 = lane & 31, hi = lane >> 5;
    LAS float* wsf = (LAS float*)(lds + WSOFF + wid * 256);
    float m_reg = -1e30f, l_reg = 0.f;
#pragma unroll
    for (int d = 0; d < 4; ++d)
#pragma unroll
        for (int r = 0; r < 16; ++r) o[d][r] = 0.f;
    bf16x8 qr[ND0];
    const int qi = U.q0 + wid * 32 + r32;
    {   const bf16* Qw = U.Q + (size_t)(wid * 32 + r32) * U.ldq + hi * 8;
#pragma unroll
        for (int d0 = 0; d0 < ND0; ++d0) qr[d0] = *(const bf16x8*)(Qw + d0 * 16);
        if constexpr (ROPEQ) {
#pragma unroll
            for (int pb = 0; pb < 2; ++pb) { bf16x8 a = qr[ND0 - 4 + pb], b = qr[ND0 - 2 + pb];
#pragma unroll
                for (int e = 0; e < 8; ++e) { const int fi = pb * 16 + hi * 8 + e; const float inv = __builtin_amdgcn_exp2f(-0.41524101186092029f * (float)fi);
                    const float ang = (float)qi * inv; const float n = rintf(ang * 0.15915494309189535f);
                    float rr = fmaf(-n, 6.2831854820251465f, ang); rr = fmaf(-n, -1.7484555e-07f, rr); const float fr = rr * 0.15915494309189535f;
                    const float sn = __builtin_amdgcn_sinf(fr), cs = __builtin_amdgcn_cosf(fr);
                    const float x1 = __uint_as_float((unsigned)(unsigned short)a[e] << 16), x2 = __uint_as_float((unsigned)(unsigned short)b[e] << 16);
                    const unsigned w = cvtpk(x1 * cs - x2 * sn, x1 * sn + x2 * cs); a[e] = (short)(w & 0xffffu); b[e] = (short)(w >> 16); }
                qr[ND0 - 4 + pb] = a; qr[ND0 - 2 + pb] = b; }
        }
    }
    unsigned kgo[KPT], vgo[2];
#pragma unroll
    for (int i_ = 0; i_ < KPT; ++i_) { const int p_ = (wid + 8 * i_) * 1024 + lane * 16, row_ = p_ / KROWB, wi_ = (p_ % KROWB) ^ ((row_ & 7) << 4); kgo[i_] = (unsigned)((size_t)row_ * U.ldk * 2 + wi_); }
#pragma unroll
    for (int i_ = 0; i_ < 2; ++i_) { const int p_ = (wid + 8 * i_) * 1024 + lane * 16, sub_ = p_ >> 9, rem_ = p_ & 511, kk_ = (sub_ >> 2) * 8 + (rem_ >> 6), k_ = (kk_ & ~0xC) | ((kk_ & 4) << 1) | ((kk_ & 8) >> 1), col_ = (sub_ & 3) * 32 + ((rem_ & 63) >> 1);
        vgo[i_] = (unsigned)(((size_t)k_ * U.ldv + col_) * 2); }
#define FA_DMA(k0_, b_) do { const char* kg_ = (const char*)U.K + (size_t)(k0_) * U.ldk * 2; const char* vg_ = (const char*)U.V + (size_t)(k0_) * U.ldv * 2; \
        _Pragma("unroll") for (int i_ = 0; i_ < KPT; ++i_) __builtin_amdgcn_global_load_lds((const unsigned*)(kg_ + kgo[i_]), (LAS unsigned*)(lds + KOFF + (b_) * SHM_K + (wid + 8 * i_) * 1024), 16, 0, 0); \
        _Pragma("unroll") for (int i_ = 0; i_ < 2; ++i_) __builtin_amdgcn_global_load_lds((const unsigned*)(vg_ + vgo[i_]), (LAS unsigned*)(lds + (b_) * SHM_V + (wid + 8 * i_) * 1024), 16, 0, 0); } while (0)
    const int vb0 = (int)(unsigned)(uintptr_t)lds + v_rd_base(lane);
    const int NT = U.kt1 - U.kt0;
    const int qw0 = U.q0 + wid * 32, qw1 = qw0 + 31;
    u32x2 mw = {0u, 0u}, mwn = {0u, 0u};
    const unsigned* mrow = MASK ? U.mask + (size_t)(wid * 32 + r32) * 512 : nullptr;
    FA_DMA(U.kt0 * 64, 0); if constexpr (MASK) mw = *(const u32x2*)(mrow + U.kt0 * 2);
    asm volatile("s_waitcnt vmcnt(0)" ::: "memory"); __syncthreads();
    for (int jt = 0; jt < NT; ++jt) {
        const int k0 = (U.kt0 + jt) * 64, buf = jt & 1;
        const bool more = jt + 1 < NT;
        if (more) { FA_DMA(k0 + 64, buf ^ 1); if constexpr (MASK) mwn = *(const u32x2*)(mrow + (k0 >> 5) + 2); }
        const bool active = (k0 <= qw1) && (!WINDOW || (k0 + 63 >= qw0 - WIN));
        if (active) {
            f32x16 p0, p1;
#pragma unroll
            for (int r = 0; r < 16; ++r) { p0[r] = 0.f; p1[r] = 0.f; }
            const LAS unsigned char* kb = lds + KOFF + buf * SHM_K + r32 * KROWB; const int lp = (hi * 16) ^ ((r32 & 7) << 4);
            const LAS unsigned char* kq[4] = {kb + lp, kb + (lp ^ 32), kb + (lp ^ 64), kb + (lp ^ 96)};
#pragma unroll
            for (int d0 = 0; d0 < ND0; ++d0) {
                const bf16x8 b0 = *(const LAS bf16x8*)(kq[d0 & 3] + (d0 >> 2) * 128), b1 = *(const LAS bf16x8*)(kq[d0 & 3] + (d0 >> 2) * 128 + 32 * KROWB);
                p0 = __builtin_amdgcn_mfma_f32_32x32x16_bf16(b0, qr[d0], p0, 0, 0, 0);
                p1 = __builtin_amdgcn_mfma_f32_32x32x16_bf16(b1, qr[d0], p1, 0, 0, 0);
                if ((d0 & 3) == 3) FA_SBAR(); }
            const int lim = qi - k0 - 4 * hi;
            const float tb = ALIBI ? U.sl2 * (float)(-lim) : 0.f;
#pragma unroll
            for (int r = 0; r < 16; ++r) { const int c = (r & 3) + 8 * (r >> 2);
                if constexpr (ALIBI) { p0[r] = fmaf(p0[r], U.c2, fmaf((float)c, U.sl2, tb)); p1[r] = fmaf(p1[r], U.c2, fmaf((float)(c + 32), U.sl2, tb)); }
                else { p0[r] *= U.c2; p1[r] *= U.c2; } }
            const bool need_mask = (k0 + 63 > qw0) || (WINDOW && (k0 < qw1 - WIN));
            if (need_mask) {
#pragma unroll
                for (int r = 0; r < 16; ++r) { const int c = (r & 3) + 8 * (r >> 2); const int d0_ = lim - c, d1_ = lim - c - 32;
                    const bool ok0 = WINDOW ? ((unsigned)d0_ <= (unsigned)WIN) : (d0_ >= 0), ok1 = WINDOW ? ((unsigned)d1_ <= (unsigned)WIN) : (d1_ >= 0);
                    p0[r] = ok0 ? p0[r] : -INFINITY; p1[r] = ok1 ? p1[r] : -INFINITY; }
            }
            if constexpr (MASK) { const unsigned w0 = mw.x >> (4 * hi), w1 = mw.y >> (4 * hi);
#pragma unroll
                for (int r = 0; r < 16; ++r) { const int c = (r & 3) + 8 * (r >> 2);
                    const unsigned b0 = (unsigned)((int)(w0 << (31 - c)) >> 31), b1 = (unsigned)((int)(w1 << (31 - c)) >> 31);
                    p0[r] = __uint_as_float((__float_as_uint(p0[r]) & b0) | (0xff800000u & ~b0)); p1[r] = __uint_as_float((__float_as_uint(p1[r]) & b1) | (0xff800000u & ~b1)); }
            }
            FA_SBAR();
            float pmax = p0[0];
#pragma unroll
            for (int r = 1; r < 16; ++r) pmax = fmaxf(pmax, p0[r]);
#pragma unroll
            for (int r = 0; r < 16; ++r) pmax = fmaxf(pmax, p1[r]);
            { auto rr = __builtin_amdgcn_permlane32_swap(__float_as_uint(pmax), __float_as_uint(pmax), false, false); pmax = fmaxf(__uint_as_float(rr[0]), __uint_as_float(rr[1])); }
            float mn, alpha;
            if (__builtin_expect(__all(pmax - m_reg <= THR2), 1)) { mn = m_reg; alpha = 1.f; }
            else { mn = fmaxf(m_reg, pmax); alpha = __builtin_amdgcn_exp2f(m_reg - mn); m_reg = mn; }
            float ps = 0.f;
#pragma unroll
            for (int r = 0; r < 16; ++r) { p0[r] = __builtin_amdgcn_exp2f(p0[r] - mn); p1[r] = __builtin_amdgcn_exp2f(p1[r] - mn); ps += p0[r] + p1[r]; }
            { auto rr = __builtin_amdgcn_permlane32_swap(__float_as_uint(ps), __float_as_uint(ps), false, false); ps = __uint_as_float(rr[0]) + __uint_as_float(rr[1]); }
            l_reg = l_reg * alpha + ps;
            FA_SBAR();
            bf16x8 pa0, pa1, pa2, pa3;
#define FA_PK4(P, BASE, OUT) do { unsigned a0 = cvtpk(P[BASE + 0], P[BASE + 1]), a1 = cvtpk(P[BASE + 2], P[BASE + 3]);   \
    unsigned b0 = cvtpk(P[BASE + 4], P[BASE + 5]), b1 = cvtpk(P[BASE + 6], P[BASE + 7]);                              \
    auto r0 = __builtin_amdgcn_permlane32_swap(a0, b0, false, false); auto r1 = __builtin_amdgcn_permlane32_swap(a1, b1, false, false); \
    u32x4 w = {r0[0], r1[0], r0[1], r1[1]}; OUT = *reinterpret_cast<bf16x8*>(&w); } while (0)
            FA_PK4(p0, 0, pa0); FA_PK4(p0, 8, pa1); FA_PK4(p1, 0, pa2); FA_PK4(p1, 8, pa3);
#undef FA_PK4
            FA_SBAR();
            if (__any(alpha < 1.f)) { if (hi == 0) wsf[r32] = alpha; asm volatile("s_waitcnt lgkmcnt(0)" ::: "memory");
#pragma unroll
                for (int r = 0; r < 16; ++r) { const float al = wsf[crow(r, hi)];
#pragma unroll
                    for (int d = 0; d < 4; ++d) o[d][r] *= al; }
                asm volatile("s_waitcnt lgkmcnt(0)" ::: "memory"); }
            pv_d0(o, vb0 + buf * SHM_V, pa0, pa1, pa2, pa3);
        }
        if (more) { if constexpr (MASK) mw = mwn; }
        asm volatile("s_waitcnt vmcnt(0)" ::: "memory");
        __syncthreads();
    }
    if (hi == 0) wsf[32 + r32] = l_reg; asm volatile("s_waitcnt lgkmcnt(0)" ::: "memory");
#pragma unroll
    for (int r = 0; r < 16; ++r) { const float rl = __builtin_amdgcn_rcpf(wsf[32 + crow(r, hi)]);
#pragma unroll
        for (int d = 0; d < 4; ++d) o[d][r] *= rl; }
    asm volatile("s_waitcnt lgkmcnt(0)" ::: "memory");
    lse2 = m_reg + __builtin_amdgcn_logf(l_reg);
#undef FA_DMA
}
template <int DQK, bool ALIBI, bool MASK, bool ROPEQ>
__device__ __forceinline__ void attn_unit4(const UnitP& U, LAS unsigned char* lds, f32x16 (&o)[4], float& lse2) {
    constexpr int KROWB = DQK * 2, SHM_V = 16384, SHM_K = 64 * KROWB, KOFF = 3 * SHM_V, WSOFF = KOFF + 3 * 64 * 192 * 2, AUGOFF = WSOFF + 2048;
    constexpr int KCH = DQK / 8, KPT = 64 * KCH / 512, ND0 = DQK / 16;
#define FA4_SWZ(row_) ((KROWB == 256) ? (((row_) & 15) << 4) : ((((row_) >> 1) & 7) << 4))
    int tid_o_ = threadIdx.x; asm volatile("" : "+v"(tid_o_)); const int tid = tid_o_, wid = __builtin_amdgcn_readfirstlane(tid >> 6), lane = tid & 63, r32 = lane & 31, hi = lane >> 5;
    LAS float* wsf = (LAS float*)(lds + WSOFF + wid * 256);
    float m_reg = -1e30f, l_reg = 0.f;
#pragma unroll
    for (int d = 0; d < 4; ++d)
#pragma unroll
        for (int r = 0; r < 16; ++r) o[d][r] = 0.f;
    bf16x8 qr[ND0];
    const int qi = U.q0 + wid * 32 + r32;
    {   const bf16* Qw = U.Q + (size_t)(wid * 32 + r32) * U.ldq + hi * 8;
#pragma unroll
        for (int d0 = 0; d0 < ND0; ++d0) qr[d0] = *(const bf16x8*)(Qw + d0 * 16);
        if constexpr (ROPEQ) {
#pragma unroll
            for (int pb = 0; pb < 2; ++pb) { bf16x8 a = qr[ND0 - 4 + pb], b = qr[ND0 - 2 + pb];
#pragma unroll
                for (int e = 0; e < 8; ++e) { const int fi = pb * 16 + hi * 8 + e; const float inv = __builtin_amdgcn_exp2f(-0.41524101186092029f * (float)fi);
                    const float ang = (float)qi * inv; const float n = rintf(ang * 0.15915494309189535f);
                    float rr = fmaf(-n, 6.2831854820251465f, ang); rr = fmaf(-n, -1.7484555e-07f, rr); const float fr = rr * 0.15915494309189535f;
                    const float sn = __builtin_amdgcn_sinf(fr), cs = __builtin_amdgcn_cosf(fr);
                    const float x1 = __uint_as_float((unsigned)(unsigned short)a[e] << 16), x2 = __uint_as_float((unsigned)(unsigned short)b[e] << 16);
                    const unsigned w = cvtpk(x1 * cs - x2 * sn, x1 * sn + x2 * cs); a[e] = (short)(w & 0xffffu); b[e] = (short)(w >> 16); }
                qr[ND0 - 4 + pb] = a; qr[ND0 - 2 + pb] = b; }
        }
    }
    bf16x8 qaug = {0, 0, 0, 0, 0, 0, 0, 0};
    if constexpr (ALIBI) { const float g_ = U.sl2 / U.c2; const unsigned gh_ = (__float_as_uint(g_) + 0x7fffu + ((__float_as_uint(g_) >> 16) & 1u)) & 0xffff0000u; const float gl_ = g_ - __uint_as_float(gh_);
        const unsigned glb_ = (__float_as_uint(gl_) + 0x7fffu + ((__float_as_uint(gl_) >> 16) & 1u)) & 0xffff0000u;
        const unsigned w0_ = (__float_as_uint(-128.f * __uint_as_float(gh_)) >> 16) | (__float_as_uint(-__uint_as_float(gh_)) & 0xffff0000u);
        const unsigned w1_ = (__float_as_uint(-128.f * __uint_as_float(glb_)) >> 16) | (__float_as_uint(-__uint_as_float(glb_)) & 0xffff0000u);
        const u32x4 qa_ = {hi ? 0u : w0_, hi ? 0u : w1_, 0u, 0u}; qaug = *reinterpret_cast<const bf16x8*>(&qa_); }
    const LAS unsigned char* augp = lds + AUGOFF + r32 * 32 + hi * 16;
    unsigned kgo[KPT], vgo[2];
#pragma unroll
    for (int i_ = 0; i_ < KPT; ++i_) { const int p_ = (wid + 8 * i_) * 1024 + lane * 16, row_ = p_ / KROWB, wi_ = (p_ % KROWB) ^ FA4_SWZ(row_); kgo[i_] = (unsigned)((size_t)row_ * U.ldk * 2 + wi_); }
#pragma unroll
    for (int i_ = 0; i_ < 2; ++i_) { const int p_ = (wid + 8 * i_) * 1024 + lane * 16, sub_ = p_ >> 9, rem_ = p_ & 511, kk_ = (sub_ >> 2) * 8 + (rem_ >> 6), k_ = (kk_ & ~0xC) | ((kk_ & 4) << 1) | ((kk_ & 8) >> 1), col_ = (sub_ & 3) * 32 + ((rem_ & 63) >> 1);
        vgo[i_] = (unsigned)(((size_t)k_ * U.ldv + col_) * 2); }
#define FA3_DMA(k0_, kb_, vb_) do { const char* kg_ = (const char*)U.K + (size_t)(k0_) * U.ldk * 2; const char* vg_ = (const char*)U.V + (size_t)(k0_) * U.ldv * 2; \
        _Pragma("unroll") for (int i_ = 0; i_ < KPT; ++i_) __builtin_amdgcn_global_load_lds((const unsigned*)(kg_ + kgo[i_]), (LAS unsigned*)(lds + KOFF + (kb_) * SHM_K + (wid + 8 * i_) * 1024), 16, 0, 0); \
        _Pragma("unroll") for (int i_ = 0; i_ < 2; ++i_) __builtin_amdgcn_global_load_lds((const unsigned*)(vg_ + vgo[i_]), (LAS unsigned*)(lds + (vb_) * SHM_V + (wid + 8 * i_) * 1024), 16, 0, 0); \
        if constexpr (ALIBI) { if (tid < 128) { const int rel_ = U.q0 + 255 - ((k0_) + (tid >> 1)); const unsigned ab_ = (__float_as_uint((float)(rel_ >> 7)) >> 16) | (__float_as_uint((float)(rel_ & 127)) & 0xffff0000u); \
            const unsigned z_ = (tid & 1) ? 0u : ab_; *(LAS u32x4*)(lds + AUGOFF + (kb_) * 2048 + tid * 16) = (u32x4){z_, z_, 0u, 0u}; } } } while (0)
    const int vb0 = (int)(unsigned)(uintptr_t)lds + v_rd_base(lane);
    const int NT = U.kt1 - U.kt0;
    const int qw0 = U.q0 + wid * 32, qw1 = qw0 + 31;
    const int swz_ = FA4_SWZ(r32); const int lp = (hi * 16) ^ (swz_ & 0x70); const int hsw = (KROWB == 256) ? (swz_ & 0x80) : 0;
    const LAS unsigned char* kbase = lds + KOFF + r32 * KROWB;
    const LAS unsigned char* kq0 = kbase + lp; const LAS unsigned char* kq1 = kbase + (lp ^ 32); const LAS unsigned char* kq2 = kbase + (lp ^ 64); const LAS unsigned char* kq3 = kbase + (lp ^ 96);
    bf16x8 pa0, pa1, pa2, pa3;
#define FA3_PK4(P, BASE, OUT) do { unsigned a0 = cvtpk(P[BASE + 0], P[BASE + 1]), a1 = cvtpk(P[BASE + 2], P[BASE + 3]);   \
    unsigned b0 = cvtpk(P[BASE + 4], P[BASE + 5]), b1 = cvtpk(P[BASE + 6], P[BASE + 7]);                              \
    auto r0 = __builtin_amdgcn_permlane32_swap(a0, b0, false, false); auto r1 = __builtin_amdgcn_permlane32_swap(a1, b1, false, false); \
    u32x4 w = {r0[0], r1[0], r0[1], r1[1]}; OUT = *reinterpret_cast<bf16x8*>(&w); } while (0)
#define FA3_SCORE(kb_, k0_, MW) do { f32x16 p0, p1; _Pragma("unroll") for (int r = 0; r < 16; ++r) { p0[r] = 0.f; p1[r] = 0.f; } const int so_ = (kb_) * SHM_K; \
          \
        bf16x8 kfa_[ND0], kfb_[ND0]; bf16x8 a0_ = qaug, a1_ = qaug; \
        _Pragma("unroll") for (int d0 = 0; d0 < ND0 + 2; ++d0) { \
            if (d0 < ND0) { const LAS unsigned char* kp_ = ((d0 & 3) == 0 ? kq0 : (d0 & 3) == 1 ? kq1 : (d0 & 3) == 2 ? kq2 : kq3) + so_ + ((KROWB == 256) ? (((d0 >> 2) * 128) ^ hsw) : (d0 >> 2) * 128); \
                kfa_[d0] = *(const LAS bf16x8*)(kp_); kfb_[d0] = *(const LAS bf16x8*)(kp_ + 32 * KROWB); } \
            if constexpr (ALIBI) { if (d0 == ND0) { a0_ = *(const LAS bf16x8*)(augp + (kb_) * 2048); a1_ = *(const LAS bf16x8*)(augp + (kb_) * 2048 + 1024); } } \
            FA_SBAR(); \
            if (d0 >= 2) { p0 = __builtin_amdgcn_mfma_f32_32x32x16_bf16(kfa_[d0 - 2], qr[d0 - 2], p0, 0, 0, 0); p1 = __builtin_amdgcn_mfma_f32_32x32x16_bf16(kfb_[d0 - 2], qr[d0 - 2], p1, 0, 0, 0); } \
            FA_SBAR(); } \
        if constexpr (ALIBI) { p0 = __builtin_amdgcn_mfma_f32_32x32x16_bf16(a0_, qaug, p0, 0, 0, 0); p1 = __builtin_amdgcn_mfma_f32_32x32x16_bf16(a1_, qaug, p1, 0, 0, 0); } \
        const int lim_ = qi - (k0_) - 4 * hi; \
        if ((k0_) + 63 > qw0) { _Pragma("unroll") for (int r = 0; r < 16; ++r) { const int c = (r & 3) + 8 * (r >> 2); p0[r] = (lim_ - c >= 0) ? p0[r] : -INFINITY; p1[r] = (lim_ - c - 32 >= 0) ? p1[r] : -INFINITY; } } \
        if constexpr (MASK) { const unsigned w0_ = MW.x >> (4 * hi), w1_ = MW.y >> (4 * hi); \
            _Pragma("unroll") for (int r = 0; r < 16; ++r) { const int c = (r & 3) + 8 * (r >> 2); \
                const unsigned b0_ = (unsigned)((int)(w0_ << (31 - c)) >> 31), b1_ = (unsigned)((int)(w1_ << (31 - c)) >> 31); \
                p0[r] = __uint_as_float((__float_as_uint(p0[r]) & b0_) | (0xff800000u & ~b0_)); p1[r] = __uint_as_float((__float_as_uint(p1[r]) & b1_) | (0xff800000u & ~b1_)); } } \
        FA_SBAR(); \
        float pmax_ = p0[0]; \
        _Pragma("unroll") for (int r = 1; r < 16; ++r) pmax_ = fmaxf(pmax_, p0[r]); \
        _Pragma("unroll") for (int r = 0; r < 16; ++r) pmax_ = fmaxf(pmax_, p1[r]); \
        { auto rr = __builtin_amdgcn_permlane32_swap(__float_as_uint(pmax_), __float_as_uint(pmax_), false, false); pmax_ = fmaxf(__uint_as_float(rr[0]), __uint_as_float(rr[1])); } \
        pmax_ *= U.c2; float mn_, alpha_; \
        if (__builtin_expect(__all(pmax_ - m_reg <= THR2), 1)) { mn_ = m_reg; alpha_ = 1.f; } \
        else { mn_ = fmaxf(m_reg, pmax_); alpha_ = __builtin_amdgcn_exp2f(m_reg - mn_); m_reg = mn_; } \
        float ps_ = 0.f; \
        _Pragma("unroll") for (int r = 0; r < 16; ++r) { p0[r] = __builtin_amdgcn_exp2f(fmaf(p0[r], U.c2, -mn_)); p1[r] = __builtin_amdgcn_exp2f(fmaf(p1[r], U.c2, -mn_)); ps_ += p0[r] + p1[r]; } \
        { auto rr = __builtin_amdgcn_permlane32_swap(__float_as_uint(ps_), __float_as_uint(ps_), false, false); ps_ = __uint_as_float(rr[0]) + __uint_as_float(rr[1]); } \
        l_reg = l_reg * alpha_ + ps_; \
        FA_SBAR(); \
        FA3_PK4(p0, 0, pa0); FA3_PK4(p0, 8, pa1); FA3_PK4(p1, 0, pa2); FA3_PK4(p1, 8, pa3); \
        FA_SBAR(); \
        if (__any(alpha_ < 1.f)) { if (hi == 0) wsf[r32] = alpha_; asm volatile("s_waitcnt lgkmcnt(0)" ::: "memory"); \
            _Pragma("unroll") for (int r = 0; r < 16; ++r) { const float al = wsf[crow(r, hi)]; _Pragma("unroll") for (int d = 0; d < 4; ++d) o[d][r] *= al; } \
            asm volatile("s_waitcnt lgkmcnt(0)" ::: "memory"); } } while (0)
    u32x2 mw = {0u, 0u}, mwn = {0u, 0u};
    const unsigned* mrow = MASK ? U.mask + (size_t)(wid * 32 + r32) * 512 : nullptr;
    FA3_DMA(U.kt0 * 64, 0, 0); if constexpr (MASK) mw = *(const u32x2*)(mrow + U.kt0 * 2);
    if (NT > 1) FA3_DMA(U.kt0 * 64 + 64, 1, 1);
    asm volatile("s_waitcnt vmcnt(0)" ::: "memory"); __syncthreads();
    int sl = 0;
#pragma nounroll
    for (int jt = 0; jt < NT; ++jt) {
        const int k0 = (U.kt0 + jt) * 64; const int s2 = sl == 0 ? 2 : sl - 1;
        if constexpr (MASK) { if (jt + 1 < NT) mwn = *(const u32x2*)(mrow + (k0 >> 5) + 2); }
        const bool more2 = jt + 2 < NT;
        if (more2) FA3_DMA(k0 + 128, s2, s2);
        if (k0 <= qw1) { FA3_SCORE(sl, k0, mw); pv_pipe(o, vb0 + sl * SHM_V, pa0, pa1, pa2, pa3); }
        if constexpr (MASK) mw = mwn;
        sl = sl == 2 ? 0 : sl + 1;
        if (more2) asm volatile("s_waitcnt vmcnt(%0)" :: "n"(KPT + 2) : "memory");
        else asm volatile("s_waitcnt vmcnt(0)" ::: "memory");
        __syncthreads();
    }
    if (hi == 0) wsf[32 + r32] = l_reg; asm volatile("s_waitcnt lgkmcnt(0)" ::: "memory");
#pragma unroll
    for (int r = 0; r < 16; ++r) { const float rl = __builtin_amdgcn_rcpf(wsf[32 + crow(r, hi)]);
#pragma unroll
        for (int d = 0; d < 4; ++d) o[d][r] *= rl; }
    asm volatile("s_waitcnt lgkmcnt(0)" ::: "memory");
    lse2 = m_reg + __builtin_amdgcn_logf(l_reg);
#undef FA3_DMA
#undef FA4_SWZ
#undef FA3_PK4
#undef FA3_SCORE
}
__device__ __forceinline__ void store_o_bf16(const f32x16 (&o)[4], bf16* outw, size_t ldo, int r32, int hi) {
    asm volatile("" : "+v"(r32), "+v"(hi));
    const bool odd = r32 & 1; const int lo_ = lane_opaque();
#pragma unroll
    for (int d0 = 0; d0 < 4; ++d0)
#pragma unroll
        for (int rp = 0; rp < 8; ++rp) { const int r0 = 2 * rp, r1 = 2 * rp + 1;
            float e0_ = o[d0][r0], e1_ = o[d0][r1]; asm("" : "+v"(e0_), "+v"(e1_));
            const float send = odd ? e0_ : e1_; const float recv = shx(send, 1, lo_);
            const unsigned w = odd ? cvtpk(recv, e1_) : cvtpk(e0_, recv);
            const int row = crow(odd ? r1 : r0, hi), col = d0 * 32 + (r32 & ~1);
            *(unsigned*)(outw + (size_t)row * ldo + col) = w; }
}
}
struct Frame {
    LAS unsigned char* lds;
    volatile LAS unsigned* MISC;
    gu32* ctl;
    int tid, lane, wave;
    int vcu, G, gw, NGW;
};
__device__ __forceinline__ float wave_sum(float v) {
    int l = (int)__builtin_amdgcn_mbcnt_hi(~0u, __builtin_amdgcn_mbcnt_lo(~0u, 0u)); asm volatile("" : "+v"(l));
#pragma unroll
    for (int o = 1; o < 64; o <<= 1) v += __int_as_float(__builtin_amdgcn_ds_bpermute((l ^ o) << 2, __float_as_int(v)));
    return v;
}
template <int MODE>
__device__ __forceinline__ void transpose_item(const float* W, int K, int N, int nblk, bf16* WT, const float* kscale, LAS float* scr, int item, int lane) {
    const int kb = item / nblk, nb = item % nblk, k0 = 64 * kb, n0 = 32 * nb;
    const int c4 = 4 * (lane & 7), nl = n0 + c4; const bool inb = nl < N;
    f32x4 v[8];
#pragma unroll
    for (int i = 0; i < 8; ++i) { const int kk = 8 * i + (lane >> 3); v[i] = inb ? *(const GAS f32x4*)(W + (size_t)(k0 + kk) * N + nl) : (f32x4){0.f, 0.f, 0.f, 0.f}; }
#pragma unroll
    for (int i = 0; i < 8; ++i) { const int kk = 8 * i + (lane >> 3); f32x4 x = v[i]; if (kscale) x = x * kscale[k0 + kk];
        LAS float* d = scr + kk * 33 + c4; d[0] = x[0]; d[1] = x[1]; d[2] = x[2]; d[3] = x[3]; }
    LDS_WAIT(); asm volatile("" ::: "memory");
    const int c = lane & 7;
#pragma unroll
    for (int j = 0; j < 4; ++j) { const int n = (lane >> 3) + 8 * j; const LAS float* s = scr + (8 * c) * 33 + n;
        v4u o; o.x = pk2(s[0 * 33], s[1 * 33]); o.y = pk2(s[2 * 33], s[3 * 33]); o.z = pk2(s[4 * 33], s[5 * 33]); o.w = pk2(s[6 * 33], s[7 * 33]);
        const int ng = n0 + n; const int drow = MODE == 0 ? ng : ((ng >> 7) * 256 + (ng & 127) + (MODE == 2 ? 128 : 0));
        *(GAS v4u*)(WT + (size_t)drow * K + k0 + 8 * c) = o; }
    LDS_WAIT(); asm volatile("" ::: "memory");
}
template <int MODE>
__device__ __forceinline__ void convert_weight(Frame& F, const float* W, int K, int N, int Npad, bf16* WT, const float* kscale) {
    LAS float* scr = (LAS float*)(F.lds + RING_OFF + F.wave * 16384);
    const int nblk = Npad / 32, nitems = (K / 64) * nblk;
    for (int it = F.gw; it < nitems; it += F.NGW) transpose_item<MODE>(W, K, N, nblk, WT, kscale, scr, it, F.lane);
}
__device__ __forceinline__ void convert_ffn(Frame& F, const float* wg, const float* wu, const float* wd, unsigned char* dst) {
    convert_weight<1>(F, wg, DM, DFF, DFF, (bf16*)dst, nullptr);
    convert_weight<2>(F, wu, DM, DFF, DFF, (bf16*)dst, nullptr);
    convert_weight<0>(F, wd, DFF, DM, DM, (bf16*)(dst + WF_DOWN_OFF), nullptr);
}
__device__ __forceinline__ void convert_x(Frame& F, const float* x, bf16* X) {
    const size_t n8 = (size_t)S * DM / 8;
    for (size_t i = (size_t)F.gw * 64 + F.lane; i < n8; i += (size_t)F.NGW * 64) {
        const f32x4 a = *(const GAS f32x4*)(x + i * 8), b = *(const GAS f32x4*)(x + i * 8 + 4);
        v4u o; o.x = pk2(a[0], a[1]); o.y = pk2(a[2], a[3]); o.z = pk2(b[0], b[1]); o.w = pk2(b[2], b[3]);
        *(GAS v4u*)(X + i * 8) = o; }
}
__device__ __forceinline__ void scale_x(Frame& F, const bf16* X, float* Y) {
    const size_t n8 = (size_t)S * DM / 8;
    for (size_t i = (size_t)F.gw * 64 + F.lane; i < n8; i += (size_t)F.NGW * 64) {
        const v4u w = *(const GAS v4u*)(X + i * 8);
        f32x4 a = {ALPHA * bflo(w.x), ALPHA * bfhi(w.x), ALPHA * bflo(w.y), ALPHA * bfhi(w.y)}, b = {ALPHA * bflo(w.z), ALPHA * bfhi(w.z), ALPHA * bflo(w.w), ALPHA * bfhi(w.w)};
        *(GAS f32x4*)(Y + i * 8) = a; *(GAS f32x4*)(Y + i * 8 + 4) = b; }
}
template <bool FINAL>
__device__ __forceinline__ void ln_phase(Frame& F, const bf16* Y, const float* g, const float* b, bf16* X, float* out) {
    for (int row = F.gw; row < S; row += F.NGW) {
        const GAS v4u* yr = (const GAS v4u*)(Y + (size_t)row * DM) + F.lane;
        float v[4][8]; float s = 0.f;
#pragma unroll
        for (int j = 0; j < 4; ++j) { const v4u w = yr[64 * j]; v[j][0] = bflo(w.x); v[j][1] = bfhi(w.x); v[j][2] = bflo(w.y); v[j][3] = bfhi(w.y); v[j][4] = bflo(w.z); v[j][5] = bfhi(w.z); v[j][6] = bflo(w.w); v[j][7] = bfhi(w.w);
#pragma unroll
            for (int e = 0; e < 8; ++e) s += v[j][e]; }
        const float mean = wave_sum(s) * (1.f / DM); float s2 = 0.f;
#pragma unroll
        for (int j = 0; j < 4; ++j)
#pragma unroll
            for (int e = 0; e < 8; ++e) { v[j][e] -= mean; s2 += v[j][e] * v[j][e]; }
        const float rstd = 1.f / sqrtf(wave_sum(s2) * (1.f / DM) + LN_EPS);
#pragma unroll
        for (int j = 0; j < 4; ++j) { const int c0 = 8 * (64 * j + F.lane);
            const f32x4 g0 = *(const GAS f32x4*)(g + c0), g1 = *(const GAS f32x4*)(g + c0 + 4), b0 = *(const GAS f32x4*)(b + c0), b1 = *(const GAS f32x4*)(b + c0 + 4);
            f32x4 o0, o1;
#pragma unroll
            for (int e = 0; e < 4; ++e) { o0[e] = v[j][e] * rstd * g0[e] + b0[e]; o1[e] = v[j][4 + e] * rstd * g1[e] + b1[e]; }
            if (FINAL) { *(GAS f32x4*)(out + (size_t)row * DM + c0) = o0; *(GAS f32x4*)(out + (size_t)row * DM + c0 + 4) = o1; }
            else { v4u w; w.x = pk2(o0[0], o0[1]); w.y = pk2(o0[2], o0[3]); w.z = pk2(o1[0], o1[1]); w.w = pk2(o1[2], o1[3]); *(GAS v4u*)(X + (size_t)row * DM + c0) = w; } }
    }
}
constexpr float LOG2E = 1.4426950408889634f;
__device__ __forceinline__ void mixer_a_phase(Frame& F, const bf16* P, bf16* OA, float* LSE) {
    const int wid = F.wave, r32 = F.lane & 31, hi = F.lane >> 5;
    for (int u = F.vcu; u < 1536; u += F.G) {
        const int g = u >> 9, rem = u & 511, h = rem >> 6, j = rem & 63;
        const int dsh = 2 * g, d = 1 << dsh, c = j >> (6 - dsh), blk = j & ((64 >> dsh) - 1), I0 = blk * 256;
        fa::UnitP U; U.ldq = U.ldk = U.ldv = (size_t)d * EINP;
        const bf16* base = P + (size_t)c * EINP + h * 128;
        U.Q = base + (size_t)I0 * U.ldq; U.K = base + 1024; U.V = base + 2048;
        U.q0 = I0; U.kt0 = I0 ? (I0 >> 6) - 2 : 0; U.kt1 = (I0 >> 6) + 4;
        U.sl2 = exp2f(-(float)(h + 1)) * (float)d * LOG2E; U.c2 = 0.08838834764831845f * LOG2E; U.mask = nullptr;
        fa::f32x16 o[4]; float lse2;
        fa::attn_unit<128, true, true, false, false>(U, F.lds, o, lse2);
        const int row0 = I0 + wid * 32;
        fa::store_o_bf16(o, OA + (size_t)g * S * 1024 + ((size_t)row0 * d + c) * 1024 + h * 128, (size_t)d * 1024, r32, hi);
        if (hi == 0) LSE[((size_t)g * S + (size_t)(row0 + r32) * d + c) * 8 + h] = lse2;
    }
}
__device__ __forceinline__ void merge_a(Frame& F, const bf16* OA, const float* LSE, bf16* O) {
    const int h = F.lane >> 3;
    for (int pos = F.gw; pos < S; pos += F.NGW) {
        const float l0 = LSE[((size_t)0 * S + pos) * 8 + h], l1 = LSE[((size_t)1 * S + pos) * 8 + h], l2 = LSE[((size_t)2 * S + pos) * 8 + h];
        const float mx = fmaxf(l0, fmaxf(l1, l2)); float w0 = exp2f(l0 - mx), w1 = exp2f(l1 - mx), w2 = exp2f(l2 - mx); const float inv = 1.f / (w0 + w1 + w2); w0 *= inv; w1 *= inv; w2 *= inv;
#pragma unroll
        for (int hf = 0; hf < 2; ++hf) { const size_t off = (size_t)pos * 1024 + 16 * F.lane + 8 * hf;
            const v4u a = *(const GAS v4u*)(OA + off), b = *(const GAS v4u*)(OA + (size_t)S * 1024 + off), c = *(const GAS v4u*)(OA + (size_t)2 * S * 1024 + off);
            v4u o;
            o.x = pk2(w0 * bflo(a.x) + w1 * bflo(b.x) + w2 * bflo(c.x), w0 * bfhi(a.x) + w1 * bfhi(b.x) + w2 * bfhi(c.x));
            o.y = pk2(w0 * bflo(a.y) + w1 * bflo(b.y) + w2 * bflo(c.y), w0 * bfhi(a.y) + w1 * bfhi(b.y) + w2 * bfhi(c.y));
            o.z = pk2(w0 * bflo(a.z) + w1 * bflo(b.z) + w2 * bflo(c.z), w0 * bfhi(a.z) + w1 * bfhi(b.z) + w2 * bfhi(c.z));
            o.w = pk2(w0 * bflo(a.w) + w1 * bflo(b.w) + w2 * bflo(c.w), w0 * bfhi(a.w) + w1 * bfhi(b.w) + w2 * bfhi(c.w));
            *(GAS v4u*)(O + (size_t)pos * DM + 16 * F.lane + 8 * hf) = o; }
    }
}
typedef float f32x16 __attribute__((ext_vector_type(16)));
__device__ __forceinline__ unsigned okey(float f) { const unsigned u = __float_as_uint(f); return (u & 0x80000000u) ? ~u : (u | 0x80000000u); }
__device__ __forceinline__ int hswz(int w) { return (w & ~31) | ((w ^ (w >> 5)) & 31); }
__device__ __forceinline__ void find_kth(const LAS unsigned* hq, int target, int lane, int& bin, int& above, int& binc) {
    unsigned w[32]; unsigned cl = 0;
#pragma unroll
    for (int i = 0; i < 32; ++i) { w[i] = hq[32 * lane + ((i ^ lane) & 31)]; cl += (w[i] & 0xffffu) + (w[i] >> 16); }
    unsigned suf = cl;
#pragma unroll
    for (int off = 1; off < 64; off <<= 1) { const unsigned t = __shfl_down(suf, off); if (lane + off < 64) suf += t; }
    const unsigned long long bal = __ballot((int)suf >= target);
    if (bal == 0ull) { bin = -1; above = 0; binc = 0; return; }
    const int L = 63 - __clzll((long long)bal);
    int cum = (int)(suf - cl), fb = -1, fab = 0, fc = 0;
#pragma unroll
    for (int i = 31; i >= 0; --i) { const int h16 = (int)(w[i] >> 16), l16 = (int)(w[i] & 0xffffu);
        if (fb < 0) { if (cum + h16 >= target) { fb = 2 * i + 1; fab = cum; fc = h16; } else { cum += h16; if (cum + l16 >= target) { fb = 2 * i; fab = cum; fc = l16; } else cum += l16; } } }
    bin = __shfl(fb, L) + 64 * L; above = __shfl(fab, L); binc = __shfl(fc, L);
}
__device__ __forceinline__ void indexer_unit(const bf16* P, unsigned* MASKB, unsigned* NEARBLK, LAS unsigned char* lds, int unit, int wid, int lane) {
    const int r32 = lane & 31, hi = lane >> 5, wu = unit * 8 + wid, q = 2 * wu + hi;
    LAS unsigned* hist = (LAS unsigned*)(lds + RING_OFF + wid * 16384);
    LAS unsigned char* ring = lds + KI_RING_OFF;
    bf16x8 af[4];
    {   const int jq = (r32 >> 2) & 1, head = (r32 & 3) + 4 * (r32 >> 3);
        const bf16* qrow = P + (size_t)(2 * wu + jq) * EINP + 6144 + head * 64 + hi * 8;
#pragma unroll
        for (int ks = 0; ks < 4; ++ks) af[ks] = *(const bf16x8*)(qrow + ks * 16); }
    float wq[16];
    {   const v4u a = *(const GAS v4u*)(P + (size_t)q * EINP + 7232), b = *(const GAS v4u*)(P + (size_t)q * EINP + 7240);
        wq[0] = bflo(a.x); wq[1] = bfhi(a.x); wq[2] = bflo(a.y); wq[3] = bfhi(a.y); wq[4] = bflo(a.z); wq[5] = bfhi(a.z); wq[6] = bflo(a.w); wq[7] = bfhi(a.w);
        wq[8] = bflo(b.x); wq[9] = bfhi(b.x); wq[10] = bflo(b.y); wq[11] = bfhi(b.y); wq[12] = bflo(b.z); wq[13] = bfhi(b.z); wq[14] = bflo(b.w); wq[15] = bfhi(b.w);
#pragma unroll
        for (int r = 0; r < 16; ++r) wq[r] *= 0.03125f; }
    const int NS = (16 * unit + 16 + 63) >> 6;
    const bool any256 = 16 * unit + 15 >= 255;
    const int prow = wid * 8 + (lane >> 3);
    const char* kgsrc = (const char*)(P + 7168) + (size_t)prow * EINP * 2 + (((lane & 7) * 16) ^ ((prow & 7) << 4));
    const int lp = (hi * 16) ^ ((r32 & 7) << 4);
    const int fo0 = r32 * 128 + lp, fo1 = r32 * 128 + (lp ^ 32), fo2 = r32 * 128 + (lp ^ 64), fo3 = r32 * 128 + (lp ^ 96);
#define IDX_DMA(s_) __builtin_amdgcn_global_load_lds((const unsigned*)(kgsrc + (size_t)(s_) * 64 * EINP * 2), (LAS unsigned*)(ring + ((s_) & 1) * 8192 + wid * 1024), 16, 0, 0)
#define IDX_SCORE2(slot_, keyA_, keyB_) do { const LAS unsigned char* fb_ = ring + (slot_) * 8192; \
        const bf16x8 b00_ = *(const LAS bf16x8*)(fb_ + fo0), b10_ = *(const LAS bf16x8*)(fb_ + 4096 + fo0), b01_ = *(const LAS bf16x8*)(fb_ + fo1), b11_ = *(const LAS bf16x8*)(fb_ + 4096 + fo1); \
        const bf16x8 b02_ = *(const LAS bf16x8*)(fb_ + fo2), b12_ = *(const LAS bf16x8*)(fb_ + 4096 + fo2), b03_ = *(const LAS bf16x8*)(fb_ + fo3), b13_ = *(const LAS bf16x8*)(fb_ + 4096 + fo3); \
        __builtin_amdgcn_sched_barrier(0); \
        f32x16 a0_, a1_; _Pragma("unroll") for (int r = 0; r < 16; ++r) { a0_[r] = 0.f; a1_[r] = 0.f; } \
        a0_ = __builtin_amdgcn_mfma_f32_32x32x16_bf16(af[0], b00_, a0_, 0, 0, 0); a1_ = __builtin_amdgcn_mfma_f32_32x32x16_bf16(af[0], b10_, a1_, 0, 0, 0); \
        a0_ = __builtin_amdgcn_mfma_f32_32x32x16_bf16(af[1], b01_, a0_, 0, 0, 0); a1_ = __builtin_amdgcn_mfma_f32_32x32x16_bf16(af[1], b11_, a1_, 0, 0, 0); \
        a0_ = __builtin_amdgcn_mfma_f32_32x32x16_bf16(af[2], b02_, a0_, 0, 0, 0); a1_ = __builtin_amdgcn_mfma_f32_32x32x16_bf16(af[2], b12_, a1_, 0, 0, 0); \
        a0_ = __builtin_amdgcn_mfma_f32_32x32x16_bf16(af[3], b03_, a0_, 0, 0, 0); a1_ = __builtin_amdgcn_mfma_f32_32x32x16_bf16(af[3], b13_, a1_, 0, 0, 0); \
        __builtin_amdgcn_sched_barrier(0); \
        float s0a_ = 0.f, s0b_ = 0.f, s1a_ = 0.f, s1b_ = 0.f, t0a_ = 0.f, t0b_ = 0.f, t1a_ = 0.f, t1b_ = 0.f; \
        _Pragma("unroll") for (int r = 0; r < 16; r += 2) { s0a_ = fmaf(wq[r], a0_[r], s0a_); s0b_ = fmaf(wq[r + 1], a0_[r + 1], s0b_); s1a_ = fmaf(wq[r], a1_[r], s1a_); s1b_ = fmaf(wq[r + 1], a1_[r + 1], s1b_); \
            t0a_ = fmaf(wq[r], __builtin_fabsf(a0_[r]), t0a_); t0b_ = fmaf(wq[r + 1], __builtin_fabsf(a0_[r + 1]), t0b_); t1a_ = fmaf(wq[r], __builtin_fabsf(a1_[r]), t1a_); t1b_ = fmaf(wq[r + 1], __builtin_fabsf(a1_[r + 1]), t1b_); \
            asm("" : "+v"(t0a_), "+v"(t0b_), "+v"(t1a_), "+v"(t1b_)); }   \
        keyA_ = okey((s0a_ + s0b_) + (t0a_ + t0b_)); keyB_ = okey((s1a_ + s1b_) + (t1a_ + t1b_)); } while (0)
#define IDX_ZERO() do { _Pragma("unroll") for (int i = 0; i < 16; ++i) ((LAS v4u*)hist)[i * 64 + lane] = (v4u){0u, 0u, 0u, 0u}; LDS_WAIT(); } while (0)
#define IDX_PASS(...) do { IDX_DMA(0); \
        for (int s_ = 0; s_ < NS; ++s_) { asm volatile("s_waitcnt vmcnt(0)" ::: "memory"); __builtin_amdgcn_s_barrier(); asm volatile("" ::: "memory"); \
            if (s_ + 1 < NS) IDX_DMA(s_ + 1); \
            unsigned keyA_, keyB_; IDX_SCORE2(s_ & 1, keyA_, keyB_); \
            { const int kt = 2 * s_; const unsigned key32 = keyA_; __VA_ARGS__ } { const int kt = 2 * s_ + 1; const unsigned key32 = keyB_; __VA_ARGS__ } } \
        __builtin_amdgcn_s_barrier(); } while (0)
    IDX_ZERO();
    IDX_PASS({ if (kt * 32 + r32 <= q) { const int bin = (int)(key32 >> 20); __hip_atomic_fetch_add(hist + hi * 2048 + hswz(bin >> 1), 1u << ((bin & 1) * 16), __ATOMIC_RELAXED, __HIP_MEMORY_SCOPE_WORKGROUP); } });
    LDS_WAIT();
    int b0, a0, c0, b1, a1, c1; find_kth(hist, 256, lane, b0, a0, c0); find_kth(hist + 2048, 256, lane, b1, a1, c1);
    const int mybin = hi ? b1 : b0;
    int last0 = 0, last1 = 0;
    constexpr int IDX_CAP = 384;
    volatile LAS unsigned* uflag = (volatile LAS unsigned*)(lds + MISC_OFF + 96);
    if ((b0 >= 0 && c0 > IDX_CAP) || (b1 >= 0 && c1 > IDX_CAP)) { if (lane == 0) *uflag = 1u; }
    LDS_WAIT(); __builtin_amdgcn_s_barrier(); asm volatile("" ::: "memory");
    const bool use_list = any256 && (*uflag == 0u);
    __builtin_amdgcn_s_barrier(); asm volatile("" ::: "memory");
    if (wid == 0 && lane == 0) *uflag = 0u;
    if (use_list) {
        LAS unsigned* rows = hist;
        LAS unsigned long long* lists = (LAS unsigned long long*)((LAS unsigned char*)hist + 4096);
        LAS unsigned* cnt = (LAS unsigned*)((LAS unsigned char*)hist + 4096 + 2 * IDX_CAP * 8);
#pragma unroll
        for (int i = 0; i < 4; ++i) ((LAS v4u*)rows)[i * 64 + lane] = (v4u){0u, 0u, 0u, 0u};
        if (lane < 4) cnt[lane] = 0u;
        LDS_WAIT();
        IDX_PASS({ const bool valid = kt * 32 + r32 <= q; const int bin = (int)(key32 >> 20);
                   const bool defin = valid && (mybin < 0 || bin > mybin); const bool amb = valid && mybin >= 0 && bin == mybin;
                   const unsigned long long bal = __ballot(defin); const unsigned w0_ = (unsigned)bal, w1_ = (unsigned)(bal >> 32);
                   if (w0_) last0 = kt * 32 + 31 - __clz((int)w0_); if (w1_) last1 = kt * 32 + 31 - __clz((int)w1_);
                   if (lane == 0) rows[kt] = w0_; if (lane == 32) rows[512 + kt] = w1_;
                   if (amb) { const unsigned idx = __hip_atomic_fetch_add(cnt + hi, 1u, __ATOMIC_RELAXED, __HIP_MEMORY_SCOPE_WORKGROUP);
                              if (idx < (unsigned)IDX_CAP) lists[hi * IDX_CAP + idx] = ((unsigned long long)key32 << 32) | (unsigned)(kt * 32 + r32); } });
        LDS_WAIT();
#pragma unroll
        for (int j = 0; j < 2; ++j) {
            const int bj = j ? b1 : b0; if (bj < 0) continue;
            const int n = (int)cnt[j] < IDX_CAP ? (int)cnt[j] : IDX_CAP, rsel = 256 - (j ? a1 : a0);
            const LAS unsigned long long* L = lists + j * IDX_CAP;
            for (int i0_ = 0; i0_ < n; i0_ += 64) { const int i = i0_ + lane; const unsigned long long mine = i < n ? L[i] : 0ull; int rank = 0;
                for (int t = 0; t < n; ++t) { const unsigned long long o = L[t];
                    rank += ((unsigned)(o >> 32) > (unsigned)(mine >> 32)) || ((unsigned)(o >> 32) == (unsigned)(mine >> 32) && (unsigned)o < (unsigned)mine) ? 1 : 0; }
                if (i < n && rank < rsel) { const unsigned pos = (unsigned)mine; __hip_atomic_fetch_or(rows + j * 512 + (pos >> 5), 1u << (pos & 31), __ATOMIC_RELAXED, __HIP_MEMORY_SCOPE_WORKGROUP);
                    __hip_atomic_fetch_max(cnt + 2 + j, pos, __ATOMIC_RELAXED, __HIP_MEMORY_SCOPE_WORKGROUP); } }
        }
        LDS_WAIT();
        { const int l0_ = (int)cnt[2], l1_ = (int)cnt[3]; if (l0_ > last0) last0 = l0_; if (l1_ > last1) last1 = l1_; }
#pragma unroll
        for (int i = 0; i < 4; ++i) { const v4u w = ((const LAS v4u*)rows)[i * 64 + lane]; *(GAS v4u*)(MASKB + (size_t)(2 * wu + (i >> 1)) * 512 + (i & 1) * 256 + lane * 4) = w; }
    } else {
        unsigned tau = 0u;
        if (any256) {
            IDX_ZERO();
            IDX_PASS({ if (kt * 32 + r32 <= q && (int)(key32 >> 20) == mybin) { const int bin = (int)((key32 >> 8) & 0xfffu); __hip_atomic_fetch_add(hist + hi * 2048 + hswz(bin >> 1), 1u << ((bin & 1) * 16), __ATOMIC_RELAXED, __HIP_MEMORY_SCOPE_WORKGROUP); } });
            LDS_WAIT();
            int s0 = 0, s1 = 0, t0, t1, u0, u1;
            if (b0 >= 0) find_kth(hist, 256 - a0, lane, s0, t0, u0);
            if (b1 >= 0) find_kth(hist + 2048, 256 - a1, lane, s1, t1, u1);
            const int mysub = hi ? s1 : s0;
            tau = mybin < 0 ? 0u : (((unsigned)mybin << 20) | ((unsigned)(mysub < 0 ? 0 : mysub) << 8));
        }
        IDX_PASS({ const bool sel = (kt * 32 + r32 <= q) && (key32 >= tau); const unsigned long long bal = __ballot(sel);
                   const unsigned w0_ = (unsigned)bal, w1_ = (unsigned)(bal >> 32);
                   if (w0_) last0 = kt * 32 + 31 - __clz((int)w0_); if (w1_) last1 = kt * 32 + 31 - __clz((int)w1_);
                   if (lane == 0) MASKB[(size_t)(2 * wu) * 512 + kt] = w0_;
                   if (lane == 32) MASKB[(size_t)(2 * wu + 1) * 512 + kt] = w1_; });
    }
    if (lane == 0) { const int d0_ = 2 * wu - last0, d1_ = 2 * wu + 1 - last1; atomicMax(NEARBLK + (wu >> 7), (unsigned)(d0_ > d1_ ? d0_ : d1_)); }
#undef IDX_DMA
#undef IDX_SCORE2
#undef IDX_ZERO
#undef IDX_PASS
}
__device__ __forceinline__ void indexer_phase(Frame& F, const bf16* P, unsigned* MASKB, unsigned* NEARBLK) {
    for (int i = 0;; ++i) { const int idx = F.vcu + i * F.G; if (idx >= 1024) break;
        const int seg = idx >> 8, r = idx & 255, unit = (seg & 1) ? (seg * 256 + 255 - r) : (seg * 256 + r);
        indexer_unit(P, MASKB, NEARBLK, F.lds, unit, F.wave, F.lane); }
}
__device__ __forceinline__ void b_norm_bounds(Frame& F, const bf16* P, unsigned* NRM) {
    float mx = 0.f;
    for (int s = F.gw; s < S; s += F.NGW) {
        const v4u* rp = (const v4u*)(P + (size_t)s * EINP + 3072 + 32 * F.lane); float ss = 0.f;
#pragma unroll
        for (int j = 0; j < 4; ++j) { const v4u w = rp[j];
            ss += bflo(w.x) * bflo(w.x) + bfhi(w.x) * bfhi(w.x) + bflo(w.y) * bflo(w.y) + bfhi(w.y) * bfhi(w.y) + bflo(w.z) * bflo(w.z) + bfhi(w.z) * bfhi(w.z) + bflo(w.w) * bflo(w.w) + bfhi(w.w) * bfhi(w.w); }
        ss += __shfl_xor(ss, 1); ss += __shfl_xor(ss, 2); mx = fmaxf(mx, ss); }
    if ((F.lane & 3) == 0) atomicMax(NRM + (F.lane >> 2), __float_as_uint(mx));
}
__device__ __forceinline__ void mixer_b_phase(Frame& F, const bf16* P, const unsigned* MASKB, bf16* O, const unsigned* NRM, const unsigned* NEARBLK, gu32* qctr) {
    const int wid = F.wave, r32 = F.lane & 31, hi = F.lane >> 5;
    for (;;) {
        if (F.tid == 0) F.MISC[16] = __hip_atomic_fetch_add(qctr, 1u, __ATOMIC_RELAXED, __HIP_MEMORY_SCOPE_AGENT);
        __syncthreads(); const int e = (int)F.MISC[16]; __syncthreads();
        if (e >= 512) break;
        const int h = 7 - (e >> 6), qb = 63 - (e & 63);
        fa::UnitP U; U.ldq = U.ldk = U.ldv = (size_t)EINP;
        U.Q = P + (size_t)(qb * 256) * EINP + 3072 + h * 128; U.K = P + 4096 + h * 128; U.V = P + 5120 + h * 128;
        U.q0 = qb * 256; U.kt0 = 0; U.kt1 = (qb + 1) * 4;
        U.sl2 = exp2f(-(float)(h + 1)) * LOG2E; U.c2 = 0.08838834764831845f * LOG2E; U.mask = MASKB + (size_t)(qb * 256) * 512;
        {
            const float B = sqrtf(__uint_as_float(NRM[h]) * __uint_as_float(NRM[8 + h])) * U.c2 * 1.01f;
            const float dmax = (2.f * B + 160.f) / U.sl2 + (float)NEARBLK[qb]; const float kmin = (float)U.q0 - dmax;
            if (kmin > 0.f) U.kt0 = (int)(kmin * (1.f / 64.f)); }
        fa::f32x16 o[4]; float lse2;
        fa::attn_unit4<128, true, true, false>(U, F.lds, o, lse2);
        fa::store_o_bf16(o, O + (size_t)(qb * 256 + wid * 32) * DM + 1024 + h * 128, (size_t)DM, r32, hi);
    }
}
__device__ __forceinline__ void kpe_fill(Frame& F, const bf16* P, bf16* KD) {
    const int h = F.lane >> 3, c = F.lane & 7, cc = c & 3;
    float inv[8];
#pragma unroll
    for (int e = 0; e < 8; ++e) inv[e] = exp2f(-0.41524101186092029f * (float)(8 * cc + e));
    for (int s = F.gw; s < S; s += F.NGW) {
        const bf16* kp = P + (size_t)s * OINP + 4352;
        const v4u a = *(const GAS v4u*)(kp + 8 * cc), b = *(const GAS v4u*)(kp + 32 + 8 * cc);
        const float x1[8] = {bflo(a.x), bfhi(a.x), bflo(a.y), bfhi(a.y), bflo(a.z), bfhi(a.z), bflo(a.w), bfhi(a.w)};
        const float x2[8] = {bflo(b.x), bfhi(b.x), bflo(b.y), bfhi(b.y), bflo(b.z), bfhi(b.z), bflo(b.w), bfhi(b.w)};
        float o[8];
#pragma unroll
        for (int e = 0; e < 8; ++e) { const float ang = (float)s * inv[e]; const float n = rintf(ang * 0.15915494309189535f);
            float rr = fmaf(-n, 6.2831854820251465f, ang); rr = fmaf(-n, -1.7484555e-07f, rr); const float fr = rr * 0.15915494309189535f;
            const float sn = __builtin_amdgcn_sinf(fr), cs = __builtin_amdgcn_cosf(fr);
            o[e] = c < 4 ? x1[e] * cs - x2[e] * sn : x1[e] * sn + x2[e] * cs; }
        v4u w; w.x = pk2(o[0], o[1]); w.y = pk2(o[2], o[3]); w.z = pk2(o[4], o[5]); w.w = pk2(o[6], o[7]);
        *(GAS v4u*)(KD + (size_t)s * 1536 + h * 192 + 128 + 8 * c) = w;
    }
}
__device__ __forceinline__ void c_norm_bounds(Frame& F, const bf16* P, unsigned* NRM) {
    float mx = 0.f;
    for (int s = F.gw; s < S; s += F.NGW) {
        const v4u* rp = (const v4u*)(P + (size_t)s * OINP + 32 * F.lane); float ss = 0.f;
#pragma unroll
        for (int j = 0; j < 4; ++j) { const v4u w = rp[j];
            ss += bflo(w.x) * bflo(w.x) + bfhi(w.x) * bfhi(w.x) + bflo(w.y) * bflo(w.y) + bfhi(w.y) * bfhi(w.y) + bflo(w.z) * bflo(w.z) + bfhi(w.z) * bfhi(w.z) + bflo(w.w) * bflo(w.w) + bfhi(w.w) * bfhi(w.w); }
        ss += __shfl_xor(ss, 1); mx = fmaxf(mx, ss); }
    if ((F.lane & 1) == 0) atomicMax(NRM + (F.lane >> 1), __float_as_uint(mx));
}
__device__ __forceinline__ void mixer_c_unit(Frame& F, const bf16* P, float lam, const float* subln_g, float lam_init, float* SCR, bf16* O, const unsigned* NRM, int h, int qb, int ord) {
    const int wid = F.wave, r32 = F.lane & 31, hi = F.lane >> 5;
    {
        int tq_ = F.tid; asm volatile("" : "+v"(tq_));
        f32x4* scr = (f32x4*)(SCR + (((size_t)(ord & 1) * F.G + blockIdx.x) * 512 + tq_) * 64);
        for (int sub = 0; sub < 2; ++sub) {
            fa::UnitP U; U.ldq = U.ldk = U.ldv = (size_t)OINP;
            U.Q = P + (size_t)(qb * 256) * OINP + h * 128 + sub * 64; U.K = P + 1024 + h * 128 + sub * 64; U.V = P + 2048 + h * 128;
            U.q0 = qb * 256; U.kt0 = 0; U.kt1 = (qb + 1) * 4;
            U.sl2 = exp2f(-(float)(h + 1)) * LOG2E; U.c2 = 0.125f * LOG2E; U.mask = nullptr;
            {
                const float B = sqrtf(__uint_as_float(NRM[h * 2 + sub]) * __uint_as_float(NRM[16 + h * 2 + sub])) * U.c2 * 1.01f;
                const float dmax = (2.f * B + 160.f) / U.sl2; const float kmin = (float)U.q0 - dmax;
                if (kmin > 0.f) U.kt0 = (int)(kmin * (1.f / 64.f)); }
            fa::f32x16 o[4]; float lse2;
            fa::attn_unit4<64, true, false, false>(U, F.lds, o, lse2);
            if (sub == 0) {
#pragma unroll
                for (int d = 0; d < 4; ++d)
#pragma unroll
                    for (int k = 0; k < 4; ++k) scr[d * 4 + k] = (f32x4){o[d][4 * k], o[d][4 * k + 1], o[d][4 * k + 2], o[d][4 * k + 3]};
            } else {
                float ss[16]; const int lo_ = fa::lane_opaque();
#pragma unroll
                for (int r = 0; r < 16; ++r) ss[r] = 0.f;
#pragma unroll
                for (int d = 0; d < 4; ++d)
#pragma unroll
                    for (int k = 0; k < 4; ++k) { const f32x4 s1 = scr[d * 4 + k];
#pragma unroll
                        for (int e2 = 0; e2 < 4; ++e2) { const int r = 4 * k + e2; const float v = s1[e2] - lam * o[d][r]; o[d][r] = v; ss[r] += v * v; } }
#pragma unroll
                for (int r = 0; r < 16; ++r) { float t = ss[r]; t += fa::shx(t, 1, lo_); t += fa::shx(t, 2, lo_); t += fa::shx(t, 4, lo_); t += fa::shx(t, 8, lo_); t += fa::shx(t, 16, lo_);
                    ss[r] = (1.0f - lam_init) / sqrtf(t * (1.0f / 128.0f) + DIFF_EPS); }
#pragma unroll
                for (int d = 0; d < 4; ++d) { const float gcol = subln_g[d * 32 + r32];
#pragma unroll
                    for (int r = 0; r < 16; ++r) o[d][r] *= ss[r] * gcol; }
                fa::store_o_bf16(o, O + (size_t)(qb * 256 + wid * 32) * DM + h * 128, (size_t)DM, r32, hi);
            }
        }
    }
}
__device__ __forceinline__ void mixer_d_unit(Frame& F, const bf16* QF, const bf16* KD, const bf16* VD, bf16* O, int h, int qb) {
    const int wid = F.wave, r32 = F.lane & 31, hi = F.lane >> 5;
    {
        fa::UnitP U; U.ldq = 1536; U.ldk = 1536; U.ldv = 1024;
        U.Q = QF + (size_t)(qb * 256) * 1536 + h * 192; U.K = KD + h * 192; U.V = VD + h * 128;
        U.q0 = qb * 256; U.kt0 = 0; U.kt1 = (qb + 1) * 4;
        U.sl2 = 0.f; U.c2 = 0.07216878364870322f * LOG2E; U.mask = nullptr;
        fa::f32x16 o[4]; float lse2;
        fa::attn_unit4<192, false, false, true>(U, F.lds, o, lse2);
        fa::store_o_bf16(o, O + (size_t)(qb * 256 + wid * 32) * DM + 1024 + h * 128, (size_t)DM, r32, hi);
    }
}
__device__ __forceinline__ void mixer_cd_phase(Frame& F, const bf16* P, const float* lam_p, const float* subln_g, float lam_init, float* SCR, const unsigned* NRM,
                                               const bf16* QF, const bf16* KD, const bf16* VD, bf16* O, gu32* qctr) {
    const float lam = expf(wave_sum(lam_p[F.lane] * lam_p[64 + F.lane])) - expf(wave_sum(lam_p[128 + F.lane] * lam_p[192 + F.lane])) + lam_init;
    int ord = 0;
    for (;;) {
        if (F.tid == 0) F.MISC[16] = __hip_atomic_fetch_add(qctr, 1u, __ATOMIC_RELAXED, __HIP_MEMORY_SCOPE_AGENT);
        __syncthreads(); const int e = (int)F.MISC[16]; __syncthreads();
        if (e >= 1024) break;
        const int idx = e >> 1;
        if ((e & 1) == 0) { mixer_c_unit(F, P, lam, subln_g, lam_init, SCR, O, NRM, 7 - (idx >> 6), 63 - (idx & 63), ord); ++ord; }
        else mixer_d_unit(F, QF, KD, VD, O, idx & 7, 63 - (idx >> 3));
    }
}
struct Args { const float* in[16]; float* out; unsigned char* ws; };
#define GRID_BAR() do { xcd_barrier(bar); int t_ = threadIdx.x; asm volatile("" : "+v"(t_)); F.tid = t_; F.lane = t_ & 63; } while (0)

#define FFN_PHASES(WF)                                                                                                           \
    {   pg8::Gemm g{X, (const bf16*)(WF), S, NGU, DM, DM}; pg8::StaticOrder So; So.init(S, NGU, F.G, (int)blockIdx.x);            \
        pg8::EpiSwiglu E{H, DFF};                                                                                                 \
        pg8::gemm_phase<pg8::EpiSwiglu, pg8::StaticOrder, true, true>(F.lds + RING_OFF, g, So, E); }                              \
    GRID_BAR();                                                                                                                   \
    {   pg8::Gemm g{H, (const bf16*)((WF) + WF_DOWN_OFF), S, DM, DFF, DFF}; pg8::StaticOrder So; So.init(S, DM, F.G, (int)blockIdx.x); \
        pg8::EpiResid E{X, Y, DM, ALPHA, 0.5f};                                                                                   \
        pg8::gemm_phase<pg8::EpiResid, pg8::StaticOrder, true, true>(F.lds + RING_OFF, g, So, E); }                               \
    GRID_BAR();

__global__ void __launch_bounds__(NWAVES * 64, 2) fwd_kernel(Args args) {
    extern __shared__ __attribute__((aligned(16))) unsigned char lds[];
    Frame F;
    F.lds = (LAS unsigned char*)lds;
    F.MISC = (volatile LAS unsigned*)(F.lds + MISC_OFF);
    F.tid = threadIdx.x; F.lane = F.tid & 63; F.wave = __builtin_amdgcn_readfirstlane(F.tid >> 6);
    F.G = gridDim.x; { const int bx = blockIdx.x; F.vcu = (F.G % 8 == 0) ? (bx % 8) * (F.G / 8) + bx / 8 : bx; }
    F.gw = F.vcu * NWAVES + F.wave; F.NGW = F.G * NWAVES;
    unsigned char* ws = args.ws;
    F.ctl = (gu32*)(ws + WS_CTL);
    for (int u = F.tid; u < (LDS_BYTES - LDSCTL_OFF) / 4; u += NWAVES * 64) ((LAS unsigned*)(F.lds + LDSCTL_OFF))[u] = 0u;
    __syncthreads();
    XcdBarrier bar = xcd_barrier_post((unsigned*)(F.ctl + CW_BAR), F.MISC + 8);

    const float* x_in = args.in[0];
    const float* w_gate = args.in[1]; const float* w_up = args.in[2]; const float* w_down = args.in[3];
    const float* ln_g = args.in[4]; const float* ln_b = args.in[5];
    bf16* X = (bf16*)(ws + WS_X); bf16* Y = (bf16*)(ws + WS_YB); bf16* H = (bf16*)(ws + WS_HP);
    bf16* P = (bf16*)(ws + WS_HP); bf16* O = (bf16*)(ws + WS_O);
    bf16* OA = (bf16*)(ws + WS_Y); unsigned* MASKB = (unsigned*)(ws + WS_Y + 96 * MiB); float* LSE = (float*)(ws + WS_LSE);
    bf16* QF = (bf16*)(ws + WS_Y); bf16* KD = (bf16*)(ws + WS_Y + 48 * MiB); bf16* VD = (bf16*)(ws + WS_Y + 96 * MiB);
    float* SQQ = (float*)(ws + (size_t)CW_SQQ * 4); float* SQKV = (float*)(ws + (size_t)CW_SQKV * 4);
    unsigned char* WFA = ws + WS_WFA; unsigned char* WFB = ws + WS_WFB;
    constexpr size_t GSZ = (size_t)DM * DFF;

    convert_ffn(F, w_gate + 0 * GSZ, w_up + 0 * GSZ, w_down + 0 * GSZ, WFA);
    convert_ffn(F, w_gate + 1 * GSZ, w_up + 1 * GSZ, w_down + 1 * GSZ, WFB);
    convert_weight<0>(F, args.in[6], DM, EIN, EINP, (bf16*)(ws + WS_WEIN), nullptr);
    convert_weight<0>(F, args.in[7], DM, DM, DM, (bf16*)(ws + WS_WEOUT), nullptr);
    convert_weight<0>(F, args.in[8], DM, OIN, OINP, (bf16*)(ws + WS_WOIN), nullptr);
    convert_weight<0>(F, args.in[9], DM, DM, DM, (bf16*)(ws + WS_WOOUT), nullptr);
    convert_weight<0>(F, args.in[14], 768, 1536, 1536, (bf16*)(ws + WS_WUQ), args.in[12]);
    convert_weight<0>(F, args.in[15], 512, 2048, 2048, (bf16*)(ws + WS_WUKV), args.in[13]);
    convert_x(F, x_in, X);
    GRID_BAR();
    FFN_PHASES(WFA)
    ln_phase<false>(F, Y, ln_g + 0 * DM, ln_b + 0 * DM, X, nullptr);
    convert_ffn(F, w_gate + 2 * GSZ, w_up + 2 * GSZ, w_down + 2 * GSZ, WFA);
    GRID_BAR();
    {
        pg8::Gemm g{X, (const bf16*)(ws + WS_WEIN), S, EINP, DM, DM}; pg8::StaticOrder So; So.init(S, EINP, F.G, (int)blockIdx.x);
        pg8::EpiBf16 E{P, EINP, nullptr, 0, 0, nullptr, 0, 0};
        pg8::gemm_phase<pg8::EpiBf16, pg8::StaticOrder, true, true>(F.lds + RING_OFF, g, So, E); }
    GRID_BAR();
    mixer_a_phase(F, P, OA, LSE);
    __syncthreads();
    indexer_phase(F, P, MASKB, (unsigned*)(F.ctl + CW_NEAR));
    b_norm_bounds(F, P, (unsigned*)(F.ctl + CW_NRMB));
    GRID_BAR();
    merge_a(F, OA, LSE, O);
    mixer_b_phase(F, P, MASKB, O, (const unsigned*)(F.ctl + CW_NRMB), (const unsigned*)(F.ctl + CW_NEAR), F.ctl + CW_QB);
    GRID_BAR();
    {
        pg8::Gemm g{O, (const bf16*)(ws + WS_WEOUT), S, DM, DM, DM}; pg8::StaticOrder So; So.init(S, DM, F.G, (int)blockIdx.x);
        pg8::EpiResid E{X, Y, DM, ALPHA, 1.0f};
        pg8::gemm_phase<pg8::EpiResid, pg8::StaticOrder, true, true>(F.lds + RING_OFF, g, So, E); }
    GRID_BAR();
    ln_phase<false>(F, Y, ln_g + 1 * DM, ln_b + 1 * DM, X, nullptr);
    GRID_BAR();
    FFN_PHASES(WFB)
    ln_phase<false>(F, Y, ln_g + 2 * DM, ln_b + 2 * DM, X, nullptr);
    convert_ffn(F, w_gate + 3 * GSZ, w_up + 3 * GSZ, w_down + 3 * GSZ, WFB);
    GRID_BAR();
    FFN_PHASES(WFA)
    ln_phase<false>(F, Y, ln_g + 3 * DM, ln_b + 3 * DM, X, nullptr);
    GRID_BAR();
    {
        pg8::Gemm g{X, (const bf16*)(ws + WS_WOIN), S, OINP, DM, DM}; pg8::StaticOrder So; So.init(S, OINP, F.G, (int)blockIdx.x);
        pg8::EpiBf16 E{P, OINP, SQQ, 12, 15, SQKV, 15, 17};
        pg8::gemm_phase<pg8::EpiBf16, pg8::StaticOrder, true, true>(F.lds + RING_OFF, g, So, E); }
    GRID_BAR();
    {
        pg8::Gemm g{P + 3072, (const bf16*)(ws + WS_WUQ), S, 1536, 768, OINP}; pg8::StaticOrder So; So.init(S, 1536, F.G, (int)blockIdx.x);
        pg8::EpiScaleRow E{QF, 1536, SQQ, 1.0f / 768.0f, RMS_EPS};
        pg8::gemm_phase<pg8::EpiScaleRow, pg8::StaticOrder, true, true>(F.lds + RING_OFF, g, So, E); }
    {   pg8::Gemm g{P + 3840, (const bf16*)(ws + WS_WUKV), S, 2048, 512, OINP}; pg8::StaticOrder So; So.init(S, 2048, F.G, (int)blockIdx.x);
        pg8::EpiUkv E{KD, VD, SQKV, 1.0f / 512.0f, RMS_EPS};
        pg8::gemm_phase<pg8::EpiUkv, pg8::StaticOrder, true, true>(F.lds + RING_OFF, g, So, E); }
    kpe_fill(F, P, KD);
    c_norm_bounds(F, P, (unsigned*)(F.ctl + CW_NRM));
    GRID_BAR();
    mixer_cd_phase(F, P, args.in[10], args.in[11], 0.35550906759096874f, (float*)(ws + WS_HP + 160 * MiB), (const unsigned*)(F.ctl + CW_NRM), QF, KD, VD, O, F.ctl + CW_QCD);
    GRID_BAR();
    {
        pg8::Gemm g{O, (const bf16*)(ws + WS_WOOUT), S, DM, DM, DM}; pg8::StaticOrder So; So.init(S, DM, F.G, (int)blockIdx.x);
        pg8::EpiResid E{X, Y, DM, ALPHA, 1.0f};
        pg8::gemm_phase<pg8::EpiResid, pg8::StaticOrder, true, true>(F.lds + RING_OFF, g, So, E); }
    GRID_BAR();
    ln_phase<false>(F, Y, ln_g + 4 * DM, ln_b + 4 * DM, X, nullptr);
    GRID_BAR();
    FFN_PHASES(WFB)
    ln_phase<true>(F, Y, ln_g + 5 * DM, ln_b + 5 * DM, nullptr, args.out);
}

extern "C" void kernel_launch(void* const* d_in, const int* in_sizes, int n_in, void* d_out, int out_size, void* d_ws, size_t ws_size, hipStream_t stream) {
    static int grid = 0;
    if (grid == 0) {
        if (n_in != 16 || in_sizes[0] != S * DM || out_size != S * DM || ws_size < WS_END) { fprintf(stderr, "kernel_launch: unexpected shapes (n_in %d, in0 %d, out %d, ws %zu < %zu)\n", n_in, n_in > 0 ? in_sizes[0] : -1, out_size, ws_size, (size_t)WS_END); grid = -1; return; }
        int dev = 0, cus = 0, per_cu = 0;
        if (hipGetDevice(&dev) != hipSuccess || hipDeviceGetAttribute(&cus, hipDeviceAttributeMultiprocessorCount, dev) != hipSuccess) { grid = -1; return; }
        if (hipFuncSetAttribute((const void*)fwd_kernel, hipFuncAttributeMaxDynamicSharedMemorySize, LDS_BYTES) != hipSuccess) { fprintf(stderr, "kernel_launch: hipFuncSetAttribute failed\n"); grid = -1; return; }
        if (hipOccupancyMaxActiveBlocksPerMultiprocessor(&per_cu, (const void*)fwd_kernel, NWAVES * 64, LDS_BYTES) != hipSuccess || per_cu < 1)
            fprintf(stderr, "kernel_launch: occupancy query reports %d workgroups per CU\n", per_cu);
        (void)hipGetLastError();
        grid = cus;
    }
    if (grid < 0) return;
    if (hipMemsetAsync((char*)d_ws + WS_CTL, 0, CTL_ZERO_BYTES, stream) != hipSuccess) return;
    Args a{};
    for (int i = 0; i < 16; ++i) a.in[i] = (const float*)d_in[i];
    a.out = (float*)d_out; a.ws = (unsigned char*)d_ws;
    hipLaunchKernelGGL(fwd_kernel, dim3(grid), dim3(NWAVES * 64), LDS_BYTES, stream, a);
}
```
